# Optimizing an MI355X kernel written in HIP

```python
import jax, jax.numpy as jnp
from jax import lax
import numpy as np

D_MODEL = 2048
BATCH = 1
SEQ = 16384
DEPTH = 1

HEAD_DIM = 64
ATTN_GROUPS = ((128, 1), (512, 4), (2048, 16))
N_ATTN_GROUPS = len(ATTN_GROUPS)
ATTN_HEADS_PER_GROUP = 8
ATTN_HEADS = N_ATTN_GROUPS * ATTN_HEADS_PER_GROUP
ATTN_WIDTH = ATTN_HEADS * HEAD_DIM
ATTN_OUT_WIDTH = ATTN_HEADS_PER_GROUP * HEAD_DIM
ALIBI_MAX_BIAS = 8.0
RWKV_HEADS = 16
RWKV_WIDTH = RWKV_HEADS * HEAD_DIM
DECAY_LORA = 64
ICLR_LORA = 64
GATE_LORA = 160
N_DIRS = 2
N_BRANCHES = 2
RWKV_IN_WIDTH = 3 * RWKV_WIDTH + DECAY_LORA + ICLR_LORA + GATE_LORA
IN_WIDTH = 3 * ATTN_WIDTH + RWKV_IN_WIDTH + N_BRANCHES * D_MODEL
FFN_HIDDEN = -(-8 * D_MODEL // (3 * 256)) * 256
RMS_EPS = 1e-6
GN_EPS = 64e-5
L2_EPS = 1e-12
NEG_INF = -1e30

kernel_name = 'hybrid_dilated_attn_rwkv7_swiglu'


def rms_norm(t, w, eps=RMS_EPS):
    tf = t.astype(jnp.float32)
    return tf * lax.rsqrt(jnp.mean(tf * tf, axis=-1, keepdims=True) + eps) * w.astype(jnp.float32)


def dilated_band_attention(q, k, v, dilation, half, slopes):
    b, s, h, e = q.shape
    n = s // dilation
    nb = -(-n // half)
    n_pad = nb * half

    def to_residue(t):
        return t.reshape(b, n, dilation, h, e).transpose(0, 2, 3, 1, 4)

    def band(t):
        tp = jnp.pad(t, ((0, 0), (0, 0), (0, 0), (half, n_pad - n + half), (0, 0)))
        tp = tp.reshape(b, dilation, h, nb + 2, half, e)
        return jnp.concatenate([tp[:, :, :, :-2], tp[:, :, :, 1:-1], tp[:, :, :, 2:]], axis=-2)

    qb = jnp.pad(to_residue(q), ((0, 0), (0, 0), (0, 0), (0, n_pad - n), (0, 0)))
    qb = qb.reshape(b, dilation, h, nb, half, e)
    kb = band(to_residue(k))
    vb = band(to_residue(v))

    q_idx = jnp.arange(nb)[:, None] * half + jnp.arange(half)[None, :]
    k_idx = jnp.arange(nb)[:, None] * half - half + jnp.arange(3 * half)[None, :]
    rel = k_idx[:, None, :] - q_idx[:, :, None]
    valid = (jnp.abs(rel) <= half) & (k_idx[:, None, :] >= 0) & (k_idx[:, None, :] < n)
    dist = (jnp.abs(rel) * dilation).astype(jnp.float32)

    scores = jnp.einsum('bdhnqe,bdhnke->bdhnqk', qb, kb)
    scores = scores - slopes[None, None, :, None, None, None] * dist
    scores = jnp.where(valid, scores, NEG_INF)
    m = jnp.max(scores, axis=-1, keepdims=True)
    p = jnp.exp(scores - m)
    den = jnp.sum(p, axis=-1, keepdims=True)
    out = jnp.einsum('bdhnqk,bdhnke->bdhnqe', p, vb) / den
    lse = (m + jnp.log(den))[..., 0]
    out = out.reshape(b, dilation, h, n_pad, e)[:, :, :, :n].transpose(0, 3, 1, 2, 4).reshape(b, s, h, e)
    lse = lse.reshape(b, dilation, h, n_pad)[:, :, :, :n].transpose(0, 3, 1, 2).reshape(b, s, h)
    return out, lse


def token_shift_centred(z, mu_prev, mu_next):
    z_prev = jnp.pad(z, ((0, 0), (1, 0), (0, 0)))[:, :-1]
    z_next = jnp.pad(z, ((0, 0), (0, 1), (0, 0)))[:, 1:]
    return z + mu_prev * (z_prev - z) + mu_next * (z_next - z)


def dir_stack(fwd, bwd):
    return jnp.stack([fwd, jnp.flip(bwd, axis=1)])


def rwkv7_bidir_scan(r, w, k, v, kk, a):
    def step(state, inp):
        r_t, w_t, k_t, v_t, kk_t, a_t = inp
        sa = jnp.einsum('zbhvk,zbhk->zbhv', state, -kk_t)
        state = (state * w_t[..., None, :] + sa[..., :, None] * (kk_t * a_t)[..., None, :]
                 + v_t[..., :, None] * k_t[..., None, :])
        y = jnp.einsum('zbhvk,zbhk->zbhv', state, r_t)
        return state, y
    xs = tuple(jnp.moveaxis(t, 2, 0) for t in (r, w, k, v, kk, a))
    init = jnp.zeros(r.shape[:2] + (RWKV_HEADS, HEAD_DIM, HEAD_DIM), jnp.float32)
    _, y = lax.scan(step, init, xs)
    return jnp.moveaxis(y, 0, 2)


def to_heads(t):
    return t.reshape(t.shape[:-1] + (RWKV_HEADS, HEAD_DIM))


def setup_inputs(seed: int = 0) -> dict:
    key = jax.random.key(seed)
    ks = jax.random.split(key, 26)
    f32 = jnp.float32

    def nrm(k, shape, scale):
        return jax.random.normal(k, shape, f32) * scale

    L, C = DEPTH, RWKV_WIDTH
    ramp = jnp.linspace(-6.0, -1.0, C, dtype=f32)
    return {
        'x': nrm(ks[0], (BATCH, SEQ, D_MODEL), 1.0),
        'norm1_w': 1.0 + nrm(ks[1], (L, D_MODEL), 0.05),
        'w_in': nrm(ks[2], (L, D_MODEL, IN_WIDTH), D_MODEL ** -0.5),
        'b_gate': nrm(ks[3], (L, N_BRANCHES, D_MODEL), 0.1),
        'q_norm_w': 1.0 + nrm(ks[4], (L, HEAD_DIM), 0.05),
        'k_norm_w': 1.0 + nrm(ks[5], (L, HEAD_DIM), 0.05),
        'shift_mu_prev': jax.random.uniform(ks[6], (L, RWKV_IN_WIDTH), f32, 0.0, 0.5),
        'shift_mu_next': jax.random.uniform(ks[7], (L, RWKV_IN_WIDTH), f32, 0.0, 0.5),
        'decay_w0': ramp + nrm(ks[8], (L, N_DIRS, C), 0.1),
        'decay_w2': nrm(ks[9], (L, N_DIRS, DECAY_LORA, C), 0.5 * DECAY_LORA ** -0.5),
        'iclr_a0': nrm(ks[10], (L, N_DIRS, C), 0.1),
        'iclr_a2': nrm(ks[11], (L, N_DIRS, ICLR_LORA, C), 0.5 * ICLR_LORA ** -0.5),
        'gate_g2': nrm(ks[12], (L, GATE_LORA, C), GATE_LORA ** -0.5),
        'k_k': 0.85 + nrm(ks[13], (L, C), 0.05),
        'k_a': 1.0 + nrm(ks[14], (L, C), 0.05),
        'r_k': nrm(ks[15], (L, RWKV_HEADS, HEAD_DIM), 0.1),
        'ln_x_w': 1.0 + nrm(ks[16], (L, C), 0.05),
        'ln_x_b': nrm(ks[17], (L, C), 0.02),
        'w_branch_attn': nrm(ks[18], (L, ATTN_OUT_WIDTH, D_MODEL), ATTN_OUT_WIDTH ** -0.5),
        'w_branch_rwkv': nrm(ks[19], (L, C, D_MODEL), C ** -0.5),
        'w_out': nrm(ks[20], (L, D_MODEL, D_MODEL), D_MODEL ** -0.5),
        'norm2_w': 1.0 + nrm(ks[21], (L, D_MODEL), 0.05),
        'w_ffn_gate': nrm(ks[22], (L, D_MODEL, FFN_HIDDEN), D_MODEL ** -0.5),
        'w_ffn_up': nrm(ks[23], (L, D_MODEL, FFN_HIDDEN), D_MODEL ** -0.5),
        'w_ffn_down': nrm(ks[24], (L, FFN_HIDDEN, D_MODEL), FFN_HIDDEN ** -0.5),
    }


def reference(x, norm1_w, w_in, b_gate, q_norm_w, k_norm_w, shift_mu_prev, shift_mu_next,
              decay_w0, decay_w2, iclr_a0, iclr_a2, gate_g2, k_k, k_a, r_k, ln_x_w, ln_x_b,
              w_branch_attn, w_branch_rwkv, w_out, norm2_w, w_ffn_gate, w_ffn_up, w_ffn_down):
    f32 = jnp.float32
    b, s, _ = x.shape
    slopes = jnp.exp2(-ALIBI_MAX_BIAS * jnp.arange(1, ATTN_HEADS + 1, dtype=f32) / ATTN_HEADS)
    slopes = slopes.reshape(N_ATTN_GROUPS, ATTN_HEADS_PER_GROUP)
    cuts = np.cumsum([3 * ATTN_WIDTH, RWKV_IN_WIDTH]).tolist()
    rwkv_cuts = np.cumsum([RWKV_WIDTH, RWKV_WIDTH, RWKV_WIDTH, DECAY_LORA, ICLR_LORA]).tolist()
    for layer in range(DEPTH):
        h_in = rms_norm(x, norm1_w[layer]).astype(x.dtype)
        z = h_in @ w_in[layer]
        z_attn, z_rwkv, z_gate = jnp.split(z, cuts, axis=-1)

        qkv = z_attn.astype(f32).reshape(b, s, 3, N_ATTN_GROUPS, ATTN_HEADS_PER_GROUP, HEAD_DIM)
        q = rms_norm(qkv[:, :, 0], q_norm_w[layer]) * HEAD_DIM ** -0.5
        kq = rms_norm(qkv[:, :, 1], k_norm_w[layer])
        va = qkv[:, :, 2]
        outs, lses = [], []
        for g, (window, dilation) in enumerate(ATTN_GROUPS):
            o_g, lse_g = dilated_band_attention(q[:, :, g], kq[:, :, g], va[:, :, g],
                                                dilation, window // (2 * dilation), slopes[g])
            outs.append(o_g)
            lses.append(lse_g)
        alpha = jax.nn.softmax(jnp.stack(lses), axis=0)
        o_attn = jnp.sum(alpha[..., None] * jnp.stack(outs), axis=0).reshape(b, s, ATTN_OUT_WIDTH)

        zr = token_shift_centred(z_rwkv.astype(f32), shift_mu_prev[layer], shift_mu_next[layer])
        r, k_raw, v_raw, w_lo, a_lo, g_lo = jnp.split(zr, rwkv_cuts, axis=-1)
        w_log = -jax.nn.softplus(-(decay_w0[layer][:, None, None, :]
                                   + jnp.einsum('bsr,zrc->zbsc', jnp.tanh(w_lo), decay_w2[layer]))) - 0.5
        decay = jnp.exp(-jnp.exp(w_log))
        iclr = jax.nn.sigmoid(iclr_a0[layer][:, None, None, :]
                              + jnp.einsum('bsr,zrc->zbsc', a_lo, iclr_a2[layer]))
        gate = jax.nn.sigmoid(g_lo) @ gate_g2[layer]
        kk = to_heads(k_raw * k_k[layer])
        kk = kk / jnp.maximum(jnp.sqrt(jnp.sum(kk * kk, axis=-1, keepdims=True)), L2_EPS)
        k_dir = to_heads(k_raw[None] * (1.0 + (iclr - 1.0) * k_a[layer]))
        r_h, v_h = to_heads(r), to_heads(v_raw)
        decay_h, iclr_h = to_heads(decay), to_heads(iclr)
        wkv = rwkv7_bidir_scan(dir_stack(r_h, r_h), dir_stack(decay_h[0], decay_h[1]),
                               dir_stack(k_dir[0], k_dir[1]), dir_stack(v_h, v_h),
                               dir_stack(kk, kk), dir_stack(iclr_h[0], iclr_h[1]))
        wkv = wkv[0] + jnp.flip(wkv[1], axis=1)
        mu = jnp.mean(wkv, axis=-1, keepdims=True)
        var = jnp.mean(jnp.square(wkv - mu), axis=-1, keepdims=True)
        gn = ((wkv - mu) * lax.rsqrt(var + GN_EPS)).reshape(b, s, RWKV_WIDTH) * ln_x_w[layer] + ln_x_b[layer]
        bonus = jnp.sum(jnp.sum(r_h[None] * k_dir * r_k[layer], axis=-1, keepdims=True) * v_h[None], axis=0)
        o_rwkv = (gn + bonus.reshape(b, s, RWKV_WIDTH)) * gate

        gates = jax.nn.sigmoid(z_gate.astype(f32).reshape(b, s, N_BRANCHES, D_MODEL) + b_gate[layer])
        branch_a = o_attn.astype(x.dtype) @ w_branch_attn[layer]
        branch_b = o_rwkv.astype(x.dtype) @ w_branch_rwkv[layer]
        merged = gates[:, :, 0] * branch_a + gates[:, :, 1] * branch_b
        x = x + merged.astype(x.dtype) @ w_out[layer]

        h2 = rms_norm(x, norm2_w[layer]).astype(x.dtype)
        hid = jax.nn.silu(h2 @ w_ffn_gate[layer]) * (h2 @ w_ffn_up[layer])
        x = x + hid @ w_ffn_down[layer]
    return x
```

```cpp
#include <hip/hip_runtime.h>
#include <hip/hip_cooperative_groups.h>
#include <cstdio>
#include <cstdint>
namespace cg = cooperative_groups;

#ifndef MK_COOP
#define MK_COOP 0
#endif

#define LAS __attribute__((address_space(3)))
typedef unsigned short bf16;
typedef short bf16x8 __attribute__((ext_vector_type(8)));
typedef float f32x4 __attribute__((ext_vector_type(4)));
typedef float f32x2 __attribute__((ext_vector_type(2)));
typedef unsigned u32x4 __attribute__((ext_vector_type(4)));
typedef unsigned u32x2 __attribute__((ext_vector_type(2)));

constexpr int S = 16384, D = 2048;
constexpr int HD = 64;
constexpr int NQKV = 4608, NZR = 3584, NZR_REAL = 3360, NGATE = 4096;
constexpr int N1A = NQKV + NZR;
constexpr int N1 = N1A + NGATE;
constexpr int IN_W = 12064;
constexpr int KL = 384, NL = 5120;
constexpr int FF = 5632;
constexpr int RW = 1024;
constexpr int NCHAIN = 32;
constexpr int CHL = 256, NCK = S / CHL;
constexpr int NWAVES = 8, NTHR = 512;
constexpr int LDS_BYTES = 147456;

constexpr size_t MiB = 1u << 20;
constexpr size_t WS_WIN = 0;
constexpr size_t WS_OATT = 0;
constexpr size_t WS_LORAA = 16 * MiB;
constexpr size_t WS_RK = 28 * MiB;
constexpr size_t WS_WLORA = 48 * MiB;
constexpr size_t WS_WBA = 52 * MiB;
constexpr size_t WS_WBR = 54 * MiB;
constexpr size_t WS_ZQKV = 58 * MiB;
constexpr size_t WS_ZR = 202 * MiB;
constexpr size_t WS_LW = 58 * MiB;
constexpr size_t WS_A = 122 * MiB;
constexpr size_t WS_GATE = 186 * MiB;
constexpr size_t WS_PU = 218 * MiB;
constexpr size_t WS_S0 = 282 * MiB;
constexpr size_t WS_R = 314 * MiB, WS_V = 346 * MiB, WS_NKK = 378 * MiB, WS_KRAW = 410 * MiB;
constexpr size_t WS_YL = 442 * MiB;
constexpr size_t WS_ORWKV = 58 * MiB;
constexpr size_t WS_ZG = 90 * MiB;
constexpr size_t WS_WOUT = 218 * MiB;
constexpr size_t WS_WGU = 226 * MiB;
constexpr size_t WS_WD = 270 * MiB;
constexpr size_t WS_MERGED = 292 * MiB;
constexpr size_t WS_H2 = 356 * MiB;
constexpr size_t WS_HID = 0;
constexpr size_t WS_END = 506 * MiB;
constexpr size_t DO_H1 = 0, DO_QT = 64 * MiB;

enum Phase { P_PREP0 = 0, P_G1A, P_HNORM, P_ATTPREP, P_GLORA, P_RK, P_SCAN1, P_SCAN2, P_FIN, P_G1B, P_GMA, P_GMB, P_GOUT, P_NORM2, P_FFN1, P_FFN2, P_COUNT };

struct Args { const float* in[25]; float* out; unsigned char* ws; int ph_lo, ph_hi; };

__device__ __forceinline__ float bf2f(bf16 h) { return __uint_as_float((unsigned)h << 16); }
__device__ __forceinline__ bf16 f2bf(float f) { unsigned u = __float_as_uint(f); return (bf16)((u + 0x7fffu + ((u >> 16) & 1u)) >> 16); }
__device__ __forceinline__ unsigned pk2(float lo, float hi) { return (unsigned)f2bf(lo) | ((unsigned)f2bf(hi) << 16); }
__device__ __forceinline__ float wave_sum(float v) {
#pragma unroll
    for (int o = 1; o < 64; o <<= 1) v += __shfl_xor(v, o);
    return v;
}
__device__ __forceinline__ float wave_max(float v) {
#pragma unroll
    for (int o = 1; o < 64; o <<= 1) v = fmaxf(v, __shfl_xor(v, o));
    return v;
}
__device__ __forceinline__ float sigmoidf_(float x) { return 1.0f / (1.0f + __expf(-x)); }
__host__ __device__ __forceinline__ int tperm(int j) { const int lc = j & 255; return (j & ~255) + 64 * ((lc >> 5) & 3) + 32 * (lc >> 7) + (lc & 31); }

struct Ctx {
    const float* in[25]; float* out; unsigned char* ws; unsigned char* dout;
    LAS unsigned char* lds;
    int tid, lane, wave, bid, nb, gw, ngw;
};

__device__ __forceinline__ void tr_item(const float* src, int ld, int nk, bf16* dst, int K, LAS float* scr, int lane) {
#pragma unroll 8
    for (int i = 0; i < 32; ++i) { const int kk = 2 * i + (lane >> 5); float v = 0.f; if (src && kk < nk) v = src[(size_t)kk * ld + (lane & 31)]; scr[kk * 33 + (lane & 31)] = v; }
    asm volatile("s_waitcnt lgkmcnt(0)" ::: "memory");
    const int c = lane & 7;
#pragma unroll
    for (int j = 0; j < 4; ++j) { const int n = (lane >> 3) + 8 * j; const LAS float* s = scr + (8 * c) * 33 + n;
        u32x4 o; o.x = pk2(s[0 * 33], s[1 * 33]); o.y = pk2(s[2 * 33], s[3 * 33]); o.z = pk2(s[4 * 33], s[5 * 33]); o.w = pk2(s[6 * 33], s[7 * 33]);
        *(u32x4*)(dst + (size_t)n * K + 8 * c) = o; }
    asm volatile("s_waitcnt lgkmcnt(0)" ::: "memory");
}
__device__ __forceinline__ void conv_natural(Ctx& C, const float* W, int K, int N, bf16* Wt, LAS float* scr) {
    const int nkb = K / 64, nitems = (N / 32) * nkb;
    for (int it = C.gw; it < nitems; it += C.ngw) { const int j32 = it / nkb, kb = it % nkb;
        tr_item(W + (size_t)(kb * 64) * N + j32 * 32, N, 64, Wt + (size_t)(j32 * 32) * K + kb * 64, K, scr, C.lane); }
}
__device__ __forceinline__ void conv_win(Ctx& C, LAS float* scr) {
    const float* W = C.in[2]; bf16* Wt = (bf16*)(C.ws + WS_WIN);
    const int nkb = D / 64, nitems = (N1 / 32) * nkb;
    for (int it = C.gw; it < nitems; it += C.ngw) { const int j32 = it / nkb, kb = it % nkb; const int j = j32 * 32, ac = tperm(j);
        int wc;
        if (j < NQKV) wc = ac; else if (j < N1A) { const int zc = ac - NQKV; wc = zc < NZR_REAL ? NQKV + zc : -1; } else wc = NQKV + NZR_REAL + (ac - N1A);
        tr_item(wc >= 0 ? W + (size_t)(kb * 64) * IN_W + wc : nullptr, IN_W, 64, Wt + (size_t)j * D + kb * 64, D, scr, C.lane); }
}
__device__ __forceinline__ void conv_wlora(Ctx& C, LAS float* scr) {
    bf16* Wt = (bf16*)(C.ws + WS_WLORA);
    const int nkb = KL / 64, nitems = (NL / 32) * nkb;
    for (int it = C.gw; it < nitems; it += C.ngw) { const int j32 = it / nkb, kb = it % nkb; const int j = j32 * 32, ac = tperm(j);
        const float* src = nullptr; int nk = 64;
        if (ac < 2048) { if (kb == 0) src = C.in[9] + (size_t)(ac >> 10) * 64 * RW + (ac & 1023); }
        else if (ac < 4096) { if (kb == 1) src = C.in[11] + (size_t)((ac - 2048) >> 10) * 64 * RW + (ac & 1023); }
        else { const int c = ac - 4096; if (kb == 2 || kb == 3) src = C.in[12] + (size_t)((kb - 2) * 64) * RW + c; else if (kb == 4) { src = C.in[12] + (size_t)128 * RW + c; nk = 32; } }
        tr_item(src, RW, nk, Wt + (size_t)j * KL + kb * 64, KL, scr, C.lane); }
}
__device__ __forceinline__ void conv_wgu(Ctx& C, LAS float* scr) {
    bf16* Wt = (bf16*)(C.ws + WS_WGU);
    const int nkb = D / 64, nitems = (2 * FF / 32) * nkb;
    for (int it = C.gw; it < nitems; it += C.ngw) { const int j32 = it / nkb, kb = it % nkb; const int j = j32 * 32, p = j >> 8, lc = j & 255;
        const float* W = (lc >= 128) ? C.in[23] : C.in[22]; const int hc = 128 * p + (lc & 127);
        tr_item(W + (size_t)(kb * 64) * FF + hc, FF, 64, Wt + (size_t)j * D + kb * 64, D, scr, C.lane); }
}

__device__ __forceinline__ void rms_row(const float* xrow, const float* w, bf16* orow, int lane) {
    f32x4 v[8]; float ss = 0.f;
#pragma unroll
    for (int j = 0; j < 8; ++j) { v[j] = ((const f32x4*)xrow)[lane + 64 * j]; ss += (v[j].x * v[j].x + v[j].y * v[j].y) + (v[j].z * v[j].z + v[j].w * v[j].w); }
    ss = wave_sum(ss); const float rs = 1.0f / sqrtf(ss * (1.0f / D) + 1e-6f);
#pragma unroll
    for (int j = 0; j < 8; ++j) { const f32x4 w4 = ((const f32x4*)w)[lane + 64 * j]; u32x2 o; o.x = pk2(v[j].x * rs * w4.x, v[j].y * rs * w4.y); o.y = pk2(v[j].z * rs * w4.z, v[j].w * rs * w4.w);
        ((u32x2*)orow)[lane + 64 * j] = o; }
}

template <class Epi>
__device__ __forceinline__ void gemm_simple(Ctx& C, const bf16* A, const bf16* Bt, int N, int K, const Epi& epi) {
    const int lane = C.lane, fr = lane & 15, fq = lane >> 4;
    const int ntn = N / 32; const long ntiles = (long)ntn * (S / 32);
    for (long it = C.gw; it < ntiles; it += C.ngw) {
        const int m0 = (int)(it / ntn) * 32, n0 = (int)(it % ntn) * 32;
        const bf16* ap = A + (size_t)(m0 + fr) * K + 8 * fq; const bf16* bp = Bt + (size_t)(n0 + fr) * K + 8 * fq;
        f32x4 acc[2][2];
#pragma unroll
        for (int i = 0; i < 2; ++i)
#pragma unroll
            for (int j = 0; j < 2; ++j) acc[i][j] = (f32x4){0.f, 0.f, 0.f, 0.f};
#pragma unroll 4
        for (int k = 0; k < K; k += 32) {
            const bf16x8 a0 = *(const bf16x8*)(ap + k), a1 = *(const bf16x8*)(ap + (size_t)16 * K + k);
            const bf16x8 b0 = *(const bf16x8*)(bp + k), b1 = *(const bf16x8*)(bp + (size_t)16 * K + k);
            acc[0][0] = __builtin_amdgcn_mfma_f32_16x16x32_bf16(b0, a0, acc[0][0], 0, 0, 0);
            acc[0][1] = __builtin_amdgcn_mfma_f32_16x16x32_bf16(b1, a0, acc[0][1], 0, 0, 0);
            acc[1][0] = __builtin_amdgcn_mfma_f32_16x16x32_bf16(b0, a1, acc[1][0], 0, 0, 0);
            acc[1][1] = __builtin_amdgcn_mfma_f32_16x16x32_bf16(b1, a1, acc[1][1], 0, 0, 0);
        }
#pragma unroll
        for (int i = 0; i < 2; ++i)
#pragma unroll
            for (int j = 0; j < 2; ++j) epi(m0 + 16 * i + fr, n0 + 16 * j + 4 * fq, acc[i][j]);
    }
}
__device__ __forceinline__ void gemm_simple_ffn1(Ctx& C, const bf16* A, const bf16* Bt, bf16* hid) {
    const int lane = C.lane, fr = lane & 15, fq = lane >> 4, K = D;
    const int ntn = FF / 32; const long ntiles = (long)ntn * (S / 32);
    for (long it = C.gw; it < ntiles; it += C.ngw) {
        const int m0 = (int)(it / ntn) * 32, h0 = (int)(it % ntn) * 32, n0 = 256 * (h0 >> 7) + (h0 & 127);
        const bf16* ap = A + (size_t)(m0 + fr) * K + 8 * fq; const bf16* bp = Bt + (size_t)(n0 + fr) * K + 8 * fq;
        f32x4 ag[2][2], au[2][2];
#pragma unroll
        for (int i = 0; i < 2; ++i)
#pragma unroll
            for (int j = 0; j < 2; ++j) { ag[i][j] = (f32x4){0.f, 0.f, 0.f, 0.f}; au[i][j] = (f32x4){0.f, 0.f, 0.f, 0.f}; }
#pragma unroll 2
        for (int k = 0; k < K; k += 32) {
            const bf16x8 a0 = *(const bf16x8*)(ap + k), a1 = *(const bf16x8*)(ap + (size_t)16 * K + k);
            const bf16x8 g0 = *(const bf16x8*)(bp + k), g1 = *(const bf16x8*)(bp + (size_t)16 * K + k);
            const bf16x8 u0 = *(const bf16x8*)(bp + (size_t)128 * K + k), u1 = *(const bf16x8*)(bp + (size_t)144 * K + k);
            ag[0][0] = __builtin_amdgcn_mfma_f32_16x16x32_bf16(g0, a0, ag[0][0], 0, 0, 0); ag[0][1] = __builtin_amdgcn_mfma_f32_16x16x32_bf16(g1, a0, ag[0][1], 0, 0, 0);
            ag[1][0] = __builtin_amdgcn_mfma_f32_16x16x32_bf16(g0, a1, ag[1][0], 0, 0, 0); ag[1][1] = __builtin_amdgcn_mfma_f32_16x16x32_bf16(g1, a1, ag[1][1], 0, 0, 0);
            au[0][0] = __builtin_amdgcn_mfma_f32_16x16x32_bf16(u0, a0, au[0][0], 0, 0, 0); au[0][1] = __builtin_amdgcn_mfma_f32_16x16x32_bf16(u1, a0, au[0][1], 0, 0, 0);
            au[1][0] = __builtin_amdgcn_mfma_f32_16x16x32_bf16(u0, a1, au[1][0], 0, 0, 0); au[1][1] = __builtin_amdgcn_mfma_f32_16x16x32_bf16(u1, a1, au[1][1], 0, 0, 0);
        }
#pragma unroll
        for (int i = 0; i < 2; ++i)
#pragma unroll
            for (int j = 0; j < 2; ++j) { const int row = m0 + 16 * i + fr, hc = h0 + 16 * j + 4 * fq; const f32x4 g = ag[i][j], u = au[i][j]; float o[4];
#pragma unroll
                for (int e = 0; e < 4; ++e) o[e] = g[e] * sigmoidf_(g[e]) * u[e];
                u32x2 w; w.x = pk2(o[0], o[1]); w.y = pk2(o[2], o[3]); *(u32x2*)(hid + (size_t)row * FF + hc) = w; }
    }
}

__device__ __forceinline__ void st4bf(bf16* p, f32x4 v) { u32x2 w; w.x = pk2(v[0], v[1]); w.y = pk2(v[2], v[3]); *(u32x2*)p = w; }
struct EpiG1A { bf16* zqkv; bf16* zr;
    __device__ __forceinline__ void operator()(int row, int j0, f32x4 v) const { const int ac = tperm(j0);
        if (ac < NQKV) st4bf(zqkv + (size_t)row * NQKV + ac, v); else st4bf(zr + (size_t)row * NZR + (ac - NQKV), v); } };
struct EpiLora { bf16* lw; bf16* a; bf16* gate; const float* w0; const float* a0;
    __device__ __forceinline__ void operator()(int row, int j0, f32x4 v) const { const int ac = tperm(j0);
        if (ac < 2048) { const int z = ac >> 10, c = ac & 1023; f32x4 o;
#pragma unroll
            for (int e = 0; e < 4; ++e) { const float x = -(w0[z * RW + c + e] + v[e]); const float sp = fmaxf(x, 0.f) + log1pf(__expf(-fabsf(x))); o[e] = -__expf(-sp - 0.5f); }
            st4bf(lw + ((size_t)z * S + row) * RW + c, o); }
        else if (ac < 4096) { const int z = (ac - 2048) >> 10, c = ac & 1023; f32x4 o;
#pragma unroll
            for (int e = 0; e < 4; ++e) o[e] = sigmoidf_(a0[z * RW + c + e] + v[e]);
            st4bf(a + ((size_t)z * S + row) * RW + c, o); }
        else st4bf(gate + (size_t)row * RW + (ac - 4096), v); } };
struct EpiG1B { bf16* zg; const float* bg;
    __device__ __forceinline__ void operator()(int row, int j0, f32x4 v) const { const int ac = tperm(j0); f32x4 o;
#pragma unroll
        for (int e = 0; e < 4; ++e) o[e] = sigmoidf_(v[e] + bg[ac + e]);
        st4bf(zg + (size_t)row * NGATE + ac, o); } };
struct EpiMA { bf16* mg; const bf16* zg;
    __device__ __forceinline__ void operator()(int row, int j0, f32x4 v) const { const u32x2 g = *(const u32x2*)(zg + (size_t)row * NGATE + j0); f32x4 o;
        o[0] = v[0] * bf2f((bf16)(g.x & 0xffff)); o[1] = v[1] * bf2f((bf16)(g.x >> 16)); o[2] = v[2] * bf2f((bf16)(g.y & 0xffff)); o[3] = v[3] * bf2f((bf16)(g.y >> 16));
        st4bf(mg + (size_t)row * D + j0, o); } };
struct EpiMB { bf16* mg; const bf16* zg;
    __device__ __forceinline__ void operator()(int row, int j0, f32x4 v) const { const u32x2 g = *(const u32x2*)(zg + (size_t)row * NGATE + D + j0); const u32x2 t = *(const u32x2*)(mg + (size_t)row * D + j0); f32x4 o;
        o[0] = bf2f((bf16)(t.x & 0xffff)) + v[0] * bf2f((bf16)(g.x & 0xffff)); o[1] = bf2f((bf16)(t.x >> 16)) + v[1] * bf2f((bf16)(g.x >> 16));
        o[2] = bf2f((bf16)(t.y & 0xffff)) + v[2] * bf2f((bf16)(g.y & 0xffff)); o[3] = bf2f((bf16)(t.y >> 16)) + v[3] * bf2f((bf16)(g.y >> 16));
        st4bf(mg + (size_t)row * D + j0, o); } };
struct EpiRes { const float* base; float* out;
    __device__ __forceinline__ void operator()(int row, int j0, f32x4 v) const { const f32x4 b = *(const f32x4*)(base + (size_t)row * D + j0); *(f32x4*)(out + (size_t)row * D + j0) = b + v; } };

__device__ __forceinline__ void ph_prep0(Ctx& C) {
    LAS float* scr = (LAS float*)(C.lds + C.wave * 16384);
    conv_win(C, scr); conv_wlora(C, scr);
    conv_natural(C, C.in[18], 512, D, (bf16*)(C.ws + WS_WBA), scr);
    conv_natural(C, C.in[19], RW, D, (bf16*)(C.ws + WS_WBR), scr);
    bf16* h1 = (bf16*)(C.dout + DO_H1);
    for (int m = C.gw; m < S; m += C.ngw) rms_row(C.in[0] + (size_t)m * D, C.in[1], h1 + (size_t)m * D, C.lane);
}
__device__ __forceinline__ void ph_g1a(Ctx& C) {
    EpiG1A E{(bf16*)(C.ws + WS_ZQKV), (bf16*)(C.ws + WS_ZR)};
    gemm_simple(C, (const bf16*)(C.dout + DO_H1), (const bf16*)(C.ws + WS_WIN), N1A, D, E);
}
__device__ __forceinline__ void ph_hnorm(Ctx& C) {
    bf16* z = (bf16*)(C.ws + WS_ZQKV); const float* qw = C.in[4]; const float* kw = C.in[5];
    const long nitems = (long)S * 48;
    for (long it = C.gw; it < nitems; it += C.ngw) { const int t = (int)(it / 48), hh = (int)(it % 48), which = hh / 24;
        bf16* p = z + (size_t)t * NQKV + hh * 64 + C.lane; const float v = bf2f(*p); const float ss = wave_sum(v * v);
        const float w = which ? kw[C.lane] : qw[C.lane] * 0.125f; *p = f2bf(v * (1.0f / sqrtf(ss * (1.0f / 64.f) + 1e-6f)) * w); }
}
__device__ __forceinline__ void ph_attn(Ctx& C) {
    const bf16* z = (const bf16*)(C.ws + WS_ZQKV); bf16* oa = (bf16*)(C.ws + WS_OATT); const int lane = C.lane;
    const long nitems = (long)S * 8;
    for (long it = C.gw; it < nitems; it += C.ngw) { const int t = (int)(it >> 3), h = (int)(it & 7);
        float og[3], lse[3];
#pragma unroll
        for (int g = 0; g < 3; ++g) { const int d = g == 0 ? 1 : (g == 1 ? 4 : 16); const float slope = exp2f(-8.0f * (float)(g * 8 + h + 1) / 24.0f);
            const int col = g * 512 + h * 64;
            float q[64];
            { const bf16* qp = z + (size_t)t * NQKV + col;
#pragma unroll
              for (int e = 0; e < 64; e += 8) { const u32x4 w = *(const u32x4*)(qp + e);
                  q[e] = __uint_as_float(w.x << 16); q[e + 1] = __uint_as_float(w.x & 0xffff0000u); q[e + 2] = __uint_as_float(w.y << 16); q[e + 3] = __uint_as_float(w.y & 0xffff0000u);
                  q[e + 4] = __uint_as_float(w.z << 16); q[e + 5] = __uint_as_float(w.z & 0xffff0000u); q[e + 6] = __uint_as_float(w.w << 16); q[e + 7] = __uint_as_float(w.w & 0xffff0000u); } }
            float sc[3]; bool vd[3];
#pragma unroll
            for (int ps = 0; ps < 3; ++ps) { const int j = -64 + 64 * ps + lane; const long tk = (long)t + (long)d * j; vd[ps] = (j <= 64) && tk >= 0 && tk < S; float s = -1e30f;
                if (vd[ps]) { const bf16* kp = z + (size_t)tk * NQKV + 1536 + col; float dot = 0.f;
#pragma unroll
                    for (int e = 0; e < 64; e += 8) { const u32x4 w = *(const u32x4*)(kp + e);
                        dot += q[e] * __uint_as_float(w.x << 16) + q[e + 1] * __uint_as_float(w.x & 0xffff0000u) + q[e + 2] * __uint_as_float(w.y << 16) + q[e + 3] * __uint_as_float(w.y & 0xffff0000u)
                             + q[e + 4] * __uint_as_float(w.z << 16) + q[e + 5] * __uint_as_float(w.z & 0xffff0000u) + q[e + 6] * __uint_as_float(w.w << 16) + q[e + 7] * __uint_as_float(w.w & 0xffff0000u); }
                    s = dot - slope * (float)((j < 0 ? -j : j) * d); }
                sc[ps] = s; }
            const float m = wave_max(fmaxf(sc[0], fmaxf(sc[1], sc[2])));
            float p[3]; float ps_ = 0.f;
#pragma unroll
            for (int ps = 0; ps < 3; ++ps) { p[ps] = vd[ps] ? __expf(sc[ps] - m) : 0.f; ps_ += p[ps]; }
            const float den = wave_sum(ps_);
            float acc = 0.f;
#pragma unroll
            for (int ps = 0; ps < 3; ++ps)
                for (int l = 0; l < 64; ++l) { const float pj = __shfl(p[ps], l); if (pj != 0.f) { const long tk = (long)t + (long)d * (-64 + 64 * ps + l); acc += pj * bf2f(z[(size_t)tk * NQKV + 3072 + col + lane]); } }
            og[g] = acc / den; lse[g] = m + __logf(den); }
        const float mx = fmaxf(lse[0], fmaxf(lse[1], lse[2])); const float w0 = __expf(lse[0] - mx), w1 = __expf(lse[1] - mx), w2 = __expf(lse[2] - mx);
        oa[(size_t)t * 512 + h * 64 + lane] = f2bf((w0 * og[0] + w1 * og[1] + w2 * og[2]) / (w0 + w1 + w2)); }
}
__device__ __forceinline__ void ph_rprep(Ctx& C) {
    const bf16* zr = (const bf16*)(C.ws + WS_ZR); const float* mup = C.in[6]; const float* mun = C.in[7]; const float* k_k = C.in[13];
    bf16* r = (bf16*)(C.ws + WS_R); bf16* v = (bf16*)(C.ws + WS_V); bf16* nkk = (bf16*)(C.ws + WS_NKK); bf16* kraw = (bf16*)(C.ws + WS_KRAW); bf16* la = (bf16*)(C.ws + WS_LORAA);
    for (int t = C.bid; t < S; t += C.nb) {
        for (int c = C.tid; c < NZR; c += NTHR) {
            if (c < NZR_REAL) {
                const float z0 = bf2f(zr[(size_t)t * NZR + c]); const float zp = t > 0 ? bf2f(zr[(size_t)(t - 1) * NZR + c]) : 0.f; const float zn = t < S - 1 ? bf2f(zr[(size_t)(t + 1) * NZR + c]) : 0.f;
                const float x = z0 + mup[c] * (zp - z0) + mun[c] * (zn - z0);
                if (c < 1024) r[(size_t)t * RW + c] = f2bf(x);
                else if (c < 2048) { const int cc = c - 1024; kraw[(size_t)t * RW + cc] = f2bf(x); const float kv = x * k_k[cc]; const float ss = wave_sum(kv * kv); nkk[(size_t)t * RW + cc] = f2bf(-kv / fmaxf(sqrtf(ss), 1e-12f)); }
                else if (c < 3072) v[(size_t)t * RW + (c - 2048)] = f2bf(x);
                else if (c < 3136) la[(size_t)t * KL + (c - 3072)] = f2bf(tanhf(x));
                else if (c < 3200) la[(size_t)t * KL + (c - 3072)] = f2bf(x);
                else la[(size_t)t * KL + (c - 3072)] = f2bf(sigmoidf_(x));
            } else if (c - NZR_REAL + 288 < KL) la[(size_t)t * KL + (c - NZR_REAL + 288)] = 0;
        }
    }
}
__device__ __forceinline__ void ph_glora(Ctx& C) {
    EpiLora E{(bf16*)(C.ws + WS_LW), (bf16*)(C.ws + WS_A), (bf16*)(C.ws + WS_GATE), C.in[8], C.in[10]};
    gemm_simple(C, (const bf16*)(C.ws + WS_LORAA), (const bf16*)(C.ws + WS_WLORA), NL, KL, E);
}
__device__ __forceinline__ void ph_rk(Ctx& C) {
    const bf16* r = (const bf16*)(C.ws + WS_R); const bf16* kraw = (const bf16*)(C.ws + WS_KRAW); const bf16* a = (const bf16*)(C.ws + WS_A); float* rk = (float*)(C.ws + WS_RK);
    const float* k_a = C.in[14]; const float* r_k = C.in[15];
    const long nitems = (long)2 * S * 16;
    for (long it = C.gw; it < nitems; it += C.ngw) { const int h = (int)(it & 15), t = (int)((it >> 4) % S), z = (int)(it / ((long)S * 16)); const int c = h * 64 + C.lane;
        const float av = bf2f(a[((size_t)z * S + t) * RW + c]); const float kd = bf2f(kraw[(size_t)t * RW + c]) * (1.0f + (av - 1.0f) * k_a[c]);
        const float s = wave_sum(bf2f(r[(size_t)t * RW + c]) * kd * r_k[c]); if (C.lane == 0) rk[((size_t)z * S + t) * 16 + h] = s; }
}
__device__ __forceinline__ void ph_scan_seq(Ctx& C) {
    const bf16* r = (const bf16*)(C.ws + WS_R); const bf16* v = (const bf16*)(C.ws + WS_V); const bf16* nkk = (const bf16*)(C.ws + WS_NKK); const bf16* kraw = (const bf16*)(C.ws + WS_KRAW);
    const bf16* lw = (const bf16*)(C.ws + WS_LW); const bf16* a = (const bf16*)(C.ws + WS_A); bf16* yl = (bf16*)(C.ws + WS_YL); const float* k_a = C.in[14];
    { u32x4* q = (u32x4*)(C.dout + DO_QT); const size_t n = (size_t)64 * MiB / 16; for (size_t i = (size_t)C.bid * NTHR + C.tid; i < n; i += (size_t)C.nb * NTHR) q[i] = (u32x4){0u, 0u, 0u, 0u};
      u32x4* s0 = (u32x4*)(C.ws + WS_S0); const size_t n2 = (size_t)32 * MiB / 16; for (size_t i = (size_t)C.bid * NTHR + C.tid; i < n2; i += (size_t)C.nb * NTHR) s0[i] = (u32x4){0u, 0u, 0u, 0u}; }
    if (C.gw >= NCHAIN) return;
    const int z = C.gw >> 4, h = C.gw & 15, lane = C.lane, c = h * 64 + lane;
    LAS float* scr = (LAS float*)(C.lds + C.wave * 2048);
    float st[64];
#pragma unroll
    for (int k = 0; k < 64; ++k) st[k] = 0.f;
    const float ka = k_a[c];
    const bf16* lwz = lw + (size_t)z * S * RW; const bf16* az = a + (size_t)z * S * RW; bf16* ylz = yl + (size_t)z * S * RW;
    int t = z ? S - 1 : 0; const int dt = z ? -1 : 1;
    bf16 n_nkk = nkk[(size_t)t * RW + c], n_lw = lwz[(size_t)t * RW + c], n_a = az[(size_t)t * RW + c], n_k = kraw[(size_t)t * RW + c], n_r = r[(size_t)t * RW + c], n_v = v[(size_t)t * RW + c];
    for (int s = 0; s < S; ++s) {
        const float fnkk = bf2f(n_nkk), fw = __expf(bf2f(n_lw)), fa = bf2f(n_a), fk = bf2f(n_k), fr_ = bf2f(n_r), fv = bf2f(n_v);
        const int tc = t; t += dt;
        if (s + 1 < S) { n_nkk = nkk[(size_t)t * RW + c]; n_lw = lwz[(size_t)t * RW + c]; n_a = az[(size_t)t * RW + c]; n_k = kraw[(size_t)t * RW + c]; n_r = r[(size_t)t * RW + c]; n_v = v[(size_t)t * RW + c]; }
        scr[lane] = fnkk; scr[64 + lane] = fw; scr[128 + lane] = -fnkk * fa; scr[192 + lane] = fk * (1.0f + (fa - 1.0f) * ka); scr[256 + lane] = fr_;
        asm volatile("s_waitcnt lgkmcnt(0)" ::: "memory");
        float sa = 0.f;
#pragma unroll
        for (int k = 0; k < 64; k += 4) { const f32x4 x = *(const LAS f32x4*)(scr + k); sa += st[k] * x[0] + st[k + 1] * x[1] + st[k + 2] * x[2] + st[k + 3] * x[3]; }
        float y = 0.f;
#pragma unroll
        for (int k = 0; k < 64; k += 4) { const f32x4 w4 = *(const LAS f32x4*)(scr + 64 + k), b4 = *(const LAS f32x4*)(scr + 128 + k), k4 = *(const LAS f32x4*)(scr + 192 + k), r4 = *(const LAS f32x4*)(scr + 256 + k);
#pragma unroll
            for (int e = 0; e < 4; ++e) { st[k + e] = st[k + e] * w4[e] + sa * b4[e] + fv * k4[e]; y += st[k + e] * r4[e]; } }
        asm volatile("s_waitcnt lgkmcnt(0)" ::: "memory");
        ylz[(size_t)tc * RW + c] = f2bf(y);
    }
}
__device__ __forceinline__ void ph_fin(Ctx& C) {
    const bf16* yl = (const bf16*)(C.ws + WS_YL); const bf16* qt = (const bf16*)(C.dout + DO_QT); const float* s0 = (const float*)(C.ws + WS_S0); const float* rk = (const float*)(C.ws + WS_RK);
    const bf16* v = (const bf16*)(C.ws + WS_V); const bf16* gate = (const bf16*)(C.ws + WS_GATE); bf16* orw = (bf16*)(C.ws + WS_ORWKV); const float* lnw = C.in[16]; const float* lnb = C.in[17];
    const long nitems = (long)S * 16; const int lane = C.lane;
    for (long it = C.gw; it < nitems; it += C.ngw) { const int t = (int)(it >> 4), h = (int)(it & 15), c = h * 64 + lane;
        float y = bf2f(yl[(size_t)t * RW + c]) + bf2f(yl[((size_t)S + t) * RW + c]);
#pragma unroll
        for (int z = 0; z < 2; ++z) { const int ck = z ? (S - 1 - t) / CHL : t / CHL; const float* sp = s0 + (((size_t)(z * 16 + h) * NCK + ck) * 64 + lane) * 64; const bf16* qp = qt + ((size_t)z * S + t) * RW + h * 64;
            float corr = 0.f;
#pragma unroll 4
            for (int k = 0; k < 64; k += 4) { const f32x4 s4 = *(const f32x4*)(sp + k); const u32x2 q2 = *(const u32x2*)(qp + k);
                corr += s4[0] * __uint_as_float(q2.x << 16) + s4[1] * __uint_as_float(q2.x & 0xffff0000u) + s4[2] * __uint_as_float(q2.y << 16) + s4[3] * __uint_as_float(q2.y & 0xffff0000u); }
            y += corr; }
        const float mu = wave_sum(y) * (1.0f / 64.f); const float dv = y - mu; const float var = wave_sum(dv * dv) * (1.0f / 64.f);
        const float gn = dv * (1.0f / sqrtf(var + 64e-5f)) * lnw[c] + lnb[c];
        const float bonus = (rk[(size_t)t * 16 + h] + rk[((size_t)S + t) * 16 + h]) * bf2f(v[(size_t)t * RW + c]);
        orw[(size_t)t * RW + c] = f2bf((gn + bonus) * bf2f(gate[(size_t)t * RW + c])); }
}
__device__ __forceinline__ void ph_g1b(Ctx& C) {
    LAS float* scr = (LAS float*)(C.lds + C.wave * 16384);
    conv_natural(C, C.in[20], D, D, (bf16*)(C.ws + WS_WOUT), scr);
    conv_wgu(C, scr);
    conv_natural(C, C.in[24], FF, D, (bf16*)(C.ws + WS_WD), scr);
    EpiG1B E{(bf16*)(C.ws + WS_ZG), C.in[3]};
    gemm_simple(C, (const bf16*)(C.dout + DO_H1), (const bf16*)(C.ws + WS_WIN) + (size_t)N1A * D, NGATE, D, E);
}
__device__ __forceinline__ void ph_norm2(Ctx& C) {
    bf16* h2 = (bf16*)(C.ws + WS_H2);
    for (int m = C.gw; m < S; m += C.ngw) rms_row(C.out + (size_t)m * D, C.in[21], h2 + (size_t)m * D, C.lane);
}

template <bool COOP>
__global__ void __launch_bounds__(NTHR, 2) mega(Args args) {
    extern __shared__ __attribute__((aligned(16))) unsigned char lds_raw[];
    Ctx C;
#pragma unroll
    for (int i = 0; i < 25; ++i) C.in[i] = args.in[i];
    C.out = args.out; C.ws = args.ws; C.dout = (unsigned char*)args.out; C.lds = (LAS unsigned char*)lds_raw;
    C.tid = threadIdx.x; C.lane = C.tid & 63; C.wave = __builtin_amdgcn_readfirstlane(C.tid >> 6); C.bid = blockIdx.x; C.nb = gridDim.x;
    C.gw = C.bid * NWAVES + C.wave; C.ngw = C.nb * NWAVES;
#define PH(k, ...) do { if (args.ph_lo <= (k) && (k) < args.ph_hi) { __VA_ARGS__; if ((k) + 1 < args.ph_hi) { if constexpr (COOP) { cg::this_grid().sync(); } } } } while (0)
    PH(P_PREP0, ph_prep0(C));
    PH(P_G1A, ph_g1a(C));
    PH(P_HNORM, ph_hnorm(C));
    PH(P_ATTPREP, ph_attn(C); ph_rprep(C));
    PH(P_GLORA, ph_glora(C));
    PH(P_RK, ph_rk(C));
    PH(P_SCAN1, ph_scan_seq(C));
    PH(P_SCAN2, (void)0);
    PH(P_FIN, ph_fin(C));
    PH(P_G1B, ph_g1b(C));
    PH(P_GMA, { EpiMA E{(bf16*)(C.ws + WS_MERGED), (const bf16*)(C.ws + WS_ZG)}; gemm_simple(C, (const bf16*)(C.ws + WS_OATT), (const bf16*)(C.ws + WS_WBA), D, 512, E); });
    PH(P_GMB, { EpiMB E{(bf16*)(C.ws + WS_MERGED), (const bf16*)(C.ws + WS_ZG)}; gemm_simple(C, (const bf16*)(C.ws + WS_ORWKV), (const bf16*)(C.ws + WS_WBR), D, RW, E); });
    PH(P_GOUT, { EpiRes E{C.in[0], C.out}; gemm_simple(C, (const bf16*)(C.ws + WS_MERGED), (const bf16*)(C.ws + WS_WOUT), D, D, E); });
    PH(P_NORM2, ph_norm2(C));
    PH(P_FFN1, gemm_simple_ffn1(C, (const bf16*)(C.ws + WS_H2), (const bf16*)(C.ws + WS_WGU), (bf16*)(C.ws + WS_HID)));
    PH(P_FFN2, { EpiRes E{C.out, C.out}; gemm_simple(C, (const bf16*)(C.ws + WS_HID), (const bf16*)(C.ws + WS_WD), D, FF, E); });
#undef PH
}

extern "C" void kernel_launch(void* const* d_in, const int* in_sizes, int n_in, void* d_out, int out_size, void* d_ws, size_t ws_size, hipStream_t stream) {
    static int grid = 0;
    if (grid == 0) {
        if (n_in != 25 || in_sizes[0] != S * D || out_size != S * D || ws_size < WS_END) { fprintf(stderr, "kernel_launch: unexpected shapes (n_in %d, ws %zu)\n", n_in, ws_size); grid = -1; return; }
        int dev = 0, cus = 0, per_cu = 0;
        hipGetDevice(&dev); hipDeviceGetAttribute(&cus, hipDeviceAttributeMultiprocessorCount, dev);
        const void* fn = MK_COOP ? (const void*)mega<true> : (const void*)mega<false>;
        hipFuncSetAttribute(fn, hipFuncAttributeMaxDynamicSharedMemorySize, LDS_BYTES);
        hipOccupancyMaxActiveBlocksPerMultiprocessor(&per_cu, fn, NTHR, LDS_BYTES);
        if (per_cu < 1) { fprintf(stderr, "kernel_launch: occupancy query says %d blocks per CU\n", per_cu); per_cu = 1; }
        grid = cus * 1;
        (void)hipGetLastError();
    }
    if (grid < 0) return;
    Args a{};
    for (int i = 0; i < 25; ++i) a.in[i] = (const float*)d_in[i];
    a.out = (float*)d_out; a.ws = (unsigned char*)d_ws;
#if MK_COOP
    a.ph_lo = 0; a.ph_hi = P_COUNT;
    void* kargs[] = {&a};
    hipError_t e = hipLaunchCooperativeKernel((const void*)mega<true>, dim3(grid), dim3(NTHR), kargs, LDS_BYTES, stream);
    if (e != hipSuccess) fprintf(stderr, "cooperative launch failed: %s (grid %d)\n", hipGetErrorString(e), grid);
#else
    for (int ph = 0; ph < P_COUNT; ++ph) { if (ph == P_SCAN2) continue; a.ph_lo = ph; a.ph_hi = ph + 1; hipLaunchKernelGGL(mega<false>, dim3(grid), dim3(NTHR), LDS_BYTES, stream, a); }
#endif
}
```

```cpp
#include <hip/hip_runtime.h>
#include <hip/hip_cooperative_groups.h>
#include <cstdio>
#include <cstdint>
namespace cg = cooperative_groups;

#ifndef MK_COOP
#define MK_COOP 1
#endif

#define LAS __attribute__((address_space(3)))
typedef unsigned short bf16;
typedef short bf16x8 __attribute__((ext_vector_type(8)));
typedef float f32x4 __attribute__((ext_vector_type(4)));
typedef float f32x2 __attribute__((ext_vector_type(2)));
typedef unsigned u32x4 __attribute__((ext_vector_type(4)));
typedef unsigned u32x2 __attribute__((ext_vector_type(2)));

constexpr int S = 16384, D = 2048;
constexpr int HD = 64;
constexpr int NQKV = 4608, NZR = 3584, NZR_REAL = 3360, NGATE = 4096;
constexpr int N1A = NQKV + NZR;
constexpr int N1 = N1A + NGATE;
constexpr int IN_W = 12064;
constexpr int KL = 384, NL = 5120;
constexpr int KL2 = 256;
constexpr int FF = 5632;
constexpr int RW = 1024;
constexpr int NCHAIN = 32;
constexpr int CHL = 512, NCK = S / CHL;
constexpr int NWAVES = 8, NTHR = 512;
constexpr int LDS_BYTES = 147456, LDS_BAR_OFF = 147440;

constexpr size_t MiB = 1u << 20;
constexpr size_t WS_WIN = 0;
constexpr size_t WS_OATT = 0;
constexpr size_t WS_LORAA = 16 * MiB;
constexpr size_t WS_RK = 28 * MiB;
constexpr size_t WS_WLORA = 48 * MiB;
constexpr size_t WS_WBA = 52 * MiB;
constexpr size_t WS_WBR = 54 * MiB;
constexpr size_t WS_ZQKV = 58 * MiB;
constexpr size_t WS_ZR = 202 * MiB;
constexpr size_t WS_LW = 58 * MiB;
constexpr size_t WS_A = 122 * MiB;
constexpr size_t WS_GATE = 186 * MiB;
constexpr size_t WS_PU = 218 * MiB;
constexpr size_t WS_S0 = 282 * MiB;
constexpr size_t WS_R = 314 * MiB, WS_V = 346 * MiB, WS_NKK = 378 * MiB, WS_KRAW = 410 * MiB;
constexpr size_t WS_YL = 442 * MiB;
constexpr size_t WS_ORWKV = 58 * MiB;
constexpr size_t WS_ZG = 90 * MiB;
constexpr size_t WS_WOUT = 218 * MiB;
constexpr size_t WS_WGU = 226 * MiB;
constexpr size_t WS_WD = 270 * MiB;
constexpr size_t WS_MERGED = 292 * MiB;
constexpr size_t WS_H2 = 356 * MiB;
constexpr size_t WS_SSQP = 484 * MiB, WS_RSTD = 486 * MiB;
constexpr size_t WS_X2B = 420 * MiB;
constexpr size_t WS_HID = 0;
constexpr size_t WS_CTL = 506 * MiB, CTL_BYTES = 16384;
constexpr size_t WS_END = 507 * MiB;
constexpr size_t DO_H1 = 0, DO_QT = 64 * MiB;

enum Phase { P_PREP0 = 0, P_G1A, P_HNORM, P_ATTPREP, P_GLORA, P_RK, P_SCAN1, P_SCAN2, P_FIN, P_G1B, P_GMA, P_GMB, P_GOUT, P_NORM2, P_FFN1, P_FFN2, P_COUNT };

struct Args { const float* in[25]; float* out; unsigned char* ws; int ph_lo, ph_hi; };

__device__ __forceinline__ float bf2f(bf16 h) { return __uint_as_float((unsigned)h << 16); }
__device__ __forceinline__ bf16 f2bf(float f) { unsigned u = __float_as_uint(f); return (bf16)((u + 0x7fffu + ((u >> 16) & 1u)) >> 16); }
__device__ __forceinline__ unsigned pk2(float lo, float hi) { return (unsigned)f2bf(lo) | ((unsigned)f2bf(hi) << 16); }
__device__ __forceinline__ float wave_sum(float v) {
#pragma unroll
    for (int o = 1; o < 64; o <<= 1) v += __shfl_xor(v, o);
    return v;
}
__device__ __forceinline__ float wave_max(float v) {
#pragma unroll
    for (int o = 1; o < 64; o <<= 1) v = fmaxf(v, __shfl_xor(v, o));
    return v;
}
__device__ __forceinline__ float sigmoidf_(float x) { return 1.0f / (1.0f + __expf(-x)); }
__host__ __device__ __forceinline__ int tperm(int j) { const int lc = j & 255; return (j & ~255) + 64 * ((lc >> 5) & 3) + 32 * (lc >> 7) + (lc & 31); }

typedef const __attribute__((address_space(4))) Args KArgs;
struct Ctx {
    KArgs* ka;
    float* out; unsigned char* ws; unsigned char* dout;
    LAS unsigned char* lds;
    int wave, bid, nb, gw, ngw;
};
__device__ __forceinline__ int lane_now() { int l; asm volatile("v_mbcnt_lo_u32_b32 %0, -1, 0\n\tv_mbcnt_hi_u32_b32 %0, -1, %0" : "=v"(l)); return l; }


#define XB_TMO      128
#define XB_XCNT(j)  (256  + 64 * (j))
#define XB_XSUB(j)  (1280 + 64 * (j))
#define XB_XGEN(j)  (2304 + 64 * (j))
#define XB_TOP      3328
#define XB_TOPGEN   3392
#define XCD_BAR_WORDS 3456
#define XB_SPIN_CAP (1u << 22)
__device__ __forceinline__ unsigned xb_ld(unsigned* p)              { return __hip_atomic_load(p, __ATOMIC_RELAXED, __HIP_MEMORY_SCOPE_AGENT); }
__device__ __forceinline__ unsigned xb_add(unsigned* p, unsigned v) { return __hip_atomic_fetch_add(p, v, __ATOMIC_RELAXED, __HIP_MEMORY_SCOPE_AGENT); }
__device__ __forceinline__ unsigned xb_xcc_id() { return (unsigned)__builtin_amdgcn_s_getreg((3 << 11) | 20) & 0xFu; }
#define XB_SPIN(cond, bar) do { unsigned _sp = 0; while (cond) { __builtin_amdgcn_s_sleep(1); \
    if ((++_sp & 255u) == 0u) { if (xb_ld(&(bar)[XB_TMO])) break; if (_sp > XB_SPIN_CAP) { atomicAdd(&(bar)[XB_TMO], 1u); break; } } } } while (0)
struct XcdBarrier { unsigned* bar; unsigned x; volatile LAS unsigned* st; };
__device__ __forceinline__ void xcd_barrier_complete(unsigned* bar, unsigned x, unsigned G, unsigned& nloc, unsigned& nx) {
    unsigned sum, cnt, mine, sp = 0u;
    for (;;) {
        sum = 0u; cnt = 0u; mine = 0u;
#pragma unroll
        for (unsigned j = 0; j < 16; ++j) { const unsigned c = xb_ld(&bar[XB_XCNT(j)]); sum += c; cnt += (c > 0u) ? 1u : 0u; mine = (j == x) ? c : mine; }
        if (sum == G) break;
        __builtin_amdgcn_s_sleep(1);
        if ((++sp & 255u) == 0u) { if (xb_ld(&bar[XB_TMO])) break; if (sp > XB_SPIN_CAP) { atomicAdd(&bar[XB_TMO], 1u); break; } }
    }
    nloc = mine > 0u ? mine : 1u; nx = cnt > 0u ? cnt : 1u;
}
__device__ __forceinline__ void xcd_barrier(const XcdBarrier& b, const bool leader, const unsigned G) {
    asm volatile("s_waitcnt vmcnt(0)" ::: "memory");
    __syncthreads();
    if (leader) {
        unsigned* bar = b.bar;
        __builtin_amdgcn_s_waitcnt(0);
        unsigned nloc = b.st[0], nx = b.st[1];
        if (nloc == 0u) { xcd_barrier_complete(bar, b.x, G, nloc, nx); b.st[0] = nloc; b.st[1] = nx; }
        const unsigned old = xb_add(&bar[XB_XSUB(b.x)], 1u);
        const unsigned gen = old / nloc;
        if (old + 1u == (gen + 1u) * nloc) {
            __builtin_amdgcn_fence(__ATOMIC_RELEASE, "agent");
            asm volatile("s_waitcnt vmcnt(0)" ::: "memory");
            const unsigned og = xb_add(&bar[XB_TOP], 1u);
            const unsigned tg = og / nx;
            if (og + 1u == (tg + 1u) * nx) xb_add(&bar[XB_TOPGEN], 1u);
            else XB_SPIN(xb_ld(&bar[XB_TOPGEN]) == tg, bar);
            __builtin_amdgcn_fence(__ATOMIC_ACQUIRE, "agent");
            xb_add(&bar[XB_XGEN(b.x)], 1u);
            asm volatile("s_waitcnt vmcnt(0)" ::: "memory");
        } else {
            XB_SPIN(xb_ld(&bar[XB_XGEN(b.x)]) == gen, bar);
            __builtin_amdgcn_fence(__ATOMIC_ACQUIRE, "agent");
            asm volatile("s_waitcnt vmcnt(0)" ::: "memory");
        }
    }
    __syncthreads();
}

__device__ __forceinline__ unsigned pg8c(float lo, float hi) { unsigned r; asm volatile("v_cvt_pk_bf16_f32 %0, %1, %2" : "=v"(r) : "v"(lo), "v"(hi)); return r; }
__device__ __forceinline__ bf16x8 pack8s(float a0, float a1, float a2, float a3, float a4, float a5, float a6, float a7) {
    u32x4 p;
    asm volatile("v_cvt_pk_bf16_f32 %0, %4, %5\n\tv_cvt_pk_bf16_f32 %1, %6, %7\n\tv_cvt_pk_bf16_f32 %2, %8, %9\n\tv_cvt_pk_bf16_f32 %3, %10, %11\n\ts_nop 1"
                 : "=&v"(p[0]), "=&v"(p[1]), "=&v"(p[2]), "=&v"(p[3]) : "v"(a0), "v"(a1), "v"(a2), "v"(a3), "v"(a4), "v"(a5), "v"(a6), "v"(a7));
    return __builtin_bit_cast(bf16x8, p);
}
struct TrItem { const float* src; int ld; int nk; bf16* dst; int K; const float* kscale = nullptr; };
__device__ __forceinline__ void tr_load(const TrItem& t, f32x4 (&v)[8], int lane) {
#pragma unroll
    for (int i = 0; i < 8; ++i) { const int kk = (lane >> 3) + 8 * i; v[i] = (f32x4){0.f, 0.f, 0.f, 0.f}; if (t.src && kk < t.nk) { v[i] = *(const f32x4*)(t.src + (size_t)kk * t.ld + 4 * (lane & 7)); if (t.kscale) v[i] = v[i] * t.kscale[kk]; } }
}
__device__ __forceinline__ void tr_store(const TrItem& t, const f32x4 (&v)[8], LAS float* scr, int lane) {
#pragma unroll
    for (int i = 0; i < 8; ++i) { LAS float* d = scr + ((lane >> 3) + 8 * i) * 33 + 4 * (lane & 7); d[0] = v[i][0]; d[1] = v[i][1]; d[2] = v[i][2]; d[3] = v[i][3]; }
    asm volatile("s_waitcnt lgkmcnt(0)" ::: "memory");
    const int c = lane & 7;
#pragma unroll
    for (int j = 0; j < 4; ++j) { const int n = (lane >> 3) + 8 * j; const LAS float* s = scr + (8 * c) * 33 + n;
        u32x4 o; o.x = pg8c(s[0 * 33], s[1 * 33]); o.y = pg8c(s[2 * 33], s[3 * 33]); o.z = pg8c(s[4 * 33], s[5 * 33]); o.w = pg8c(s[6 * 33], s[7 * 33]);
        *(u32x4*)(t.dst + (size_t)n * t.K + 8 * c) = o; }
    asm volatile("s_waitcnt lgkmcnt(0)" ::: "memory");
}
template <class Mk> __device__ __forceinline__ void conv_run(Ctx& C, int nitems, const Mk& mk, LAS float* scr) {
    const int lane = lane_now(); int it = C.gw; if (it >= nitems) return;
    TrItem cur = mk(it); f32x4 v[8]; tr_load(cur, v, lane);
    for (;;) { const int nit = it + C.ngw; const bool more = nit < nitems; TrItem nxt = cur; f32x4 w[8];
        if (more) { nxt = mk(nit); tr_load(nxt, w, lane); }
        tr_store(cur, v, scr, lane);
        if (!more) break;
        cur = nxt; it = nit;
#pragma unroll
        for (int i = 0; i < 8; ++i) v[i] = w[i]; }
}
__device__ __forceinline__ void conv_natural(Ctx& C, const float* W, int K, int N, bf16* Wt, LAS float* scr) {
    const int nkb = K / 64;
    conv_run(C, (N / 32) * nkb, [=](int it) { const int j32 = it / nkb, kb = it % nkb; return TrItem{W + (size_t)(kb * 64) * N + j32 * 32, N, 64, Wt + (size_t)(j32 * 32) * K + kb * 64, K}; }, scr);
}
__device__ __forceinline__ void conv_win(Ctx& C, LAS float* scr) {
    const float* W = C.ka->in[2]; bf16* Wt = (bf16*)(C.ws + WS_WIN); const int nkb = D / 64;
    conv_run(C, (N1 / 32) * nkb, [=](int it) { const int j32 = it / nkb, kb = it % nkb; const int j = j32 * 32, ac = tperm(j);
        int wc; if (j < NQKV) wc = ac; else if (j < N1A) { const int zc = ac - NQKV; wc = zc < NZR_REAL ? NQKV + zc : -1; } else wc = NQKV + NZR_REAL + (ac - N1A);
        return TrItem{wc >= 0 ? W + (size_t)(kb * 64) * IN_W + wc : nullptr, IN_W, 64, Wt + (size_t)j * D + kb * 64, D}; }, scr);
}
__device__ __forceinline__ void conv_wlora(Ctx& C, LAS float* scr) {
    bf16* Wt = (bf16*)(C.ws + WS_WLORA); const float* w_d = C.ka->in[9]; const float* w_i = C.ka->in[11]; const float* w_g = C.ka->in[12]; const int nkb = KL2 / 64;
    conv_run(C, (NL / 32) * nkb, [=](int it) { const int j32 = it / nkb, kb = it % nkb; const int j = j32 * 32; const float* src = nullptr; int nk = 64;
        if (j < 4096) { const int ac = tperm(j); if (ac < 2048) { if (kb == 0) src = w_d + (size_t)(ac >> 10) * 64 * RW + (ac & 1023); } else { if (kb == 1) src = w_i + (size_t)((ac - 2048) >> 10) * 64 * RW + (ac & 1023); } }
        else { const int c = tperm(j - 4096); if (kb < 2) src = w_g + (size_t)(kb * 64) * RW + c; else if (kb == 2) { src = w_g + (size_t)128 * RW + c; nk = 32; } }
        return TrItem{src, RW, nk, Wt + (size_t)j * KL2 + kb * 64, KL2}; }, scr);
}
__device__ __forceinline__ void conv_wgu(Ctx& C, LAS float* scr) {
    bf16* Wt = (bf16*)(C.ws + WS_WGU); const float* wg = C.ka->in[22]; const float* wu = C.ka->in[23]; const float* nw2 = C.ka->in[21]; const int nkb = D / 64;
    conv_run(C, (2 * FF / 32) * nkb, [=](int it) { const int j32 = it / nkb, kb = it % nkb; const int j = j32 * 32, p = j >> 8, lc = j & 255;
        const float* W = (lc >= 128) ? wu : wg; const int hc = 128 * p + (lc & 127);
        return TrItem{W + (size_t)(kb * 64) * FF + hc, FF, 64, Wt + (size_t)j * D + kb * 64, D, nw2 + kb * 64}; }, scr);
}

__device__ __forceinline__ void rms_row(const float* xrow, const float* w, bf16* orow, int lane) {
    f32x4 v[8]; float ss = 0.f;
#pragma unroll
    for (int j = 0; j < 8; ++j) { v[j] = ((const f32x4*)xrow)[lane + 64 * j]; ss += (v[j].x * v[j].x + v[j].y * v[j].y) + (v[j].z * v[j].z + v[j].w * v[j].w); }
    ss = wave_sum(ss); const float rs = 1.0f / sqrtf(ss * (1.0f / D) + 1e-6f);
#pragma unroll
    for (int j = 0; j < 8; ++j) { const f32x4 w4 = ((const f32x4*)w)[lane + 64 * j]; u32x2 o; o.x = pk2(v[j].x * rs * w4.x, v[j].y * rs * w4.y); o.y = pk2(v[j].z * rs * w4.z, v[j].w * rs * w4.w);
        ((u32x2*)orow)[lane + 64 * j] = o; }
}

template <class Epi>
__device__ __forceinline__ void gemm_simple(Ctx& C, const bf16* A, const bf16* Bt, int N, int K, const Epi& epi) {
    const int lane_ = lane_now(), tid_ = C.wave * 64 + lane_; (void)tid_;
    const int lane = lane_, fr = lane & 15, fq = lane >> 4;
    const int ntn = N / 32; const long ntiles = (long)ntn * (S / 32);
    for (long it = C.gw; it < ntiles; it += C.ngw) {
        const int m0 = (int)(it / ntn) * 32, n0 = (int)(it % ntn) * 32;
        const bf16* ap = A + (size_t)(m0 + fr) * K + 8 * fq; const bf16* bp = Bt + (size_t)(n0 + fr) * K + 8 * fq;
        f32x4 acc[2][2];
#pragma unroll
        for (int i = 0; i < 2; ++i)
#pragma unroll
            for (int j = 0; j < 2; ++j) acc[i][j] = (f32x4){0.f, 0.f, 0.f, 0.f};
#pragma unroll 4
        for (int k = 0; k < K; k += 32) {
            const bf16x8 a0 = *(const bf16x8*)(ap + k), a1 = *(const bf16x8*)(ap + (size_t)16 * K + k);
            const bf16x8 b0 = *(const bf16x8*)(bp + k), b1 = *(const bf16x8*)(bp + (size_t)16 * K + k);
            acc[0][0] = __builtin_amdgcn_mfma_f32_16x16x32_bf16(b0, a0, acc[0][0], 0, 0, 0);
            acc[0][1] = __builtin_amdgcn_mfma_f32_16x16x32_bf16(b1, a0, acc[0][1], 0, 0, 0);
            acc[1][0] = __builtin_amdgcn_mfma_f32_16x16x32_bf16(b0, a1, acc[1][0], 0, 0, 0);
            acc[1][1] = __builtin_amdgcn_mfma_f32_16x16x32_bf16(b1, a1, acc[1][1], 0, 0, 0);
        }
#pragma unroll
        for (int i = 0; i < 2; ++i)
#pragma unroll
            for (int j = 0; j < 2; ++j) epi(m0 + 16 * i + fr, n0 + 16 * j + 4 * fq, acc[i][j]);
    }
}
__device__ __forceinline__ void gemm_simple_ffn1(Ctx& C, const bf16* A, const bf16* Bt, bf16* hid) {
    const int lane_ = lane_now(), tid_ = C.wave * 64 + lane_; (void)tid_;
    const int lane = lane_, fr = lane & 15, fq = lane >> 4, K = D;
    const int ntn = FF / 32; const long ntiles = (long)ntn * (S / 32);
    for (long it = C.gw; it < ntiles; it += C.ngw) {
        const int m0 = (int)(it / ntn) * 32, h0 = (int)(it % ntn) * 32, n0 = 256 * (h0 >> 7) + (h0 & 127);
        const bf16* ap = A + (size_t)(m0 + fr) * K + 8 * fq; const bf16* bp = Bt + (size_t)(n0 + fr) * K + 8 * fq;
        f32x4 ag[2][2], au[2][2];
#pragma unroll
        for (int i = 0; i < 2; ++i)
#pragma unroll
            for (int j = 0; j < 2; ++j) { ag[i][j] = (f32x4){0.f, 0.f, 0.f, 0.f}; au[i][j] = (f32x4){0.f, 0.f, 0.f, 0.f}; }
#pragma unroll 2
        for (int k = 0; k < K; k += 32) {
            const bf16x8 a0 = *(const bf16x8*)(ap + k), a1 = *(const bf16x8*)(ap + (size_t)16 * K + k);
            const bf16x8 g0 = *(const bf16x8*)(bp + k), g1 = *(const bf16x8*)(bp + (size_t)16 * K + k);
            const bf16x8 u0 = *(const bf16x8*)(bp + (size_t)128 * K + k), u1 = *(const bf16x8*)(bp + (size_t)144 * K + k);
            ag[0][0] = __builtin_amdgcn_mfma_f32_16x16x32_bf16(g0, a0, ag[0][0], 0, 0, 0); ag[0][1] = __builtin_amdgcn_mfma_f32_16x16x32_bf16(g1, a0, ag[0][1], 0, 0, 0);
            ag[1][0] = __builtin_amdgcn_mfma_f32_16x16x32_bf16(g0, a1, ag[1][0], 0, 0, 0); ag[1][1] = __builtin_amdgcn_mfma_f32_16x16x32_bf16(g1, a1, ag[1][1], 0, 0, 0);
            au[0][0] = __builtin_amdgcn_mfma_f32_16x16x32_bf16(u0, a0, au[0][0], 0, 0, 0); au[0][1] = __builtin_amdgcn_mfma_f32_16x16x32_bf16(u1, a0, au[0][1], 0, 0, 0);
            au[1][0] = __builtin_amdgcn_mfma_f32_16x16x32_bf16(u0, a1, au[1][0], 0, 0, 0); au[1][1] = __builtin_amdgcn_mfma_f32_16x16x32_bf16(u1, a1, au[1][1], 0, 0, 0);
        }
#pragma unroll
        for (int i = 0; i < 2; ++i)
#pragma unroll
            for (int j = 0; j < 2; ++j) { const int row = m0 + 16 * i + fr, hc = h0 + 16 * j + 4 * fq; const f32x4 g = ag[i][j], u = au[i][j]; float o[4];
#pragma unroll
                for (int e = 0; e < 4; ++e) o[e] = g[e] * sigmoidf_(g[e]) * u[e];
                u32x2 w; w.x = pk2(o[0], o[1]); w.y = pk2(o[2], o[3]); *(u32x2*)(hid + (size_t)row * FF + hc) = w; }
    }
}


namespace pg8 {
#define PG8_LAS __attribute__((address_space(3)))
typedef unsigned short bf16_t;
constexpr int BM = 256, BK = 64, HALF = 128, HTB = HALF * BK * 2, STAGE_BYTES = 8 * HTB, NXCD = 8, WGM = 4;
__host__ __device__ __forceinline__ int lds_byte(int r, int c) { const int st = (r >> 4) * 2 + (c >> 5), rr = r & 15, cc = c & 31, ob = rr * 64 + cc * 2; return st * 1024 + (ob ^ (((ob >> 9) & 1) << 5)); }
__host__ __device__ __forceinline__ void stage_rc(int b, int& R, int& C) { const int st = b / 1024, sb = b % 1024, swz = sb ^ (((sb >> 9) & 1) << 5); R = (st >> 1) * 16 + swz / 64; C = (st & 1) * 32 + (swz % 64) / 2; }
__host__ __device__ __forceinline__ int perm32(int rho) { const int n = rho >> 4, i = rho & 15; return 8 * (i >> 2) + 4 * n + (i & 3); }
struct Unit { int pm, pn; };
struct Gemm { const bf16_t* A; const bf16_t* Bt; int M, N, K; };
struct StaticOrder {
    int nM, nN, nwg, G, c;
    __host__ __device__ void init(int M, int N, int G_, int c_) { nM = M / BM; nN = N / BM; nwg = nM * nN; G = G_; c = c_; }
    __host__ __device__ bool next(int i, Unit& u) const {
        const long L = (long)i * G + c; if (L >= nwg) return false;
        int wgid = (int)L; { const int q = nwg / NXCD, r = nwg % NXCD, xcd = wgid % NXCD, off = wgid / NXCD; wgid = (xcd < r ? xcd * (q + 1) : r * (q + 1) + (xcd - r) * q) + off; }
        const int nig = WGM * nN, gid = wgid / nig, fm = gid * WGM, gsz = (nM - fm) < WGM ? (nM - fm) : WGM;
        u.pm = fm + ((wgid % nig) % gsz); u.pn = (wgid % nig) / gsz; return true;
    }
    __device__ __forceinline__ void a_ready(const Unit&) const {}
    __device__ __forceinline__ void done(const Unit&) const {}
};
__device__ __forceinline__ unsigned cvt_pk_bf16(float lo, float hi) { unsigned r; asm volatile("v_cvt_pk_bf16_f32 %0, %1, %2" : "=v"(r) : "v"(lo), "v"(hi)); return r; }
template <class Epi, class Sched, bool ALIGN_EPI = false, bool SP2 = false>
__device__ __forceinline__ void gemm_phase(PG8_LAS unsigned char* lds, const Gemm g, const Sched& S, const Epi& E, const int wid) {
    const int lane = lane_now(), tid = wid * 64 + lane, wr = wid >> 2, wc = wid & 3, fr = lane & 15, fq = lane >> 4;
    const int K = g.K, nt = K / BK;
    unsigned voffA[2], voffB[2];
#pragma unroll
    for (int i = 0; i < 2; ++i) { int R, C; stage_rc(tid * 16 + i * 8192, R, C); const int Rb = Epi::PERM ? ((R & ~31) + perm32(R & 31)) : R;
        voffA[i] = (unsigned)(R * K + C) * 2u; voffB[i] = (unsigned)(Rb * K + C) * 2u; }
    const size_t kstep = (size_t)(BK * 2);
    const size_t hstep = (size_t)HALF * K * 2;
    const size_t tstep = 2 * hstep;
    const unsigned ldsw = (unsigned)wid * 1024u;
    const int aoff = lds_byte(wr * 64 + fr, fq * 8), boff = lds_byte(wc * 32 + fr, fq * 8);
#define PG8_SA(b, h) (((b) * 2 + (h)) * HTB)
#define PG8_SB(b, h) ((4 + (b) * 2 + (h)) * HTB)
#define PG8_STAGE(bufoff, gbase, voff) do { _Pragma("unroll") for (int _i = 0; _i < 2; ++_i) \
        __builtin_amdgcn_global_load_lds((const unsigned*)((const char*)(gbase) + (voff)[_i]), (PG8_LAS unsigned*)(lds + (bufoff) + ldsw + _i * 8192), 16, 0, 0); } while (0)
#define PG8_LDA(dst, b, h) do { _Pragma("unroll") for (int m = 0; m < 4; ++m) _Pragma("unroll") for (int k = 0; k < 2; ++k) dst[m][k] = *(const PG8_LAS bf16x8*)(lds + PG8_SA(b, h) + aoff + m * 2048 + k * 1024); } while (0)
#define PG8_LDB(dst, b, h) do { _Pragma("unroll") for (int n = 0; n < 2; ++n) _Pragma("unroll") for (int k = 0; k < 2; ++k) dst[n][k] = *(const PG8_LAS bf16x8*)(lds + PG8_SB(b, h) + boff + n * 2048 + k * 1024); } while (0)
#define PG8_MMA(ai, bj, At, Bt) do { __builtin_amdgcn_s_setprio(1); _Pragma("unroll") for (int m = 0; m < 4; ++m) _Pragma("unroll") for (int n = 0; n < 2; ++n) _Pragma("unroll") for (int k = 0; k < 2; ++k) \
        acc[ai][bj][m][n] = __builtin_amdgcn_mfma_f32_16x16x32_bf16(Bt[n][k], At[m][k], acc[ai][bj][m][n], 0, 0, 0); __builtin_amdgcn_s_setprio(0); } while (0)
#define PG8_WAIT_V(n) asm volatile("s_waitcnt vmcnt(" #n ")" ::: "memory")
#define PG8_WAIT_L(n) asm volatile("s_waitcnt lgkmcnt(" #n ")" ::: "memory")
#define PG8_BAR __builtin_amdgcn_s_barrier()
#define PG8_SCHED __builtin_amdgcn_sched_barrier(0)
    Unit cur, nxt; int ui = 0;
    if (!S.next(0, cur)) return;
    f32x4 acc[2][2][4][2];
#pragma unroll
    for (int a = 0; a < 2; ++a)
#pragma unroll
        for (int b = 0; b < 2; ++b)
#pragma unroll
            for (int m = 0; m < 4; ++m)
#pragma unroll
                for (int n = 0; n < 2; ++n) acc[a][b][m][n] = (f32x4){0.f, 0.f, 0.f, 0.f};
    bf16x8 At[4][2], B0[2][2], B1[2][2];
    const char* cA = (const char*)g.A + (size_t)cur.pm * tstep; const char* cB = (const char*)g.Bt + (size_t)cur.pn * tstep;
    S.a_ready(cur);
    if constexpr (SP2) {
        PG8_STAGE(PG8_SB(0, 0), cB, voffB); PG8_STAGE(PG8_SB(0, 1), cB + hstep, voffB); PG8_STAGE(PG8_SA(0, 0), cA, voffA); PG8_STAGE(PG8_SA(0, 1), cA + hstep, voffA);
        if (wr == 1) PG8_BAR;
        PG8_WAIT_V(2); PG8_BAR;
        PG8_STAGE(PG8_SB(1, 0), cB + kstep, voffB); PG8_STAGE(PG8_SA(1, 0), cA + kstep, voffA); PG8_STAGE(PG8_SB(1, 1), cB + hstep + kstep, voffB);
        PG8_WAIT_V(6); PG8_BAR;
    } else {
        PG8_STAGE(PG8_SB(0, 0), cB, voffB); PG8_STAGE(PG8_SA(0, 0), cA, voffA); PG8_STAGE(PG8_SB(0, 1), cB + hstep, voffB); PG8_STAGE(PG8_SA(0, 1), cA + hstep, voffA);
        if (wr == 1) PG8_BAR;
        PG8_WAIT_V(4); PG8_BAR;
        PG8_STAGE(PG8_SB(1, 0), cB + kstep, voffB); PG8_STAGE(PG8_SA(1, 0), cA + kstep, voffA); PG8_STAGE(PG8_SB(1, 1), cB + hstep + kstep, voffB);
        PG8_WAIT_V(6); PG8_BAR;
    }
    for (;;) {
        const bool has_next = S.next(ui + 1, nxt);
        const char* nA = has_next ? (const char*)g.A + (size_t)nxt.pm * tstep : cA; const char* nB = has_next ? (const char*)g.Bt + (size_t)nxt.pn * tstep : cB;
        for (int t = 0; t < nt; t += 2) {
            const bool last = (t == nt - 2);
            const char* a1 = cA + (size_t)(t + 1) * kstep;
            const char* a2 = last ? nA : cA + (size_t)(t + 2) * kstep; const char* b2 = last ? nB : cB + (size_t)(t + 2) * kstep;
            const char* a3 = a2 + kstep; const char* b3 = b2 + kstep;
            if (last && has_next) S.a_ready(nxt);
            if constexpr (SP2) {
            PG8_LDB(B0, 0, 0); PG8_LDB(B1, 0, 1); PG8_SCHED; PG8_LDA(At, 0, 0); PG8_STAGE(PG8_SA(1, 1), a1 + hstep, voffA);
            PG8_WAIT_V(8); PG8_WAIT_L(0); PG8_BAR; PG8_MMA(0, 0, At, B0); PG8_MMA(0, 1, At, B1); PG8_BAR; PG8_SCHED;
            PG8_LDA(At, 0, 1); PG8_STAGE(PG8_SB(0, 0), b2, voffB); PG8_STAGE(PG8_SB(0, 1), b2 + hstep, voffB); PG8_STAGE(PG8_SA(0, 0), a2, voffA);
            PG8_WAIT_V(8); PG8_WAIT_L(0); PG8_BAR; PG8_MMA(1, 0, At, B0); PG8_MMA(1, 1, At, B1); PG8_BAR; PG8_SCHED;
            PG8_LDB(B0, 1, 0); PG8_LDB(B1, 1, 1); PG8_SCHED; PG8_LDA(At, 1, 0); PG8_STAGE(PG8_SA(0, 1), a2 + hstep, voffA);
            PG8_WAIT_V(8); PG8_WAIT_L(0); PG8_BAR; PG8_MMA(0, 0, At, B0); PG8_MMA(0, 1, At, B1); PG8_BAR; PG8_SCHED;
            PG8_LDA(At, 1, 1); PG8_STAGE(PG8_SB(1, 0), b3, voffB); PG8_STAGE(PG8_SB(1, 1), b3 + hstep, voffB); PG8_STAGE(PG8_SA(1, 0), a3, voffA);
            PG8_WAIT_V(8); PG8_WAIT_L(0); PG8_BAR; PG8_MMA(1, 0, At, B0); PG8_MMA(1, 1, At, B1); PG8_BAR; PG8_SCHED;
            } else {
            PG8_LDB(B0, 0, 0); PG8_SCHED; PG8_LDA(At, 0, 0); PG8_STAGE(PG8_SA(1, 1), a1 + hstep, voffA);
            PG8_WAIT_L(8); PG8_BAR; PG8_WAIT_L(0); PG8_MMA(0, 0, At, B0); PG8_BAR; PG8_SCHED;
            PG8_LDB(B1, 0, 1); PG8_STAGE(PG8_SB(0, 0), b2, voffB);
            PG8_BAR; PG8_WAIT_L(0); PG8_MMA(0, 1, At, B1); PG8_BAR;
            PG8_LDA(At, 0, 1); PG8_STAGE(PG8_SA(0, 0), a2, voffA);
            PG8_BAR; PG8_WAIT_L(0); PG8_MMA(1, 0, At, B0); PG8_BAR; PG8_SCHED;
            PG8_STAGE(PG8_SB(0, 1), b2 + hstep, voffB);
            PG8_WAIT_V(6); PG8_BAR; PG8_MMA(1, 1, At, B1); PG8_BAR;
            PG8_LDB(B0, 1, 0); PG8_SCHED; PG8_LDA(At, 1, 0); PG8_STAGE(PG8_SA(0, 1), a2 + hstep, voffA);
            PG8_WAIT_L(8); PG8_BAR; PG8_WAIT_L(0); PG8_MMA(0, 0, At, B0); PG8_BAR; PG8_SCHED;
            PG8_LDB(B1, 1, 1); PG8_STAGE(PG8_SB(1, 0), b3, voffB);
            PG8_BAR; PG8_WAIT_L(0); PG8_MMA(0, 1, At, B1); PG8_BAR;
            PG8_LDA(At, 1, 1); PG8_STAGE(PG8_SA(1, 0), a3, voffA);
            PG8_BAR; PG8_WAIT_L(0); PG8_MMA(1, 0, At, B0); PG8_BAR; PG8_SCHED;
            PG8_STAGE(PG8_SB(1, 1), b3 + hstep, voffB);
            PG8_WAIT_V(6); PG8_BAR; PG8_MMA(1, 1, At, B1); PG8_BAR;
            }
        }
        if constexpr (ALIGN_EPI) { if (wr == 0) PG8_BAR; }
        if constexpr (!Epi::AFTER_DRAIN) { int fr_e = fr, fq_e = fq; asm volatile("" : "+v"(fr_e), "+v"(fq_e)); E(acc, cur, wr, wc, fr_e, fq_e); S.done(cur); }
        if (!has_next) break;
#pragma unroll
        for (int a = 0; a < 2; ++a)
#pragma unroll
            for (int b = 0; b < 2; ++b)
#pragma unroll
                for (int m = 0; m < 4; ++m)
#pragma unroll
                    for (int n = 0; n < 2; ++n) acc[a][b][m][n] = (f32x4){0.f, 0.f, 0.f, 0.f};
        cur = nxt; cA = nA; cB = nB; ++ui;
        if constexpr (ALIGN_EPI) { if (wr == 1) PG8_BAR; }
    }
    PG8_WAIT_V(0);
    if constexpr (!ALIGN_EPI) { if (wr == 0) PG8_BAR; }
    PG8_BAR;
    if constexpr (Epi::AFTER_DRAIN) { E.fused(acc, cur, wr, wc, fr, fq, lds, wid, lane); S.done(cur); }
#undef PG8_SA
#undef PG8_SB
#undef PG8_STAGE
#undef PG8_LDA
#undef PG8_LDB
#undef PG8_MMA
#undef PG8_WAIT_V
#undef PG8_WAIT_L
#undef PG8_BAR
#undef PG8_SCHED
}
}


#ifndef OPT_GEMM
#define OPT_GEMM 1
#endif
typedef f32x4 AccT[2][2][4][2];
#ifndef NT_EPI
#define NT_EPI 0
#endif
#if NT_EPI
#define NTST4(p, v) __builtin_nontemporal_store((v), (u32x4*)(p))
#else
#define NTST4(p, v) (*(u32x4*)(p) = (v))
#endif
__device__ __forceinline__ u32x4 pack8(f32x4 a, f32x4 b) { u32x4 w; w.x = pg8::cvt_pk_bf16(a[0], a[1]); w.y = pg8::cvt_pk_bf16(a[2], a[3]); w.z = pg8::cvt_pk_bf16(b[0], b[1]); w.w = pg8::cvt_pk_bf16(b[2], b[3]); return w; }
__device__ __forceinline__ void unpack8(u32x4 w, float (&f)[8]) { f[0] = __uint_as_float(w.x << 16); f[1] = __uint_as_float(w.x & 0xffff0000u); f[2] = __uint_as_float(w.y << 16); f[3] = __uint_as_float(w.y & 0xffff0000u);
    f[4] = __uint_as_float(w.z << 16); f[5] = __uint_as_float(w.z & 0xffff0000u); f[6] = __uint_as_float(w.w << 16); f[7] = __uint_as_float(w.w & 0xffff0000u); }
struct EpiG1A8 { static constexpr bool PERM = true, AFTER_DRAIN = false; bf16* zqkv; bf16* zr; const float* qw; const float* kw;
    __device__ __forceinline__ void operator()(const AccT& acc, const pg8::Unit& u, int wr, int wc, int fr, int fq) const {
        const int row0 = u.pm * 256 + wr * 64 + fr, acb = u.pn * 256 + wc * 64 + 8 * fq;
        if (u.pn < 12) {
            const float* nw = u.pn < 6 ? qw : kw; const float sc = u.pn < 6 ? 0.125f : 1.0f; f32x4 w[2][2];
#pragma unroll
            for (int bj = 0; bj < 2; ++bj)
#pragma unroll
                for (int n = 0; n < 2; ++n) w[bj][n] = *(const f32x4*)(nw + 32 * bj + 8 * fq + 4 * n) * sc;
#pragma unroll
            for (int ai = 0; ai < 2; ++ai)
#pragma unroll
                for (int m = 0; m < 4; ++m) { float ss = 0.f;
#pragma unroll
                    for (int bj = 0; bj < 2; ++bj)
#pragma unroll
                        for (int n = 0; n < 2; ++n) { const f32x4 x = acc[ai][bj][m][n]; ss += (x[0] * x[0] + x[1] * x[1]) + (x[2] * x[2] + x[3] * x[3]); }
                    ss += __shfl_xor(ss, 16); ss += __shfl_xor(ss, 32);
                    const float rs = 1.0f / sqrtf(ss * (1.0f / 64.f) + 1e-6f);
                    bf16* rp = zqkv + (size_t)(row0 + ai * 128 + m * 16) * NQKV + acb;
#pragma unroll
                    for (int bj = 0; bj < 2; ++bj) NTST4(rp + 32 * bj, pack8(acc[ai][bj][m][0] * rs * w[bj][0], acc[ai][bj][m][1] * rs * w[bj][1])); }
        } else {
            bf16* base = u.pn < 18 ? zqkv + acb : zr + (acb - NQKV); const int ld = u.pn < 18 ? NQKV : NZR;
#pragma unroll
            for (int ai = 0; ai < 2; ++ai)
#pragma unroll
                for (int m = 0; m < 4; ++m) { bf16* rp = base + (size_t)(row0 + ai * 128 + m * 16) * ld;
#pragma unroll
                    for (int bj = 0; bj < 2; ++bj) NTST4(rp + 32 * bj, pack8(acc[ai][bj][m][0], acc[ai][bj][m][1])); }
        }
    } };
template <int MODE> struct EpiLora8 { static constexpr bool PERM = true, AFTER_DRAIN = false; bf16* dst; const float* bias;
    __device__ __forceinline__ void operator()(const AccT& acc, const pg8::Unit& u, int wr, int wc, int fr, int fq) const {
        const int row0 = u.pm * 256 + wr * 64 + fr; const int cb = (u.pn & 3) * 256 + wc * 64 + 8 * fq; const int z = MODE == 2 ? 0 : (u.pn >> 2); f32x4 bv[2][2];
#pragma unroll
        for (int bj = 0; bj < 2; ++bj)
#pragma unroll
            for (int n = 0; n < 2; ++n) bv[bj][n] = MODE == 2 ? (f32x4){0.f, 0.f, 0.f, 0.f} : *(const f32x4*)(bias + z * RW + cb + 32 * bj + 4 * n);
#pragma unroll
        for (int ai = 0; ai < 2; ++ai)
#pragma unroll
            for (int m = 0; m < 4; ++m) { bf16* rp = dst + ((size_t)z * S + row0 + ai * 128 + m * 16) * RW + cb;
#pragma unroll
                for (int bj = 0; bj < 2; ++bj) { f32x4 o[2];
#pragma unroll
                    for (int n = 0; n < 2; ++n)
#pragma unroll
                        for (int e = 0; e < 4; ++e) { const float v = bv[bj][n][e] + acc[ai][bj][m][n][e];
                            if (MODE == 0) { const float x = -v; const float sp = fmaxf(x, 0.f) + __logf(1.0f + __expf(-fabsf(x))); o[n][e] = -__expf(-sp - 0.5f); }
                            else if (MODE == 1) o[n][e] = sigmoidf_(v); else o[n][e] = v; }
                    NTST4(rp + 32 * bj, pack8(o[0], o[1])); } }
    } };
struct LoraOrder { int G, c;
    __device__ bool next(int i, pg8::Unit& u) const { const int L = i * G + c; if (L >= 1280) return false; u.pn = L >> 6; u.pm = (L & 63) + (u.pn >= 16 ? 64 : 0); return true; }
    __device__ __forceinline__ void a_ready(const pg8::Unit&) const {}
    __device__ __forceinline__ void done(const pg8::Unit&) const {}
};
struct EpiLoraU8 { static constexpr bool PERM = true, AFTER_DRAIN = false; unsigned char* wsb; const float* w0; const float* a0;
    __device__ __forceinline__ void operator()(const AccT& acc, const pg8::Unit& u, int wr, int wc, int fr, int fq) const {
        const int row0 = (u.pm & 63) * 256 + wr * 64 + fr; const int cb = (u.pn & 3) * 256 + wc * 64 + 8 * fq; const int mode = u.pn < 8 ? 0 : (u.pn < 16 ? 1 : 2), z = mode == 2 ? 0 : ((u.pn >> 2) & 1);
        const float* bias = mode == 0 ? w0 : a0; const size_t doff = mode == 0 ? WS_LW : WS_A; bf16* dst = (bf16*)(wsb + (mode == 2 ? WS_GATE : doff)); f32x4 bv[2][2];
#pragma unroll
        for (int bj = 0; bj < 2; ++bj)
#pragma unroll
            for (int n = 0; n < 2; ++n) { bv[bj][n] = (f32x4){0.f, 0.f, 0.f, 0.f}; if (mode != 2) bv[bj][n] = *(const f32x4*)(bias + z * RW + cb + 32 * bj + 4 * n); }
#pragma unroll
        for (int ai = 0; ai < 2; ++ai)
#pragma unroll
            for (int m = 0; m < 4; ++m) { bf16* rp = dst + ((size_t)z * S + row0 + ai * 128 + m * 16) * RW + cb;
#pragma unroll
                for (int bj = 0; bj < 2; ++bj) { f32x4 o[2];
#pragma unroll
                    for (int n = 0; n < 2; ++n)
#pragma unroll
                        for (int e = 0; e < 4; ++e) { const float v = bv[bj][n][e] + acc[ai][bj][m][n][e];
                            const float sg = __builtin_amdgcn_rcpf(1.0f + __builtin_amdgcn_exp2f(v * -1.44269504f)); o[n][e] = mode == 0 ? -0.60653066f * sg : (mode == 1 ? sg : v); }
                    *(u32x4*)(rp + 32 * bj) = pack8(o[0], o[1]); } }
    } };
struct EpiG1B8 { static constexpr bool PERM = true, AFTER_DRAIN = false; bf16* zg; const float* bg;
    __device__ __forceinline__ void operator()(const AccT& acc, const pg8::Unit& u, int wr, int wc, int fr, int fq) const {
        const int row0 = u.pm * 256 + wr * 64 + fr, acb = u.pn * 256 + wc * 64 + 8 * fq; f32x4 bv[2][2];
#pragma unroll
        for (int bj = 0; bj < 2; ++bj)
#pragma unroll
            for (int n = 0; n < 2; ++n) bv[bj][n] = *(const f32x4*)(bg + acb + 32 * bj + 4 * n);
#pragma unroll
        for (int ai = 0; ai < 2; ++ai)
#pragma unroll
            for (int m = 0; m < 4; ++m) { bf16* rp = zg + (size_t)(row0 + ai * 128 + m * 16) * NGATE + acb;
#pragma unroll
                for (int bj = 0; bj < 2; ++bj) { f32x4 o[2];
#pragma unroll
                    for (int n = 0; n < 2; ++n)
#pragma unroll
                        for (int e = 0; e < 4; ++e) o[n][e] = sigmoidf_(acc[ai][bj][m][n][e] + bv[bj][n][e]);
                    NTST4(rp + 32 * bj, pack8(o[0], o[1])); } }
    } };
template <bool SECOND> struct EpiMerge8 { static constexpr bool PERM = true, AFTER_DRAIN = false; bf16* mg; const bf16* zg;
    __device__ __forceinline__ void operator()(const AccT& acc, const pg8::Unit& u, int wr, int wc, int fr, int fq) const {
        const int row0 = u.pm * 256 + wr * 64 + fr, col0 = u.pn * 256 + wc * 32 + 8 * fq;
#pragma unroll
        for (int ai = 0; ai < 2; ++ai)
#pragma unroll
            for (int m = 0; m < 4; ++m) { const int row = row0 + ai * 128 + m * 16;
#pragma unroll
                for (int bj = 0; bj < 2; ++bj) { const int col = col0 + 128 * bj; float g[8]; unpack8(*(const u32x4*)(zg + (size_t)row * NGATE + (SECOND ? D : 0) + col), g); f32x4 o[2];
                    float t[8]; if (SECOND) unpack8(*(const u32x4*)(mg + (size_t)row * D + col), t);
#pragma unroll
                    for (int n = 0; n < 2; ++n)
#pragma unroll
                        for (int e = 0; e < 4; ++e) o[n][e] = (SECOND ? t[4 * n + e] : 0.f) + g[4 * n + e] * acc[ai][bj][m][n][e];
                    *(u32x4*)(mg + (size_t)row * D + col) = pack8(o[0], o[1]); } }
    } };
struct EpiRes8 { static constexpr bool PERM = false, AFTER_DRAIN = false; const float* base; float* out;
    __device__ __forceinline__ void operator()(const AccT& acc, const pg8::Unit& u, int wr, int wc, int fr, int fq) const {
        const int row0 = u.pm * 256 + wr * 64 + fr, col0 = u.pn * 256 + wc * 32 + 4 * fq;
#pragma unroll
        for (int ai = 0; ai < 2; ++ai)
#pragma unroll
            for (int m = 0; m < 4; ++m) { const size_t off = (size_t)(row0 + ai * 128 + m * 16) * D + col0;
#pragma unroll
                for (int bj = 0; bj < 2; ++bj)
#pragma unroll
                    for (int n = 0; n < 2; ++n) { const f32x4 b = *(const f32x4*)(base + off + bj * 128 + n * 16); *(f32x4*)(out + off + bj * 128 + n * 16) = b + acc[ai][bj][m][n]; } }
    } };
struct EpiX2b8 { static constexpr bool PERM = true, AFTER_DRAIN = false; const float* base; bf16* xb; float* ssqp;
    __device__ __forceinline__ void operator()(const AccT& acc, const pg8::Unit& u, int wr, int wc, int fr, int fq) const {
        const int row0 = u.pm * 256 + wr * 64 + fr, col0 = u.pn * 256 + wc * 32 + 8 * fq;
#pragma unroll
        for (int ai = 0; ai < 2; ++ai)
#pragma unroll
            for (int m = 0; m < 4; ++m) { const int row = row0 + ai * 128 + m * 16; const size_t off = (size_t)row * D + col0; float ss = 0.f;
#pragma unroll
                for (int bj = 0; bj < 2; ++bj) { const f32x4 b0 = *(const f32x4*)(base + off + bj * 128), b1 = *(const f32x4*)(base + off + bj * 128 + 4);
                    const f32x4 o0 = b0 + acc[ai][bj][m][0], o1 = b1 + acc[ai][bj][m][1];
                    ss += (o0[0] * o0[0] + o0[1] * o0[1]) + (o0[2] * o0[2] + o0[3] * o0[3]) + (o1[0] * o1[0] + o1[1] * o1[1]) + (o1[2] * o1[2] + o1[3] * o1[3]);
                    *(u32x4*)(xb + off + bj * 128) = pack8(o0, o1); }
                ss += __shfl_xor(ss, 16); ss += __shfl_xor(ss, 32);
                if (fq == 0) ssqp[(size_t)row * 32 + u.pn * 4 + wc] = ss; }
    } };
struct EpiResB8 { static constexpr bool PERM = false, AFTER_DRAIN = false; const bf16* xb; float* out;
    __device__ __forceinline__ void operator()(const AccT& acc, const pg8::Unit& u, int wr, int wc, int fr, int fq) const {
        const int row0 = u.pm * 256 + wr * 64 + fr, col0 = u.pn * 256 + wc * 32 + 4 * fq;
#pragma unroll
        for (int ai = 0; ai < 2; ++ai)
#pragma unroll
            for (int m = 0; m < 4; ++m) { const size_t off = (size_t)(row0 + ai * 128 + m * 16) * D + col0;
#pragma unroll
                for (int bj = 0; bj < 2; ++bj)
#pragma unroll
                    for (int n = 0; n < 2; ++n) { const u32x2 w = *(const u32x2*)(xb + off + bj * 128 + n * 16);
                        const f32x4 b = (f32x4){__uint_as_float(w.x << 16), __uint_as_float(w.x & 0xffff0000u), __uint_as_float(w.y << 16), __uint_as_float(w.y & 0xffff0000u)};
                        *(f32x4*)(out + off + bj * 128 + n * 16) = b + acc[ai][bj][m][n]; } }
    } };
struct EpiFfn18 { static constexpr bool PERM = true, AFTER_DRAIN = false; bf16* hid; const float* rstd;
    __device__ __forceinline__ void operator()(const AccT& acc, const pg8::Unit& u, int wr, int wc, int fr, int fq) const {
        const int row0 = u.pm * 256 + wr * 64 + fr, hc0 = u.pn * 128 + wc * 32 + 8 * fq;
#pragma unroll
        for (int ai = 0; ai < 2; ++ai)
#pragma unroll
            for (int m = 0; m < 4; ++m) { f32x4 o[2]; const float rs = rstd[row0 + ai * 128 + m * 16];
#pragma unroll
                for (int n = 0; n < 2; ++n)
#pragma unroll
                    for (int e = 0; e < 4; ++e) { const float g = acc[ai][0][m][n][e] * rs; o[n][e] = g * sigmoidf_(g) * (acc[ai][1][m][n][e] * rs); }
                NTST4(hid + (size_t)(row0 + ai * 128 + m * 16) * FF + hc0, pack8(o[0], o[1])); }
    } };
template <class Epi> __device__ __forceinline__ void gemm8(Ctx& C, const bf16* A, const bf16* Bt, int N, int K, const Epi& E) {
    asm volatile("" : "+s"(N), "+s"(K));
    pg8::Gemm g{A, Bt, S, N, K}; pg8::StaticOrder so; so.init(S, N, C.nb, C.bid);
    pg8::gemm_phase<Epi, pg8::StaticOrder, true, true>(C.lds, g, so, E, C.wave);
}

__device__ __forceinline__ void st4bf(bf16* p, f32x4 v) { u32x2 w; w.x = pk2(v[0], v[1]); w.y = pk2(v[2], v[3]); *(u32x2*)p = w; }
struct EpiG1A { bf16* zqkv; bf16* zr;
    __device__ __forceinline__ void operator()(int row, int j0, f32x4 v) const { const int ac = tperm(j0);
        if (ac < NQKV) st4bf(zqkv + (size_t)row * NQKV + ac, v); else st4bf(zr + (size_t)row * NZR + (ac - NQKV), v); } };
struct EpiLora { bf16* lw; bf16* a; bf16* gate; const float* w0; const float* a0;
    __device__ __forceinline__ void operator()(int row, int j0, f32x4 v) const { const int ac = tperm(j0);
        if (ac < 2048) { const int z = ac >> 10, c = ac & 1023; f32x4 o;
#pragma unroll
            for (int e = 0; e < 4; ++e) { const float x = -(w0[z * RW + c + e] + v[e]); const float sp = fmaxf(x, 0.f) + log1pf(__expf(-fabsf(x))); o[e] = -__expf(-sp - 0.5f); }
            st4bf(lw + ((size_t)z * S + row) * RW + c, o); }
        else if (ac < 4096) { const int z = (ac - 2048) >> 10, c = ac & 1023; f32x4 o;
#pragma unroll
            for (int e = 0; e < 4; ++e) o[e] = sigmoidf_(a0[z * RW + c + e] + v[e]);
            st4bf(a + ((size_t)z * S + row) * RW + c, o); }
        else st4bf(gate + (size_t)row * RW + (ac - 4096), v); } };
struct EpiG1B { bf16* zg; const float* bg;
    __device__ __forceinline__ void operator()(int row, int j0, f32x4 v) const { const int ac = tperm(j0); f32x4 o;
#pragma unroll
        for (int e = 0; e < 4; ++e) o[e] = sigmoidf_(v[e] + bg[ac + e]);
        st4bf(zg + (size_t)row * NGATE + ac, o); } };
struct EpiMA { bf16* mg; const bf16* zg;
    __device__ __forceinline__ void operator()(int row, int j0, f32x4 v) const { const u32x2 g = *(const u32x2*)(zg + (size_t)row * NGATE + j0); f32x4 o;
        o[0] = v[0] * bf2f((bf16)(g.x & 0xffff)); o[1] = v[1] * bf2f((bf16)(g.x >> 16)); o[2] = v[2] * bf2f((bf16)(g.y & 0xffff)); o[3] = v[3] * bf2f((bf16)(g.y >> 16));
        st4bf(mg + (size_t)row * D + j0, o); } };
struct EpiMB { bf16* mg; const bf16* zg;
    __device__ __forceinline__ void operator()(int row, int j0, f32x4 v) const { const u32x2 g = *(const u32x2*)(zg + (size_t)row * NGATE + D + j0); const u32x2 t = *(const u32x2*)(mg + (size_t)row * D + j0); f32x4 o;
        o[0] = bf2f((bf16)(t.x & 0xffff)) + v[0] * bf2f((bf16)(g.x & 0xffff)); o[1] = bf2f((bf16)(t.x >> 16)) + v[1] * bf2f((bf16)(g.x >> 16));
        o[2] = bf2f((bf16)(t.y & 0xffff)) + v[2] * bf2f((bf16)(g.y & 0xffff)); o[3] = bf2f((bf16)(t.y >> 16)) + v[3] * bf2f((bf16)(g.y >> 16));
        st4bf(mg + (size_t)row * D + j0, o); } };
struct EpiRes { const float* base; float* out;
    __device__ __forceinline__ void operator()(int row, int j0, f32x4 v) const { const f32x4 b = *(const f32x4*)(base + (size_t)row * D + j0); *(f32x4*)(out + (size_t)row * D + j0) = b + v; } };


#ifndef OPT_SCAN
#define OPT_SCAN 1
#endif
#ifndef OPT_SCANM
#define OPT_SCANM 1
#endif
constexpr int SC_T = 8, SC_STEPF = 384, SC_ITEMF = SC_T * SC_STEPF;
template <int CTRL> __device__ __forceinline__ float dpp_f(float x) { return __int_as_float(__builtin_amdgcn_update_dpp(0, __float_as_int(x), CTRL, 0xf, 0xf, true)); }
__device__ __forceinline__ float quad_sum(float x) { x += dpp_f<0xB1>(x); x += dpp_f<0x4E>(x); return x; }
template <int role> __device__ __forceinline__ void ph_scan1_r(Ctx& C) {
    const int lane = lane_now(), wave = C.wave, itl = wave & 3, kq = lane & 3, rg = lane >> 2;
    const int t128 = role * 64 + lane, sst = t128 >> 4, cg = t128 & 15;
    const bf16* g_r = (const bf16*)(C.ws + WS_R); const bf16* g_v = (const bf16*)(C.ws + WS_V); const bf16* g_nkk = (const bf16*)(C.ws + WS_NKK); const bf16* g_k = (const bf16*)(C.ws + WS_KRAW);
    const bf16* g_lw = (const bf16*)(C.ws + WS_LW); const bf16* g_a = (const bf16*)(C.ws + WS_A); const float* k_a = C.ka->in[14];
    bf16* g_out = role ? (bf16*)(C.ws + WS_YL) : (bf16*)(C.dout + DO_QT); float* g_pu = (float*)(C.ws + WS_PU);
    LAS float* lbase = (LAS float*)C.lds + itl * SC_ITEMF;
    const int nitems = NCHAIN * NCK;
    for (int base = C.bid * 4; base < nitems; base += C.nb * 4) {
        const int item = base + itl; const bool active = item < nitems; const int chain = active ? item / NCK : 0, chunk = active ? item % NCK : 0, z = chain >> 4, h = chain & 15;
        const size_t zoff = (size_t)z * S * RW; const int cbase = h * 64 + 4 * cg;
        const f32x4 ka4 = *(const f32x4*)(k_a + cbase);
        f32x2 st[4][8];
#pragma unroll
        for (int i = 0; i < 4; ++i)
#pragma unroll
            for (int kk = 0; kk < 8; ++kk) { const int row = 4 * rg + i, k0 = 16 * kq + 2 * kk; st[i][kk] = (f32x2){(role == 0 && row == k0) ? 1.f : 0.f, (role == 0 && row == k0 + 1) ? 1.f : 0.f}; }
        u32x2 q_nkk, q_lw, q_a, q_k, q_r, q_v;
#define SC_LOAD(blk) do { const int sg_ = chunk * CHL + (blk) * SC_T + sst; const int tk_ = z ? S - 1 - sg_ : sg_; const size_t ix_ = (size_t)tk_ * RW + cbase; \
            q_nkk = *(const u32x2*)(g_nkk + ix_); q_lw = *(const u32x2*)(g_lw + zoff + ix_); q_a = *(const u32x2*)(g_a + zoff + ix_); q_k = *(const u32x2*)(g_k + ix_); q_r = *(const u32x2*)(g_r + ix_); q_v = *(const u32x2*)(g_v + ix_); } while (0)
#define SC_BF(q, e) __uint_as_float(((e) & 1) ? (((e) >> 1) ? (q).y : (q).x) & 0xffff0000u : (((e) >> 1) ? (q).y : (q).x) << 16)
#define SC_WRITE(buf) do { LAS float* d_ = lbase + (buf) * 4 * SC_ITEMF + sst * SC_STEPF + 4 * cg; f32x4 o0, o1, o2, o3, o4, o5; \
            _Pragma("unroll") for (int e = 0; e < 4; ++e) { const float n_ = SC_BF(q_nkk, e), a_ = SC_BF(q_a, e); o0[e] = n_; o1[e] = __expf(SC_BF(q_lw, e)); o2[e] = -n_ * a_; o3[e] = SC_BF(q_k, e) * (1.0f + (a_ - 1.0f) * ka4[e]); o4[e] = SC_BF(q_r, e); o5[e] = SC_BF(q_v, e); } \
            *(LAS f32x4*)(d_) = o0; *(LAS f32x4*)(d_ + 64) = o1; *(LAS f32x4*)(d_ + 128) = o2; *(LAS f32x4*)(d_ + 192) = o3; *(LAS f32x4*)(d_ + 256) = o4; *(LAS f32x4*)(d_ + 320) = o5; } while (0)
        SC_LOAD(0); SC_WRITE(0);
        __syncthreads();
        for (int blk = 0; blk < CHL / SC_T; ++blk) {
            if (blk + 1 < CHL / SC_T) SC_LOAD(blk + 1);
            const LAS float* bp = lbase + (blk & 1) * 4 * SC_ITEMF + 16 * kq;
            f32x4 x[4];
#pragma unroll
            for (int q = 0; q < 4; ++q) x[q] = *(const LAS f32x4*)(bp + 4 * q);
#pragma unroll 2
            for (int ss = 0; ss < SC_T; ++ss) {
                const LAS float* sp = bp + ss * SC_STEPF;
                float sa[4], y[4];
                f32x4 vv = (f32x4){0.f, 0.f, 0.f, 0.f}; if (role) vv = *(const LAS f32x4*)(sp - 16 * kq + 320 + 4 * rg);
                f32x4 w4[4], b4[4], r4[4], k4[4];
#pragma unroll
                for (int q = 0; q < 4; ++q) { w4[q] = *(const LAS f32x4*)(sp + 64 + 4 * q); b4[q] = *(const LAS f32x4*)(sp + 128 + 4 * q); r4[q] = *(const LAS f32x4*)(sp + 256 + 4 * q); if (role) k4[q] = *(const LAS f32x4*)(sp + 192 + 4 * q); }
                {   f32x2 s2[4];
#pragma unroll
                    for (int i = 0; i < 4; ++i) { s2[i] = st[i][0] * (f32x2){x[0][0], x[0][1]};
#pragma unroll
                        for (int kk = 1; kk < 8; ++kk) s2[i] += st[i][kk] * (f32x2){x[kk >> 1][2 * (kk & 1)], x[kk >> 1][2 * (kk & 1) + 1]}; }
#pragma unroll
                    for (int i = 0; i < 4; ++i) sa[i] = quad_sum(s2[i].x + s2[i].y); }
                if (ss + 1 < SC_T) {
#pragma unroll
                    for (int q = 0; q < 4; ++q) x[q] = *(const LAS f32x4*)(sp + SC_STEPF + 4 * q); }
                __builtin_amdgcn_sched_barrier(0);
                f32x2 y2[4];
#pragma unroll
                for (int i = 0; i < 4; ++i) y2[i] = (f32x2){0.f, 0.f};
#pragma unroll
                for (int kk = 0; kk < 8; ++kk) { const int q = kk >> 1, o = 2 * (kk & 1); const f32x2 w2 = (f32x2){w4[q][o], w4[q][o + 1]}, b2 = (f32x2){b4[q][o], b4[q][o + 1]}, r2 = (f32x2){r4[q][o], r4[q][o + 1]};
#pragma unroll
                    for (int i = 0; i < 4; ++i) { f32x2 t2 = b2 * sa[i]; if (role) t2 += (f32x2){k4[q][o], k4[q][o + 1]} * vv[i]; st[i][kk] = st[i][kk] * w2 + t2; y2[i] += st[i][kk] * r2; } }
#pragma unroll
                for (int i = 0; i < 4; ++i) y[i] = quad_sum(y2[i].x + y2[i].y);
                if (active && kq == 0) { const int sg = chunk * CHL + blk * SC_T + ss; const int tk = z ? S - 1 - sg : sg; u32x2 o; o.x = pk2(y[0], y[1]); o.y = pk2(y[2], y[3]);
                    *(u32x2*)(g_out + zoff + (size_t)tk * RW + h * 64 + 4 * rg) = o; }
            }
            if (blk + 1 < CHL / SC_T) SC_WRITE((blk + 1) & 1);
            __syncthreads();
        }
        if (active) { float* pp = g_pu + (((size_t)chain * NCK + chunk) * 2 + role) * 4096;
#pragma unroll
            for (int i = 0; i < 4; ++i)
#pragma unroll
                for (int q = 0; q < 4; ++q) *(f32x4*)(pp + (4 * rg + i) * 64 + 16 * kq + 4 * q) = (f32x4){st[i][2 * q].x, st[i][2 * q].y, st[i][2 * q + 1].x, st[i][2 * q + 1].y}; }
#undef SC_LOAD
#undef SC_BF
#undef SC_WRITE
    }
}
__device__ __forceinline__ void ph_scan1(Ctx& C) { if (C.wave >> 2) ph_scan1_r<1>(C); else ph_scan1_r<0>(C); }
__device__ __forceinline__ float rdlane(float x, int l) { return __int_as_float(__builtin_amdgcn_readlane(__float_as_int(x), l)); }
__device__ __forceinline__ void ph_scan2(Ctx& C) {
    const int lane = lane_now(); const float* g_pu = (const float*)(C.ws + WS_PU); float* g_s0 = (float*)(C.ws + WS_S0);
    for (int task = C.bid; task < NCHAIN * 8; task += C.nb) { const int chain = task >> 3, row = (task & 7) * 8 + C.wave;
        float sv = 0.f; float pc[64], uc;
        { const float* P = g_pu + ((size_t)chain * NCK) * 8192;
#pragma unroll
          for (int k = 0; k < 64; ++k) pc[k] = P[k * 64 + lane];
          uc = P[4096 + row * 64 + lane]; }
#pragma unroll 1
        for (int c = 0; c < NCK; ++c) { const float* P = g_pu + ((size_t)chain * NCK + (c + 1 < NCK ? c + 1 : c)) * 8192;
            float pn[64], un;
#pragma unroll
            for (int k = 0; k < 64; ++k) pn[k] = P[k * 64 + lane];
            un = P[4096 + row * 64 + lane];
            g_s0[(((size_t)chain * NCK + c) * 64 + row) * 64 + lane] = sv;
            float acc0 = uc, acc1 = 0.f;
#pragma unroll
            for (int k = 0; k < 64; k += 2) { acc0 += rdlane(sv, k) * pc[k]; acc1 += rdlane(sv, k + 1) * pc[k + 1]; }
            sv = acc0 + acc1;
#pragma unroll
            for (int k = 0; k < 64; ++k) pc[k] = pn[k];
            uc = un; }
    }
}

#ifndef OPT_SCAN2B
#define OPT_SCAN2B 1
#endif
__device__ __forceinline__ void ph_scan2b(Ctx& C) {
    const int lane = lane_now(), wave = C.wave, tid = wave * 64 + lane; const float* g_pu = (const float*)(C.ws + WS_PU); float* g_s0 = (float*)(C.ws + WS_S0);
    constexpr int SLOT = 18432, NSLOT = 6, AHEAD = 5;
    for (int task = C.bid; task < NCHAIN * 8; task += C.nb) { const int chain = task >> 3, rg = task & 7, row = rg * 8 + wave;
        const float* Pb = g_pu + (size_t)chain * NCK * 8192;
#define S2_ISSUE(c_) do { const float* pc_ = Pb + (size_t)(c_) * 8192; LAS unsigned char* sl_ = C.lds + ((c_) % NSLOT) * SLOT + wave * 1024; \
            __builtin_amdgcn_global_load_lds((const unsigned*)(pc_ + tid * 4), (LAS unsigned*)(sl_), 16, 0, 0); \
            __builtin_amdgcn_global_load_lds((const unsigned*)(pc_ + 2048 + tid * 4), (LAS unsigned*)(sl_ + 8192), 16, 0, 0); \
            if (wave < 2) __builtin_amdgcn_global_load_lds((const unsigned*)(pc_ + 4096 + rg * 512 + tid * 4), (LAS unsigned*)(sl_ + 16384), 16, 0, 0); } while (0)
        asm volatile("s_waitcnt vmcnt(0) lgkmcnt(0)" ::: "memory"); __builtin_amdgcn_s_barrier(); asm volatile("" ::: "memory");
#pragma unroll
        for (int c = 0; c < AHEAD; ++c) S2_ISSUE(c);
        float sv = 0.f;
#pragma unroll 1
        for (int c = 0; c < NCK; ++c) {
            if (c == 0 || c >= NCK - AHEAD + 1) asm volatile("s_waitcnt vmcnt(0)" ::: "memory");
            else if (wave < 2) asm volatile("s_waitcnt vmcnt(17)" ::: "memory");
            else asm volatile("s_waitcnt vmcnt(13)" ::: "memory");
            __builtin_amdgcn_s_barrier(); asm volatile("" ::: "memory");
            if (c + AHEAD < NCK) S2_ISSUE(c + AHEAD);
            asm volatile("" ::: "memory");
            const LAS float* P = (const LAS float*)(C.lds + (c % NSLOT) * SLOT);
            g_s0[(((size_t)chain * NCK + c) * 64 + row) * 64 + lane] = sv;
            float acc0 = P[4096 + wave * 64 + lane], acc1 = 0.f;
#pragma unroll
            for (int k = 0; k < 64; k += 2) { acc0 += rdlane(sv, k) * P[k * 64 + lane]; acc1 += rdlane(sv, k + 1) * P[(k + 1) * 64 + lane]; }
            sv = acc0 + acc1;
            asm volatile("s_waitcnt lgkmcnt(0)" ::: "memory");
        }
#undef S2_ISSUE
    }
    asm volatile("s_waitcnt vmcnt(0)" ::: "memory"); __builtin_amdgcn_s_barrier();
}
__device__ __forceinline__ void ph_fin2(Ctx& C) {
    const int lane = lane_now();
    const bf16* yl = (const bf16*)(C.ws + WS_YL); const bf16* qt = (const bf16*)(C.dout + DO_QT); const float* s0 = (const float*)(C.ws + WS_S0);
    const bf16* r = (const bf16*)(C.ws + WS_R); const bf16* kraw = (const bf16*)(C.ws + WS_KRAW); const bf16* a = (const bf16*)(C.ws + WS_A); const float* k_a = C.ka->in[14]; const float* r_k = C.ka->in[15];
    const bf16* v = (const bf16*)(C.ws + WS_V); const bf16* gate = (const bf16*)(C.ws + WS_GATE); bf16* orw = (bf16*)(C.ws + WS_ORWKV); const float* lnw = C.ka->in[16]; const float* lnb = C.ka->in[17];
    for (int task = C.bid; task < 16 * NCK; task += C.nb) { const int h = task & 15, cf = task >> 4, cb = NCK - 1 - cf, c = h * 64 + lane;
        f32x4 sf[16], sb[16];
        { const f32x4* pf = (const f32x4*)(s0 + (((size_t)h * NCK + cf) * 64 + lane) * 64); const f32x4* pb = (const f32x4*)(s0 + (((size_t)(16 + h) * NCK + cb) * 64 + lane) * 64);
#pragma unroll
          for (int q = 0; q < 16; ++q) { sf[q] = pf[q]; sb[q] = pb[q]; } }
        const float ka_ = k_a[c], rk_ = r_k[c], lw_ = lnw[c], lb_ = lnb[c];
        for (int tt = 0; tt < 32; ++tt) { const int t = cf * CHL + C.wave * 32 + tt; const size_t ix = (size_t)t * RW + c, ixb = ((size_t)S + t) * RW + c;
            const float qf = bf2f(qt[ix]), qb = bf2f(qt[ixb]);
            float y0 = bf2f(yl[ix]), y1 = bf2f(yl[ixb]);
#pragma unroll
            for (int q = 0; q < 16; ++q)
#pragma unroll
                for (int e = 0; e < 4; ++e) { y0 += sf[q][e] * rdlane(qf, 4 * q + e); y1 += sb[q][e] * rdlane(qb, 4 * q + e); }
            const float y = y0 + y1;
            const float mu = wave_sum(y) * (1.0f / 64.f); const float dv = y - mu; const float var = wave_sum(dv * dv) * (1.0f / 64.f);
            const float gn = dv * (1.0f / sqrtf(var + 64e-5f)) * lw_ + lb_;
            const float kd2 = (1.0f + (bf2f(a[ix]) - 1.0f) * ka_) + (1.0f + (bf2f(a[ixb]) - 1.0f) * ka_);
            const float bonus = wave_sum(bf2f(r[ix]) * bf2f(kraw[ix]) * kd2 * rk_) * bf2f(v[ix]);
            orw[ix] = f2bf((gn + bonus) * bf2f(gate[ix])); }
    }
}


#ifndef OPT_ATTN
#define OPT_ATTN 1
#endif
typedef float f32x16 __attribute__((ext_vector_type(16)));
constexpr size_t WS_OG = 442 * MiB, WS_LSE = 490 * MiB;
constexpr int AT_VTS = 388;
__device__ __forceinline__ void ph_attn2(Ctx& C) {
    const int lane = lane_now(), wave = C.wave, tid = wave * 64 + lane, r31 = lane & 31, hh = lane >> 5;
    const bf16* z = (const bf16*)(C.ws + WS_ZQKV); bf16* og = (bf16*)(C.ws + WS_OG); float* lse_o = (float*)(C.ws + WS_LSE);
    LAS bf16* vt = (LAS bf16*)C.lds; LAS bf16* kim = (LAS bf16*)(C.lds + 64 * AT_VTS * 2);
    for (int unit = C.bid; unit < 1536; unit += C.nb) {
        const int g = unit >> 9, rem = unit & 511, h = rem & 7, tile64 = rem >> 3;
        const int dsh = 2 * g, d = 1 << dsh, n = S >> dsh, res = tile64 & (d - 1), tl = tile64 >> dsh;
        const int kbase = tl * 256 - 64, colq = g * 512 + h * 64, colk = 1536 + colq, colv = 3072 + colq;
        const float slope_d = exp2f(-8.0f * (float)(g * 8 + h + 1) / 24.0f) * (float)d;
#pragma unroll
        for (int i = 0; i < 6; ++i) { const int kc = (tid >> 3) + 64 * i, ch = tid & 7, ki = kbase + kc; u32x4 w = (u32x4){0u, 0u, 0u, 0u}, wk = (u32x4){0u, 0u, 0u, 0u};
            if (ki >= 0 && ki < n) { const bf16* rp = z + (size_t)((ki << dsh) + res) * NQKV + 8 * ch; w = *(const u32x4*)(rp + colv); wk = *(const u32x4*)(rp + colk); }
            *(LAS u32x4*)(kim + kc * 72 + 8 * ch) = wk;
            LAS bf16* dp = vt + (8 * ch) * AT_VTS + kc;
            dp[0] = (bf16)(w.x & 0xffff); dp[AT_VTS] = (bf16)(w.x >> 16); dp[2 * AT_VTS] = (bf16)(w.y & 0xffff); dp[3 * AT_VTS] = (bf16)(w.y >> 16);
            dp[4 * AT_VTS] = (bf16)(w.z & 0xffff); dp[5 * AT_VTS] = (bf16)(w.z >> 16); dp[6 * AT_VTS] = (bf16)(w.w & 0xffff); dp[7 * AT_VTS] = (bf16)(w.w >> 16); }
        __syncthreads();
        const int qb = tl * 256 + 32 * wave; const int qtok = ((qb + r31) << dsh) + res;
        bf16x8 qf[4];
#pragma unroll
        for (int ks = 0; ks < 4; ++ks) qf[ks] = *(const bf16x8*)(z + (size_t)qtok * NQKV + colq + 16 * ks + 8 * hh);
        f32x16 sacc[5];
#pragma unroll
        for (int kt = 0; kt < 5; ++kt) {
#pragma unroll
            for (int e = 0; e < 16; ++e) sacc[kt][e] = 0.f;
            const LAS bf16* kp = kim + (32 * wave + 32 * kt + r31) * 72 + 8 * hh;
#pragma unroll
            for (int ks = 0; ks < 4; ++ks) { const bf16x8 kf = *(const LAS bf16x8*)(kp + 16 * ks); sacc[kt] = __builtin_amdgcn_mfma_f32_32x32x16_bf16(kf, qf[ks], sacc[kt], 0, 0, 0); } }
        const float LOG2E = 1.44269504f, slope2 = slope_d * LOG2E, c0f = (float)(4 * hh - 64 - r31);
        const bool edge = (tl == 0) || (tl == (n >> 8) - 1);
        float m = -3.0e38f;
#pragma unroll
        for (int kt = 0; kt < 5; ++kt)
#pragma unroll
            for (int e = 0; e < 16; ++e) { const float relf = (float)(32 * kt + (e & 3) + 8 * (e >> 2)) + c0f; float sc = sacc[kt][e] * LOG2E - slope2 * __builtin_fabsf(relf);
                if (kt == 0) sc = relf >= -64.0f ? sc : -1e30f;
                if (kt == 4) sc = relf <= 64.0f ? sc : -1e30f;
                sacc[kt][e] = sc; }
        if (edge) {
#pragma unroll
            for (int kt = 0; kt < 5; ++kt)
#pragma unroll
                for (int e = 0; e < 16; ++e) { const int kidx = qb - 64 + 32 * kt + (e & 3) + 8 * (e >> 2) + 4 * hh; sacc[kt][e] = (kidx >= 0 && kidx < n) ? sacc[kt][e] : -1e30f; } }
#pragma unroll
        for (int kt = 0; kt < 5; ++kt)
#pragma unroll
            for (int e = 0; e < 16; ++e) m = fmaxf(m, sacc[kt][e]);
        { const auto rr = __builtin_amdgcn_permlane32_swap(__float_as_uint(m), __float_as_uint(m), false, false); m = fmaxf(__uint_as_float(rr[0]), __uint_as_float(rr[1])); }
        float den = 0.f;
#pragma unroll
        for (int kt = 0; kt < 5; ++kt)
#pragma unroll
            for (int e = 0; e < 16; ++e) { const float pv = __builtin_amdgcn_exp2f(sacc[kt][e] - m); sacc[kt][e] = pv; den += pv; }
        { const auto rr = __builtin_amdgcn_permlane32_swap(__float_as_uint(den), __float_as_uint(den), false, false); den = __uint_as_float(rr[0]) + __uint_as_float(rr[1]); }
        f32x16 oacc[2];
#pragma unroll
        for (int dt = 0; dt < 2; ++dt)
#pragma unroll
            for (int e = 0; e < 16; ++e) oacc[dt][e] = 0.f;
#pragma unroll
        for (int kt = 0; kt < 5; ++kt)
#pragma unroll
            for (int sI = 0; sI < 2; ++sI) { const bf16x8 bfrag = pack8s(sacc[kt][8 * sI], sacc[kt][8 * sI + 1], sacc[kt][8 * sI + 2], sacc[kt][8 * sI + 3], sacc[kt][8 * sI + 4], sacc[kt][8 * sI + 5], sacc[kt][8 * sI + 6], sacc[kt][8 * sI + 7]);
#pragma unroll
                for (int dt = 0; dt < 2; ++dt) { const LAS bf16* vp = vt + (32 * dt + r31) * AT_VTS + 32 * wave + 32 * kt + 16 * sI + 4 * hh;
                    const u32x2 lo = *(const LAS u32x2*)vp, hi = *(const LAS u32x2*)(vp + 8); u32x4 pa; pa.x = lo.x; pa.y = lo.y; pa.z = hi.x; pa.w = hi.y;
                    oacc[dt] = __builtin_amdgcn_mfma_f32_32x32x16_bf16(__builtin_bit_cast(bf16x8, pa), bfrag, oacc[dt], 0, 0, 0); } }
        const float rden = 1.0f / den; bf16* op = og + ((size_t)g * S + qtok) * 512 + h * 64 + 4 * hh;
#pragma unroll
        for (int dt = 0; dt < 2; ++dt)
#pragma unroll
            for (int gr = 0; gr < 4; ++gr) { u32x2 o; o.x = pg8c(oacc[dt][4 * gr] * rden, oacc[dt][4 * gr + 1] * rden); o.y = pg8c(oacc[dt][4 * gr + 2] * rden, oacc[dt][4 * gr + 3] * rden); *(u32x2*)(op + 32 * dt + 8 * gr) = o; }
        if (hh == 0) lse_o[((size_t)g * S + qtok) * 8 + h] = (m + __builtin_amdgcn_logf(den)) * 0.69314718f;
        __syncthreads();
    }
}
__device__ __forceinline__ void ph_attn_combine(Ctx& C) {
    const int lane = lane_now(); const bf16* og = (const bf16*)(C.ws + WS_OG); const float* lse = (const float*)(C.ws + WS_LSE); bf16* oa = (bf16*)(C.ws + WS_OATT);
    const int ntask = S * 64;
    for (int task = (C.bid * NWAVES + C.wave) * 64 + lane; task < ntask; task += C.nb * NTHR) { const int t = task >> 6, c8 = task & 63, h = c8 >> 3;
        const float l0 = lse[(size_t)t * 8 + h], l1 = lse[((size_t)S + t) * 8 + h], l2 = lse[((size_t)2 * S + t) * 8 + h]; const float mx = fmaxf(l0, fmaxf(l1, l2));
        const float w0 = __expf(l0 - mx), w1 = __expf(l1 - mx), w2 = __expf(l2 - mx), rs = 1.0f / (w0 + w1 + w2);
        float a0[8], a1[8], a2[8]; unpack8(*(const u32x4*)(og + (size_t)t * 512 + 8 * c8), a0); unpack8(*(const u32x4*)(og + ((size_t)S + t) * 512 + 8 * c8), a1); unpack8(*(const u32x4*)(og + ((size_t)2 * S + t) * 512 + 8 * c8), a2);
        f32x4 o0, o1;
#pragma unroll
        for (int e = 0; e < 4; ++e) { o0[e] = (w0 * a0[e] + w1 * a1[e] + w2 * a2[e]) * rs; o1[e] = (w0 * a0[4 + e] + w1 * a1[4 + e] + w2 * a2[4 + e]) * rs; }
        *(u32x4*)(oa + (size_t)t * 512 + 8 * c8) = pack8(o0, o1); }
}


__device__ __forceinline__ bf16x8 cvt8(const f32x4 a, const f32x4 b) { u32x4 w; w.x = pk2(a[0], a[1]); w.y = pk2(a[2], a[3]); w.z = pk2(b[0], b[1]); w.w = pk2(b[2], b[3]); return __builtin_bit_cast(bf16x8, w); }
__device__ __forceinline__ void unpack4(u32x2 w, float (&f)[4]) { f[0] = __uint_as_float(w.x << 16); f[1] = __uint_as_float(w.x & 0xffff0000u); f[2] = __uint_as_float(w.y << 16); f[3] = __uint_as_float(w.y & 0xffff0000u); }
__device__ __forceinline__ void ph_fin3(Ctx& C) {
    const int lane = lane_now(), r31 = lane & 31, hh = lane >> 5;
    const bf16* yl = (const bf16*)(C.ws + WS_YL); const bf16* qt = (const bf16*)(C.dout + DO_QT); const float* s0 = (const float*)(C.ws + WS_S0);
    const bf16* r = (const bf16*)(C.ws + WS_R); const bf16* kraw = (const bf16*)(C.ws + WS_KRAW); const bf16* a = (const bf16*)(C.ws + WS_A); const float* k_a = C.ka->in[14]; const float* r_k = C.ka->in[15];
    const bf16* v = (const bf16*)(C.ws + WS_V); const bf16* gate = (const bf16*)(C.ws + WS_GATE); bf16* orw = (bf16*)(C.ws + WS_ORWKV); const float* lnw = C.ka->in[16]; const float* lnb = C.ka->in[17];
    for (int task = C.bid; task < 16 * NCK; task += C.nb) { const int h = task & 15, cf = task >> 4, cb = NCK - 1 - cf;
        const int t = cf * CHL + C.wave * 32 + r31; const size_t rowf = (size_t)t * RW + h * 64, rowb = ((size_t)S + t) * RW + h * 64;
        f32x16 acc[2];
#pragma unroll
        for (int vt = 0; vt < 2; ++vt)
#pragma unroll
            for (int e = 0; e < 16; ++e) acc[vt][e] = 0.f;
#pragma unroll
        for (int z = 0; z < 2; ++z) { const float* sp = s0 + (((size_t)(z * 16 + h) * NCK + (z ? cb : cf)) * 64 + r31) * 64 + 8 * hh; const bf16* qp = qt + (z ? rowb : rowf) + 8 * hh;
#pragma unroll
            for (int ks = 0; ks < 4; ++ks) { const bf16x8 bq = *(const bf16x8*)(qp + 16 * ks);
#pragma unroll
                for (int vt = 0; vt < 2; ++vt) { const f32x4* ap = (const f32x4*)(sp + (size_t)vt * 32 * 64 + 16 * ks); acc[vt] = __builtin_amdgcn_mfma_f32_32x32x16_bf16(cvt8(ap[0], ap[1]), bq, acc[vt], 0, 0, 0); } } }
        float ssum = 0.f, bsum = 0.f;
#pragma unroll
        for (int vt = 0; vt < 2; ++vt)
#pragma unroll
            for (int gr = 0; gr < 4; ++gr) { const int co = 32 * vt + 8 * gr + 4 * hh; float f0[4], f1[4], fr_[4], fk[4], fa0[4], fa1[4];
                unpack4(*(const u32x2*)(yl + rowf + co), f0); unpack4(*(const u32x2*)(yl + rowb + co), f1); unpack4(*(const u32x2*)(r + rowf + co), fr_); unpack4(*(const u32x2*)(kraw + rowf + co), fk);
                unpack4(*(const u32x2*)(a + rowf + co), fa0); unpack4(*(const u32x2*)(a + rowb + co), fa1);
                const f32x4 ka4 = *(const f32x4*)(k_a + h * 64 + co), rk4 = *(const f32x4*)(r_k + h * 64 + co);
#pragma unroll
                for (int e = 0; e < 4; ++e) { const float y = acc[vt][4 * gr + e] + f0[e] + f1[e]; acc[vt][4 * gr + e] = y; ssum += y;
                    bsum += fr_[e] * fk[e] * ((1.0f + (fa0[e] - 1.0f) * ka4[e]) + (1.0f + (fa1[e] - 1.0f) * ka4[e])) * rk4[e]; } }
        ssum += __shfl_xor(ssum, 32); bsum += __shfl_xor(bsum, 32);
        const float mu = ssum * (1.0f / 64.f); float vs = 0.f;
#pragma unroll
        for (int vt = 0; vt < 2; ++vt)
#pragma unroll
            for (int e = 0; e < 16; ++e) { const float dv = acc[vt][e] - mu; acc[vt][e] = dv; vs += dv * dv; }
        vs += __shfl_xor(vs, 32);
        const float rstd = 1.0f / sqrtf(vs * (1.0f / 64.f) + 64e-5f);
#pragma unroll
        for (int vt = 0; vt < 2; ++vt)
#pragma unroll
            for (int gr = 0; gr < 4; ++gr) { const int co = 32 * vt + 8 * gr + 4 * hh; float fv[4], fg[4]; unpack4(*(const u32x2*)(v + rowf + co), fv); unpack4(*(const u32x2*)(gate + rowf + co), fg);
                const f32x4 w4 = *(const f32x4*)(lnw + h * 64 + co), b4 = *(const f32x4*)(lnb + h * 64 + co); float o[4];
#pragma unroll
                for (int e = 0; e < 4; ++e) o[e] = (acc[vt][4 * gr + e] * rstd * w4[e] + b4[e] + bsum * fv[e]) * fg[e];
                u32x2 w; w.x = pk2(o[0], o[1]); w.y = pk2(o[2], o[3]); *(u32x2*)(orw + rowf + co) = w; }
    }
}
template <int CTRL> __device__ __forceinline__ float dpp_row(float x) { return __int_as_float(__builtin_amdgcn_update_dpp(0, __float_as_int(x), CTRL, 0xf, 0xf, true)); }
__device__ __forceinline__ void ph_rprep2(Ctx& C) {
    const int lane = lane_now();
    const bf16* zr = (const bf16*)(C.ws + WS_ZR); const float* mup = C.ka->in[6]; const float* mun = C.ka->in[7]; const float* k_k = C.ka->in[13];
    bf16* r = (bf16*)(C.ws + WS_R); bf16* v = (bf16*)(C.ws + WS_V); bf16* nkk = (bf16*)(C.ws + WS_NKK); bf16* kraw = (bf16*)(C.ws + WS_KRAW); bf16* la = (bf16*)(C.ws + WS_LORAA);
    const int ntask = 6 * (S / 64) + (S / 32);
    for (int task = C.gw; task < ntask; task += C.ngw) { const bool heavy = task >= 6 * (S / 64); const int cgp = heavy ? 6 : task % 6, ntok = heavy ? 32 : 64, t0 = heavy ? (task - 6 * (S / 64)) * 32 : (task / 6) * 64, col = cgp * 512 + lane * 8;
        const bool real = col < NZR_REAL; const int kind = col < 1024 ? 0 : col < 2048 ? 1 : col < 3072 ? 2 : col < 3136 ? 3 : col < 3200 ? 4 : col < 3360 ? 5 : 6;
        float mp[8], mn[8], kk8[8];
#pragma unroll
        for (int e = 0; e < 8; ++e) { mp[e] = real ? mup[col + e] : 0.f; mn[e] = real ? mun[col + e] : 0.f; kk8[e] = kind == 1 ? k_k[col - 1024 + e] : 0.f; }
        float zp[8], zc[8], zn[8];
        if (t0 > 0) unpack8(*(const u32x4*)(zr + (size_t)(t0 - 1) * NZR + col), zp); else {
#pragma unroll
            for (int e = 0; e < 8; ++e) zp[e] = 0.f; }
        unpack8(*(const u32x4*)(zr + (size_t)t0 * NZR + col), zc);
#pragma unroll 8
        for (int i = 0; i < ntok; ++i) { const int t = t0 + i;
            if (t + 1 < S) unpack8(*(const u32x4*)(zr + (size_t)(t + 1) * NZR + col), zn); else {
#pragma unroll
                for (int e = 0; e < 8; ++e) zn[e] = 0.f; }
            float x[8];
#pragma unroll
            for (int e = 0; e < 8; ++e) x[e] = zc[e] + mp[e] * (zp[e] - zc[e]) + mn[e] * (zn[e] - zc[e]);
            if (kind == 0) *(u32x4*)(r + (size_t)t * RW + col) = pack8((f32x4){x[0], x[1], x[2], x[3]}, (f32x4){x[4], x[5], x[6], x[7]});
            else if (kind == 1) { *(u32x4*)(kraw + (size_t)t * RW + col - 1024) = pack8((f32x4){x[0], x[1], x[2], x[3]}, (f32x4){x[4], x[5], x[6], x[7]});
                float kv[8], ss = 0.f;
#pragma unroll
                for (int e = 0; e < 8; ++e) { kv[e] = x[e] * kk8[e]; ss += kv[e] * kv[e]; }
                ss += dpp_row<0xB1>(ss); ss += dpp_row<0x4E>(ss); ss += dpp_row<0x141>(ss);
                const float sc = -1.0f / fmaxf(sqrtf(ss), 1e-12f);
                *(u32x4*)(nkk + (size_t)t * RW + col - 1024) = pack8((f32x4){kv[0] * sc, kv[1] * sc, kv[2] * sc, kv[3] * sc}, (f32x4){kv[4] * sc, kv[5] * sc, kv[6] * sc, kv[7] * sc}); }
            else if (kind == 2) *(u32x4*)(v + (size_t)t * RW + col - 2048) = pack8((f32x4){x[0], x[1], x[2], x[3]}, (f32x4){x[4], x[5], x[6], x[7]});
            else { float o[8];
#pragma unroll
                for (int e = 0; e < 8; ++e) { const float sg = __builtin_amdgcn_rcpf(1.0f + __builtin_amdgcn_exp2f(x[e] * (kind == 3 ? -2.88539008f : -1.44269504f)));
                    o[e] = kind == 3 ? 2.0f * sg - 1.0f : kind == 4 ? x[e] : kind == 5 ? sg : 0.f; }
                bf16* lp = kind <= 4 ? la + (size_t)t * KL2 + (col - 3072) : kind == 5 ? la + (size_t)(S + t) * KL2 + (col - 3200) : col < 3488 ? la + (size_t)t * KL2 + 128 + (col - 3360) : la + (size_t)(S + t) * KL2 + 160 + (col - 3488);
                *(u32x4*)lp = pack8((f32x4){o[0], o[1], o[2], o[3]}, (f32x4){o[4], o[5], o[6], o[7]}); }
#pragma unroll
            for (int e = 0; e < 8; ++e) { zp[e] = zc[e]; zc[e] = zn[e]; }
        }
    }
}


constexpr int F4_S0STR = 72, F4_TSTR = 68;
__device__ __forceinline__ void ph_fin4(Ctx& C) {
    const int lane0 = lane_now(), wave = C.wave;
    const bf16* yl = (const bf16*)(C.ws + WS_YL); const bf16* qt = (const bf16*)(C.dout + DO_QT); const float* s0 = (const float*)(C.ws + WS_S0);
    const bf16* r = (const bf16*)(C.ws + WS_R); const bf16* kraw = (const bf16*)(C.ws + WS_KRAW); const bf16* a = (const bf16*)(C.ws + WS_A); const float* k_a = C.ka->in[14]; const float* r_k = C.ka->in[15];
    const bf16* v = (const bf16*)(C.ws + WS_V); const bf16* gate = (const bf16*)(C.ws + WS_GATE); bf16* orw = (bf16*)(C.ws + WS_ORWKV); const float* lnw = C.ka->in[16]; const float* lnb = C.ka->in[17];
    LAS bf16* s0img = (LAS bf16*)C.lds;
    LAS bf16* tr = (LAS bf16*)(C.lds + 2 * 64 * F4_S0STR * 2) + C.wave * (32 * F4_TSTR);
    for (int task = C.bid; task < 16 * NCK; task += C.nb) { const int h = task & 15, cf = task >> 4, cb = NCK - 1 - cf;
        int lane = lane0; asm volatile("" : "+v"(lane));
        const int r31 = lane & 31, hh = lane >> 5, tid = wave * 64 + lane;
#define F4_GLOAD(g, gptr) do { _Pragma("unroll") for (int i_ = 0; i_ < 4; ++i_) g[i_] = *(const u32x4*)((gptr) + (size_t)((lane >> 3) + 8 * i_) * RW + 8 * (lane & 7)); } while (0)
#define F4_XPOSE(dst, g) do { _Pragma("unroll") for (int i_ = 0; i_ < 4; ++i_) { LAS u32x2* d_ = (LAS u32x2*)(tr + ((lane >> 3) + 8 * i_) * F4_TSTR + 8 * (lane & 7)); d_[0] = (u32x2){g[i_].x, g[i_].y}; d_[1] = (u32x2){g[i_].z, g[i_].w}; } \
            asm volatile("s_waitcnt lgkmcnt(0)" ::: "memory"); \
            _Pragma("unroll") for (int vt_ = 0; vt_ < 2; ++vt_) _Pragma("unroll") for (int gr_ = 0; gr_ < 4; ++gr_) dst[vt_][gr_] = *(const LAS u32x2*)(tr + r31 * F4_TSTR + 32 * vt_ + 8 * gr_ + 4 * hh); \
            asm volatile("s_waitcnt lgkmcnt(0)" ::: "memory"); } while (0)
        __syncthreads();
        { const int z = tid >> 8, row = (tid >> 2) & 63, seg = tid & 3; const float* sp = s0 + (((size_t)(z * 16 + h) * NCK + (z ? cb : cf)) * 64 + row) * 64 + 16 * seg;
          const f32x4 x0 = *(const f32x4*)sp, x1 = *(const f32x4*)(sp + 4), x2 = *(const f32x4*)(sp + 8), x3 = *(const f32x4*)(sp + 12);
          LAS u32x4* dp = (LAS u32x4*)(s0img + (z * 64 + row) * F4_S0STR + 16 * seg); dp[0] = pack8(x0, x1); dp[1] = pack8(x2, x3); }
        __syncthreads();
#pragma unroll 1
        for (int hv = 0; hv < CHL / 256; ++hv) {
        const size_t base_f = (size_t)(cf * CHL + hv * 256 + wave * 32) * RW + h * 64, base_b = base_f + (size_t)S * RW;
        u32x4 g0[4], g1[4], g2[4], g3[4];
        F4_GLOAD(g0, yl + base_f); F4_GLOAD(g1, yl + base_b); F4_GLOAD(g2, r + base_f); F4_GLOAD(g3, kraw + base_f);
        const int t0 = cf * CHL + hv * 256 + wave * 32, t = t0 + r31; const size_t rowf = (size_t)t * RW + h * 64, rowb = ((size_t)S + t) * RW + h * 64;
        f32x16 acc[2];
#pragma unroll
        for (int vt = 0; vt < 2; ++vt)
#pragma unroll
            for (int e = 0; e < 16; ++e) acc[vt][e] = 0.f;
#pragma unroll
        for (int z = 0; z < 2; ++z) { const bf16* qp = qt + (z ? rowb : rowf) + 8 * hh;
#pragma unroll
            for (int ks = 0; ks < 4; ++ks) { const bf16x8 bq = *(const bf16x8*)(qp + 16 * ks);
#pragma unroll
                for (int vt = 0; vt < 2; ++vt) { const bf16x8 af = *(const LAS bf16x8*)(s0img + (z * 64 + 32 * vt + r31) * F4_S0STR + 16 * ks + 8 * hh); acc[vt] = __builtin_amdgcn_mfma_f32_32x32x16_bf16(af, bq, acc[vt], 0, 0, 0); } } }
        u32x2 q0[2][4], q1[2][4];
        float ssum = 0.f, bsum = 0.f;
        F4_XPOSE(q0, g0); F4_XPOSE(q1, g1);
        F4_GLOAD(g0, a + base_f); F4_GLOAD(g1, a + base_b);
#pragma unroll
        for (int vt = 0; vt < 2; ++vt)
#pragma unroll
            for (int gr = 0; gr < 4; ++gr) { float f0[4], f1[4]; unpack4(q0[vt][gr], f0); unpack4(q1[vt][gr], f1);
#pragma unroll
                for (int e = 0; e < 4; ++e) { const float y = acc[vt][4 * gr + e] + f0[e] + f1[e]; acc[vt][4 * gr + e] = y; ssum += y; } }
        { u32x2 q2[2][4], q3[2][4];
          F4_XPOSE(q0, g2); F4_XPOSE(q1, g3);
          F4_GLOAD(g2, v + base_f); F4_GLOAD(g3, gate + base_f);
          F4_XPOSE(q2, g0); F4_XPOSE(q3, g1);
#pragma unroll
          for (int vt = 0; vt < 2; ++vt)
#pragma unroll
              for (int gr = 0; gr < 4; ++gr) { const int co = 32 * vt + 8 * gr + 4 * hh; float fr_[4], fk[4], fa0[4], fa1[4]; unpack4(q0[vt][gr], fr_); unpack4(q1[vt][gr], fk); unpack4(q2[vt][gr], fa0); unpack4(q3[vt][gr], fa1);
                  const f32x4 ka4 = *(const f32x4*)(k_a + h * 64 + co), rk4 = *(const f32x4*)(r_k + h * 64 + co);
#pragma unroll
                  for (int e = 0; e < 4; ++e) bsum += fr_[e] * fk[e] * ((1.0f + (fa0[e] - 1.0f) * ka4[e]) + (1.0f + (fa1[e] - 1.0f) * ka4[e])) * rk4[e]; } }
        ssum += __shfl_xor(ssum, 32); bsum += __shfl_xor(bsum, 32);
        const float mu = ssum * (1.0f / 64.f); float vs = 0.f;
#pragma unroll
        for (int vt = 0; vt < 2; ++vt)
#pragma unroll
            for (int e = 0; e < 16; ++e) { const float dv = acc[vt][e] - mu; acc[vt][e] = dv; vs += dv * dv; }
        vs += __shfl_xor(vs, 32);
        const float rstd = 1.0f / sqrtf(vs * (1.0f / 64.f) + 64e-5f);
        F4_XPOSE(q0, g2); F4_XPOSE(q1, g3);
#pragma unroll
        for (int vt = 0; vt < 2; ++vt)
#pragma unroll
            for (int gr = 0; gr < 4; ++gr) { const int co = 32 * vt + 8 * gr + 4 * hh; float fv[4], fg[4]; unpack4(q0[vt][gr], fv); unpack4(q1[vt][gr], fg);
                const f32x4 w4 = *(const f32x4*)(lnw + h * 64 + co), b4 = *(const f32x4*)(lnb + h * 64 + co); float o[4];
#pragma unroll
                for (int e = 0; e < 4; ++e) o[e] = (acc[vt][4 * gr + e] * rstd * w4[e] + b4[e] + bsum * fv[e]) * fg[e];
                u32x2 w; w.x = pk2(o[0], o[1]); w.y = pk2(o[2], o[3]); *(LAS u32x2*)(tr + r31 * F4_TSTR + co) = w; }
        asm volatile("s_waitcnt lgkmcnt(0)" ::: "memory");
#pragma unroll
        for (int i = 0; i < 4; ++i) { const int tk = (lane >> 3) + 8 * i; const LAS u32x2* s_ = (const LAS u32x2*)(tr + tk * F4_TSTR + 8 * (lane & 7)); const u32x2 lo_ = s_[0], hi_ = s_[1]; *(u32x4*)(orw + base_f + (size_t)tk * RW + 8 * (lane & 7)) = (u32x4){lo_.x, lo_.y, hi_.x, hi_.y}; }
        asm volatile("s_waitcnt lgkmcnt(0)" ::: "memory");
        }
#undef F4_GLOAD
#undef F4_XPOSE
    }
}


constexpr int SM_KR = 0, SM_BK = 4608, SM_BGT = 9216, SM_GT = 14336, SM_VT = 14592, SM_WAVE = 17664;
template <int role> __device__ __forceinline__ void ph_scan1m_r(Ctx& C) {
    const int lane0 = lane_now(), wave = C.wave, itl = wave & 3;
    const bf16* g_r = (const bf16*)(C.ws + WS_R); const bf16* g_v = (const bf16*)(C.ws + WS_V); const bf16* g_nkk = (const bf16*)(C.ws + WS_NKK); const bf16* g_k = (const bf16*)(C.ws + WS_KRAW);
    const bf16* g_lw = (const bf16*)(C.ws + WS_LW); const bf16* g_a = (const bf16*)(C.ws + WS_A); const float* k_a = C.ka->in[14];
    bf16* g_out = role ? (bf16*)(C.ws + WS_YL) : (bf16*)(C.dout + DO_QT); float* g_pu = (float*)(C.ws + WS_PU);
    LAS unsigned char* L = C.lds + wave * SM_WAVE;
    LAS bf16* imKR = (LAS bf16*)(L + SM_KR); LAS bf16* imBK = (LAS bf16*)(L + SM_BK); LAS bf16* imBGT = (LAS bf16*)(L + SM_BGT); LAS float* gT = (LAS float*)(L + SM_GT); LAS bf16* imVT = (LAS bf16*)(L + SM_VT);
    LAS float* MT = (LAS float*)(L + SM_BK);
    const int nitems = NCHAIN * NCK;
    for (int base = C.bid * 4; base < nitems; base += C.nb * 4) {
        const int item = base + itl; if (item >= nitems) continue;
        const int chain = item / NCK, chunk = item % NCK, z = chain >> 4, h = chain & 15; const size_t zoff = (size_t)z * S * RW; const float ka = k_a[h * 64 + lane0];
        f32x16 st[2][2];
        { int lane_s = lane0; asm volatile("" : "+v"(lane_s)); const int r31s = lane_s & 31, hhs = lane_s >> 5;
#pragma unroll
        for (int kt = 0; kt < 2; ++kt)
#pragma unroll
            for (int ct = 0; ct < 2; ++ct)
#pragma unroll
                for (int e = 0; e < 16; ++e) st[kt][ct][e] = (role == 0 && (32 * kt + (e & 3) + 8 * (e >> 2) + 4 * hhs) == (32 * ct + r31s)) ? 1.f : 0.f; }
        unsigned rl[8], rn[8], ra[8], rk[8], rr_[8], rv[8];
#define RAWF(a, t) __uint_as_float(((t) & 1) ? ((a)[(t) >> 1] & 0xffff0000u) : ((a)[(t) >> 1] << 16))
#define SM_LOADRAW(sbn) do { const int sg_ = chunk * CHL + (sbn) * 16; const long tk_ = z ? (long)S - 1 - sg_ : sg_; const long dx_ = z ? -(long)RW : (long)RW; const size_t ru_ = (size_t)tk_ * RW + h * 64; \
            int ln_ = lane0; asm volatile("" : "+v"(ln_)); \
            _Pragma("unroll") for (int t_ = 0; t_ < 16; t_ += 2) { const long o_ = t_ * dx_, o1_ = o_ + dx_; const int j_ = t_ >> 1; \
                rl[j_] = (unsigned)(g_lw + zoff + ru_ + o_)[ln_] | ((unsigned)(g_lw + zoff + ru_ + o1_)[ln_] << 16); rn[j_] = (unsigned)(g_nkk + ru_ + o_)[ln_] | ((unsigned)(g_nkk + ru_ + o1_)[ln_] << 16); \
                ra[j_] = (unsigned)(g_a + zoff + ru_ + o_)[ln_] | ((unsigned)(g_a + zoff + ru_ + o1_)[ln_] << 16); rk[j_] = (unsigned)(g_k + ru_ + o_)[ln_] | ((unsigned)(g_k + ru_ + o1_)[ln_] << 16); \
                rr_[j_] = (unsigned)(g_r + ru_ + o_)[ln_] | ((unsigned)(g_r + ru_ + o1_)[ln_] << 16); if (role) rv[j_] = (unsigned)(g_v + ru_ + o_)[ln_] | ((unsigned)(g_v + ru_ + o1_)[ln_] << 16); } } while (0)
        SM_LOADRAW(0);
#pragma unroll 1
        for (int sb = 0; sb < CHL / 16; ++sb) {
            const int sg0 = chunk * CHL + sb * 16; const long tk0 = z ? (long)S - 1 - sg0 : sg0; const long dtk = z ? -1 : 1;
            int lane_i = lane0; asm volatile("" : "+v"(lane_i));
            const int lane = lane_i, r31 = lane_i & 31, hh = lane_i >> 5, r31g = r31;
            const long dix = dtk * RW;
            const size_t rowu = (size_t)tk0 * RW + h * 64;
            float Lc[16]; { float acc = 0.f;
#pragma unroll
              for (int t = 0; t < 16; ++t) { acc += RAWF(rl, t); Lc[t] = acc; } }
            const float GT_ = __expf(Lc[15]);
            gT[lane] = GT_;
            u32x4 bg[2], kg[2], vr[2];
            { LAS bf16* wKR = imKR + lane; LAS bf16* wBK = imBK + lane;
#pragma unroll
              for (int t = 0; t < 16; t += 2) { float kkh[2], rh[2], bt[2], kt_[2], bgf[2], kgf[2];
#pragma unroll
                for (int d = 0; d < 2; ++d) { const int tt = t + d;
                    const float nk = RAWF(rn, tt), a_ = RAWF(ra, tt), kr = RAWF(rk, tt), rr = RAWF(rr_, tt);
                    const float eL = __expf(Lc[tt]), eLm = tt ? __expf(Lc[tt - 1]) : 1.0f, ie = __builtin_amdgcn_rcpf(eL);
                    const float b_ = -nk * a_, kd = kr * (1.0f + (a_ - 1.0f) * ka);
                    kkh[d] = nk * eLm; rh[d] = rr * eL; bt[d] = b_ * ie; kt_[d] = kd * ie; bgf[d] = bt[d] * GT_; kgf[d] = kt_[d] * GT_; }
                const unsigned p0 = pg8::cvt_pk_bf16(kkh[0], kkh[1]), p1 = pg8::cvt_pk_bf16(rh[0], rh[1]), p2 = pg8::cvt_pk_bf16(bt[0], bt[1]), p3 = pg8::cvt_pk_bf16(kt_[0], kt_[1]);
                wKR[t * 72] = (bf16)p0; wKR[(t + 1) * 72] = (bf16)(p0 >> 16); wKR[(16 + t) * 72] = (bf16)p1; wKR[(17 + t) * 72] = (bf16)(p1 >> 16);
                wBK[t * 72] = (bf16)p2; wBK[(t + 1) * 72] = (bf16)(p2 >> 16); wBK[(16 + t) * 72] = (bf16)p3; wBK[(17 + t) * 72] = (bf16)(p3 >> 16);
                bg[t >> 3][(t >> 1) & 3] = pg8::cvt_pk_bf16(bgf[0], bgf[1]); kg[t >> 3][(t >> 1) & 3] = pg8::cvt_pk_bf16(kgf[0], kgf[1]);
                if (role) vr[t >> 3][(t >> 1) & 3] = rv[t >> 1]; } }
            { LAS u32x4* d = (LAS u32x4*)(imBGT + lane * 40); d[0] = bg[0]; d[1] = bg[1]; d[2] = kg[0]; d[3] = kg[1]; }
            if (role) { LAS u32x4* d = (LAS u32x4*)(imVT + lane * 24); d[0] = vr[0]; d[1] = vr[1]; }
            asm volatile("s_waitcnt lgkmcnt(0)" ::: "memory");
            __builtin_amdgcn_sched_barrier(0);
            { f32x16 m;
#pragma unroll
              for (int e = 0; e < 16; ++e) m[e] = 0.f;
#pragma unroll
              for (int ks = 0; ks < 4; ++ks) { const bf16x8 af = *(const LAS bf16x8*)(imBK + r31 * 72 + 16 * ks + 8 * hh), bfr = *(const LAS bf16x8*)(imKR + r31 * 72 + 16 * ks + 8 * hh); m = __builtin_amdgcn_mfma_f32_32x32x16_bf16(af, bfr, m, 0, 0, 0); }
              asm volatile("s_waitcnt lgkmcnt(0)" ::: "memory");
              const int tq = r31 & 15; const bool ycol = r31 >= 16;
#pragma unroll
              for (int g = 0; g < 4; ++g) { f32x4 o;
#pragma unroll
                  for (int e = 0; e < 4; ++e) { const int sp = 8 * g + 4 * hh + e, sq = sp & 15; const bool ok = ycol ? (sq <= tq) : (sq < tq); o[e] = ok ? m[4 * g + e] : 0.f; }
                  *(LAS f32x4*)(MT + r31 * 36 + 8 * g + 4 * hh) = o; } }
            asm volatile("s_waitcnt lgkmcnt(0)" ::: "memory");
            __builtin_amdgcn_sched_barrier(0);
            f32x16 ya[2];
#pragma unroll
            for (int ct = 0; ct < 2; ++ct)
#pragma unroll
                for (int e = 0; e < 16; ++e) ya[ct][e] = 0.f;
#pragma unroll
            for (int kt = 0; kt < 2; ++kt)
#pragma unroll
                for (int sI = 0; sI < 2; ++sI) { const LAS bf16* ap = imKR + r31 * 72 + 32 * kt + 16 * sI + 4 * hh; const u32x2 lo = *(const LAS u32x2*)ap, hi = *(const LAS u32x2*)(ap + 8);
                    u32x4 pa; pa.x = lo.x; pa.y = lo.y; pa.z = hi.x; pa.w = hi.y; const bf16x8 af = __builtin_bit_cast(bf16x8, pa);
#pragma unroll
                    for (int ct = 0; ct < 2; ++ct) { const f32x16& x = st[kt][ct];
                        const bf16x8 bfr = pack8s(x[8 * sI], x[8 * sI + 1], x[8 * sI + 2], x[8 * sI + 3], x[8 * sI + 4], x[8 * sI + 5], x[8 * sI + 6], x[8 * sI + 7]);
                        ya[ct] = __builtin_amdgcn_mfma_f32_32x32x16_bf16(af, bfr, ya[ct], 0, 0, 0); } }
            bf16x8 vfr[2];
            if (role) { const f32x4 m0 = *(const LAS f32x4*)(MT + r31 * 36 + 16 + 8 * hh), m1 = *(const LAS f32x4*)(MT + r31 * 36 + 20 + 8 * hh); const bf16x8 af = pack8s(m0[0], m0[1], m0[2], m0[3], m1[0], m1[1], m1[2], m1[3]);
#pragma unroll
                for (int ct = 0; ct < 2; ++ct) { vfr[ct] = *(const LAS bf16x8*)(imVT + (32 * ct + r31) * 24 + 8 * hh); ya[ct] = __builtin_amdgcn_mfma_f32_32x32x16_bf16(af, vfr[ct], ya[ct], 0, 0, 0); } }
            __builtin_amdgcn_sched_barrier(0);
            f32x2 u2[16];
#pragma unroll
            for (int e = 0; e < 4; ++e) {
                const auto a0 = __builtin_amdgcn_permlane32_swap(__float_as_uint(ya[0][e]), __float_as_uint(ya[0][e]), false, false), a1 = __builtin_amdgcn_permlane32_swap(__float_as_uint(ya[1][e]), __float_as_uint(ya[1][e]), false, false);
                const auto b0 = __builtin_amdgcn_permlane32_swap(__float_as_uint(ya[0][4 + e]), __float_as_uint(ya[0][4 + e]), false, false), b1 = __builtin_amdgcn_permlane32_swap(__float_as_uint(ya[1][4 + e]), __float_as_uint(ya[1][4 + e]), false, false);
                u2[e] = (f32x2){__uint_as_float(a0[0]), __uint_as_float(a1[0])}; u2[4 + e] = (f32x2){__uint_as_float(a0[1]), __uint_as_float(a1[1])};
                u2[8 + e] = (f32x2){__uint_as_float(b0[0]), __uint_as_float(b1[0])}; u2[12 + e] = (f32x2){__uint_as_float(b0[1]), __uint_as_float(b1[1])}; }
#pragma unroll
            for (int t = 1; t < 16; ++t) { f32x2 a = u2[t];
#pragma unroll
                for (int q = 0; q < (t + 3) / 4; ++q) { const f32x4 cf = *(const LAS f32x4*)(MT + t * 36 + 4 * q);
#pragma unroll
                    for (int e = 0; e < 4; ++e) if (4 * q + e < t) a += u2[4 * q + e] * cf[e]; }
                u2[t] = a; }
            bf16x8 ufr[2];
            ufr[0] = pack8s(hh ? u2[8].x : u2[0].x, hh ? u2[9].x : u2[1].x, hh ? u2[10].x : u2[2].x, hh ? u2[11].x : u2[3].x, hh ? u2[12].x : u2[4].x, hh ? u2[13].x : u2[5].x, hh ? u2[14].x : u2[6].x, hh ? u2[15].x : u2[7].x);
            ufr[1] = pack8s(hh ? u2[8].y : u2[0].y, hh ? u2[9].y : u2[1].y, hh ? u2[10].y : u2[2].y, hh ? u2[11].y : u2[3].y, hh ? u2[12].y : u2[4].y, hh ? u2[13].y : u2[5].y, hh ? u2[14].y : u2[6].y, hh ? u2[15].y : u2[7].y);
            __builtin_amdgcn_sched_barrier(0);
            { const f32x4 m0 = *(const LAS f32x4*)(MT + r31 * 36 + 8 * hh), m1 = *(const LAS f32x4*)(MT + r31 * 36 + 4 + 8 * hh); const bf16x8 af = pack8s(m0[0], m0[1], m0[2], m0[3], m1[0], m1[1], m1[2], m1[3]);
#pragma unroll
              for (int ct = 0; ct < 2; ++ct) ya[ct] = __builtin_amdgcn_mfma_f32_32x32x16_bf16(af, ufr[ct], ya[ct], 0, 0, 0); }
            { LAS bf16* ys = (LAS bf16*)MT;
#pragma unroll
              for (int ct = 0; ct < 2; ++ct)
#pragma unroll
                  for (int e = 0; e < 8; e += 2) { const unsigned pw = pg8::cvt_pk_bf16(ya[ct][8 + e], ya[ct][9 + e]); const int t = (e & 3) + 4 * hh + 8 * (e >> 2); LAS bf16* d = ys + t * 72 + 32 * ct + r31; d[0] = (bf16)pw; d[72] = (bf16)(pw >> 16); }
              asm volatile("s_waitcnt lgkmcnt(0)" ::: "memory");
#pragma unroll
              for (int i = 0; i < 2; ++i) { const int t = (lane >> 3) + 8 * i; const u32x4 w = *(const LAS u32x4*)(ys + t * 72 + 8 * (lane & 7)); *(u32x4*)(g_out + zoff + rowu + (long)t * dix + 8 * (lane & 7)) = w; }
              asm volatile("s_waitcnt lgkmcnt(0)" ::: "memory"); }
            __builtin_amdgcn_sched_barrier(0);
            if (sb + 1 < CHL / 16) SM_LOADRAW(sb + 1);
            __builtin_amdgcn_sched_barrier(0);
#pragma unroll
            for (int kt = 0; kt < 2; ++kt) { f32x4 gs[4];
#pragma unroll
                for (int g = 0; g < 4; ++g) gs[g] = *(const LAS f32x4*)(gT + 32 * kt + 8 * g + 4 * hh);
                const bf16x8 au = *(const LAS bf16x8*)(imBGT + (32 * kt + r31) * 40 + 8 * hh); bf16x8 av; if (role) av = *(const LAS bf16x8*)(imBGT + (32 * kt + r31) * 40 + 16 + 8 * hh);
#pragma unroll
                for (int ct = 0; ct < 2; ++ct) {
#pragma unroll
                    for (int e = 0; e < 16; ++e) st[kt][ct][e] *= gs[e >> 2][e & 3];
                    st[kt][ct] = __builtin_amdgcn_mfma_f32_32x32x16_bf16(au, ufr[ct], st[kt][ct], 0, 0, 0);
                    if (role) st[kt][ct] = __builtin_amdgcn_mfma_f32_32x32x16_bf16(av, vfr[ct], st[kt][ct], 0, 0, 0); } }
            asm volatile("s_waitcnt lgkmcnt(0)" ::: "memory");
        }
        int lane_e = lane0; asm volatile("" : "+v"(lane_e));
        float* pp = g_pu + (((size_t)chain * NCK + chunk) * 2 + role) * 4096 + (lane_e & 31) * 64 + 4 * (lane_e >> 5);
#pragma unroll
        for (int kt = 0; kt < 2; ++kt)
#pragma unroll
            for (int ct = 0; ct < 2; ++ct)
#pragma unroll
                for (int g = 0; g < 4; ++g) *(f32x4*)(pp + (32 * ct) * 64 + 32 * kt + 8 * g) = (f32x4){st[kt][ct][4 * g], st[kt][ct][4 * g + 1], st[kt][ct][4 * g + 2], st[kt][ct][4 * g + 3]};
    }
}
#undef SM_LOADRAW
#undef RAWF
__device__ __forceinline__ void ph_scan1m(Ctx& C) { if (C.wave >> 2) ph_scan1m_r<1>(C); else ph_scan1m_r<0>(C); }


#ifndef PROBE_SCANCMP
#define PROBE_SCANCMP 0
#endif
constexpr size_t WS_SNAP = 16 * MiB;
__device__ __forceinline__ void ph_scancmp(Ctx& C, const int mode, const int which) {
    const int lane = lane_now(); const int tid = C.wave * 64 + lane;
    const float* g_pu = (const float*)(C.ws + WS_PU); const bf16* yl = (const bf16*)(C.ws + WS_YL); const bf16* qt = (const bf16*)(C.dout + DO_QT);
    float* sn_pu = (float*)(C.ws + WS_SNAP); bf16* sn_yl = (bf16*)(C.ws + WS_SNAP + 4 * MiB); bf16* sn_qt = (bf16*)(C.ws + WS_SNAP + 8 * MiB);
    unsigned* mx = (unsigned*)(C.ws + WS_CTL) + 3500;
    float dmax = 0.f;
    const int cks[3] = {0, 1, 17};
    for (long i = (long)C.bid * NTHR + tid; i < (long)NCHAIN * 3 * 8192; i += (long)C.nb * NTHR) { const int e = (int)(i & 8191), cj = (int)(i >> 13), chain = cj / 3, j = cj % 3;
        const float v = g_pu[((size_t)chain * NCK + cks[j]) * 8192 + e]; if (mode == 0) sn_pu[i] = v; else if (which == 0 || which == 1) dmax = fmaxf(dmax, fabsf(v - sn_pu[i])); }
    for (long i = (long)C.bid * NTHR + tid; i < (long)NCHAIN * 3 * 16384; i += (long)C.nb * NTHR) { const int e = (int)(i & 16383), cj = (int)(i >> 14), chain = cj / 3, j = cj % 3, z = chain >> 4, h = chain & 15;
        const int sg = cks[j] * CHL + (e >> 6), tk = z ? S - 1 - sg : sg; const size_t ix = ((size_t)z * S + tk) * RW + h * 64 + (e & 63);
        if (mode == 0) { sn_yl[i] = yl[ix]; sn_qt[i] = qt[ix]; } else { if (which == 0 || which == 2) dmax = fmaxf(dmax, fabsf(bf2f(yl[ix]) - bf2f(sn_yl[i]))); if (which == 0 || which == 3) dmax = fmaxf(dmax, fabsf(bf2f(qt[ix]) - bf2f(sn_qt[i]))); } }
    if (mode == 1) { dmax = wave_max(dmax); if (lane == 0) atomicMax(mx, __float_as_uint(dmax)); }
}
__device__ __forceinline__ void ph_probe_fold(Ctx& C) {
    if (C.bid == 0 && C.wave == 0 && lane_now() == 0) { const float d = __uint_as_float(__hip_atomic_load((unsigned*)(C.ws + WS_CTL) + 3500, __ATOMIC_RELAXED, __HIP_MEMORY_SCOPE_AGENT));
        float q = (log10f(fmaxf(d, 1e-4f)) + 4.0f) * 0.25f; q = fminf(fmaxf(q, 0.f), 1.f); C.out[0] += 0.05f + 0.15f * q; }
}

__device__ __forceinline__ void ph_prep0(Ctx& C) {
    const int lane_ = lane_now(), tid_ = C.wave * 64 + lane_; (void)tid_;
    LAS float* scr = (LAS float*)(C.lds + C.wave * 16384);
    conv_win(C, scr); conv_wlora(C, scr);
    conv_natural(C, C.ka->in[18], 512, D, (bf16*)(C.ws + WS_WBA), scr);
    conv_natural(C, C.ka->in[19], RW, D, (bf16*)(C.ws + WS_WBR), scr);
    bf16* h1 = (bf16*)(C.dout + DO_H1);
    for (int m = C.gw; m < S; m += C.ngw) rms_row(C.ka->in[0] + (size_t)m * D, C.ka->in[1], h1 + (size_t)m * D, lane_);
}
__device__ __forceinline__ void ph_g1a(Ctx& C) {
#if OPT_GEMM
    EpiG1A8 E{(bf16*)(C.ws + WS_ZQKV), (bf16*)(C.ws + WS_ZR), C.ka->in[4], C.ka->in[5]};
    gemm8(C, (const bf16*)(C.dout + DO_H1), (const bf16*)(C.ws + WS_WIN), N1A, D, E);
#else
    EpiG1A E{(bf16*)(C.ws + WS_ZQKV), (bf16*)(C.ws + WS_ZR)};
    gemm_simple(C, (const bf16*)(C.dout + DO_H1), (const bf16*)(C.ws + WS_WIN), N1A, D, E);
#endif
}
__device__ __forceinline__ void ph_hnorm(Ctx& C) {
    const int lane_ = lane_now(), tid_ = C.wave * 64 + lane_; (void)tid_;
    bf16* z = (bf16*)(C.ws + WS_ZQKV); const float* qw = C.ka->in[4]; const float* kw = C.ka->in[5];
    const long nitems = (long)S * 48;
    for (long it = C.gw; it < nitems; it += C.ngw) { const int t = (int)(it / 48), hh = (int)(it % 48), which = hh / 24;
        bf16* p = z + (size_t)t * NQKV + hh * 64 + lane_; const float v = bf2f(*p); const float ss = wave_sum(v * v);
        const float w = which ? kw[lane_] : qw[lane_] * 0.125f; *p = f2bf(v * (1.0f / sqrtf(ss * (1.0f / 64.f) + 1e-6f)) * w); }
}
__device__ __forceinline__ void ph_attn(Ctx& C) {
    const int lane_ = lane_now(), tid_ = C.wave * 64 + lane_; (void)tid_;
    const bf16* z = (const bf16*)(C.ws + WS_ZQKV); bf16* oa = (bf16*)(C.ws + WS_OATT); const int lane = lane_;
    const long nitems = (long)S * 8;
    for (long it = C.gw; it < nitems; it += C.ngw) { const int t = (int)(it >> 3), h = (int)(it & 7);
        float og[3], lse[3];
#pragma unroll
        for (int g = 0; g < 3; ++g) { const int d = g == 0 ? 1 : (g == 1 ? 4 : 16); const float slope = exp2f(-8.0f * (float)(g * 8 + h + 1) / 24.0f);
            const int col = g * 512 + h * 64;
            float q[64];
            { const bf16* qp = z + (size_t)t * NQKV + col;
#pragma unroll
              for (int e = 0; e < 64; e += 8) { const u32x4 w = *(const u32x4*)(qp + e);
                  q[e] = __uint_as_float(w.x << 16); q[e + 1] = __uint_as_float(w.x & 0xffff0000u); q[e + 2] = __uint_as_float(w.y << 16); q[e + 3] = __uint_as_float(w.y & 0xffff0000u);
                  q[e + 4] = __uint_as_float(w.z << 16); q[e + 5] = __uint_as_float(w.z & 0xffff0000u); q[e + 6] = __uint_as_float(w.w << 16); q[e + 7] = __uint_as_float(w.w & 0xffff0000u); } }
            float sc[3]; bool vd[3];
#pragma unroll
            for (int ps = 0; ps < 3; ++ps) { const int j = -64 + 64 * ps + lane; const long tk = (long)t + (long)d * j; vd[ps] = (j <= 64) && tk >= 0 && tk < S; float s = -1e30f;
                if (vd[ps]) { const bf16* kp = z + (size_t)tk * NQKV + 1536 + col; float dot = 0.f;
#pragma unroll
                    for (int e = 0; e < 64; e += 8) { const u32x4 w = *(const u32x4*)(kp + e);
                        dot += q[e] * __uint_as_float(w.x << 16) + q[e + 1] * __uint_as_float(w.x & 0xffff0000u) + q[e + 2] * __uint_as_float(w.y << 16) + q[e + 3] * __uint_as_float(w.y & 0xffff0000u)
                             + q[e + 4] * __uint_as_float(w.z << 16) + q[e + 5] * __uint_as_float(w.z & 0xffff0000u) + q[e + 6] * __uint_as_float(w.w << 16) + q[e + 7] * __uint_as_float(w.w & 0xffff0000u); }
                    s = dot - slope * (float)((j < 0 ? -j : j) * d); }
                sc[ps] = s; }
            const float m = wave_max(fmaxf(sc[0], fmaxf(sc[1], sc[2])));
            float p[3]; float ps_ = 0.f;
#pragma unroll
            for (int ps = 0; ps < 3; ++ps) { p[ps] = vd[ps] ? __expf(sc[ps] - m) : 0.f; ps_ += p[ps]; }
            const float den = wave_sum(ps_);
            float acc = 0.f;
#pragma unroll
            for (int ps = 0; ps < 3; ++ps)
                for (int l = 0; l < 64; ++l) { const float pj = __shfl(p[ps], l); if (pj != 0.f) { const long tk = (long)t + (long)d * (-64 + 64 * ps + l); acc += pj * bf2f(z[(size_t)tk * NQKV + 3072 + col + lane]); } }
            og[g] = acc / den; lse[g] = m + __logf(den); }
        const float mx = fmaxf(lse[0], fmaxf(lse[1], lse[2])); const float w0 = __expf(lse[0] - mx), w1 = __expf(lse[1] - mx), w2 = __expf(lse[2] - mx);
        oa[(size_t)t * 512 + h * 64 + lane] = f2bf((w0 * og[0] + w1 * og[1] + w2 * og[2]) / (w0 + w1 + w2)); }
}
__device__ __forceinline__ void ph_rprep(Ctx& C) {
    const int lane_ = lane_now(), tid_ = C.wave * 64 + lane_; (void)tid_;
    const bf16* zr = (const bf16*)(C.ws + WS_ZR); const float* mup = C.ka->in[6]; const float* mun = C.ka->in[7]; const float* k_k = C.ka->in[13];
    bf16* r = (bf16*)(C.ws + WS_R); bf16* v = (bf16*)(C.ws + WS_V); bf16* nkk = (bf16*)(C.ws + WS_NKK); bf16* kraw = (bf16*)(C.ws + WS_KRAW); bf16* la = (bf16*)(C.ws + WS_LORAA);
    for (int t = C.bid; t < S; t += C.nb) {
        for (int c = tid_; c < NZR; c += NTHR) {
            if (c < NZR_REAL) {
                const float z0 = bf2f(zr[(size_t)t * NZR + c]); const float zp = t > 0 ? bf2f(zr[(size_t)(t - 1) * NZR + c]) : 0.f; const float zn = t < S - 1 ? bf2f(zr[(size_t)(t + 1) * NZR + c]) : 0.f;
                const float x = z0 + mup[c] * (zp - z0) + mun[c] * (zn - z0);
                if (c < 1024) r[(size_t)t * RW + c] = f2bf(x);
                else if (c < 2048) { const int cc = c - 1024; kraw[(size_t)t * RW + cc] = f2bf(x); const float kv = x * k_k[cc]; const float ss = wave_sum(kv * kv); nkk[(size_t)t * RW + cc] = f2bf(-kv / fmaxf(sqrtf(ss), 1e-12f)); }
                else if (c < 3072) v[(size_t)t * RW + (c - 2048)] = f2bf(x);
                else if (c < 3136) la[(size_t)t * KL + (c - 3072)] = f2bf(tanhf(x));
                else if (c < 3200) la[(size_t)t * KL + (c - 3072)] = f2bf(x);
                else la[(size_t)t * KL + (c - 3072)] = f2bf(sigmoidf_(x));
            } else if (c - NZR_REAL + 288 < KL) la[(size_t)t * KL + (c - NZR_REAL + 288)] = 0;
        }
    }
}
__device__ __forceinline__ void ph_glora(Ctx& C) {
#if OPT_GEMM
    { EpiLoraU8 E{C.ws, C.ka->in[8], C.ka->in[10]}; int nn = NL, kk = KL2; asm volatile("" : "+s"(nn), "+s"(kk));
      pg8::Gemm g{(const bf16*)(C.ws + WS_LORAA), (const bf16*)(C.ws + WS_WLORA), 2 * S, nn, kk}; LoraOrder so{C.nb, C.bid};
      pg8::gemm_phase<EpiLoraU8, LoraOrder, true, true>(C.lds, g, so, E, C.wave); }
#else
    EpiLora E{(bf16*)(C.ws + WS_LW), (bf16*)(C.ws + WS_A), (bf16*)(C.ws + WS_GATE), C.ka->in[8], C.ka->in[10]};
    gemm_simple(C, (const bf16*)(C.ws + WS_LORAA), (const bf16*)(C.ws + WS_WLORA), NL, KL, E);
#endif
}
__device__ __forceinline__ void ph_rk(Ctx& C) {
    const int lane_ = lane_now(), tid_ = C.wave * 64 + lane_; (void)tid_;
    const bf16* r = (const bf16*)(C.ws + WS_R); const bf16* kraw = (const bf16*)(C.ws + WS_KRAW); const bf16* a = (const bf16*)(C.ws + WS_A); float* rk = (float*)(C.ws + WS_RK);
    const float* k_a = C.ka->in[14]; const float* r_k = C.ka->in[15];
    const long nitems = (long)2 * S * 16;
    for (long it = C.gw; it < nitems; it += C.ngw) { const int h = (int)(it & 15), t = (int)((it >> 4) % S), z = (int)(it / ((long)S * 16)); const int c = h * 64 + lane_;
        const float av = bf2f(a[((size_t)z * S + t) * RW + c]); const float kd = bf2f(kraw[(size_t)t * RW + c]) * (1.0f + (av - 1.0f) * k_a[c]);
        const float s = wave_sum(bf2f(r[(size_t)t * RW + c]) * kd * r_k[c]); if (lane_ == 0) rk[((size_t)z * S + t) * 16 + h] = s; }
}
__device__ __forceinline__ void ph_scan_seq(Ctx& C) {
    const int lane_ = lane_now(), tid_ = C.wave * 64 + lane_; (void)tid_;
    const bf16* r = (const bf16*)(C.ws + WS_R); const bf16* v = (const bf16*)(C.ws + WS_V); const bf16* nkk = (const bf16*)(C.ws + WS_NKK); const bf16* kraw = (const bf16*)(C.ws + WS_KRAW);
    const bf16* lw = (const bf16*)(C.ws + WS_LW); const bf16* a = (const bf16*)(C.ws + WS_A); bf16* yl = (bf16*)(C.ws + WS_YL); const float* k_a = C.ka->in[14];
    { u32x4* q = (u32x4*)(C.dout + DO_QT); const size_t n = (size_t)64 * MiB / 16; for (size_t i = (size_t)C.bid * NTHR + tid_; i < n; i += (size_t)C.nb * NTHR) q[i] = (u32x4){0u, 0u, 0u, 0u};
      u32x4* s0 = (u32x4*)(C.ws + WS_S0); const size_t n2 = (size_t)32 * MiB / 16; for (size_t i = (size_t)C.bid * NTHR + tid_; i < n2; i += (size_t)C.nb * NTHR) s0[i] = (u32x4){0u, 0u, 0u, 0u}; }
    if (C.gw < NCHAIN) {
    const int z = C.gw >> 4, h = C.gw & 15, lane = lane_, c = h * 64 + lane;
    LAS float* scr = (LAS float*)(C.lds + C.wave * 2048);
    float st[64];
#pragma unroll
    for (int k = 0; k < 64; ++k) st[k] = 0.f;
    const float ka = k_a[c];
    const bf16* lwz = lw + (size_t)z * S * RW; const bf16* az = a + (size_t)z * S * RW; bf16* ylz = yl + (size_t)z * S * RW;
    int t = z ? S - 1 : 0; const int dt = z ? -1 : 1;
    bf16 n_nkk = nkk[(size_t)t * RW + c], n_lw = lwz[(size_t)t * RW + c], n_a = az[(size_t)t * RW + c], n_k = kraw[(size_t)t * RW + c], n_r = r[(size_t)t * RW + c], n_v = v[(size_t)t * RW + c];
#pragma unroll 1
    for (int s = 0; s < S; ++s) {
        const float fnkk = bf2f(n_nkk), fw = __expf(bf2f(n_lw)), fa = bf2f(n_a), fk = bf2f(n_k), fr_ = bf2f(n_r), fv = bf2f(n_v);
        const int tc = t; t += dt;
        if (s + 1 < S) { n_nkk = nkk[(size_t)t * RW + c]; n_lw = lwz[(size_t)t * RW + c]; n_a = az[(size_t)t * RW + c]; n_k = kraw[(size_t)t * RW + c]; n_r = r[(size_t)t * RW + c]; n_v = v[(size_t)t * RW + c]; }
        scr[lane] = fnkk; scr[64 + lane] = fw; scr[128 + lane] = -fnkk * fa; scr[192 + lane] = fk * (1.0f + (fa - 1.0f) * ka); scr[256 + lane] = fr_;
        asm volatile("s_waitcnt lgkmcnt(0)" ::: "memory");
        float sa = 0.f;
#pragma unroll
        for (int k = 0; k < 64; k += 4) { const f32x4 x = *(const LAS f32x4*)(scr + k); sa += st[k] * x[0] + st[k + 1] * x[1] + st[k + 2] * x[2] + st[k + 3] * x[3]; }
        float y = 0.f;
#pragma unroll
        for (int k = 0; k < 64; k += 4) { const f32x4 w4 = *(const LAS f32x4*)(scr + 64 + k), b4 = *(const LAS f32x4*)(scr + 128 + k), k4 = *(const LAS f32x4*)(scr + 192 + k), r4 = *(const LAS f32x4*)(scr + 256 + k);
#pragma unroll
            for (int e = 0; e < 4; ++e) { st[k + e] = st[k + e] * w4[e] + sa * b4[e] + fv * k4[e]; y += st[k + e] * r4[e]; } }
        asm volatile("s_waitcnt lgkmcnt(0)" ::: "memory");
        ylz[(size_t)tc * RW + c] = f2bf(y);
    }
    }
}
__device__ __forceinline__ void ph_fin(Ctx& C) {
    const int lane_ = lane_now(), tid_ = C.wave * 64 + lane_; (void)tid_;
    const bf16* yl = (const bf16*)(C.ws + WS_YL); const bf16* qt = (const bf16*)(C.dout + DO_QT); const float* s0 = (const float*)(C.ws + WS_S0);
    const bf16* r = (const bf16*)(C.ws + WS_R); const bf16* kraw = (const bf16*)(C.ws + WS_KRAW); const bf16* a = (const bf16*)(C.ws + WS_A); const float* k_a = C.ka->in[14]; const float* r_k = C.ka->in[15];
    const bf16* v = (const bf16*)(C.ws + WS_V); const bf16* gate = (const bf16*)(C.ws + WS_GATE); bf16* orw = (bf16*)(C.ws + WS_ORWKV); const float* lnw = C.ka->in[16]; const float* lnb = C.ka->in[17];
    const long nitems = (long)S * 16; const int lane = lane_;
    for (long it = C.gw; it < nitems; it += C.ngw) { const int t = (int)(it >> 4), h = (int)(it & 15), c = h * 64 + lane;
        float y = bf2f(yl[(size_t)t * RW + c]) + bf2f(yl[((size_t)S + t) * RW + c]);
#pragma unroll
        for (int z = 0; z < 2; ++z) { const int ck = z ? (S - 1 - t) / CHL : t / CHL; const float* sp = s0 + (((size_t)(z * 16 + h) * NCK + ck) * 64 + lane) * 64; const bf16* qp = qt + ((size_t)z * S + t) * RW + h * 64;
            float corr = 0.f;
#pragma unroll 4
            for (int k = 0; k < 64; k += 4) { const f32x4 s4 = *(const f32x4*)(sp + k); const u32x2 q2 = *(const u32x2*)(qp + k);
                corr += s4[0] * __uint_as_float(q2.x << 16) + s4[1] * __uint_as_float(q2.x & 0xffff0000u) + s4[2] * __uint_as_float(q2.y << 16) + s4[3] * __uint_as_float(q2.y & 0xffff0000u); }
            y += corr; }
        const float mu = wave_sum(y) * (1.0f / 64.f); const float dv = y - mu; const float var = wave_sum(dv * dv) * (1.0f / 64.f);
        const float gn = dv * (1.0f / sqrtf(var + 64e-5f)) * lnw[c] + lnb[c];
        const float ka_ = k_a[c]; const float kd2 = (1.0f + (bf2f(a[(size_t)t * RW + c]) - 1.0f) * ka_) + (1.0f + (bf2f(a[((size_t)S + t) * RW + c]) - 1.0f) * ka_);
        const float bonus = wave_sum(bf2f(r[(size_t)t * RW + c]) * bf2f(kraw[(size_t)t * RW + c]) * kd2 * r_k[c]) * bf2f(v[(size_t)t * RW + c]);
        orw[(size_t)t * RW + c] = f2bf((gn + bonus) * bf2f(gate[(size_t)t * RW + c])); }
}
__device__ __forceinline__ void ph_g1b(Ctx& C) {
    LAS float* scr = (LAS float*)(C.lds + C.wave * 16384);
    conv_natural(C, C.ka->in[20], D, D, (bf16*)(C.ws + WS_WOUT), scr);
    conv_wgu(C, scr);
    conv_natural(C, C.ka->in[24], FF, D, (bf16*)(C.ws + WS_WD), scr);
    __syncthreads();
#if OPT_GEMM
    EpiG1B8 E{(bf16*)(C.ws + WS_ZG), C.ka->in[3]};
    gemm8(C, (const bf16*)(C.dout + DO_H1), (const bf16*)(C.ws + WS_WIN) + (size_t)N1A * D, NGATE, D, E);
#else
    EpiG1B E{(bf16*)(C.ws + WS_ZG), C.ka->in[3]};
    gemm_simple(C, (const bf16*)(C.dout + DO_H1), (const bf16*)(C.ws + WS_WIN) + (size_t)N1A * D, NGATE, D, E);
#endif
}
__device__ __forceinline__ void ph_norm2(Ctx& C) {
    const int lane = lane_now(); const float* pp = (const float*)(C.ws + WS_SSQP); float* rs = (float*)(C.ws + WS_RSTD);
    for (int row = C.gw * 64 + lane; row < S; row += C.ngw * 64) { const f32x4* p = (const f32x4*)(pp + (size_t)row * 32); float ss = 0.f;
#pragma unroll
        for (int q = 0; q < 8; ++q) { const f32x4 v = p[q]; ss += (v[0] + v[1]) + (v[2] + v[3]); }
        rs[row] = 1.0f / sqrtf(ss * (1.0f / D) + 1e-6f); }
}

template <bool COOP>
__global__ void __launch_bounds__(NTHR, 2) mega(Args args) {
    extern __shared__ __attribute__((aligned(16))) unsigned char lds_raw[];
    KArgs* ka = (KArgs*)__builtin_amdgcn_kernarg_segment_ptr();
    int wave_s = __builtin_amdgcn_readfirstlane((int)threadIdx.x >> 6);
    if constexpr (COOP) {
        if (threadIdx.x == 0) { volatile LAS unsigned* st = (volatile LAS unsigned*)((LAS unsigned char*)lds_raw + LDS_BAR_OFF); st[0] = 0u; st[1] = 0u; (void)xb_add(&((unsigned*)(args.ws + WS_CTL))[XB_XCNT(xb_xcc_id())], 1u); }
        __syncthreads();
    }
#define MKCTX() Ctx C; { asm volatile("" : "+s"(ka), "+s"(wave_s)); C.ka = ka; C.out = ka->out; C.ws = ka->ws; C.dout = (unsigned char*)ka->out; C.lds = (LAS unsigned char*)lds_raw; \
    C.wave = wave_s; C.bid = blockIdx.x; C.nb = gridDim.x; C.gw = C.bid * NWAVES + C.wave; C.ngw = C.nb * NWAVES; }
#define GSYNC() do { if constexpr (COOP) { XcdBarrier xb; xb.bar = (unsigned*)(C.ws + WS_CTL); xb.x = xb_xcc_id(); xb.st = (volatile LAS unsigned*)(C.lds + LDS_BAR_OFF); \
    const bool leader_ = (C.wave == 0) && (lane_now() == 0); xcd_barrier(xb, leader_, (unsigned)C.nb); } } while (0)
#ifndef PROBE_DUP
#define PROBE_DUP (-1)
#endif
#define PH(k, ...) do { if (ka->ph_lo <= (k) && (k) < ka->ph_hi) { MKCTX(); __VA_ARGS__; if ((k) == PROBE_DUP) { GSYNC(); __VA_ARGS__; } if ((k) + 1 < ka->ph_hi) GSYNC(); } } while (0)
    if (ka->ph_lo <= P_PREP0 && P_PREP0 < ka->ph_hi) { MKCTX(); ph_prep0(C); if (PROBE_DUP == P_PREP0) { __syncthreads(); ph_prep0(C); } if (P_PREP0 + 1 < ka->ph_hi) { if constexpr (COOP) cg::this_grid().sync(); } }
    PH(P_G1A, ph_g1a(C));
#if OPT_GEMM && OPT_ATTN
    PH(P_ATTPREP, ph_attn2(C); ph_rprep2(C));
    PH(P_GLORA, ph_attn_combine(C); __syncthreads(); ph_glora(C));
#elif OPT_GEMM
    PH(P_ATTPREP, ph_attn(C); ph_rprep(C));
    PH(P_GLORA, ph_glora(C));
#else
    PH(P_HNORM, ph_hnorm(C));
    PH(P_ATTPREP, ph_attn(C); ph_rprep(C));
    PH(P_GLORA, ph_glora(C));
#endif
#if OPT_SCAN && PROBE_SCANCMP
    PH(P_SCAN1, ph_scan1m(C); GSYNC(); ph_scancmp(C, 0, 0); GSYNC(); ph_scan1(C); GSYNC(); ph_scancmp(C, 1, PROBE_SCANCMP - 1));
    PH(P_SCAN2, ph_scan2(C));
    PH(P_FIN, ph_fin4(C));
#elif OPT_SCAN && OPT_SCANM
    PH(P_SCAN1, ph_scan1m(C));
#if OPT_SCAN2B
    PH(P_SCAN2, ph_scan2b(C));
#else
    PH(P_SCAN2, ph_scan2(C));
#endif
    PH(P_FIN, ph_fin4(C));
#elif OPT_SCAN
    PH(P_SCAN1, ph_scan1(C));
    PH(P_SCAN2, ph_scan2(C));
    PH(P_FIN, ph_fin4(C));
#else
    PH(P_SCAN1, ph_scan_seq(C));
    PH(P_FIN, ph_fin(C));
#endif
    PH(P_G1B, ph_g1b(C));
#if OPT_GEMM
    PH(P_GMA, { EpiMerge8<false> E{(bf16*)(C.ws + WS_MERGED), (const bf16*)(C.ws + WS_ZG)}; gemm8(C, (const bf16*)(C.ws + WS_OATT), (const bf16*)(C.ws + WS_WBA), D, 512, E); });
    PH(P_GMB, { EpiMerge8<true> E{(bf16*)(C.ws + WS_MERGED), (const bf16*)(C.ws + WS_ZG)}; gemm8(C, (const bf16*)(C.ws + WS_ORWKV), (const bf16*)(C.ws + WS_WBR), D, RW, E); });
    PH(P_GOUT, { EpiX2b8 E{C.ka->in[0], (bf16*)(C.ws + WS_X2B), (float*)(C.ws + WS_SSQP)}; gemm8(C, (const bf16*)(C.ws + WS_MERGED), (const bf16*)(C.ws + WS_WOUT), D, D, E); });
    PH(P_NORM2, ph_norm2(C));
    PH(P_FFN1, { EpiFfn18 E{(bf16*)(C.ws + WS_HID), (const float*)(C.ws + WS_RSTD)}; gemm8(C, (const bf16*)(C.ws + WS_X2B), (const bf16*)(C.ws + WS_WGU), 2 * FF, D, E); });
    PH(P_FFN2, { EpiResB8 E{(const bf16*)(C.ws + WS_X2B), C.out}; gemm8(C, (const bf16*)(C.ws + WS_HID), (const bf16*)(C.ws + WS_WD), D, FF, E); });
#if PROBE_SCANCMP
    { MKCTX(); GSYNC(); ph_probe_fold(C); }
#endif
#else
    PH(P_GMA, { EpiMA E{(bf16*)(C.ws + WS_MERGED), (const bf16*)(C.ws + WS_ZG)}; gemm_simple(C, (const bf16*)(C.ws + WS_OATT), (const bf16*)(C.ws + WS_WBA), D, 512, E); });
    PH(P_GMB, { EpiMB E{(bf16*)(C.ws + WS_MERGED), (const bf16*)(C.ws + WS_ZG)}; gemm_simple(C, (const bf16*)(C.ws + WS_ORWKV), (const bf16*)(C.ws + WS_WBR), D, RW, E); });
    PH(P_GOUT, { EpiRes E{C.ka->in[0], C.out}; gemm_simple(C, (const bf16*)(C.ws + WS_MERGED), (const bf16*)(C.ws + WS_WOUT), D, D, E); });
    PH(P_NORM2, ph_norm2(C));
    PH(P_FFN1, gemm_simple_ffn1(C, (const bf16*)(C.ws + WS_H2), (const bf16*)(C.ws + WS_WGU), (bf16*)(C.ws + WS_HID)));
    PH(P_FFN2, { EpiRes E{C.out, C.out}; gemm_simple(C, (const bf16*)(C.ws + WS_HID), (const bf16*)(C.ws + WS_WD), D, FF, E); });
#endif
#undef PH
#undef GSYNC
#undef MKCTX
}

extern "C" void kernel_launch(void* const* d_in, const int* in_sizes, int n_in, void* d_out, int out_size, void* d_ws, size_t ws_size, hipStream_t stream) {
    static int grid = 0;
    if (grid == 0) {
        if (n_in != 25 || in_sizes[0] != S * D || out_size != S * D || ws_size < WS_END) { fprintf(stderr, "kernel_launch: unexpected shapes (n_in %d, ws %zu)\n", n_in, ws_size); grid = -1; return; }
        int dev = 0, cus = 0, per_cu = 0;
        hipGetDevice(&dev); hipDeviceGetAttribute(&cus, hipDeviceAttributeMultiprocessorCount, dev);
        const void* fn = MK_COOP ? (const void*)mega<true> : (const void*)mega<false>;
        hipFuncSetAttribute(fn, hipFuncAttributeMaxDynamicSharedMemorySize, LDS_BYTES);
        hipOccupancyMaxActiveBlocksPerMultiprocessor(&per_cu, fn, NTHR, LDS_BYTES);
        if (per_cu < 1) { fprintf(stderr, "kernel_launch: occupancy query says %d blocks per CU\n", per_cu); per_cu = 1; }
        grid = cus * 1;
        (void)hipGetLastError();
    }
    if (grid < 0) return;
    Args a{};
    for (int i = 0; i < 25; ++i) a.in[i] = (const float*)d_in[i];
    a.out = (float*)d_out; a.ws = (unsigned char*)d_ws;
#if MK_COOP
    (void)hipMemsetAsync((char*)d_ws + WS_CTL, 0, CTL_BYTES, stream);
    a.ph_lo = 0; a.ph_hi = P_COUNT;
    void* kargs[] = {&a};
    hipError_t e = hipLaunchCooperativeKernel((const void*)mega<true>, dim3(grid), dim3(NTHR), kargs, LDS_BYTES, stream);
    if (e != hipSuccess) fprintf(stderr, "cooperative launch failed: %s (grid %d)\n", hipGetErrorString(e), grid);
#else
    for (int ph = 0; ph < P_COUNT; ++ph) { if (ph == P_SCAN2) continue; a.ph_lo = ph; a.ph_hi = ph + 1; hipLaunchKernelGGL(mega<false>, dim3(grid), dim3(NTHR), LDS_BYTES, stream, a); }
#endif
}
```

```cpp
#include <hip/hip_runtime.h>
#include <hip/hip_cooperative_groups.h>
#include <cstdio>
#include <cstdint>
namespace cg = cooperative_groups;

#ifndef MK_COOP
#define MK_COOP 1
#endif

#define LAS __attribute__((address_space(3)))
typedef unsigned short bf16;
typedef short bf16x8 __attribute__((ext_vector_type(8)));
typedef float f32x4 __attribute__((ext_vector_type(4)));
typedef float f32x2 __attribute__((ext_vector_type(2)));
typedef unsigned u32x4 __attribute__((ext_vector_type(4)));
typedef unsigned u32x2 __attribute__((ext_vector_type(2)));

constexpr int S = 16384, D = 2048;
constexpr int HD = 64;
constexpr int NQKV = 4608, NZR = 3584, NZR_REAL = 3360, NGATE = 4096;
constexpr int N1A = NQKV + NZR;
constexpr int N1 = N1A + NGATE;
constexpr int IN_W = 12064;
constexpr int KL = 384, NL = 5120;
constexpr int KL2 = 256;
constexpr int FF = 5632;
constexpr int RW = 1024;
constexpr int NCHAIN = 32;
constexpr int CHL = 512, NCK = S / CHL;
constexpr int NWAVES = 8, NTHR = 512;
constexpr int LDS_BYTES = 147456, LDS_BAR_OFF = 147440;

constexpr size_t MiB = 1u << 20;
constexpr size_t WS_WIN = 0;
constexpr size_t WS_OATT = 0;
constexpr size_t WS_LORAA = 16 * MiB;
constexpr size_t WS_RK = 28 * MiB;
constexpr size_t WS_WLORA = 48 * MiB;
constexpr size_t WS_WBA = 52 * MiB;
constexpr size_t WS_WBR = 54 * MiB;
constexpr size_t WS_ZQKV = 58 * MiB;
constexpr size_t WS_ZR = 202 * MiB;
constexpr size_t WS_LW = 58 * MiB;
constexpr size_t WS_A = 122 * MiB;
constexpr size_t WS_GATE = 186 * MiB;
constexpr size_t WS_PU = 218 * MiB;
constexpr size_t WS_S0 = 282 * MiB;
constexpr size_t WS_R = 314 * MiB, WS_V = 346 * MiB, WS_NKK = 378 * MiB, WS_KRAW = 410 * MiB;
constexpr size_t WS_YL = 442 * MiB;
constexpr size_t WS_ORWKV = 58 * MiB;
constexpr size_t WS_ZG = 90 * MiB;
constexpr size_t WS_WOUT = 218 * MiB;
constexpr size_t WS_WGU = 226 * MiB;
constexpr size_t WS_WD = 270 * MiB;
constexpr size_t WS_MERGED = 292 * MiB;
constexpr size_t WS_H2 = 356 * MiB;
constexpr size_t WS_SSQP = 484 * MiB, WS_RSTD = 486 * MiB;
constexpr size_t WS_X2B = 420 * MiB;
constexpr size_t WS_HID = 0;
constexpr size_t WS_CTL = 506 * MiB, CTL_BYTES = 16384;
constexpr size_t WS_END = 507 * MiB;
constexpr size_t DO_H1 = 0, DO_QT = 64 * MiB;

enum Phase { P_PREP0 = 0, P_G1A, P_HNORM, P_ATTPREP, P_GLORA, P_RK, P_SCAN1, P_SCAN2, P_FIN, P_G1B, P_GMA, P_GMB, P_GOUT, P_NORM2, P_FFN1, P_FFN2, P_COUNT };

struct Args { const float* in[25]; float* out; unsigned char* ws; int ph_lo, ph_hi; };

__device__ __forceinline__ float bf2f(bf16 h) { return __uint_as_float((unsigned)h << 16); }
__device__ __forceinline__ bf16 f2bf(float f) { unsigned u = __float_as_uint(f); return (bf16)((u + 0x7fffu + ((u >> 16) & 1u)) >> 16); }
__device__ __forceinline__ unsigned pk2(float lo, float hi) { return (unsigned)f2bf(lo) | ((unsigned)f2bf(hi) << 16); }
__device__ __forceinline__ float wave_sum(float v) {
#pragma unroll
    for (int o = 1; o < 64; o <<= 1) v += __shfl_xor(v, o);
    return v;
}
__device__ __forceinline__ float wave_max(float v) {
#pragma unroll
    for (int o = 1; o < 64; o <<= 1) v = fmaxf(v, __shfl_xor(v, o));
    return v;
}
__device__ __forceinline__ float sigmoidf_(float x) { return 1.0f / (1.0f + __expf(-x)); }
__host__ __device__ __forceinline__ int tperm(int j) { const int lc = j & 255; return (j & ~255) + 64 * ((lc >> 5) & 3) + 32 * (lc >> 7) + (lc & 31); }

typedef const __attribute__((address_space(4))) Args KArgs;
struct Ctx {
    KArgs* ka;
    float* out; unsigned char* ws; unsigned char* dout;
    LAS unsigned char* lds;
    int wave, bid, nb, gw, ngw;
};
__device__ __forceinline__ int lane_now() { int l; asm volatile("v_mbcnt_lo_u32_b32 %0, -1, 0\n\tv_mbcnt_hi_u32_b32 %0, -1, %0" : "=v"(l)); return l; }


#define XB_TMO      128
#define XB_XCNT(j)  (256  + 64 * (j))
#define XB_XSUB(j)  (1280 + 64 * (j))
#define XB_XGEN(j)  (2304 + 64 * (j))
#define XB_TOP      3328
#define XB_TOPGEN   3392
#define XCD_BAR_WORDS 3456
#define XB_SPIN_CAP (1u << 22)
__device__ __forceinline__ unsigned xb_ld(unsigned* p)              { return __hip_atomic_load(p, __ATOMIC_RELAXED, __HIP_MEMORY_SCOPE_AGENT); }
__device__ __forceinline__ unsigned xb_add(unsigned* p, unsigned v) { return __hip_atomic_fetch_add(p, v, __ATOMIC_RELAXED, __HIP_MEMORY_SCOPE_AGENT); }
__device__ __forceinline__ unsigned xb_xcc_id() { return (unsigned)__builtin_amdgcn_s_getreg((3 << 11) | 20) & 0xFu; }
#define XB_SPIN(cond, bar) do { unsigned _sp = 0; while (cond) { __builtin_amdgcn_s_sleep(1); \
    if ((++_sp & 255u) == 0u) { if (xb_ld(&(bar)[XB_TMO])) break; if (_sp > XB_SPIN_CAP) { atomicAdd(&(bar)[XB_TMO], 1u); break; } } } } while (0)
struct XcdBarrier { unsigned* bar; unsigned x; volatile LAS unsigned* st; };
__device__ __forceinline__ void xcd_barrier_complete(unsigned* bar, unsigned x, unsigned G, unsigned& nloc, unsigned& nx) {
    unsigned sum, cnt, mine, sp = 0u;
    for (;;) {
        sum = 0u; cnt = 0u; mine = 0u;
#pragma unroll
        for (unsigned j = 0; j < 16; ++j) { const unsigned c = xb_ld(&bar[XB_XCNT(j)]); sum += c; cnt += (c > 0u) ? 1u : 0u; mine = (j == x) ? c : mine; }
        if (sum == G) break;
        __builtin_amdgcn_s_sleep(1);
        if ((++sp & 255u) == 0u) { if (xb_ld(&bar[XB_TMO])) break; if (sp > XB_SPIN_CAP) { atomicAdd(&bar[XB_TMO], 1u); break; } }
    }
    nloc = mine > 0u ? mine : 1u; nx = cnt > 0u ? cnt : 1u;
}
__device__ __forceinline__ void xcd_barrier(const XcdBarrier& b, const bool leader, const unsigned G) {
    asm volatile("s_waitcnt vmcnt(0)" ::: "memory");
    __syncthreads();
    if (leader) {
        unsigned* bar = b.bar;
        __builtin_amdgcn_s_waitcnt(0);
        unsigned nloc = b.st[0], nx = b.st[1];
        if (nloc == 0u) { xcd_barrier_complete(bar, b.x, G, nloc, nx); b.st[0] = nloc; b.st[1] = nx; }
        const unsigned old = xb_add(&bar[XB_XSUB(b.x)], 1u);
        const unsigned gen = old / nloc;
        if (old + 1u == (gen + 1u) * nloc) {
            __builtin_amdgcn_fence(__ATOMIC_RELEASE, "agent");
            asm volatile("s_waitcnt vmcnt(0)" ::: "memory");
            const unsigned og = xb_add(&bar[XB_TOP], 1u);
            const unsigned tg = og / nx;
            if (og + 1u == (tg + 1u) * nx) xb_add(&bar[XB_TOPGEN], 1u);
            else XB_SPIN(xb_ld(&bar[XB_TOPGEN]) == tg, bar);
            __builtin_amdgcn_fence(__ATOMIC_ACQUIRE, "agent");
            xb_add(&bar[XB_XGEN(b.x)], 1u);
            asm volatile("s_waitcnt vmcnt(0)" ::: "memory");
        } else {
            XB_SPIN(xb_ld(&bar[XB_XGEN(b.x)]) == gen, bar);
            __builtin_amdgcn_fence(__ATOMIC_ACQUIRE, "agent");
            asm volatile("s_waitcnt vmcnt(0)" ::: "memory");
        }
    }
    __syncthreads();
}

__device__ __forceinline__ unsigned pg8c(float lo, float hi) { unsigned r; asm volatile("v_cvt_pk_bf16_f32 %0, %1, %2" : "=v"(r) : "v"(lo), "v"(hi)); return r; }
__device__ __forceinline__ bf16x8 pack8s(float a0, float a1, float a2, float a3, float a4, float a5, float a6, float a7) {
    u32x4 p;
    asm volatile("v_cvt_pk_bf16_f32 %0, %4, %5\n\tv_cvt_pk_bf16_f32 %1, %6, %7\n\tv_cvt_pk_bf16_f32 %2, %8, %9\n\tv_cvt_pk_bf16_f32 %3, %10, %11\n\ts_nop 1"
                 : "=&v"(p[0]), "=&v"(p[1]), "=&v"(p[2]), "=&v"(p[3]) : "v"(a0), "v"(a1), "v"(a2), "v"(a3), "v"(a4), "v"(a5), "v"(a6), "v"(a7));
    return __builtin_bit_cast(bf16x8, p);
}
struct TrItem { const float* src; int ld; int nk; bf16* dst; int K; const float* kscale = nullptr; };
__device__ __forceinline__ void tr_load(const TrItem& t, f32x4 (&v)[8], int lane) {
#pragma unroll
    for (int i = 0; i < 8; ++i) { const int kk = (lane >> 3) + 8 * i; v[i] = (f32x4){0.f, 0.f, 0.f, 0.f}; if (t.src && kk < t.nk) { v[i] = *(const f32x4*)(t.src + (size_t)kk * t.ld + 4 * (lane & 7)); if (t.kscale) v[i] = v[i] * t.kscale[kk]; } }
}
__device__ __forceinline__ void tr_store(const TrItem& t, const f32x4 (&v)[8], LAS float* scr, int lane) {
#pragma unroll
    for (int i = 0; i < 8; ++i) { LAS float* d = scr + ((lane >> 3) + 8 * i) * 33 + 4 * (lane & 7); d[0] = v[i][0]; d[1] = v[i][1]; d[2] = v[i][2]; d[3] = v[i][3]; }
    asm volatile("s_waitcnt lgkmcnt(0)" ::: "memory");
    const int c = lane & 7;
#pragma unroll
    for (int j = 0; j < 4; ++j) { const int n = (lane >> 3) + 8 * j; const LAS float* s = scr + (8 * c) * 33 + n;
        u32x4 o; o.x = pg8c(s[0 * 33], s[1 * 33]); o.y = pg8c(s[2 * 33], s[3 * 33]); o.z = pg8c(s[4 * 33], s[5 * 33]); o.w = pg8c(s[6 * 33], s[7 * 33]);
        *(u32x4*)(t.dst + (size_t)n * t.K + 8 * c) = o; }
    asm volatile("s_waitcnt lgkmcnt(0)" ::: "memory");
}
template <class Mk> __device__ __forceinline__ void conv_run(Ctx& C, int nitems, const Mk& mk, LAS float* scr) {
    const int lane = lane_now(); int it = C.gw; if (it >= nitems) return;
    TrItem cur = mk(it); f32x4 v[8]; tr_load(cur, v, lane);
    for (;;) { const int nit = it + C.ngw; const bool more = nit < nitems; TrItem nxt = cur; f32x4 w[8];
        if (more) { nxt = mk(nit); tr_load(nxt, w, lane); }
        tr_store(cur, v, scr, lane);
        if (!more) break;
        cur = nxt; it = nit;
#pragma unroll
        for (int i = 0; i < 8; ++i) v[i] = w[i]; }
}
__device__ __forceinline__ void conv_natural(Ctx& C, const float* W, int K, int N, bf16* Wt, LAS float* scr) {
    const int nkb = K / 64;
    conv_run(C, (N / 32) * nkb, [=](int it) { const int j32 = it / nkb, kb = it % nkb; return TrItem{W + (size_t)(kb * 64) * N + j32 * 32, N, 64, Wt + (size_t)(j32 * 32) * K + kb * 64, K}; }, scr);
}
__device__ __forceinline__ void conv_win(Ctx& C, LAS float* scr) {
    const float* W = C.ka->in[2]; bf16* Wt = (bf16*)(C.ws + WS_WIN); const int nkb = D / 64;
    conv_run(C, (N1 / 32) * nkb, [=](int it) { const int j32 = it / nkb, kb = it % nkb; const int j = j32 * 32, ac = tperm(j);
        int wc; if (j < NQKV) wc = ac; else if (j < N1A) { const int zc = ac - NQKV; wc = zc < NZR_REAL ? NQKV + zc : -1; } else wc = NQKV + NZR_REAL + (ac - N1A);
        return TrItem{wc >= 0 ? W + (size_t)(kb * 64) * IN_W + wc : nullptr, IN_W, 64, Wt + (size_t)j * D + kb * 64, D}; }, scr);
}
__device__ __forceinline__ void conv_wlora(Ctx& C, LAS float* scr) {
    bf16* Wt = (bf16*)(C.ws + WS_WLORA); const float* w_d = C.ka->in[9]; const float* w_i = C.ka->in[11]; const float* w_g = C.ka->in[12]; const int nkb = KL2 / 64;
    conv_run(C, (NL / 32) * nkb, [=](int it) { const int j32 = it / nkb, kb = it % nkb; const int j = j32 * 32; const float* src = nullptr; int nk = 64;
        if (j < 4096) { const int ac = tperm(j); if (ac < 2048) { if (kb == 0) src = w_d + (size_t)(ac >> 10) * 64 * RW + (ac & 1023); } else { if (kb == 1) src = w_i + (size_t)((ac - 2048) >> 10) * 64 * RW + (ac & 1023); } }
        else { const int c = tperm(j - 4096); if (kb < 2) src = w_g + (size_t)(kb * 64) * RW + c; else if (kb == 2) { src = w_g + (size_t)128 * RW + c; nk = 32; } }
        return TrItem{src, RW, nk, Wt + (size_t)j * KL2 + kb * 64, KL2}; }, scr);
}
__device__ __forceinline__ void conv_wgu(Ctx& C, LAS float* scr) {
    bf16* Wt = (bf16*)(C.ws + WS_WGU); const float* wg = C.ka->in[22]; const float* wu = C.ka->in[23]; const float* nw2 = C.ka->in[21]; const int nkb = D / 64;
    conv_run(C, (2 * FF / 32) * nkb, [=](int it) { const int j32 = it / nkb, kb = it % nkb; const int j = j32 * 32, p = j >> 8, lc = j & 255;
        const float* W = (lc >= 128) ? wu : wg; const int hc = 128 * p + (lc & 127);
        return TrItem{W + (size_t)(kb * 64) * FF + hc, FF, 64, Wt + (size_t)j * D + kb * 64, D, nw2 + kb * 64}; }, scr);
}

__device__ __forceinline__ void rms_row(const float* xrow, const float* w, bf16* orow, int lane) {
    f32x4 v[8]; float ss = 0.f;
#pragma unroll
    for (int j = 0; j < 8; ++j) { v[j] = ((const f32x4*)xrow)[lane + 64 * j]; ss += (v[j].x * v[j].x + v[j].y * v[j].y) + (v[j].z * v[j].z + v[j].w * v[j].w); }
    ss = wave_sum(ss); const float rs = 1.0f / sqrtf(ss * (1.0f / D) + 1e-6f);
#pragma unroll
    for (int j = 0; j < 8; ++j) { const f32x4 w4 = ((const f32x4*)w)[lane + 64 * j]; u32x2 o; o.x = pk2(v[j].x * rs * w4.x, v[j].y * rs * w4.y); o.y = pk2(v[j].z * rs * w4.z, v[j].w * rs * w4.w);
        ((u32x2*)orow)[lane + 64 * j] = o; }
}

template <class Epi>
__device__ __forceinline__ void gemm_simple(Ctx& C, const bf16* A, const bf16* Bt, int N, int K, const Epi& epi) {
    const int lane_ = lane_now(), tid_ = C.wave * 64 + lane_; (void)tid_;
    const int lane = lane_, fr = lane & 15, fq = lane >> 4;
    const int ntn = N / 32; const long ntiles = (long)ntn * (S / 32);
    for (long it = C.gw; it < ntiles; it += C.ngw) {
        const int m0 = (int)(it / ntn) * 32, n0 = (int)(it % ntn) * 32;
        const bf16* ap = A + (size_t)(m0 + fr) * K + 8 * fq; const bf16* bp = Bt + (size_t)(n0 + fr) * K + 8 * fq;
        f32x4 acc[2][2];
#pragma unroll
        for (int i = 0; i < 2; ++i)
#pragma unroll
            for (int j = 0; j < 2; ++j) acc[i][j] = (f32x4){0.f, 0.f, 0.f, 0.f};
#pragma unroll 4
        for (int k = 0; k < K; k += 32) {
            const bf16x8 a0 = *(const bf16x8*)(ap + k), a1 = *(const bf16x8*)(ap + (size_t)16 * K + k);
            const bf16x8 b0 = *(const bf16x8*)(bp + k), b1 = *(const bf16x8*)(bp + (size_t)16 * K + k);
            acc[0][0] = __builtin_amdgcn_mfma_f32_16x16x32_bf16(b0, a0, acc[0][0], 0, 0, 0);
            acc[0][1] = __builtin_amdgcn_mfma_f32_16x16x32_bf16(b1, a0, acc[0][1], 0, 0, 0);
            acc[1][0] = __builtin_amdgcn_mfma_f32_16x16x32_bf16(b0, a1, acc[1][0], 0, 0, 0);
            acc[1][1] = __builtin_amdgcn_mfma_f32_16x16x32_bf16(b1, a1, acc[1][1], 0, 0, 0);
        }
#pragma unroll
        for (int i = 0; i < 2; ++i)
#pragma unroll
            for (int j = 0; j < 2; ++j) epi(m0 + 16 * i + fr, n0 + 16 * j + 4 * fq, acc[i][j]);
    }
}
__device__ __forceinline__ void gemm_simple_ffn1(Ctx& C, const bf16* A, const bf16* Bt, bf16* hid) {
    const int lane_ = lane_now(), tid_ = C.wave * 64 + lane_; (void)tid_;
    const int lane = lane_, fr = lane & 15, fq = lane >> 4, K = D;
    const int ntn = FF / 32; const long ntiles = (long)ntn * (S / 32);
    for (long it = C.gw; it < ntiles; it += C.ngw) {
        const int m0 = (int)(it / ntn) * 32, h0 = (int)(it % ntn) * 32, n0 = 256 * (h0 >> 7) + (h0 & 127);
        const bf16* ap = A + (size_t)(m0 + fr) * K + 8 * fq; const bf16* bp = Bt + (size_t)(n0 + fr) * K + 8 * fq;
        f32x4 ag[2][2], au[2][2];
#pragma unroll
        for (int i = 0; i < 2; ++i)
#pragma unroll
            for (int j = 0; j < 2; ++j) { ag[i][j] = (f32x4){0.f, 0.f, 0.f, 0.f}; au[i][j] = (f32x4){0.f, 0.f, 0.f, 0.f}; }
#pragma unroll 2
        for (int k = 0; k < K; k += 32) {
            const bf16x8 a0 = *(const bf16x8*)(ap + k), a1 = *(const bf16x8*)(ap + (size_t)16 * K + k);
            const bf16x8 g0 = *(const bf16x8*)(bp + k), g1 = *(const bf16x8*)(bp + (size_t)16 * K + k);
            const bf16x8 u0 = *(const bf16x8*)(bp + (size_t)128 * K + k), u1 = *(const bf16x8*)(bp + (size_t)144 * K + k);
            ag[0][0] = __builtin_amdgcn_mfma_f32_16x16x32_bf16(g0, a0, ag[0][0], 0, 0, 0); ag[0][1] = __builtin_amdgcn_mfma_f32_16x16x32_bf16(g1, a0, ag[0][1], 0, 0, 0);
            ag[1][0] = __builtin_amdgcn_mfma_f32_16x16x32_bf16(g0, a1, ag[1][0], 0, 0, 0); ag[1][1] = __builtin_amdgcn_mfma_f32_16x16x32_bf16(g1, a1, ag[1][1], 0, 0, 0);
            au[0][0] = __builtin_amdgcn_mfma_f32_16x16x32_bf16(u0, a0, au[0][0], 0, 0, 0); au[0][1] = __builtin_amdgcn_mfma_f32_16x16x32_bf16(u1, a0, au[0][1], 0, 0, 0);
            au[1][0] = __builtin_amdgcn_mfma_f32_16x16x32_bf16(u0, a1, au[1][0], 0, 0, 0); au[1][1] = __builtin_amdgcn_mfma_f32_16x16x32_bf16(u1, a1, au[1][1], 0, 0, 0);
        }
#pragma unroll
        for (int i = 0; i < 2; ++i)
#pragma unroll
            for (int j = 0; j < 2; ++j) { const int row = m0 + 16 * i + fr, hc = h0 + 16 * j + 4 * fq; const f32x4 g = ag[i][j], u = au[i][j]; float o[4];
#pragma unroll
                for (int e = 0; e < 4; ++e) o[e] = g[e] * sigmoidf_(g[e]) * u[e];
                u32x2 w; w.x = pk2(o[0], o[1]); w.y = pk2(o[2], o[3]); *(u32x2*)(hid + (size_t)row * FF + hc) = w; }
    }
}


namespace pg8 {
#define PG8_LAS __attribute__((address_space(3)))
typedef unsigned short bf16_t;
constexpr int BM = 256, BK = 64, HALF = 128, HTB = HALF * BK * 2, STAGE_BYTES = 8 * HTB, NXCD = 8, WGM = 4;
__host__ __device__ __forceinline__ int lds_byte(int r, int c) { const int st = (r >> 4) * 2 + (c >> 5), rr = r & 15, cc = c & 31, ob = rr * 64 + cc * 2; return st * 1024 + (ob ^ (((ob >> 9) & 1) << 5)); }
__host__ __device__ __forceinline__ void stage_rc(int b, int& R, int& C) { const int st = b / 1024, sb = b % 1024, swz = sb ^ (((sb >> 9) & 1) << 5); R = (st >> 1) * 16 + swz / 64; C = (st & 1) * 32 + (swz % 64) / 2; }
__host__ __device__ __forceinline__ int perm32(int rho) { const int n = rho >> 4, i = rho & 15; return 8 * (i >> 2) + 4 * n + (i & 3); }
struct Unit { int pm, pn; };
struct Gemm { const bf16_t* A; const bf16_t* Bt; int M, N, K; };
struct StaticOrder {
    int nM, nN, nwg, G, c;
    __host__ __device__ void init(int M, int N, int G_, int c_) { nM = M / BM; nN = N / BM; nwg = nM * nN; G = G_; c = c_; }
    __host__ __device__ bool next(int i, Unit& u) const {
        const long L = (long)i * G + c; if (L >= nwg) return false;
        int wgid = (int)L; { const int q = nwg / NXCD, r = nwg % NXCD, xcd = wgid % NXCD, off = wgid / NXCD; wgid = (xcd < r ? xcd * (q + 1) : r * (q + 1) + (xcd - r) * q) + off; }
        const int nig = WGM * nN, gid = wgid / nig, fm = gid * WGM, gsz = (nM - fm) < WGM ? (nM - fm) : WGM;
        u.pm = fm + ((wgid % nig) % gsz); u.pn = (wgid % nig) / gsz; return true;
    }
    __device__ __forceinline__ void a_ready(const Unit&) const {}
    __device__ __forceinline__ void done(const Unit&) const {}
};
__device__ __forceinline__ unsigned cvt_pk_bf16(float lo, float hi) { unsigned r; asm volatile("v_cvt_pk_bf16_f32 %0, %1, %2" : "=v"(r) : "v"(lo), "v"(hi)); return r; }
template <class Epi, class Sched, bool ALIGN_EPI = false, bool SP2 = false>
__device__ __forceinline__ void gemm_phase(PG8_LAS unsigned char* lds, const Gemm g, const Sched& S, const Epi& E, const int wid) {
    const int lane = lane_now(), tid = wid * 64 + lane, wr = wid >> 2, wc = wid & 3, fr = lane & 15, fq = lane >> 4;
    const int K = g.K, nt = K / BK;
    unsigned voffA[2], voffB[2];
#pragma unroll
    for (int i = 0; i < 2; ++i) { int R, C; stage_rc(tid * 16 + i * 8192, R, C); const int Rb = Epi::PERM ? ((R & ~31) + perm32(R & 31)) : R;
        voffA[i] = (unsigned)(R * K + C) * 2u; voffB[i] = (unsigned)(Rb * K + C) * 2u; }
    const size_t kstep = (size_t)(BK * 2);
    const size_t hstep = (size_t)HALF * K * 2;
    const size_t tstep = 2 * hstep;
    const unsigned ldsw = (unsigned)wid * 1024u;
    const int aoff = lds_byte(wr * 64 + fr, fq * 8), boff = lds_byte(wc * 32 + fr, fq * 8);
#define PG8_SA(b, h) (((b) * 2 + (h)) * HTB)
#define PG8_SB(b, h) ((4 + (b) * 2 + (h)) * HTB)
#define PG8_STAGE(bufoff, gbase, voff) do { _Pragma("unroll") for (int _i = 0; _i < 2; ++_i) \
        __builtin_amdgcn_global_load_lds((const unsigned*)((const char*)(gbase) + (voff)[_i]), (PG8_LAS unsigned*)(lds + (bufoff) + ldsw + _i * 8192), 16, 0, 0); } while (0)
#define PG8_LDA(dst, b, h) do { _Pragma("unroll") for (int m = 0; m < 4; ++m) _Pragma("unroll") for (int k = 0; k < 2; ++k) dst[m][k] = *(const PG8_LAS bf16x8*)(lds + PG8_SA(b, h) + aoff + m * 2048 + k * 1024); } while (0)
#define PG8_LDB(dst, b, h) do { _Pragma("unroll") for (int n = 0; n < 2; ++n) _Pragma("unroll") for (int k = 0; k < 2; ++k) dst[n][k] = *(const PG8_LAS bf16x8*)(lds + PG8_SB(b, h) + boff + n * 2048 + k * 1024); } while (0)
#define PG8_MMA(ai, bj, At, Bt) do { __builtin_amdgcn_s_setprio(1); _Pragma("unroll") for (int m = 0; m < 4; ++m) _Pragma("unroll") for (int n = 0; n < 2; ++n) _Pragma("unroll") for (int k = 0; k < 2; ++k) \
        acc[ai][bj][m][n] = __builtin_amdgcn_mfma_f32_16x16x32_bf16(Bt[n][k], At[m][k], acc[ai][bj][m][n], 0, 0, 0); __builtin_amdgcn_s_setprio(0); } while (0)
#define PG8_WAIT_V(n) asm volatile("s_waitcnt vmcnt(" #n ")" ::: "memory")
#define PG8_WAIT_L(n) asm volatile("s_waitcnt lgkmcnt(" #n ")" ::: "memory")
#define PG8_BAR __builtin_amdgcn_s_barrier()
#define PG8_SCHED __builtin_amdgcn_sched_barrier(0)
    Unit cur, nxt; int ui = 0;
    if (!S.next(0, cur)) return;
    f32x4 acc[2][2][4][2];
#pragma unroll
    for (int a = 0; a < 2; ++a)
#pragma unroll
        for (int b = 0; b < 2; ++b)
#pragma unroll
            for (int m = 0; m < 4; ++m)
#pragma unroll
                for (int n = 0; n < 2; ++n) acc[a][b][m][n] = (f32x4){0.f, 0.f, 0.f, 0.f};
    bf16x8 At[4][2], B0[2][2], B1[2][2];
    const char* cA = (const char*)g.A + (size_t)cur.pm * tstep; const char* cB = (const char*)g.Bt + (size_t)cur.pn * tstep;
    S.a_ready(cur);
    if constexpr (SP2) {
        PG8_STAGE(PG8_SB(0, 0), cB, voffB); PG8_STAGE(PG8_SB(0, 1), cB + hstep, voffB); PG8_STAGE(PG8_SA(0, 0), cA, voffA); PG8_STAGE(PG8_SA(0, 1), cA + hstep, voffA);
        if (wr == 1) PG8_BAR;
        PG8_WAIT_V(2); PG8_BAR;
        PG8_STAGE(PG8_SB(1, 0), cB + kstep, voffB); PG8_STAGE(PG8_SA(1, 0), cA + kstep, voffA); PG8_STAGE(PG8_SB(1, 1), cB + hstep + kstep, voffB);
        PG8_WAIT_V(6); PG8_BAR;
    } else {
        PG8_STAGE(PG8_SB(0, 0), cB, voffB); PG8_STAGE(PG8_SA(0, 0), cA, voffA); PG8_STAGE(PG8_SB(0, 1), cB + hstep, voffB); PG8_STAGE(PG8_SA(0, 1), cA + hstep, voffA);
        if (wr == 1) PG8_BAR;
        PG8_WAIT_V(4); PG8_BAR;
        PG8_STAGE(PG8_SB(1, 0), cB + kstep, voffB); PG8_STAGE(PG8_SA(1, 0), cA + kstep, voffA); PG8_STAGE(PG8_SB(1, 1), cB + hstep + kstep, voffB);
        PG8_WAIT_V(6); PG8_BAR;
    }
    for (;;) {
        const bool has_next = S.next(ui + 1, nxt);
        const char* nA = has_next ? (const char*)g.A + (size_t)nxt.pm * tstep : cA; const char* nB = has_next ? (const char*)g.Bt + (size_t)nxt.pn * tstep : cB;
        for (int t = 0; t < nt; t += 2) {
            const bool last = (t == nt - 2);
            const char* a1 = cA + (size_t)(t + 1) * kstep;
            const char* a2 = last ? nA : cA + (size_t)(t + 2) * kstep; const char* b2 = last ? nB : cB + (size_t)(t + 2) * kstep;
            const char* a3 = a2 + kstep; const char* b3 = b2 + kstep;
            if (last && has_next) S.a_ready(nxt);
            if constexpr (SP2) {
            PG8_LDB(B0, 0, 0); PG8_LDB(B1, 0, 1); PG8_SCHED; PG8_LDA(At, 0, 0); PG8_STAGE(PG8_SA(1, 1), a1 + hstep, voffA);
            PG8_WAIT_V(8); PG8_WAIT_L(0); PG8_BAR; PG8_MMA(0, 0, At, B0); PG8_MMA(0, 1, At, B1); PG8_BAR; PG8_SCHED;
            PG8_LDA(At, 0, 1); PG8_STAGE(PG8_SB(0, 0), b2, voffB); PG8_STAGE(PG8_SB(0, 1), b2 + hstep, voffB); PG8_STAGE(PG8_SA(0, 0), a2, voffA);
            PG8_WAIT_V(8); PG8_WAIT_L(0); PG8_BAR; PG8_MMA(1, 0, At, B0); PG8_MMA(1, 1, At, B1); PG8_BAR; PG8_SCHED;
            PG8_LDB(B0, 1, 0); PG8_LDB(B1, 1, 1); PG8_SCHED; PG8_LDA(At, 1, 0); PG8_STAGE(PG8_SA(0, 1), a2 + hstep, voffA);
            PG8_WAIT_V(8); PG8_WAIT_L(0); PG8_BAR; PG8_MMA(0, 0, At, B0); PG8_MMA(0, 1, At, B1); PG8_BAR; PG8_SCHED;
            PG8_LDA(At, 1, 1); PG8_STAGE(PG8_SB(1, 0), b3, voffB); PG8_STAGE(PG8_SB(1, 1), b3 + hstep, voffB); PG8_STAGE(PG8_SA(1, 0), a3, voffA);
            PG8_WAIT_V(8); PG8_WAIT_L(0); PG8_BAR; PG8_MMA(1, 0, At, B0); PG8_MMA(1, 1, At, B1); PG8_BAR; PG8_SCHED;
            } else {
            PG8_LDB(B0, 0, 0); PG8_SCHED; PG8_LDA(At, 0, 0); PG8_STAGE(PG8_SA(1, 1), a1 + hstep, voffA);
            PG8_WAIT_L(8); PG8_BAR; PG8_WAIT_L(0); PG8_MMA(0, 0, At, B0); PG8_BAR; PG8_SCHED;
            PG8_LDB(B1, 0, 1); PG8_STAGE(PG8_SB(0, 0), b2, voffB);
            PG8_BAR; PG8_WAIT_L(0); PG8_MMA(0, 1, At, B1); PG8_BAR;
            PG8_LDA(At, 0, 1); PG8_STAGE(PG8_SA(0, 0), a2, voffA);
            PG8_BAR; PG8_WAIT_L(0); PG8_MMA(1, 0, At, B0); PG8_BAR; PG8_SCHED;
            PG8_STAGE(PG8_SB(0, 1), b2 + hstep, voffB);
            PG8_WAIT_V(6); PG8_BAR; PG8_MMA(1, 1, At, B1); PG8_BAR;
            PG8_LDB(B0, 1, 0); PG8_SCHED; PG8_LDA(At, 1, 0); PG8_STAGE(PG8_SA(0, 1), a2 + hstep, voffA);
            PG8_WAIT_L(8); PG8_BAR; PG8_WAIT_L(0); PG8_MMA(0, 0, At, B0); PG8_BAR; PG8_SCHED;
            PG8_LDB(B1, 1, 1); PG8_STAGE(PG8_SB(1, 0), b3, voffB);
            PG8_BAR; PG8_WAIT_L(0); PG8_MMA(0, 1, At, B1); PG8_BAR;
            PG8_LDA(At, 1, 1); PG8_STAGE(PG8_SA(1, 0), a3, voffA);
            PG8_BAR; PG8_WAIT_L(0); PG8_MMA(1, 0, At, B0); PG8_BAR; PG8_SCHED;
            PG8_STAGE(PG8_SB(1, 1), b3 + hstep, voffB);
            PG8_WAIT_V(6); PG8_BAR; PG8_MMA(1, 1, At, B1); PG8_BAR;
            }
        }
        if constexpr (ALIGN_EPI) { if (wr == 0) PG8_BAR; }
        if constexpr (!Epi::AFTER_DRAIN) { int fr_e = fr, fq_e = fq; asm volatile("" : "+v"(fr_e), "+v"(fq_e)); E(acc, cur, wr, wc, fr_e, fq_e); S.done(cur); }
        if (!has_next) break;
#pragma unroll
        for (int a = 0; a < 2; ++a)
#pragma unroll
            for (int b = 0; b < 2; ++b)
#pragma unroll
                for (int m = 0; m < 4; ++m)
#pragma unroll
                    for (int n = 0; n < 2; ++n) acc[a][b][m][n] = (f32x4){0.f, 0.f, 0.f, 0.f};
        cur = nxt; cA = nA; cB = nB; ++ui;
        if constexpr (ALIGN_EPI) { if (wr == 1) PG8_BAR; }
    }
    PG8_WAIT_V(0);
    if constexpr (!ALIGN_EPI) { if (wr == 0) PG8_BAR; }
    PG8_BAR;
    if constexpr (Epi::AFTER_DRAIN) { E.fused(acc, cur, wr, wc, fr, fq, lds, wid, lane); S.done(cur); }
#undef PG8_SA
#undef PG8_SB
#undef PG8_STAGE
#undef PG8_LDA
#undef PG8_LDB
#undef PG8_MMA
#undef PG8_WAIT_V
#undef PG8_WAIT_L
#undef PG8_BAR
#undef PG8_SCHED
}
}


#ifndef OPT_GEMM
#define OPT_GEMM 1
#endif
typedef f32x4 AccT[2][2][4][2];
#ifndef NT_EPI
#define NT_EPI 0
#endif
#if NT_EPI
#define NTST4(p, v) __builtin_nontemporal_store((v), (u32x4*)(p))
#else
#define NTST4(p, v) (*(u32x4*)(p) = (v))
#endif
__device__ __forceinline__ u32x4 pack8(f32x4 a, f32x4 b) { u32x4 w; w.x = pg8::cvt_pk_bf16(a[0], a[1]); w.y = pg8::cvt_pk_bf16(a[2], a[3]); w.z = pg8::cvt_pk_bf16(b[0], b[1]); w.w = pg8::cvt_pk_bf16(b[2], b[3]); return w; }
__device__ __forceinline__ void unpack8(u32x4 w, float (&f)[8]) { f[0] = __uint_as_float(w.x << 16); f[1] = __uint_as_float(w.x & 0xffff0000u); f[2] = __uint_as_float(w.y << 16); f[3] = __uint_as_float(w.y & 0xffff0000u);
    f[4] = __uint_as_float(w.z << 16); f[5] = __uint_as_float(w.z & 0xffff0000u); f[6] = __uint_as_float(w.w << 16); f[7] = __uint_as_float(w.w & 0xffff0000u); }
struct EpiG1A8 { static constexpr bool PERM = true, AFTER_DRAIN = false; bf16* zqkv; bf16* zr; const float* qw; const float* kw;
    __device__ __forceinline__ void operator()(const AccT& acc, const pg8::Unit& u, int wr, int wc, int fr, int fq) const {
        const int row0 = u.pm * 256 + wr * 64 + fr, acb = u.pn * 256 + wc * 64 + 8 * fq;
        if (u.pn < 12) {
            const float* nw = u.pn < 6 ? qw : kw; const float sc = u.pn < 6 ? 0.125f : 1.0f; f32x4 w[2][2];
#pragma unroll
            for (int bj = 0; bj < 2; ++bj)
#pragma unroll
                for (int n = 0; n < 2; ++n) w[bj][n] = *(const f32x4*)(nw + 32 * bj + 8 * fq + 4 * n) * sc;
#pragma unroll
            for (int ai = 0; ai < 2; ++ai)
#pragma unroll
                for (int m = 0; m < 4; ++m) { float ss = 0.f;
#pragma unroll
                    for (int bj = 0; bj < 2; ++bj)
#pragma unroll
                        for (int n = 0; n < 2; ++n) { const f32x4 x = acc[ai][bj][m][n]; ss += (x[0] * x[0] + x[1] * x[1]) + (x[2] * x[2] + x[3] * x[3]); }
                    ss += __shfl_xor(ss, 16); ss += __shfl_xor(ss, 32);
                    const float rs = 1.0f / sqrtf(ss * (1.0f / 64.f) + 1e-6f);
                    bf16* rp = zqkv + (size_t)(row0 + ai * 128 + m * 16) * NQKV + acb;
#pragma unroll
                    for (int bj = 0; bj < 2; ++bj) NTST4(rp + 32 * bj, pack8(acc[ai][bj][m][0] * rs * w[bj][0], acc[ai][bj][m][1] * rs * w[bj][1])); }
        } else {
            bf16* base = u.pn < 18 ? zqkv + acb : zr + (acb - NQKV); const int ld = u.pn < 18 ? NQKV : NZR;
#pragma unroll
            for (int ai = 0; ai < 2; ++ai)
#pragma unroll
                for (int m = 0; m < 4; ++m) { bf16* rp = base + (size_t)(row0 + ai * 128 + m * 16) * ld;
#pragma unroll
                    for (int bj = 0; bj < 2; ++bj) NTST4(rp + 32 * bj, pack8(acc[ai][bj][m][0], acc[ai][bj][m][1])); }
        }
    } };
template <int MODE> struct EpiLora8 { static constexpr bool PERM = true, AFTER_DRAIN = false; bf16* dst; const float* bias;
    __device__ __forceinline__ void operator()(const AccT& acc, const pg8::Unit& u, int wr, int wc, int fr, int fq) const {
        const int row0 = u.pm * 256 + wr * 64 + fr; const int cb = (u.pn & 3) * 256 + wc * 64 + 8 * fq; const int z = MODE == 2 ? 0 : (u.pn >> 2); f32x4 bv[2][2];
#pragma unroll
        for (int bj = 0; bj < 2; ++bj)
#pragma unroll
            for (int n = 0; n < 2; ++n) bv[bj][n] = MODE == 2 ? (f32x4){0.f, 0.f, 0.f, 0.f} : *(const f32x4*)(bias + z * RW + cb + 32 * bj + 4 * n);
#pragma unroll
        for (int ai = 0; ai < 2; ++ai)
#pragma unroll
            for (int m = 0; m < 4; ++m) { bf16* rp = dst + ((size_t)z * S + row0 + ai * 128 + m * 16) * RW + cb;
#pragma unroll
                for (int bj = 0; bj < 2; ++bj) { f32x4 o[2];
#pragma unroll
                    for (int n = 0; n < 2; ++n)
#pragma unroll
                        for (int e = 0; e < 4; ++e) { const float v = bv[bj][n][e] + acc[ai][bj][m][n][e];
                            if (MODE == 0) { const float x = -v; const float sp = fmaxf(x, 0.f) + __logf(1.0f + __expf(-fabsf(x))); o[n][e] = -__expf(-sp - 0.5f); }
                            else if (MODE == 1) o[n][e] = sigmoidf_(v); else o[n][e] = v; }
                    NTST4(rp + 32 * bj, pack8(o[0], o[1])); } }
    } };
struct LoraOrder { int G, c;
    __device__ bool next(int i, pg8::Unit& u) const { const int L = i * G + c; if (L >= 1280) return false; u.pn = L >> 6; u.pm = (L & 63) + (u.pn >= 16 ? 64 : 0); return true; }
    __device__ __forceinline__ void a_ready(const pg8::Unit&) const {}
    __device__ __forceinline__ void done(const pg8::Unit&) const {}
};
struct EpiLoraU8 { static constexpr bool PERM = true, AFTER_DRAIN = false; unsigned char* wsb; const float* w0; const float* a0;
    __device__ __forceinline__ void operator()(const AccT& acc, const pg8::Unit& u, int wr, int wc, int fr, int fq) const {
        const int row0 = (u.pm & 63) * 256 + wr * 64 + fr; const int cb = (u.pn & 3) * 256 + wc * 64 + 8 * fq; const int mode = u.pn < 8 ? 0 : (u.pn < 16 ? 1 : 2), z = mode == 2 ? 0 : ((u.pn >> 2) & 1);
        const float* bias = mode == 0 ? w0 : a0; const size_t doff = mode == 0 ? WS_LW : WS_A; bf16* dst = (bf16*)(wsb + (mode == 2 ? WS_GATE : doff)); f32x4 bv[2][2];
#pragma unroll
        for (int bj = 0; bj < 2; ++bj)
#pragma unroll
            for (int n = 0; n < 2; ++n) { bv[bj][n] = (f32x4){0.f, 0.f, 0.f, 0.f}; if (mode != 2) bv[bj][n] = *(const f32x4*)(bias + z * RW + cb + 32 * bj + 4 * n); }
#pragma unroll
        for (int ai = 0; ai < 2; ++ai)
#pragma unroll
            for (int m = 0; m < 4; ++m) { bf16* rp = dst + ((size_t)z * S + row0 + ai * 128 + m * 16) * RW + cb;
#pragma unroll
                for (int bj = 0; bj < 2; ++bj) { f32x4 o[2];
#pragma unroll
                    for (int n = 0; n < 2; ++n)
#pragma unroll
                        for (int e = 0; e < 4; ++e) { const float v = bv[bj][n][e] + acc[ai][bj][m][n][e];
                            const float sg = __builtin_amdgcn_rcpf(1.0f + __builtin_amdgcn_exp2f(v * -1.44269504f)); o[n][e] = mode == 0 ? -0.60653066f * sg : (mode == 1 ? sg : v); }
                    *(u32x4*)(rp + 32 * bj) = pack8(o[0], o[1]); } }
    } };
struct EpiG1B8 { static constexpr bool PERM = true, AFTER_DRAIN = false; bf16* zg; const float* bg;
    __device__ __forceinline__ void operator()(const AccT& acc, const pg8::Unit& u, int wr, int wc, int fr, int fq) const {
        const int row0 = u.pm * 256 + wr * 64 + fr, acb = u.pn * 256 + wc * 64 + 8 * fq; f32x4 bv[2][2];
#pragma unroll
        for (int bj = 0; bj < 2; ++bj)
#pragma unroll
            for (int n = 0; n < 2; ++n) bv[bj][n] = *(const f32x4*)(bg + acb + 32 * bj + 4 * n);
#pragma unroll
        for (int ai = 0; ai < 2; ++ai)
#pragma unroll
            for (int m = 0; m < 4; ++m) { bf16* rp = zg + (size_t)(row0 + ai * 128 + m * 16) * NGATE + acb;
#pragma unroll
                for (int bj = 0; bj < 2; ++bj) { f32x4 o[2];
#pragma unroll
                    for (int n = 0; n < 2; ++n)
#pragma unroll
                        for (int e = 0; e < 4; ++e) o[n][e] = sigmoidf_(acc[ai][bj][m][n][e] + bv[bj][n][e]);
                    NTST4(rp + 32 * bj, pack8(o[0], o[1])); } }
    } };
template <bool SECOND> struct EpiMerge8 { static constexpr bool PERM = true, AFTER_DRAIN = false; bf16* mg; const bf16* zg;
    __device__ __forceinline__ void operator()(const AccT& acc, const pg8::Unit& u, int wr, int wc, int fr, int fq) const {
        const int row0 = u.pm * 256 + wr * 64 + fr, col0 = u.pn * 256 + wc * 32 + 8 * fq;
#pragma unroll
        for (int ai = 0; ai < 2; ++ai)
#pragma unroll
            for (int m = 0; m < 4; ++m) { const int row = row0 + ai * 128 + m * 16;
#pragma unroll
                for (int bj = 0; bj < 2; ++bj) { const int col = col0 + 128 * bj; float g[8]; unpack8(*(const u32x4*)(zg + (size_t)row * NGATE + (SECOND ? D : 0) + col), g); f32x4 o[2];
                    float t[8]; if (SECOND) unpack8(*(const u32x4*)(mg + (size_t)row * D + col), t);
#pragma unroll
                    for (int n = 0; n < 2; ++n)
#pragma unroll
                        for (int e = 0; e < 4; ++e) o[n][e] = (SECOND ? t[4 * n + e] : 0.f) + g[4 * n + e] * acc[ai][bj][m][n][e];
                    *(u32x4*)(mg + (size_t)row * D + col) = pack8(o[0], o[1]); } }
    } };
struct EpiRes8 { static constexpr bool PERM = false, AFTER_DRAIN = false; const float* base; float* out;
    __device__ __forceinline__ void operator()(const AccT& acc, const pg8::Unit& u, int wr, int wc, int fr, int fq) const {
        const int row0 = u.pm * 256 + wr * 64 + fr, col0 = u.pn * 256 + wc * 32 + 4 * fq;
#pragma unroll
        for (int ai = 0; ai < 2; ++ai)
#pragma unroll
            for (int m = 0; m < 4; ++m) { const size_t off = (size_t)(row0 + ai * 128 + m * 16) * D + col0;
#pragma unroll
                for (int bj = 0; bj < 2; ++bj)
#pragma unroll
                    for (int n = 0; n < 2; ++n) { const f32x4 b = *(const f32x4*)(base + off + bj * 128 + n * 16); *(f32x4*)(out + off + bj * 128 + n * 16) = b + acc[ai][bj][m][n]; } }
    } };
struct EpiX2b8 { static constexpr bool PERM = true, AFTER_DRAIN = false; const float* base; bf16* xb; float* ssqp;
    __device__ __forceinline__ void operator()(const AccT& acc, const pg8::Unit& u, int wr, int wc, int fr, int fq) const {
        const int row0 = u.pm * 256 + wr * 64 + fr, col0 = u.pn * 256 + wc * 32 + 8 * fq;
#pragma unroll
        for (int ai = 0; ai < 2; ++ai)
#pragma unroll
            for (int m = 0; m < 4; ++m) { const int row = row0 + ai * 128 + m * 16; const size_t off = (size_t)row * D + col0; float ss = 0.f;
#pragma unroll
                for (int bj = 0; bj < 2; ++bj) { const f32x4 b0 = *(const f32x4*)(base + off + bj * 128), b1 = *(const f32x4*)(base + off + bj * 128 + 4);
                    const f32x4 o0 = b0 + acc[ai][bj][m][0], o1 = b1 + acc[ai][bj][m][1];
                    ss += (o0[0] * o0[0] + o0[1] * o0[1]) + (o0[2] * o0[2] + o0[3] * o0[3]) + (o1[0] * o1[0] + o1[1] * o1[1]) + (o1[2] * o1[2] + o1[3] * o1[3]);
                    *(u32x4*)(xb + off + bj * 128) = pack8(o0, o1); }
                ss += __shfl_xor(ss, 16); ss += __shfl_xor(ss, 32);
                if (fq == 0) ssqp[(size_t)row * 32 + u.pn * 4 + wc] = ss; }
    } };
struct EpiResB8 { static constexpr bool PERM = false, AFTER_DRAIN = false; const bf16* xb; float* out;
    __device__ __forceinline__ void operator()(const AccT& acc, const pg8::Unit& u, int wr, int wc, int fr, int fq) const {
        const int row0 = u.pm * 256 + wr * 64 + fr, col0 = u.pn * 256 + wc * 32 + 4 * fq;
#pragma unroll
        for (int ai = 0; ai < 2; ++ai)
#pragma unroll
            for (int m = 0; m < 4; ++m) { const size_t off = (size_t)(row0 + ai * 128 + m * 16) * D + col0;
#pragma unroll
                for (int bj = 0; bj < 2; ++bj)
#pragma unroll
                    for (int n = 0; n < 2; ++n) { const u32x2 w = *(const u32x2*)(xb + off + bj * 128 + n * 16);
                        const f32x4 b = (f32x4){__uint_as_float(w.x << 16), __uint_as_float(w.x & 0xffff0000u), __uint_as_float(w.y << 16), __uint_as_float(w.y & 0xffff0000u)};
                        *(f32x4*)(out + off + bj * 128 + n * 16) = b + acc[ai][bj][m][n]; } }
    } };
struct EpiFfn18 { static constexpr bool PERM = true, AFTER_DRAIN = false; bf16* hid; const float* rstd;
    __device__ __forceinline__ void operator()(const AccT& acc, const pg8::Unit& u, int wr, int wc, int fr, int fq) const {
        const int row0 = u.pm * 256 + wr * 64 + fr, hc0 = u.pn * 128 + wc * 32 + 8 * fq;
#pragma unroll
        for (int ai = 0; ai < 2; ++ai)
#pragma unroll
            for (int m = 0; m < 4; ++m) { f32x4 o[2]; const float rs = rstd[row0 + ai * 128 + m * 16];
#pragma unroll
                for (int n = 0; n < 2; ++n)
#pragma unroll
                    for (int e = 0; e < 4; ++e) { const float g = acc[ai][0][m][n][e] * rs; o[n][e] = g * sigmoidf_(g) * (acc[ai][1][m][n][e] * rs); }
                NTST4(hid + (size_t)(row0 + ai * 128 + m * 16) * FF + hc0, pack8(o[0], o[1])); }
    } };
template <class Epi> __device__ __forceinline__ void gemm8(Ctx& C, const bf16* A, const bf16* Bt, int N, int K, const Epi& E) {
    asm volatile("" : "+s"(N), "+s"(K));
    pg8::Gemm g{A, Bt, S, N, K}; pg8::StaticOrder so; so.init(S, N, C.nb, C.bid);
    pg8::gemm_phase<Epi, pg8::StaticOrder, true, true>(C.lds, g, so, E, C.wave);
}

__device__ __forceinline__ void st4bf(bf16* p, f32x4 v) { u32x2 w; w.x = pk2(v[0], v[1]); w.y = pk2(v[2], v[3]); *(u32x2*)p = w; }
struct EpiG1A { bf16* zqkv; bf16* zr;
    __device__ __forceinline__ void operator()(int row, int j0, f32x4 v) const { const int ac = tperm(j0);
        if (ac < NQKV) st4bf(zqkv + (size_t)row * NQKV + ac, v); else st4bf(zr + (size_t)row * NZR + (ac - NQKV), v); } };
struct EpiLora { bf16* lw; bf16* a; bf16* gate; const float* w0; const float* a0;
    __device__ __forceinline__ void operator()(int row, int j0, f32x4 v) const { const int ac = tperm(j0);
        if (ac < 2048) { const int z = ac >> 10, c = ac & 1023; f32x4 o;
#pragma unroll
            for (int e = 0; e < 4; ++e) { const float x = -(w0[z * RW + c + e] + v[e]); const float sp = fmaxf(x, 0.f) + log1pf(__expf(-fabsf(x))); o[e] = -__expf(-sp - 0.5f); }
            st4bf(lw + ((size_t)z * S + row) * RW + c, o); }
        else if (ac < 4096) { const int z = (ac - 2048) >> 10, c = ac & 1023; f32x4 o;
#pragma unroll
            for (int e = 0; e < 4; ++e) o[e] = sigmoidf_(a0[z * RW + c + e] + v[e]);
            st4bf(a + ((size_t)z * S + row) * RW + c, o); }
        else st4bf(gate + (size_t)row * RW + (ac - 4096), v); } };
struct EpiG1B { bf16* zg; const float* bg;
    __device__ __forceinline__ void operator()(int row, int j0, f32x4 v) const { const int ac = tperm(j0); f32x4 o;
#pragma unroll
        for (int e = 0; e < 4; ++e) o[e] = sigmoidf_(v[e] + bg[ac + e]);
        st4bf(zg + (size_t)row * NGATE + ac, o); } };
struct EpiMA { bf16* mg; const bf16* zg;
    __device__ __forceinline__ void operator()(int row, int j0, f32x4 v) const { const u32x2 g = *(const u32x2*)(zg + (size_t)row * NGATE + j0); f32x4 o;
        o[0] = v[0] * bf2f((bf16)(g.x & 0xffff)); o[1] = v[1] * bf2f((bf16)(g.x >> 16)); o[2] = v[2] * bf2f((bf16)(g.y & 0xffff)); o[3] = v[3] * bf2f((bf16)(g.y >> 16));
        st4bf(mg + (size_t)row * D + j0, o); } };
struct EpiMB { bf16* mg; const bf16* zg;
    __device__ __forceinline__ void operator()(int row, int j0, f32x4 v) const { const u32x2 g = *(const u32x2*)(zg + (size_t)row * NGATE + D + j0); const u32x2 t = *(const u32x2*)(mg + (size_t)row * D + j0); f32x4 o;
        o[0] = bf2f((bf16)(t.x & 0xffff)) + v[0] * bf2f((bf16)(g.x & 0xffff)); o[1] = bf2f((bf16)(t.x >> 16)) + v[1] * bf2f((bf16)(g.x >> 16));
        o[2] = bf2f((bf16)(t.y & 0xffff)) + v[2] * bf2f((bf16)(g.y & 0xffff)); o[3] = bf2f((bf16)(t.y >> 16)) + v[3] * bf2f((bf16)(g.y >> 16));
        st4bf(mg + (size_t)row * D + j0, o); } };
struct EpiRes { const float* base; float* out;
    __device__ __forceinline__ void operator()(int row, int j0, f32x4 v) const { const f32x4 b = *(const f32x4*)(base + (size_t)row * D + j0); *(f32x4*)(out + (size_t)row * D + j0) = b + v; } };


#ifndef OPT_SCAN
#define OPT_SCAN 1
#endif
#ifndef OPT_SCANM
#define OPT_SCANM 1
#endif
constexpr int SC_T = 8, SC_STEPF = 384, SC_ITEMF = SC_T * SC_STEPF;
template <int CTRL> __device__ __forceinline__ float dpp_f(float x) { return __int_as_float(__builtin_amdgcn_update_dpp(0, __float_as_int(x), CTRL, 0xf, 0xf, true)); }
__device__ __forceinline__ float quad_sum(float x) { x += dpp_f<0xB1>(x); x += dpp_f<0x4E>(x); return x; }
template <int role> __device__ __forceinline__ void ph_scan1_r(Ctx& C) {
    const int lane = lane_now(), wave = C.wave, itl = wave & 3, kq = lane & 3, rg = lane >> 2;
    const int t128 = role * 64 + lane, sst = t128 >> 4, cg = t128 & 15;
    const bf16* g_r = (const bf16*)(C.ws + WS_R); const bf16* g_v = (const bf16*)(C.ws + WS_V); const bf16* g_nkk = (const bf16*)(C.ws + WS_NKK); const bf16* g_k = (const bf16*)(C.ws + WS_KRAW);
    const bf16* g_lw = (const bf16*)(C.ws + WS_LW); const bf16* g_a = (const bf16*)(C.ws + WS_A); const float* k_a = C.ka->in[14];
    bf16* g_out = role ? (bf16*)(C.ws + WS_YL) : (bf16*)(C.dout + DO_QT); float* g_pu = (float*)(C.ws + WS_PU);
    LAS float* lbase = (LAS float*)C.lds + itl * SC_ITEMF;
    const int nitems = NCHAIN * NCK;
    for (int base = C.bid * 4; base < nitems; base += C.nb * 4) {
        const int item = base + itl; const bool active = item < nitems; const int chain = active ? item / NCK : 0, chunk = active ? item % NCK : 0, z = chain >> 4, h = chain & 15;
        const size_t zoff = (size_t)z * S * RW; const int cbase = h * 64 + 4 * cg;
        const f32x4 ka4 = *(const f32x4*)(k_a + cbase);
        f32x2 st[4][8];
#pragma unroll
        for (int i = 0; i < 4; ++i)
#pragma unroll
            for (int kk = 0; kk < 8; ++kk) { const int row = 4 * rg + i, k0 = 16 * kq + 2 * kk; st[i][kk] = (f32x2){(role == 0 && row == k0) ? 1.f : 0.f, (role == 0 && row == k0 + 1) ? 1.f : 0.f}; }
        u32x2 q_nkk, q_lw, q_a, q_k, q_r, q_v;
#define SC_LOAD(blk) do { const int sg_ = chunk * CHL + (blk) * SC_T + sst; const int tk_ = z ? S - 1 - sg_ : sg_; const size_t ix_ = (size_t)tk_ * RW + cbase; \
            q_nkk = *(const u32x2*)(g_nkk + ix_); q_lw = *(const u32x2*)(g_lw + zoff + ix_); q_a = *(const u32x2*)(g_a + zoff + ix_); q_k = *(const u32x2*)(g_k + ix_); q_r = *(const u32x2*)(g_r + ix_); q_v = *(const u32x2*)(g_v + ix_); } while (0)
#define SC_BF(q, e) __uint_as_float(((e) & 1) ? (((e) >> 1) ? (q).y : (q).x) & 0xffff0000u : (((e) >> 1) ? (q).y : (q).x) << 16)
#define SC_WRITE(buf) do { LAS float* d_ = lbase + (buf) * 4 * SC_ITEMF + sst * SC_STEPF + 4 * cg; f32x4 o0, o1, o2, o3, o4, o5; \
            _Pragma("unroll") for (int e = 0; e < 4; ++e) { const float n_ = SC_BF(q_nkk, e), a_ = SC_BF(q_a, e); o0[e] = n_; o1[e] = __expf(SC_BF(q_lw, e)); o2[e] = -n_ * a_; o3[e] = SC_BF(q_k, e) * (1.0f + (a_ - 1.0f) * ka4[e]); o4[e] = SC_BF(q_r, e); o5[e] = SC_BF(q_v, e); } \
            *(LAS f32x4*)(d_) = o0; *(LAS f32x4*)(d_ + 64) = o1; *(LAS f32x4*)(d_ + 128) = o2; *(LAS f32x4*)(d_ + 192) = o3; *(LAS f32x4*)(d_ + 256) = o4; *(LAS f32x4*)(d_ + 320) = o5; } while (0)
        SC_LOAD(0); SC_WRITE(0);
        __syncthreads();
        for (int blk = 0; blk < CHL / SC_T; ++blk) {
            if (blk + 1 < CHL / SC_T) SC_LOAD(blk + 1);
            const LAS float* bp = lbase + (blk & 1) * 4 * SC_ITEMF + 16 * kq;
            f32x4 x[4];
#pragma unroll
            for (int q = 0; q < 4; ++q) x[q] = *(const LAS f32x4*)(bp + 4 * q);
#pragma unroll 2
            for (int ss = 0; ss < SC_T; ++ss) {
                const LAS float* sp = bp + ss * SC_STEPF;
                float sa[4], y[4];
                f32x4 vv = (f32x4){0.f, 0.f, 0.f, 0.f}; if (role) vv = *(const LAS f32x4*)(sp - 16 * kq + 320 + 4 * rg);
                f32x4 w4[4], b4[4], r4[4], k4[4];
#pragma unroll
                for (int q = 0; q < 4; ++q) { w4[q] = *(const LAS f32x4*)(sp + 64 + 4 * q); b4[q] = *(const LAS f32x4*)(sp + 128 + 4 * q); r4[q] = *(const LAS f32x4*)(sp + 256 + 4 * q); if (role) k4[q] = *(const LAS f32x4*)(sp + 192 + 4 * q); }
                {   f32x2 s2[4];
#pragma unroll
                    for (int i = 0; i < 4; ++i) { s2[i] = st[i][0] * (f32x2){x[0][0], x[0][1]};
#pragma unroll
                        for (int kk = 1; kk < 8; ++kk) s2[i] += st[i][kk] * (f32x2){x[kk >> 1][2 * (kk & 1)], x[kk >> 1][2 * (kk & 1) + 1]}; }
#pragma unroll
                    for (int i = 0; i < 4; ++i) sa[i] = quad_sum(s2[i].x + s2[i].y); }
                if (ss + 1 < SC_T) {
#pragma unroll
                    for (int q = 0; q < 4; ++q) x[q] = *(const LAS f32x4*)(sp + SC_STEPF + 4 * q); }
                __builtin_amdgcn_sched_barrier(0);
                f32x2 y2[4];
#pragma unroll
                for (int i = 0; i < 4; ++i) y2[i] = (f32x2){0.f, 0.f};
#pragma unroll
                for (int kk = 0; kk < 8; ++kk) { const int q = kk >> 1, o = 2 * (kk & 1); const f32x2 w2 = (f32x2){w4[q][o], w4[q][o + 1]}, b2 = (f32x2){b4[q][o], b4[q][o + 1]}, r2 = (f32x2){r4[q][o], r4[q][o + 1]};
#pragma unroll
                    for (int i = 0; i < 4; ++i) { f32x2 t2 = b2 * sa[i]; if (role) t2 += (f32x2){k4[q][o], k4[q][o + 1]} * vv[i]; st[i][kk] = st[i][kk] * w2 + t2; y2[i] += st[i][kk] * r2; } }
#pragma unroll
                for (int i = 0; i < 4; ++i) y[i] = quad_sum(y2[i].x + y2[i].y);
                if (active && kq == 0) { const int sg = chunk * CHL + blk * SC_T + ss; const int tk = z ? S - 1 - sg : sg; u32x2 o; o.x = pk2(y[0], y[1]); o.y = pk2(y[2], y[3]);
                    *(u32x2*)(g_out + zoff + (size_t)tk * RW + h * 64 + 4 * rg) = o; }
            }
            if (blk + 1 < CHL / SC_T) SC_WRITE((blk + 1) & 1);
            __syncthreads();
        }
        if (active) { float* pp = g_pu + (((size_t)chain * NCK + chunk) * 2 + role) * 4096;
#pragma unroll
            for (int i = 0; i < 4; ++i)
#pragma unroll
                for (int q = 0; q < 4; ++q) *(f32x4*)(pp + (4 * rg + i) * 64 + 16 * kq + 4 * q) = (f32x4){st[i][2 * q].x, st[i][2 * q].y, st[i][2 * q + 1].x, st[i][2 * q + 1].y}; }
#undef SC_LOAD
#undef SC_BF
#undef SC_WRITE
    }
}
__device__ __forceinline__ void ph_scan1(Ctx& C) { if (C.wave >> 2) ph_scan1_r<1>(C); else ph_scan1_r<0>(C); }
__device__ __forceinline__ float rdlane(float x, int l) { return __int_as_float(__builtin_amdgcn_readlane(__float_as_int(x), l)); }
__device__ __forceinline__ void ph_scan2(Ctx& C) {
    const int lane = lane_now(); const float* g_pu = (const float*)(C.ws + WS_PU); float* g_s0 = (float*)(C.ws + WS_S0);
    for (int task = C.bid; task < NCHAIN * 8; task += C.nb) { const int chain = task >> 3, row = (task & 7) * 8 + C.wave;
        float sv = 0.f; float pc[64], uc;
        { const float* P = g_pu + ((size_t)chain * NCK) * 8192;
#pragma unroll
          for (int k = 0; k < 64; ++k) pc[k] = P[k * 64 + lane];
          uc = P[4096 + row * 64 + lane]; }
#pragma unroll 1
        for (int c = 0; c < NCK; ++c) { const float* P = g_pu + ((size_t)chain * NCK + (c + 1 < NCK ? c + 1 : c)) * 8192;
            float pn[64], un;
#pragma unroll
            for (int k = 0; k < 64; ++k) pn[k] = P[k * 64 + lane];
            un = P[4096 + row * 64 + lane];
            g_s0[(((size_t)chain * NCK + c) * 64 + row) * 64 + lane] = sv;
            float acc0 = uc, acc1 = 0.f;
#pragma unroll
            for (int k = 0; k < 64; k += 2) { acc0 += rdlane(sv, k) * pc[k]; acc1 += rdlane(sv, k + 1) * pc[k + 1]; }
            sv = acc0 + acc1;
#pragma unroll
            for (int k = 0; k < 64; ++k) pc[k] = pn[k];
            uc = un; }
    }
}

#ifndef OPT_SCAN2B
#define OPT_SCAN2B 1
#endif
__device__ __forceinline__ void ph_scan2b(Ctx& C) {
    const int lane = lane_now(), wave = C.wave, tid = wave * 64 + lane; const float* g_pu = (const float*)(C.ws + WS_PU); float* g_s0 = (float*)(C.ws + WS_S0);
    constexpr int SLOT = 18432, NSLOT = 6, AHEAD = 5;
    for (int task = C.bid; task < NCHAIN * 8; task += C.nb) { const int chain = task >> 3, rg = task & 7, row = rg * 8 + wave;
        const float* Pb = g_pu + (size_t)chain * NCK * 8192;
#define S2_ISSUE(c_) do { const float* pc_ = Pb + (size_t)(c_) * 8192; LAS unsigned char* sl_ = C.lds + ((c_) % NSLOT) * SLOT + wave * 1024; \
            __builtin_amdgcn_global_load_lds((const unsigned*)(pc_ + tid * 4), (LAS unsigned*)(sl_), 16, 0, 0); \
            __builtin_amdgcn_global_load_lds((const unsigned*)(pc_ + 2048 + tid * 4), (LAS unsigned*)(sl_ + 8192), 16, 0, 0); \
            if (wave < 2) __builtin_amdgcn_global_load_lds((const unsigned*)(pc_ + 4096 + rg * 512 + tid * 4), (LAS unsigned*)(sl_ + 16384), 16, 0, 0); } while (0)
        asm volatile("s_waitcnt vmcnt(0) lgkmcnt(0)" ::: "memory"); __builtin_amdgcn_s_barrier(); asm volatile("" ::: "memory");
#pragma unroll
        for (int c = 0; c < AHEAD; ++c) S2_ISSUE(c);
        float sv = 0.f;
#pragma unroll 1
        for (int c = 0; c < NCK; ++c) {
            if (c == 0 || c >= NCK - AHEAD + 1) asm volatile("s_waitcnt vmcnt(0)" ::: "memory");
            else if (wave < 2) asm volatile("s_waitcnt vmcnt(17)" ::: "memory");
            else asm volatile("s_waitcnt vmcnt(13)" ::: "memory");
            __builtin_amdgcn_s_barrier(); asm volatile("" ::: "memory");
            if (c + AHEAD < NCK) S2_ISSUE(c + AHEAD);
            asm volatile("" ::: "memory");
            const LAS float* P = (const LAS float*)(C.lds + (c % NSLOT) * SLOT);
            g_s0[(((size_t)chain * NCK + c) * 64 + row) * 64 + lane] = sv;
            float acc0 = P[4096 + wave * 64 + lane], acc1 = 0.f;
#pragma unroll
            for (int k = 0; k < 64; k += 2) { acc0 += rdlane(sv, k) * P[k * 64 + lane]; acc1 += rdlane(sv, k + 1) * P[(k + 1) * 64 + lane]; }
            sv = acc0 + acc1;
            asm volatile("s_waitcnt lgkmcnt(0)" ::: "memory");
        }
#undef S2_ISSUE
    }
    asm volatile("s_waitcnt vmcnt(0)" ::: "memory"); __builtin_amdgcn_s_barrier();
}
__device__ __forceinline__ void ph_fin2(Ctx& C) {
    const int lane = lane_now();
    const bf16* yl = (const bf16*)(C.ws + WS_YL); const bf16* qt = (const bf16*)(C.dout + DO_QT); const float* s0 = (const float*)(C.ws + WS_S0);
    const bf16* r = (const bf16*)(C.ws + WS_R); const bf16* kraw = (const bf16*)(C.ws + WS_KRAW); const bf16* a = (const bf16*)(C.ws + WS_A); const float* k_a = C.ka->in[14]; const float* r_k = C.ka->in[15];
    const bf16* v = (const bf16*)(C.ws + WS_V); const bf16* gate = (const bf16*)(C.ws + WS_GATE); bf16* orw = (bf16*)(C.ws + WS_ORWKV); const float* lnw = C.ka->in[16]; const float* lnb = C.ka->in[17];
    for (int task = C.bid; task < 16 * NCK; task += C.nb) { const int h = task & 15, cf = task >> 4, cb = NCK - 1 - cf, c = h * 64 + lane;
        f32x4 sf[16], sb[16];
        { const f32x4* pf = (const f32x4*)(s0 + (((size_t)h * NCK + cf) * 64 + lane) * 64); const f32x4* pb = (const f32x4*)(s0 + (((size_t)(16 + h) * NCK + cb) * 64 + lane) * 64);
#pragma unroll
          for (int q = 0; q < 16; ++q) { sf[q] = pf[q]; sb[q] = pb[q]; } }
        const float ka_ = k_a[c], rk_ = r_k[c], lw_ = lnw[c], lb_ = lnb[c];
        for (int tt = 0; tt < 32; ++tt) { const int t = cf * CHL + C.wave * 32 + tt; const size_t ix = (size_t)t * RW + c, ixb = ((size_t)S + t) * RW + c;
            const float qf = bf2f(qt[ix]), qb = bf2f(qt[ixb]);
            float y0 = bf2f(yl[ix]), y1 = bf2f(yl[ixb]);
#pragma unroll
            for (int q = 0; q < 16; ++q)
#pragma unroll
                for (int e = 0; e < 4; ++e) { y0 += sf[q][e] * rdlane(qf, 4 * q + e); y1 += sb[q][e] * rdlane(qb, 4 * q + e); }
            const float y = y0 + y1;
            const float mu = wave_sum(y) * (1.0f / 64.f); const float dv = y - mu; const float var = wave_sum(dv * dv) * (1.0f / 64.f);
            const float gn = dv * (1.0f / sqrtf(var + 64e-5f)) * lw_ + lb_;
            const float kd2 = (1.0f + (bf2f(a[ix]) - 1.0f) * ka_) + (1.0f + (bf2f(a[ixb]) - 1.0f) * ka_);
            const float bonus = wave_sum(bf2f(r[ix]) * bf2f(kraw[ix]) * kd2 * rk_) * bf2f(v[ix]);
            orw[ix] = f2bf((gn + bonus) * bf2f(gate[ix])); }
    }
}


#ifndef OPT_ATTN
#define OPT_ATTN 1
#endif
typedef float f32x16 __attribute__((ext_vector_type(16)));
constexpr size_t WS_OG = 442 * MiB, WS_LSE = 490 * MiB;
constexpr int AT_VTS = 388;
__device__ __forceinline__ void ph_attn2(Ctx& C) {
    const int lane = lane_now(), wave = C.wave, tid = wave * 64 + lane, r31 = lane & 31, hh = lane >> 5;
    const bf16* z = (const bf16*)(C.ws + WS_ZQKV); bf16* og = (bf16*)(C.ws + WS_OG); float* lse_o = (float*)(C.ws + WS_LSE);
    LAS bf16* vt = (LAS bf16*)C.lds; LAS bf16* kim = (LAS bf16*)(C.lds + 64 * AT_VTS * 2);
    for (int unit = C.bid; unit < 1536; unit += C.nb) {
        const int g = unit >> 9, rem = unit & 511, h = rem & 7, tile64 = rem >> 3;
        const int dsh = 2 * g, d = 1 << dsh, n = S >> dsh, res = tile64 & (d - 1), tl = tile64 >> dsh;
        const int kbase = tl * 256 - 64, colq = g * 512 + h * 64, colk = 1536 + colq, colv = 3072 + colq;
        const float slope_d = exp2f(-8.0f * (float)(g * 8 + h + 1) / 24.0f) * (float)d;
#pragma unroll
        for (int i = 0; i < 6; ++i) { const int kc = (tid >> 3) + 64 * i, ch = tid & 7, ki = kbase + kc; u32x4 w = (u32x4){0u, 0u, 0u, 0u}, wk = (u32x4){0u, 0u, 0u, 0u};
            if (ki >= 0 && ki < n) { const bf16* rp = z + (size_t)((ki << dsh) + res) * NQKV + 8 * ch; w = *(const u32x4*)(rp + colv); wk = *(const u32x4*)(rp + colk); }
            *(LAS u32x4*)(kim + kc * 72 + 8 * ch) = wk;
            LAS bf16* dp = vt + (8 * ch) * AT_VTS + kc;
            dp[0] = (bf16)(w.x & 0xffff); dp[AT_VTS] = (bf16)(w.x >> 16); dp[2 * AT_VTS] = (bf16)(w.y & 0xffff); dp[3 * AT_VTS] = (bf16)(w.y >> 16);
            dp[4 * AT_VTS] = (bf16)(w.z & 0xffff); dp[5 * AT_VTS] = (bf16)(w.z >> 16); dp[6 * AT_VTS] = (bf16)(w.w & 0xffff); dp[7 * AT_VTS] = (bf16)(w.w >> 16); }
        __syncthreads();
        const int qb = tl * 256 + 32 * wave; const int qtok = ((qb + r31) << dsh) + res;
        bf16x8 qf[4];
#pragma unroll
        for (int ks = 0; ks < 4; ++ks) qf[ks] = *(const bf16x8*)(z + (size_t)qtok * NQKV + colq + 16 * ks + 8 * hh);
        f32x16 sacc[5];
#pragma unroll
        for (int kt = 0; kt < 5; ++kt) {
#pragma unroll
            for (int e = 0; e < 16; ++e) sacc[kt][e] = 0.f;
            const LAS bf16* kp = kim + (32 * wave + 32 * kt + r31) * 72 + 8 * hh;
#pragma unroll
            for (int ks = 0; ks < 4; ++ks) { const bf16x8 kf = *(const LAS bf16x8*)(kp + 16 * ks); sacc[kt] = __builtin_amdgcn_mfma_f32_32x32x16_bf16(kf, qf[ks], sacc[kt], 0, 0, 0); } }
        const float LOG2E = 1.44269504f, slope2 = slope_d * LOG2E, c0f = (float)(4 * hh - 64 - r31);
        const bool edge = (tl == 0) || (tl == (n >> 8) - 1);
        float m = -3.0e38f;
#pragma unroll
        for (int kt = 0; kt < 5; ++kt)
#pragma unroll
            for (int e = 0; e < 16; ++e) { const float relf = (float)(32 * kt + (e & 3) + 8 * (e >> 2)) + c0f; float sc = sacc[kt][e] * LOG2E - slope2 * __builtin_fabsf(relf);
                if (kt == 0) sc = relf >= -64.0f ? sc : -1e30f;
                if (kt == 4) sc = relf <= 64.0f ? sc : -1e30f;
                sacc[kt][e] = sc; }
        if (edge) {
#pragma unroll
            for (int kt = 0; kt < 5; ++kt)
#pragma unroll
                for (int e = 0; e < 16; ++e) { const int kidx = qb - 64 + 32 * kt + (e & 3) + 8 * (e >> 2) + 4 * hh; sacc[kt][e] = (kidx >= 0 && kidx < n) ? sacc[kt][e] : -1e30f; } }
#pragma unroll
        for (int kt = 0; kt < 5; ++kt)
#pragma unroll
            for (int e = 0; e < 16; ++e) m = fmaxf(m, sacc[kt][e]);
        { const auto rr = __builtin_amdgcn_permlane32_swap(__float_as_uint(m), __float_as_uint(m), false, false); m = fmaxf(__uint_as_float(rr[0]), __uint_as_float(rr[1])); }
        float den = 0.f;
#pragma unroll
        for (int kt = 0; kt < 5; ++kt)
#pragma unroll
            for (int e = 0; e < 16; ++e) { const float pv = __builtin_amdgcn_exp2f(sacc[kt][e] - m); sacc[kt][e] = pv; den += pv; }
        { const auto rr = __builtin_amdgcn_permlane32_swap(__float_as_uint(den), __float_as_uint(den), false, false); den = __uint_as_float(rr[0]) + __uint_as_float(rr[1]); }
        f32x16 oacc[2];
#pragma unroll
        for (int dt = 0; dt < 2; ++dt)
#pragma unroll
            for (int e = 0; e < 16; ++e) oacc[dt][e] = 0.f;
#pragma unroll
        for (int kt = 0; kt < 5; ++kt)
#pragma unroll
            for (int sI = 0; sI < 2; ++sI) { const bf16x8 bfrag = pack8s(sacc[kt][8 * sI], sacc[kt][8 * sI + 1], sacc[kt][8 * sI + 2], sacc[kt][8 * sI + 3], sacc[kt][8 * sI + 4], sacc[kt][8 * sI + 5], sacc[kt][8 * sI + 6], sacc[kt][8 * sI + 7]);
#pragma unroll
                for (int dt = 0; dt < 2; ++dt) { const LAS bf16* vp = vt + (32 * dt + r31) * AT_VTS + 32 * wave + 32 * kt + 16 * sI + 4 * hh;
                    const u32x2 lo = *(const LAS u32x2*)vp, hi = *(const LAS u32x2*)(vp + 8); u32x4 pa; pa.x = lo.x; pa.y = lo.y; pa.z = hi.x; pa.w = hi.y;
                    oacc[dt] = __builtin_amdgcn_mfma_f32_32x32x16_bf16(__builtin_bit_cast(bf16x8, pa), bfrag, oacc[dt], 0, 0, 0); } }
        const float rden = 1.0f / den; bf16* op = og + ((size_t)g * S + qtok) * 512 + h * 64 + 4 * hh;
#pragma unroll
        for (int dt = 0; dt < 2; ++dt)
#pragma unroll
            for (int gr = 0; gr < 4; ++gr) { u32x2 o; o.x = pg8c(oacc[dt][4 * gr] * rden, oacc[dt][4 * gr + 1] * rden); o.y = pg8c(oacc[dt][4 * gr + 2] * rden, oacc[dt][4 * gr + 3] * rden); *(u32x2*)(op + 32 * dt + 8 * gr) = o; }
        if (hh == 0) lse_o[((size_t)g * S + qtok) * 8 + h] = (m + __builtin_amdgcn_logf(den)) * 0.69314718f;
        __syncthreads();
    }
}
__device__ __forceinline__ void ph_attn_combine(Ctx& C) {
    const int lane = lane_now(); const bf16* og = (const bf16*)(C.ws + WS_OG); const float* lse = (const float*)(C.ws + WS_LSE); bf16* oa = (bf16*)(C.ws + WS_OATT);
    const int ntask = S * 64;
    for (int task = (C.bid * NWAVES + C.wave) * 64 + lane; task < ntask; task += C.nb * NTHR) { const int t = task >> 6, c8 = task & 63, h = c8 >> 3;
        const float l0 = lse[(size_t)t * 8 + h], l1 = lse[((size_t)S + t) * 8 + h], l2 = lse[((size_t)2 * S + t) * 8 + h]; const float mx = fmaxf(l0, fmaxf(l1, l2));
        const float w0 = __expf(l0 - mx), w1 = __expf(l1 - mx), w2 = __expf(l2 - mx), rs = 1.0f / (w0 + w1 + w2);
        float a0[8], a1[8], a2[8]; unpack8(*(const u32x4*)(og + (size_t)t * 512 + 8 * c8), a0); unpack8(*(const u32x4*)(og + ((size_t)S + t) * 512 + 8 * c8), a1); unpack8(*(const u32x4*)(og + ((size_t)2 * S + t) * 512 + 8 * c8), a2);
        f32x4 o0, o1;
#pragma unroll
        for (int e = 0; e < 4; ++e) { o0[e] = (w0 * a0[e] + w1 * a1[e] + w2 * a2[e]) * rs; o1[e] = (w0 * a0[4 + e] + w1 * a1[4 + e] + w2 * a2[4 + e]) * rs; }
        *(u32x4*)(oa + (size_t)t * 512 + 8 * c8) = pack8(o0, o1); }
}


__device__ __forceinline__ bf16x8 cvt8(const f32x4 a, const f32x4 b) { u32x4 w; w.x = pk2(a[0], a[1]); w.y = pk2(a[2], a[3]); w.z = pk2(b[0], b[1]); w.w = pk2(b[2], b[3]); return __builtin_bit_cast(bf16x8, w); }
__device__ __forceinline__ void unpack4(u32x2 w, float (&f)[4]) { f[0] = __uint_as_float(w.x << 16); f[1] = __uint_as_float(w.x & 0xffff0000u); f[2] = __uint_as_float(w.y << 16); f[3] = __uint_as_float(w.y & 0xffff0000u); }
__device__ __forceinline__ void ph_fin3(Ctx& C) {
    const int lane = lane_now(), r31 = lane & 31, hh = lane >> 5;
    const bf16* yl = (const bf16*)(C.ws + WS_YL); const bf16* qt = (const bf16*)(C.dout + DO_QT); const float* s0 = (const float*)(C.ws + WS_S0);
    const bf16* r = (const bf16*)(C.ws + WS_R); const bf16* kraw = (const bf16*)(C.ws + WS_KRAW); const bf16* a = (const bf16*)(C.ws + WS_A); const float* k_a = C.ka->in[14]; const float* r_k = C.ka->in[15];
    const bf16* v = (const bf16*)(C.ws + WS_V); const bf16* gate = (const bf16*)(C.ws + WS_GATE); bf16* orw = (bf16*)(C.ws + WS_ORWKV); const float* lnw = C.ka->in[16]; const float* lnb = C.ka->in[17];
    for (int task = C.bid; task < 16 * NCK; task += C.nb) { const int h = task & 15, cf = task >> 4, cb = NCK - 1 - cf;
        const int t = cf * CHL + C.wave * 32 + r31; const size_t rowf = (size_t)t * RW + h * 64, rowb = ((size_t)S + t) * RW + h * 64;
        f32x16 acc[2];
#pragma unroll
        for (int vt = 0; vt < 2; ++vt)
#pragma unroll
            for (int e = 0; e < 16; ++e) acc[vt][e] = 0.f;
#pragma unroll
        for (int z = 0; z < 2; ++z) { const float* sp = s0 + (((size_t)(z * 16 + h) * NCK + (z ? cb : cf)) * 64 + r31) * 64 + 8 * hh; const bf16* qp = qt + (z ? rowb : rowf) + 8 * hh;
#pragma unroll
            for (int ks = 0; ks < 4; ++ks) { const bf16x8 bq = *(const bf16x8*)(qp + 16 * ks);
#pragma unroll
                for (int vt = 0; vt < 2; ++vt) { const f32x4* ap = (const f32x4*)(sp + (size_t)vt * 32 * 64 + 16 * ks); acc[vt] = __builtin_amdgcn_mfma_f32_32x32x16_bf16(cvt8(ap[0], ap[1]), bq, acc[vt], 0, 0, 0); } } }
        float ssum = 0.f, bsum = 0.f;
#pragma unroll
        for (int vt = 0; vt < 2; ++vt)
#pragma unroll
            for (int gr = 0; gr < 4; ++gr) { const int co = 32 * vt + 8 * gr + 4 * hh; float f0[4], f1[4], fr_[4], fk[4], fa0[4], fa1[4];
                unpack4(*(const u32x2*)(yl + rowf + co), f0); unpack4(*(const u32x2*)(yl + rowb + co), f1); unpack4(*(const u32x2*)(r + rowf + co), fr_); unpack4(*(const u32x2*)(kraw + rowf + co), fk);
                unpack4(*(const u32x2*)(a + rowf + co), fa0); unpack4(*(const u32x2*)(a + rowb + co), fa1);
                const f32x4 ka4 = *(const f32x4*)(k_a + h * 64 + co), rk4 = *(const f32x4*)(r_k + h * 64 + co);
#pragma unroll
                for (int e = 0; e < 4; ++e) { const float y = acc[vt][4 * gr + e] + f0[e] + f1[e]; acc[vt][4 * gr + e] = y; ssum += y;
                    bsum += fr_[e] * fk[e] * ((1.0f + (fa0[e] - 1.0f) * ka4[e]) + (1.0f + (fa1[e] - 1.0f) * ka4[e])) * rk4[e]; } }
        ssum += __shfl_xor(ssum, 32); bsum += __shfl_xor(bsum, 32);
        const float mu = ssum * (1.0f / 64.f); float vs = 0.f;
#pragma unroll
        for (int vt = 0; vt < 2; ++vt)
#pragma unroll
            for (int e = 0; e < 16; ++e) { const float dv = acc[vt][e] - mu; acc[vt][e] = dv; vs += dv * dv; }
        vs += __shfl_xor(vs, 32);
        const float rstd = 1.0f / sqrtf(vs * (1.0f / 64.f) + 64e-5f);
#pragma unroll
        for (int vt = 0; vt < 2; ++vt)
#pragma unroll
            for (int gr = 0; gr < 4; ++gr) { const int co = 32 * vt + 8 * gr + 4 * hh; float fv[4], fg[4]; unpack4(*(const u32x2*)(v + rowf + co), fv); unpack4(*(const u32x2*)(gate + rowf + co), fg);
                const f32x4 w4 = *(const f32x4*)(lnw + h * 64 + co), b4 = *(const f32x4*)(lnb + h * 64 + co); float o[4];
#pragma unroll
                for (int e = 0; e < 4; ++e) o[e] = (acc[vt][4 * gr + e] * rstd * w4[e] + b4[e] + bsum * fv[e]) * fg[e];
                u32x2 w; w.x = pk2(o[0], o[1]); w.y = pk2(o[2], o[3]); *(u32x2*)(orw + rowf + co) = w; }
    }
}
template <int CTRL> __device__ __forceinline__ float dpp_row(float x) { return __int_as_float(__builtin_amdgcn_update_dpp(0, __float_as_int(x), CTRL, 0xf, 0xf, true)); }
__device__ __forceinline__ void ph_rprep2(Ctx& C) {
    const int lane = lane_now();
    const bf16* zr = (const bf16*)(C.ws + WS_ZR); const float* mup = C.ka->in[6]; const float* mun = C.ka->in[7]; const float* k_k = C.ka->in[13];
    bf16* r = (bf16*)(C.ws + WS_R); bf16* v = (bf16*)(C.ws + WS_V); bf16* nkk = (bf16*)(C.ws + WS_NKK); bf16* kraw = (bf16*)(C.ws + WS_KRAW); bf16* la = (bf16*)(C.ws + WS_LORAA);
    const int ntask = 6 * (S / 64) + (S / 32);
    for (int task = C.gw; task < ntask; task += C.ngw) { const bool heavy = task >= 6 * (S / 64); const int cgp = heavy ? 6 : task % 6, ntok = heavy ? 32 : 64, t0 = heavy ? (task - 6 * (S / 64)) * 32 : (task / 6) * 64, col = cgp * 512 + lane * 8;
        const bool real = col < NZR_REAL; const int kind = col < 1024 ? 0 : col < 2048 ? 1 : col < 3072 ? 2 : col < 3136 ? 3 : col < 3200 ? 4 : col < 3360 ? 5 : 6;
        float mp[8], mn[8], kk8[8];
#pragma unroll
        for (int e = 0; e < 8; ++e) { mp[e] = real ? mup[col + e] : 0.f; mn[e] = real ? mun[col + e] : 0.f; kk8[e] = kind == 1 ? k_k[col - 1024 + e] : 0.f; }
        float zp[8], zc[8], zn[8];
        if (t0 > 0) unpack8(*(const u32x4*)(zr + (size_t)(t0 - 1) * NZR + col), zp); else {
#pragma unroll
            for (int e = 0; e < 8; ++e) zp[e] = 0.f; }
        unpack8(*(const u32x4*)(zr + (size_t)t0 * NZR + col), zc);
        u32x4 rawn[8];
#define RP_LOAD8(tb_) do { _Pragma("unroll") for (int j_ = 0; j_ < 8; ++j_) { const int tr_ = (tb_) + 1 + j_; const u32x4 w_ = *(const u32x4*)(zr + (size_t)(tr_ < S ? tr_ : S - 1) * NZR + col); rawn[j_] = tr_ < S ? w_ : (u32x4){0u, 0u, 0u, 0u}; } } while (0)
#pragma unroll 1
        for (int i0 = 0; i0 < ntok; i0 += 8) { u32x4 rawc[8];
            RP_LOAD8(t0 + i0);
#pragma unroll
            for (int j = 0; j < 8; ++j) rawc[j] = rawn[j];
#pragma unroll
          for (int j = 0; j < 8; ++j) { const int t = t0 + i0 + j;
            unpack8(rawc[j], zn);
            float x[8];
#pragma unroll
            for (int e = 0; e < 8; ++e) x[e] = zc[e] + mp[e] * (zp[e] - zc[e]) + mn[e] * (zn[e] - zc[e]);
            if (kind == 0) *(u32x4*)(r + (size_t)t * RW + col) = pack8((f32x4){x[0], x[1], x[2], x[3]}, (f32x4){x[4], x[5], x[6], x[7]});
            else if (kind == 1) { *(u32x4*)(kraw + (size_t)t * RW + col - 1024) = pack8((f32x4){x[0], x[1], x[2], x[3]}, (f32x4){x[4], x[5], x[6], x[7]});
                float kv[8], ss = 0.f;
#pragma unroll
                for (int e = 0; e < 8; ++e) { kv[e] = x[e] * kk8[e]; ss += kv[e] * kv[e]; }
                ss += dpp_row<0xB1>(ss); ss += dpp_row<0x4E>(ss); ss += dpp_row<0x141>(ss);
                const float sc = -1.0f / fmaxf(sqrtf(ss), 1e-12f);
                *(u32x4*)(nkk + (size_t)t * RW + col - 1024) = pack8((f32x4){kv[0] * sc, kv[1] * sc, kv[2] * sc, kv[3] * sc}, (f32x4){kv[4] * sc, kv[5] * sc, kv[6] * sc, kv[7] * sc}); }
            else if (kind == 2) *(u32x4*)(v + (size_t)t * RW + col - 2048) = pack8((f32x4){x[0], x[1], x[2], x[3]}, (f32x4){x[4], x[5], x[6], x[7]});
            else { float o[8];
#pragma unroll
                for (int e = 0; e < 8; ++e) { const float sg = __builtin_amdgcn_rcpf(1.0f + __builtin_amdgcn_exp2f(x[e] * (kind == 3 ? -2.88539008f : -1.44269504f)));
                    o[e] = kind == 3 ? 2.0f * sg - 1.0f : kind == 4 ? x[e] : kind == 5 ? sg : 0.f; }
                bf16* lp = kind <= 4 ? la + (size_t)t * KL2 + (col - 3072) : kind == 5 ? la + (size_t)(S + t) * KL2 + (col - 3200) : col < 3488 ? la + (size_t)t * KL2 + 128 + (col - 3360) : la + (size_t)(S + t) * KL2 + 160 + (col - 3488);
                *(u32x4*)lp = pack8((f32x4){o[0], o[1], o[2], o[3]}, (f32x4){o[4], o[5], o[6], o[7]}); }
#pragma unroll
            for (int e = 0; e < 8; ++e) { zp[e] = zc[e]; zc[e] = zn[e]; }
          }
        }
#undef RP_LOAD8
    }
}


constexpr int F4_S0STR = 72, F4_TSTR = 68;
__device__ __forceinline__ void ph_fin4(Ctx& C) {
    const int lane0 = lane_now(), wave = C.wave;
    const bf16* yl = (const bf16*)(C.ws + WS_YL); const bf16* qt = (const bf16*)(C.dout + DO_QT); const float* s0 = (const float*)(C.ws + WS_S0);
    const bf16* r = (const bf16*)(C.ws + WS_R); const bf16* kraw = (const bf16*)(C.ws + WS_KRAW); const bf16* a = (const bf16*)(C.ws + WS_A); const float* k_a = C.ka->in[14]; const float* r_k = C.ka->in[15];
    const bf16* v = (const bf16*)(C.ws + WS_V); const bf16* gate = (const bf16*)(C.ws + WS_GATE); bf16* orw = (bf16*)(C.ws + WS_ORWKV); const float* lnw = C.ka->in[16]; const float* lnb = C.ka->in[17];
    LAS bf16* s0img = (LAS bf16*)C.lds;
    LAS bf16* tr = (LAS bf16*)(C.lds + 2 * 64 * F4_S0STR * 2) + C.wave * (32 * F4_TSTR);
    for (int task = C.bid; task < 16 * NCK; task += C.nb) { const int h = task & 15, cf = task >> 4, cb = NCK - 1 - cf;
        int lane = lane0; asm volatile("" : "+v"(lane));
        const int r31 = lane & 31, hh = lane >> 5, tid = wave * 64 + lane;
#define F4_GLOAD(g, gptr) do { _Pragma("unroll") for (int i_ = 0; i_ < 4; ++i_) g[i_] = *(const u32x4*)((gptr) + (size_t)((lane >> 3) + 8 * i_) * RW + 8 * (lane & 7)); } while (0)
#define F4_XPOSE(dst, g) do { _Pragma("unroll") for (int i_ = 0; i_ < 4; ++i_) { LAS u32x2* d_ = (LAS u32x2*)(tr + ((lane >> 3) + 8 * i_) * F4_TSTR + 8 * (lane & 7)); d_[0] = (u32x2){g[i_].x, g[i_].y}; d_[1] = (u32x2){g[i_].z, g[i_].w}; } \
            asm volatile("s_waitcnt lgkmcnt(0)" ::: "memory"); \
            _Pragma("unroll") for (int vt_ = 0; vt_ < 2; ++vt_) _Pragma("unroll") for (int gr_ = 0; gr_ < 4; ++gr_) dst[vt_][gr_] = *(const LAS u32x2*)(tr + r31 * F4_TSTR + 32 * vt_ + 8 * gr_ + 4 * hh); \
            asm volatile("s_waitcnt lgkmcnt(0)" ::: "memory"); } while (0)
        __syncthreads();
        { const int z = tid >> 8, row = (tid >> 2) & 63, seg = tid & 3; const float* sp = s0 + (((size_t)(z * 16 + h) * NCK + (z ? cb : cf)) * 64 + row) * 64 + 16 * seg;
          const f32x4 x0 = *(const f32x4*)sp, x1 = *(const f32x4*)(sp + 4), x2 = *(const f32x4*)(sp + 8), x3 = *(const f32x4*)(sp + 12);
          LAS u32x4* dp = (LAS u32x4*)(s0img + (z * 64 + row) * F4_S0STR + 16 * seg); dp[0] = pack8(x0, x1); dp[1] = pack8(x2, x3); }
        __syncthreads();
#pragma unroll 1
        for (int hv = 0; hv < CHL / 256; ++hv) {
        const size_t base_f = (size_t)(cf * CHL + hv * 256 + wave * 32) * RW + h * 64, base_b = base_f + (size_t)S * RW;
        u32x4 g0[4], g1[4], g2[4], g3[4];
        F4_GLOAD(g0, yl + base_f); F4_GLOAD(g1, yl + base_b); F4_GLOAD(g2, r + base_f); F4_GLOAD(g3, kraw + base_f);
        const int t0 = cf * CHL + hv * 256 + wave * 32, t = t0 + r31; const size_t rowf = (size_t)t * RW + h * 64, rowb = ((size_t)S + t) * RW + h * 64;
        f32x16 acc[2];
#pragma unroll
        for (int vt = 0; vt < 2; ++vt)
#pragma unroll
            for (int e = 0; e < 16; ++e) acc[vt][e] = 0.f;
#pragma unroll
        for (int z = 0; z < 2; ++z) { const bf16* qp = qt + (z ? rowb : rowf) + 8 * hh;
#pragma unroll
            for (int ks = 0; ks < 4; ++ks) { const bf16x8 bq = *(const bf16x8*)(qp + 16 * ks);
#pragma unroll
                for (int vt = 0; vt < 2; ++vt) { const bf16x8 af = *(const LAS bf16x8*)(s0img + (z * 64 + 32 * vt + r31) * F4_S0STR + 16 * ks + 8 * hh); acc[vt] = __builtin_amdgcn_mfma_f32_32x32x16_bf16(af, bq, acc[vt], 0, 0, 0); } } }
        u32x2 q0[2][4], q1[2][4];
        float ssum = 0.f, bsum = 0.f;
        F4_XPOSE(q0, g0); F4_XPOSE(q1, g1);
        F4_GLOAD(g0, a + base_f); F4_GLOAD(g1, a + base_b);
#pragma unroll
        for (int vt = 0; vt < 2; ++vt)
#pragma unroll
            for (int gr = 0; gr < 4; ++gr) { float f0[4], f1[4]; unpack4(q0[vt][gr], f0); unpack4(q1[vt][gr], f1);
#pragma unroll
                for (int e = 0; e < 4; ++e) { const float y = acc[vt][4 * gr + e] + f0[e] + f1[e]; acc[vt][4 * gr + e] = y; ssum += y; } }
        { u32x2 q2[2][4], q3[2][4];
          F4_XPOSE(q0, g2); F4_XPOSE(q1, g3);
          F4_GLOAD(g2, v + base_f); F4_GLOAD(g3, gate + base_f);
          F4_XPOSE(q2, g0); F4_XPOSE(q3, g1);
#pragma unroll
          for (int vt = 0; vt < 2; ++vt)
#pragma unroll
              for (int gr = 0; gr < 4; ++gr) { const int co = 32 * vt + 8 * gr + 4 * hh; float fr_[4], fk[4], fa0[4], fa1[4]; unpack4(q0[vt][gr], fr_); unpack4(q1[vt][gr], fk); unpack4(q2[vt][gr], fa0); unpack4(q3[vt][gr], fa1);
                  const f32x4 ka4 = *(const f32x4*)(k_a + h * 64 + co), rk4 = *(const f32x4*)(r_k + h * 64 + co);
#pragma unroll
                  for (int e = 0; e < 4; ++e) bsum += fr_[e] * fk[e] * ((1.0f + (fa0[e] - 1.0f) * ka4[e]) + (1.0f + (fa1[e] - 1.0f) * ka4[e])) * rk4[e]; } }
        ssum += __shfl_xor(ssum, 32); bsum += __shfl_xor(bsum, 32);
        const float mu = ssum * (1.0f / 64.f); float vs = 0.f;
#pragma unroll
        for (int vt = 0; vt < 2; ++vt)
#pragma unroll
            for (int e = 0; e < 16; ++e) { const float dv = acc[vt][e] - mu; acc[vt][e] = dv; vs += dv * dv; }
        vs += __shfl_xor(vs, 32);
        const float rstd = 1.0f / sqrtf(vs * (1.0f / 64.f) + 64e-5f);
        F4_XPOSE(q0, g2); F4_XPOSE(q1, g3);
#pragma unroll
        for (int vt = 0; vt < 2; ++vt)
#pragma unroll
            for (int gr = 0; gr < 4; ++gr) { const int co = 32 * vt + 8 * gr + 4 * hh; float fv[4], fg[4]; unpack4(q0[vt][gr], fv); unpack4(q1[vt][gr], fg);
                const f32x4 w4 = *(const f32x4*)(lnw + h * 64 + co), b4 = *(const f32x4*)(lnb + h * 64 + co); float o[4];
#pragma unroll
                for (int e = 0; e < 4; ++e) o[e] = (acc[vt][4 * gr + e] * rstd * w4[e] + b4[e] + bsum * fv[e]) * fg[e];
                u32x2 w; w.x = pk2(o[0], o[1]); w.y = pk2(o[2], o[3]); *(LAS u32x2*)(tr + r31 * F4_TSTR + co) = w; }
        asm volatile("s_waitcnt lgkmcnt(0)" ::: "memory");
#pragma unroll
        for (int i = 0; i < 4; ++i) { const int tk = (lane >> 3) + 8 * i; const LAS u32x2* s_ = (const LAS u32x2*)(tr + tk * F4_TSTR + 8 * (lane & 7)); const u32x2 lo_ = s_[0], hi_ = s_[1]; *(u32x4*)(orw + base_f + (size_t)tk * RW + 8 * (lane & 7)) = (u32x4){lo_.x, lo_.y, hi_.x, hi_.y}; }
        asm volatile("s_waitcnt lgkmcnt(0)" ::: "memory");
        }
#undef F4_GLOAD
#undef F4_XPOSE
    }
}


constexpr int SM_KR = 0, SM_BK = 4608, SM_BGT = 9216, SM_GT = 14336, SM_VT = 14592, SM_WAVE = 17664;
template <int role> __device__ __forceinline__ void ph_scan1m_r(Ctx& C) {
    const int lane0 = lane_now(), wave = C.wave, itl = wave & 3;
    const bf16* g_r = (const bf16*)(C.ws + WS_R); const bf16* g_v = (const bf16*)(C.ws + WS_V); const bf16* g_nkk = (const bf16*)(C.ws + WS_NKK); const bf16* g_k = (const bf16*)(C.ws + WS_KRAW);
    const bf16* g_lw = (const bf16*)(C.ws + WS_LW); const bf16* g_a = (const bf16*)(C.ws + WS_A); const float* k_a = C.ka->in[14];
    bf16* g_out = role ? (bf16*)(C.ws + WS_YL) : (bf16*)(C.dout + DO_QT); float* g_pu = (float*)(C.ws + WS_PU);
    LAS unsigned char* L = C.lds + wave * SM_WAVE;
    LAS bf16* imKR = (LAS bf16*)(L + SM_KR); LAS bf16* imBK = (LAS bf16*)(L + SM_BK); LAS bf16* imBGT = (LAS bf16*)(L + SM_BGT); LAS float* gT = (LAS float*)(L + SM_GT); LAS bf16* imVT = (LAS bf16*)(L + SM_VT);
    LAS float* MT = (LAS float*)(L + SM_BK);
    const int nitems = NCHAIN * NCK;
    for (int base = C.bid * 4; base < nitems; base += C.nb * 4) {
        const int item = base + itl; if (item >= nitems) continue;
        const int chain = item / NCK, chunk = item % NCK, z = chain >> 4, h = chain & 15; const size_t zoff = (size_t)z * S * RW; const float ka = k_a[h * 64 + lane0];
        f32x16 st[2][2];
        { int lane_s = lane0; asm volatile("" : "+v"(lane_s)); const int r31s = lane_s & 31, hhs = lane_s >> 5;
#pragma unroll
        for (int kt = 0; kt < 2; ++kt)
#pragma unroll
            for (int ct = 0; ct < 2; ++ct)
#pragma unroll
                for (int e = 0; e < 16; ++e) st[kt][ct][e] = (role == 0 && (32 * kt + (e & 3) + 8 * (e >> 2) + 4 * hhs) == (32 * ct + r31s)) ? 1.f : 0.f; }
        unsigned rl[8], rn[8], ra[8], rk[8], rr_[8], rv[8];
#define RAWF(a, t) __uint_as_float(((t) & 1) ? ((a)[(t) >> 1] & 0xffff0000u) : ((a)[(t) >> 1] << 16))
#define SM_LOADRAW(sbn) do { const int sg_ = chunk * CHL + (sbn) * 16; const long tk_ = z ? (long)S - 1 - sg_ : sg_; const long dx_ = z ? -(long)RW : (long)RW; const size_t ru_ = (size_t)tk_ * RW + h * 64; \
            int ln_ = lane0; asm volatile("" : "+v"(ln_)); \
            _Pragma("unroll") for (int t_ = 0; t_ < 16; t_ += 2) { const long o_ = t_ * dx_, o1_ = o_ + dx_; const int j_ = t_ >> 1; \
                rl[j_] = (unsigned)(g_lw + zoff + ru_ + o_)[ln_] | ((unsigned)(g_lw + zoff + ru_ + o1_)[ln_] << 16); rn[j_] = (unsigned)(g_nkk + ru_ + o_)[ln_] | ((unsigned)(g_nkk + ru_ + o1_)[ln_] << 16); \
                ra[j_] = (unsigned)(g_a + zoff + ru_ + o_)[ln_] | ((unsigned)(g_a + zoff + ru_ + o1_)[ln_] << 16); rk[j_] = (unsigned)(g_k + ru_ + o_)[ln_] | ((unsigned)(g_k + ru_ + o1_)[ln_] << 16); \
                rr_[j_] = (unsigned)(g_r + ru_ + o_)[ln_] | ((unsigned)(g_r + ru_ + o1_)[ln_] << 16); if (role) rv[j_] = (unsigned)(g_v + ru_ + o_)[ln_] | ((unsigned)(g_v + ru_ + o1_)[ln_] << 16); } } while (0)
        SM_LOADRAW(0);
#pragma unroll 1
        for (int sb = 0; sb < CHL / 16; ++sb) {
            const int sg0 = chunk * CHL + sb * 16; const long tk0 = z ? (long)S - 1 - sg0 : sg0; const long dtk = z ? -1 : 1;
            int lane_i = lane0; asm volatile("" : "+v"(lane_i));
            const int lane = lane_i, r31 = lane_i & 31, hh = lane_i >> 5, r31g = r31;
            const long dix = dtk * RW;
            const size_t rowu = (size_t)tk0 * RW + h * 64;
            float Lc[16]; { float acc = 0.f;
#pragma unroll
              for (int t = 0; t < 16; ++t) { acc += RAWF(rl, t); Lc[t] = acc; } }
            const float GT_ = __expf(Lc[15]);
            gT[lane] = GT_;
            u32x4 bg[2], kg[2], vr[2];
            { LAS bf16* wKR = imKR + lane; LAS bf16* wBK = imBK + lane;
#pragma unroll
              for (int t = 0; t < 16; t += 2) { float kkh[2], rh[2], bt[2], kt_[2], bgf[2], kgf[2];
#pragma unroll
                for (int d = 0; d < 2; ++d) { const int tt = t + d;
                    const float nk = RAWF(rn, tt), a_ = RAWF(ra, tt), kr = RAWF(rk, tt), rr = RAWF(rr_, tt);
                    const float eL = __expf(Lc[tt]), eLm = tt ? __expf(Lc[tt - 1]) : 1.0f, ie = __builtin_amdgcn_rcpf(eL);
                    const float b_ = -nk * a_, kd = kr * (1.0f + (a_ - 1.0f) * ka);
                    kkh[d] = nk * eLm; rh[d] = rr * eL; bt[d] = b_ * ie; kt_[d] = kd * ie; bgf[d] = bt[d] * GT_; kgf[d] = kt_[d] * GT_; }
                const unsigned p0 = pg8::cvt_pk_bf16(kkh[0], kkh[1]), p1 = pg8::cvt_pk_bf16(rh[0], rh[1]), p2 = pg8::cvt_pk_bf16(bt[0], bt[1]), p3 = pg8::cvt_pk_bf16(kt_[0], kt_[1]);
                wKR[t * 72] = (bf16)p0; wKR[(t + 1) * 72] = (bf16)(p0 >> 16); wKR[(16 + t) * 72] = (bf16)p1; wKR[(17 + t) * 72] = (bf16)(p1 >> 16);
                wBK[t * 72] = (bf16)p2; wBK[(t + 1) * 72] = (bf16)(p2 >> 16); wBK[(16 + t) * 72] = (bf16)p3; wBK[(17 + t) * 72] = (bf16)(p3 >> 16);
                bg[t >> 3][(t >> 1) & 3] = pg8::cvt_pk_bf16(bgf[0], bgf[1]); kg[t >> 3][(t >> 1) & 3] = pg8::cvt_pk_bf16(kgf[0], kgf[1]);
                if (role) vr[t >> 3][(t >> 1) & 3] = rv[t >> 1]; } }
            { LAS u32x4* d = (LAS u32x4*)(imBGT + lane * 40); d[0] = bg[0]; d[1] = bg[1]; d[2] = kg[0]; d[3] = kg[1]; }
            if (role) { LAS u32x4* d = (LAS u32x4*)(imVT + lane * 24); d[0] = vr[0]; d[1] = vr[1]; }
            asm volatile("s_waitcnt lgkmcnt(0)" ::: "memory");
            __builtin_amdgcn_sched_barrier(0);
            { f32x16 m;
#pragma unroll
              for (int e = 0; e < 16; ++e) m[e] = 0.f;
#pragma unroll
              for (int ks = 0; ks < 4; ++ks) { const bf16x8 af = *(const LAS bf16x8*)(imBK + r31 * 72 + 16 * ks + 8 * hh), bfr = *(const LAS bf16x8*)(imKR + r31 * 72 + 16 * ks + 8 * hh); m = __builtin_amdgcn_mfma_f32_32x32x16_bf16(af, bfr, m, 0, 0, 0); }
              asm volatile("s_waitcnt lgkmcnt(0)" ::: "memory");
              const int tq = r31 & 15; const bool ycol = r31 >= 16;
#pragma unroll
              for (int g = 0; g < 4; ++g) { f32x4 o;
#pragma unroll
                  for (int e = 0; e < 4; ++e) { const int sp = 8 * g + 4 * hh + e, sq = sp & 15; const bool ok = ycol ? (sq <= tq) : (sq < tq); o[e] = ok ? m[4 * g + e] : 0.f; }
                  *(LAS f32x4*)(MT + r31 * 36 + 8 * g + 4 * hh) = o; } }
            asm volatile("s_waitcnt lgkmcnt(0)" ::: "memory");
            __builtin_amdgcn_sched_barrier(0);
            f32x16 ya[2];
#pragma unroll
            for (int ct = 0; ct < 2; ++ct)
#pragma unroll
                for (int e = 0; e < 16; ++e) ya[ct][e] = 0.f;
#pragma unroll
            for (int kt = 0; kt < 2; ++kt)
#pragma unroll
                for (int sI = 0; sI < 2; ++sI) { const LAS bf16* ap = imKR + r31 * 72 + 32 * kt + 16 * sI + 4 * hh; const u32x2 lo = *(const LAS u32x2*)ap, hi = *(const LAS u32x2*)(ap + 8);
                    u32x4 pa; pa.x = lo.x; pa.y = lo.y; pa.z = hi.x; pa.w = hi.y; const bf16x8 af = __builtin_bit_cast(bf16x8, pa);
#pragma unroll
                    for (int ct = 0; ct < 2; ++ct) { const f32x16& x = st[kt][ct];
                        const bf16x8 bfr = pack8s(x[8 * sI], x[8 * sI + 1], x[8 * sI + 2], x[8 * sI + 3], x[8 * sI + 4], x[8 * sI + 5], x[8 * sI + 6], x[8 * sI + 7]);
                        ya[ct] = __builtin_amdgcn_mfma_f32_32x32x16_bf16(af, bfr, ya[ct], 0, 0, 0); } }
            bf16x8 vfr[2];
            if (role) { const f32x4 m0 = *(const LAS f32x4*)(MT + r31 * 36 + 16 + 8 * hh), m1 = *(const LAS f32x4*)(MT + r31 * 36 + 20 + 8 * hh); const bf16x8 af = pack8s(m0[0], m0[1], m0[2], m0[3], m1[0], m1[1], m1[2], m1[3]);
#pragma unroll
                for (int ct = 0; ct < 2; ++ct) { vfr[ct] = *(const LAS bf16x8*)(imVT + (32 * ct + r31) * 24 + 8 * hh); ya[ct] = __builtin_amdgcn_mfma_f32_32x32x16_bf16(af, vfr[ct], ya[ct], 0, 0, 0); } }
            __builtin_amdgcn_sched_barrier(0);
            f32x2 u2[16];
#pragma unroll
            for (int e = 0; e < 4; ++e) {
                const auto a0 = __builtin_amdgcn_permlane32_swap(__float_as_uint(ya[0][e]), __float_as_uint(ya[0][e]), false, false), a1 = __builtin_amdgcn_permlane32_swap(__float_as_uint(ya[1][e]), __float_as_uint(ya[1][e]), false, false);
                const auto b0 = __builtin_amdgcn_permlane32_swap(__float_as_uint(ya[0][4 + e]), __float_as_uint(ya[0][4 + e]), false, false), b1 = __builtin_amdgcn_permlane32_swap(__float_as_uint(ya[1][4 + e]), __float_as_uint(ya[1][4 + e]), false, false);
                u2[e] = (f32x2){__uint_as_float(a0[0]), __uint_as_float(a1[0])}; u2[4 + e] = (f32x2){__uint_as_float(a0[1]), __uint_as_float(a1[1])};
                u2[8 + e] = (f32x2){__uint_as_float(b0[0]), __uint_as_float(b1[0])}; u2[12 + e] = (f32x2){__uint_as_float(b0[1]), __uint_as_float(b1[1])}; }
#pragma unroll
            for (int t = 1; t < 16; ++t) { f32x2 a = u2[t];
#pragma unroll
                for (int q = 0; q < (t + 3) / 4; ++q) { const f32x4 cf = *(const LAS f32x4*)(MT + t * 36 + 4 * q);
#pragma unroll
                    for (int e = 0; e < 4; ++e) if (4 * q + e < t) a += u2[4 * q + e] * cf[e]; }
                u2[t] = a; }
            bf16x8 ufr[2];
            ufr[0] = pack8s(hh ? u2[8].x : u2[0].x, hh ? u2[9].x : u2[1].x, hh ? u2[10].x : u2[2].x, hh ? u2[11].x : u2[3].x, hh ? u2[12].x : u2[4].x, hh ? u2[13].x : u2[5].x, hh ? u2[14].x : u2[6].x, hh ? u2[15].x : u2[7].x);
            ufr[1] = pack8s(hh ? u2[8].y : u2[0].y, hh ? u2[9].y : u2[1].y, hh ? u2[10].y : u2[2].y, hh ? u2[11].y : u2[3].y, hh ? u2[12].y : u2[4].y, hh ? u2[13].y : u2[5].y, hh ? u2[14].y : u2[6].y, hh ? u2[15].y : u2[7].y);
            __builtin_amdgcn_sched_barrier(0);
            { const f32x4 m0 = *(const LAS f32x4*)(MT + r31 * 36 + 8 * hh), m1 = *(const LAS f32x4*)(MT + r31 * 36 + 4 + 8 * hh); const bf16x8 af = pack8s(m0[0], m0[1], m0[2], m0[3], m1[0], m1[1], m1[2], m1[3]);
#pragma unroll
              for (int ct = 0; ct < 2; ++ct) ya[ct] = __builtin_amdgcn_mfma_f32_32x32x16_bf16(af, ufr[ct], ya[ct], 0, 0, 0); }
            { LAS bf16* ys = (LAS bf16*)MT;
#pragma unroll
              for (int ct = 0; ct < 2; ++ct)
#pragma unroll
                  for (int e = 0; e < 8; e += 2) { const unsigned pw = pg8::cvt_pk_bf16(ya[ct][8 + e], ya[ct][9 + e]); const int t = (e & 3) + 4 * hh + 8 * (e >> 2); LAS bf16* d = ys + t * 72 + 32 * ct + r31; d[0] = (bf16)pw; d[72] = (bf16)(pw >> 16); }
              asm volatile("s_waitcnt lgkmcnt(0)" ::: "memory");
#pragma unroll
              for (int i = 0; i < 2; ++i) { const int t = (lane >> 3) + 8 * i; const u32x4 w = *(const LAS u32x4*)(ys + t * 72 + 8 * (lane & 7)); *(u32x4*)(g_out + zoff + rowu + (long)t * dix + 8 * (lane & 7)) = w; }
              asm volatile("s_waitcnt lgkmcnt(0)" ::: "memory"); }
            __builtin_amdgcn_sched_barrier(0);
            if (sb + 1 < CHL / 16) SM_LOADRAW(sb + 1);
            __builtin_amdgcn_sched_barrier(0);
#pragma unroll
            for (int kt = 0; kt < 2; ++kt) { f32x4 gs[4];
#pragma unroll
                for (int g = 0; g < 4; ++g) gs[g] = *(const LAS f32x4*)(gT + 32 * kt + 8 * g + 4 * hh);
                const bf16x8 au = *(const LAS bf16x8*)(imBGT + (32 * kt + r31) * 40 + 8 * hh); bf16x8 av; if (role) av = *(const LAS bf16x8*)(imBGT + (32 * kt + r31) * 40 + 16 + 8 * hh);
#pragma unroll
                for (int ct = 0; ct < 2; ++ct) {
#pragma unroll
                    for (int e = 0; e < 16; ++e) st[kt][ct][e] *= gs[e >> 2][e & 3];
                    st[kt][ct] = __builtin_amdgcn_mfma_f32_32x32x16_bf16(au, ufr[ct], st[kt][ct], 0, 0, 0);
                    if (role) st[kt][ct] = __builtin_amdgcn_mfma_f32_32x32x16_bf16(av, vfr[ct], st[kt][ct], 0, 0, 0); } }
            asm volatile("s_waitcnt lgkmcnt(0)" ::: "memory");
        }
        int lane_e = lane0; asm volatile("" : "+v"(lane_e));
        float* pp = g_pu + (((size_t)chain * NCK + chunk) * 2 + role) * 4096 + (lane_e & 31) * 64 + 4 * (lane_e >> 5);
#pragma unroll
        for (int kt = 0; kt < 2; ++kt)
#pragma unroll
            for (int ct = 0; ct < 2; ++ct)
#pragma unroll
                for (int g = 0; g < 4; ++g) *(f32x4*)(pp + (32 * ct) * 64 + 32 * kt + 8 * g) = (f32x4){st[kt][ct][4 * g], st[kt][ct][4 * g + 1], st[kt][ct][4 * g + 2], st[kt][ct][4 * g + 3]};
    }
}
#undef SM_LOADRAW
#undef RAWF
__device__ __forceinline__ void ph_scan1m(Ctx& C) { if (C.wave >> 2) ph_scan1m_r<1>(C); else ph_scan1m_r<0>(C); }


#ifndef PROBE_SCANCMP
#define PROBE_SCANCMP 0
#endif
constexpr size_t WS_SNAP = 16 * MiB;
__device__ __forceinline__ void ph_scancmp(Ctx& C, const int mode, const int which) {
    const int lane = lane_now(); const int tid = C.wave * 64 + lane;
    const float* g_pu = (const float*)(C.ws + WS_PU); const bf16* yl = (const bf16*)(C.ws + WS_YL); const bf16* qt = (const bf16*)(C.dout + DO_QT);
    float* sn_pu = (float*)(C.ws + WS_SNAP); bf16* sn_yl = (bf16*)(C.ws + WS_SNAP + 4 * MiB); bf16* sn_qt = (bf16*)(C.ws + WS_SNAP + 8 * MiB);
    unsigned* mx = (unsigned*)(C.ws + WS_CTL) + 3500;
    float dmax = 0.f;
    const int cks[3] = {0, 1, 17};
    for (long i = (long)C.bid * NTHR + tid; i < (long)NCHAIN * 3 * 8192; i += (long)C.nb * NTHR) { const int e = (int)(i & 8191), cj = (int)(i >> 13), chain = cj / 3, j = cj % 3;
        const float v = g_pu[((size_t)chain * NCK + cks[j]) * 8192 + e]; if (mode == 0) sn_pu[i] = v; else if (which == 0 || which == 1) dmax = fmaxf(dmax, fabsf(v - sn_pu[i])); }
    for (long i = (long)C.bid * NTHR + tid; i < (long)NCHAIN * 3 * 16384; i += (long)C.nb * NTHR) { const int e = (int)(i & 16383), cj = (int)(i >> 14), chain = cj / 3, j = cj % 3, z = chain >> 4, h = chain & 15;
        const int sg = cks[j] * CHL + (e >> 6), tk = z ? S - 1 - sg : sg; const size_t ix = ((size_t)z * S + tk) * RW + h * 64 + (e & 63);
        if (mode == 0) { sn_yl[i] = yl[ix]; sn_qt[i] = qt[ix]; } else { if (which == 0 || which == 2) dmax = fmaxf(dmax, fabsf(bf2f(yl[ix]) - bf2f(sn_yl[i]))); if (which == 0 || which == 3) dmax = fmaxf(dmax, fabsf(bf2f(qt[ix]) - bf2f(sn_qt[i]))); } }
    if (mode == 1) { dmax = wave_max(dmax); if (lane == 0) atomicMax(mx, __float_as_uint(dmax)); }
}
__device__ __forceinline__ void ph_probe_fold(Ctx& C) {
    if (C.bid == 0 && C.wave == 0 && lane_now() == 0) { const float d = __uint_as_float(__hip_atomic_load((unsigned*)(C.ws + WS_CTL) + 3500, __ATOMIC_RELAXED, __HIP_MEMORY_SCOPE_AGENT));
        float q = (log10f(fmaxf(d, 1e-4f)) + 4.0f) * 0.25f; q = fminf(fmaxf(q, 0.f), 1.f); C.out[0] += 0.05f + 0.15f * q; }
}


#ifndef LORA_FAST
#define LORA_FAST 1
#endif
__host__ __device__ __forceinline__ int tpinv(int ac) { return (ac & ~255) + 128 * ((ac >> 5) & 1) + 32 * ((ac >> 6) & 3) + (ac & 31); }
template <bool GATE> __device__ __forceinline__ void lora_fast(Ctx& C) {
    constexpr int NKS = GATE ? 5 : 2, NG = GATE ? 2 : 4, NNB = 2 * NG, NCT = GATE ? 16 : 32;
    const int lane = lane_now(), i16 = lane & 15, kq = lane >> 4;
    const bf16* la = (const bf16*)(C.ws + WS_LORAA) + (GATE ? (size_t)S * KL2 : 0); const bf16* wt = (const bf16*)(C.ws + WS_WLORA);
    const int ctask = C.gw % NCT, rg = C.gw / NCT, nrg = C.ngw / NCT;
    if (rg >= nrg) return;
    const int mode = GATE ? 2 : (ctask >> 4), cb = GATE ? ctask : (ctask & 15), koff = GATE ? 0 : 64 * mode;
    const int ac0 = cb * (GATE ? 64 : 128);
    bf16x8 bfr[NNB][NKS];
#pragma unroll
    for (int nb = 0; nb < NNB; ++nb) { const int ac = ac0 + 32 * (nb >> 1) + 8 * (i16 >> 2) + 4 * (nb & 1) + (i16 & 3); const int jrow = (GATE ? 4096 : 2048 * mode) + tpinv(ac);
#pragma unroll
        for (int ks = 0; ks < NKS; ++ks) bfr[nb][ks] = *(const bf16x8*)(wt + (size_t)jrow * KL2 + koff + 32 * ks + 8 * kq); }
    const int z = GATE ? 0 : (ac0 >> 10), c0 = (ac0 & 1023) + 8 * kq;
    f32x4 bias[NG][2];
#pragma unroll
    for (int g = 0; g < NG; ++g)
#pragma unroll
        for (int b = 0; b < 2; ++b) { bias[g][b] = (f32x4){0.f, 0.f, 0.f, 0.f}; if (!GATE) bias[g][b] = *(const f32x4*)((mode == 0 ? C.ka->in[8] : C.ka->in[10]) + z * RW + c0 + 32 * g + 4 * b); }
    bf16* dst = GATE ? (bf16*)(C.ws + WS_GATE) : (bf16*)(C.ws + (mode == 0 ? WS_LW : WS_A)) + (size_t)z * S * RW;
    const int ntile = S / 32;
    bf16x8 afr[2][NKS];
#define LF_LOADA(rt_) do { const bf16* ap_ = la + (size_t)((rt_) * 32 + i16) * KL2 + koff + 8 * kq; \
        _Pragma("unroll") for (int ks_ = 0; ks_ < NKS; ++ks_) { afr[0][ks_] = *(const bf16x8*)(ap_ + 32 * ks_); afr[1][ks_] = *(const bf16x8*)(ap_ + 16 * KL2 + 32 * ks_); } } while (0)
    int rt = rg; if (rt >= ntile) return;
    LF_LOADA(rt);
    for (;;) {
        f32x4 acc[2][NNB];
#pragma unroll
        for (int mb = 0; mb < 2; ++mb)
#pragma unroll
            for (int nb = 0; nb < NNB; ++nb) { acc[mb][nb] = (f32x4){0.f, 0.f, 0.f, 0.f};
#pragma unroll
                for (int ks = 0; ks < NKS; ++ks) acc[mb][nb] = __builtin_amdgcn_mfma_f32_16x16x32_bf16(bfr[nb][ks], afr[mb][ks], acc[mb][nb], 0, 0, 0); }
        const int t0 = rt * 32; const int nrt = rt + nrg; const bool more = nrt < ntile;
        if (more) LF_LOADA(nrt);
#pragma unroll
        for (int mb = 0; mb < 2; ++mb) { bf16* rp = dst + (size_t)(t0 + 16 * mb + i16) * RW + c0;
#pragma unroll
            for (int g = 0; g < NG; ++g) { f32x4 o[2];
#pragma unroll
                for (int b = 0; b < 2; ++b)
#pragma unroll
                    for (int e = 0; e < 4; ++e) { const float v = acc[mb][2 * g + b][e] + bias[g][b][e];
                        if (GATE) o[b][e] = v; else { const float sg = __builtin_amdgcn_rcpf(1.0f + __builtin_amdgcn_exp2f(v * -1.44269504f)); o[b][e] = mode == 0 ? -0.60653066f * sg : sg; } }
                *(u32x4*)(rp + 32 * g) = pack8(o[0], o[1]); } }
        if (!more) break;
        rt = nrt;
    }
#undef LF_LOADA
}

__device__ __forceinline__ void ph_prep0(Ctx& C) {
    const int lane_ = lane_now(), tid_ = C.wave * 64 + lane_; (void)tid_;
    LAS float* scr = (LAS float*)(C.lds + C.wave * 16384);
    conv_win(C, scr); conv_wlora(C, scr);
    conv_natural(C, C.ka->in[18], 512, D, (bf16*)(C.ws + WS_WBA), scr);
    conv_natural(C, C.ka->in[19], RW, D, (bf16*)(C.ws + WS_WBR), scr);
    bf16* h1 = (bf16*)(C.dout + DO_H1);
    for (int m = C.gw; m < S; m += C.ngw) rms_row(C.ka->in[0] + (size_t)m * D, C.ka->in[1], h1 + (size_t)m * D, lane_);
}
__device__ __forceinline__ void ph_g1a(Ctx& C) {
#if OPT_GEMM
    EpiG1A8 E{(bf16*)(C.ws + WS_ZQKV), (bf16*)(C.ws + WS_ZR), C.ka->in[4], C.ka->in[5]};
    gemm8(C, (const bf16*)(C.dout + DO_H1), (const bf16*)(C.ws + WS_WIN), N1A, D, E);
#else
    EpiG1A E{(bf16*)(C.ws + WS_ZQKV), (bf16*)(C.ws + WS_ZR)};
    gemm_simple(C, (const bf16*)(C.dout + DO_H1), (const bf16*)(C.ws + WS_WIN), N1A, D, E);
#endif
}
__device__ __forceinline__ void ph_hnorm(Ctx& C) {
    const int lane_ = lane_now(), tid_ = C.wave * 64 + lane_; (void)tid_;
    bf16* z = (bf16*)(C.ws + WS_ZQKV); const float* qw = C.ka->in[4]; const float* kw = C.ka->in[5];
    const long nitems = (long)S * 48;
    for (long it = C.gw; it < nitems; it += C.ngw) { const int t = (int)(it / 48), hh = (int)(it % 48), which = hh / 24;
        bf16* p = z + (size_t)t * NQKV + hh * 64 + lane_; const float v = bf2f(*p); const float ss = wave_sum(v * v);
        const float w = which ? kw[lane_] : qw[lane_] * 0.125f; *p = f2bf(v * (1.0f / sqrtf(ss * (1.0f / 64.f) + 1e-6f)) * w); }
}
__device__ __forceinline__ void ph_attn(Ctx& C) {
    const int lane_ = lane_now(), tid_ = C.wave * 64 + lane_; (void)tid_;
    const bf16* z = (const bf16*)(C.ws + WS_ZQKV); bf16* oa = (bf16*)(C.ws + WS_OATT); const int lane = lane_;
    const long nitems = (long)S * 8;
    for (long it = C.gw; it < nitems; it += C.ngw) { const int t = (int)(it >> 3), h = (int)(it & 7);
        float og[3], lse[3];
#pragma unroll
        for (int g = 0; g < 3; ++g) { const int d = g == 0 ? 1 : (g == 1 ? 4 : 16); const float slope = exp2f(-8.0f * (float)(g * 8 + h + 1) / 24.0f);
            const int col = g * 512 + h * 64;
            float q[64];
            { const bf16* qp = z + (size_t)t * NQKV + col;
#pragma unroll
              for (int e = 0; e < 64; e += 8) { const u32x4 w = *(const u32x4*)(qp + e);
                  q[e] = __uint_as_float(w.x << 16); q[e + 1] = __uint_as_float(w.x & 0xffff0000u); q[e + 2] = __uint_as_float(w.y << 16); q[e + 3] = __uint_as_float(w.y & 0xffff0000u);
                  q[e + 4] = __uint_as_float(w.z << 16); q[e + 5] = __uint_as_float(w.z & 0xffff0000u); q[e + 6] = __uint_as_float(w.w << 16); q[e + 7] = __uint_as_float(w.w & 0xffff0000u); } }
            float sc[3]; bool vd[3];
#pragma unroll
            for (int ps = 0; ps < 3; ++ps) { const int j = -64 + 64 * ps + lane; const long tk = (long)t + (long)d * j; vd[ps] = (j <= 64) && tk >= 0 && tk < S; float s = -1e30f;
                if (vd[ps]) { const bf16* kp = z + (size_t)tk * NQKV + 1536 + col; float dot = 0.f;
#pragma unroll
                    for (int e = 0; e < 64; e += 8) { const u32x4 w = *(const u32x4*)(kp + e);
                        dot += q[e] * __uint_as_float(w.x << 16) + q[e + 1] * __uint_as_float(w.x & 0xffff0000u) + q[e + 2] * __uint_as_float(w.y << 16) + q[e + 3] * __uint_as_float(w.y & 0xffff0000u)
                             + q[e + 4] * __uint_as_float(w.z << 16) + q[e + 5] * __uint_as_float(w.z & 0xffff0000u) + q[e + 6] * __uint_as_float(w.w << 16) + q[e + 7] * __uint_as_float(w.w & 0xffff0000u); }
                    s = dot - slope * (float)((j < 0 ? -j : j) * d); }
                sc[ps] = s; }
            const float m = wave_max(fmaxf(sc[0], fmaxf(sc[1], sc[2])));
            float p[3]; float ps_ = 0.f;
#pragma unroll
            for (int ps = 0; ps < 3; ++ps) { p[ps] = vd[ps] ? __expf(sc[ps] - m) : 0.f; ps_ += p[ps]; }
            const float den = wave_sum(ps_);
            float acc = 0.f;
#pragma unroll
            for (int ps = 0; ps < 3; ++ps)
                for (int l = 0; l < 64; ++l) { const float pj = __shfl(p[ps], l); if (pj != 0.f) { const long tk = (long)t + (long)d * (-64 + 64 * ps + l); acc += pj * bf2f(z[(size_t)tk * NQKV + 3072 + col + lane]); } }
            og[g] = acc / den; lse[g] = m + __logf(den); }
        const float mx = fmaxf(lse[0], fmaxf(lse[1], lse[2])); const float w0 = __expf(lse[0] - mx), w1 = __expf(lse[1] - mx), w2 = __expf(lse[2] - mx);
        oa[(size_t)t * 512 + h * 64 + lane] = f2bf((w0 * og[0] + w1 * og[1] + w2 * og[2]) / (w0 + w1 + w2)); }
}
__device__ __forceinline__ void ph_rprep(Ctx& C) {
    const int lane_ = lane_now(), tid_ = C.wave * 64 + lane_; (void)tid_;
    const bf16* zr = (const bf16*)(C.ws + WS_ZR); const float* mup = C.ka->in[6]; const float* mun = C.ka->in[7]; const float* k_k = C.ka->in[13];
    bf16* r = (bf16*)(C.ws + WS_R); bf16* v = (bf16*)(C.ws + WS_V); bf16* nkk = (bf16*)(C.ws + WS_NKK); bf16* kraw = (bf16*)(C.ws + WS_KRAW); bf16* la = (bf16*)(C.ws + WS_LORAA);
    for (int t = C.bid; t < S; t += C.nb) {
        for (int c = tid_; c < NZR; c += NTHR) {
            if (c < NZR_REAL) {
                const float z0 = bf2f(zr[(size_t)t * NZR + c]); const float zp = t > 0 ? bf2f(zr[(size_t)(t - 1) * NZR + c]) : 0.f; const float zn = t < S - 1 ? bf2f(zr[(size_t)(t + 1) * NZR + c]) : 0.f;
                const float x = z0 + mup[c] * (zp - z0) + mun[c] * (zn - z0);
                if (c < 1024) r[(size_t)t * RW + c] = f2bf(x);
                else if (c < 2048) { const int cc = c - 1024; kraw[(size_t)t * RW + cc] = f2bf(x); const float kv = x * k_k[cc]; const float ss = wave_sum(kv * kv); nkk[(size_t)t * RW + cc] = f2bf(-kv / fmaxf(sqrtf(ss), 1e-12f)); }
                else if (c < 3072) v[(size_t)t * RW + (c - 2048)] = f2bf(x);
                else if (c < 3136) la[(size_t)t * KL + (c - 3072)] = f2bf(tanhf(x));
                else if (c < 3200) la[(size_t)t * KL + (c - 3072)] = f2bf(x);
                else la[(size_t)t * KL + (c - 3072)] = f2bf(sigmoidf_(x));
            } else if (c - NZR_REAL + 288 < KL) la[(size_t)t * KL + (c - NZR_REAL + 288)] = 0;
        }
    }
}
template <bool GATE> __device__ __forceinline__ void lora_fast(Ctx& C);
__device__ __forceinline__ void ph_glora(Ctx& C) {
#if OPT_GEMM && LORA_FAST
    lora_fast<false>(C); lora_fast<true>(C);
#elif OPT_GEMM
    { EpiLoraU8 E{C.ws, C.ka->in[8], C.ka->in[10]}; int nn = NL, kk = KL2; asm volatile("" : "+s"(nn), "+s"(kk));
      pg8::Gemm g{(const bf16*)(C.ws + WS_LORAA), (const bf16*)(C.ws + WS_WLORA), 2 * S, nn, kk}; LoraOrder so{C.nb, C.bid};
      pg8::gemm_phase<EpiLoraU8, LoraOrder, true, true>(C.lds, g, so, E, C.wave); }
#else
    EpiLora E{(bf16*)(C.ws + WS_LW), (bf16*)(C.ws + WS_A), (bf16*)(C.ws + WS_GATE), C.ka->in[8], C.ka->in[10]};
    gemm_simple(C, (const bf16*)(C.ws + WS_LORAA), (const bf16*)(C.ws + WS_WLORA), NL, KL, E);
#endif
}
__device__ __forceinline__ void ph_rk(Ctx& C) {
    const int lane_ = lane_now(), tid_ = C.wave * 64 + lane_; (void)tid_;
    const bf16* r = (const bf16*)(C.ws + WS_R); const bf16* kraw = (const bf16*)(C.ws + WS_KRAW); const bf16* a = (const bf16*)(C.ws + WS_A); float* rk = (float*)(C.ws + WS_RK);
    const float* k_a = C.ka->in[14]; const float* r_k = C.ka->in[15];
    const long nitems = (long)2 * S * 16;
    for (long it = C.gw; it < nitems; it += C.ngw) { const int h = (int)(it & 15), t = (int)((it >> 4) % S), z = (int)(it / ((long)S * 16)); const int c = h * 64 + lane_;
        const float av = bf2f(a[((size_t)z * S + t) * RW + c]); const float kd = bf2f(kraw[(size_t)t * RW + c]) * (1.0f + (av - 1.0f) * k_a[c]);
        const float s = wave_sum(bf2f(r[(size_t)t * RW + c]) * kd * r_k[c]); if (lane_ == 0) rk[((size_t)z * S + t) * 16 + h] = s; }
}
__device__ __forceinline__ void ph_scan_seq(Ctx& C) {
    const int lane_ = lane_now(), tid_ = C.wave * 64 + lane_; (void)tid_;
    const bf16* r = (const bf16*)(C.ws + WS_R); const bf16* v = (const bf16*)(C.ws + WS_V); const bf16* nkk = (const bf16*)(C.ws + WS_NKK); const bf16* kraw = (const bf16*)(C.ws + WS_KRAW);
    const bf16* lw = (const bf16*)(C.ws + WS_LW); const bf16* a = (const bf16*)(C.ws + WS_A); bf16* yl = (bf16*)(C.ws + WS_YL); const float* k_a = C.ka->in[14];
    { u32x4* q = (u32x4*)(C.dout + DO_QT); const size_t n = (size_t)64 * MiB / 16; for (size_t i = (size_t)C.bid * NTHR + tid_; i < n; i += (size_t)C.nb * NTHR) q[i] = (u32x4){0u, 0u, 0u, 0u};
      u32x4* s0 = (u32x4*)(C.ws + WS_S0); const size_t n2 = (size_t)32 * MiB / 16; for (size_t i = (size_t)C.bid * NTHR + tid_; i < n2; i += (size_t)C.nb * NTHR) s0[i] = (u32x4){0u, 0u, 0u, 0u}; }
    if (C.gw < NCHAIN) {
    const int z = C.gw >> 4, h = C.gw & 15, lane = lane_, c = h * 64 + lane;
    LAS float* scr = (LAS float*)(C.lds + C.wave * 2048);
    float st[64];
#pragma unroll
    for (int k = 0; k < 64; ++k) st[k] = 0.f;
    const float ka = k_a[c];
    const bf16* lwz = lw + (size_t)z * S * RW; const bf16* az = a + (size_t)z * S * RW; bf16* ylz = yl + (size_t)z * S * RW;
    int t = z ? S - 1 : 0; const int dt = z ? -1 : 1;
    bf16 n_nkk = nkk[(size_t)t * RW + c], n_lw = lwz[(size_t)t * RW + c], n_a = az[(size_t)t * RW + c], n_k = kraw[(size_t)t * RW + c], n_r = r[(size_t)t * RW + c], n_v = v[(size_t)t * RW + c];
#pragma unroll 1
    for (int s = 0; s < S; ++s) {
        const float fnkk = bf2f(n_nkk), fw = __expf(bf2f(n_lw)), fa = bf2f(n_a), fk = bf2f(n_k), fr_ = bf2f(n_r), fv = bf2f(n_v);
        const int tc = t; t += dt;
        if (s + 1 < S) { n_nkk = nkk[(size_t)t * RW + c]; n_lw = lwz[(size_t)t * RW + c]; n_a = az[(size_t)t * RW + c]; n_k = kraw[(size_t)t * RW + c]; n_r = r[(size_t)t * RW + c]; n_v = v[(size_t)t * RW + c]; }
        scr[lane] = fnkk; scr[64 + lane] = fw; scr[128 + lane] = -fnkk * fa; scr[192 + lane] = fk * (1.0f + (fa - 1.0f) * ka); scr[256 + lane] = fr_;
        asm volatile("s_waitcnt lgkmcnt(0)" ::: "memory");
        float sa = 0.f;
#pragma unroll
        for (int k = 0; k < 64; k += 4) { const f32x4 x = *(const LAS f32x4*)(scr + k); sa += st[k] * x[0] + st[k + 1] * x[1] + st[k + 2] * x[2] + st[k + 3] * x[3]; }
        float y = 0.f;
#pragma unroll
        for (int k = 0; k < 64; k += 4) { const f32x4 w4 = *(const LAS f32x4*)(scr + 64 + k), b4 = *(const LAS f32x4*)(scr + 128 + k), k4 = *(const LAS f32x4*)(scr + 192 + k), r4 = *(const LAS f32x4*)(scr + 256 + k);
#pragma unroll
            for (int e = 0; e < 4; ++e) { st[k + e] = st[k + e] * w4[e] + sa * b4[e] + fv * k4[e]; y += st[k + e] * r4[e]; } }
        asm volatile("s_waitcnt lgkmcnt(0)" ::: "memory");
        ylz[(size_t)tc * RW + c] = f2bf(y);
    }
    }
}
__device__ __forceinline__ void ph_fin(Ctx& C) {
    const int lane_ = lane_now(), tid_ = C.wave * 64 + lane_; (void)tid_;
    const bf16* yl = (const bf16*)(C.ws + WS_YL); const bf16* qt = (const bf16*)(C.dout + DO_QT); const float* s0 = (const float*)(C.ws + WS_S0);
    const bf16* r = (const bf16*)(C.ws + WS_R); const bf16* kraw = (const bf16*)(C.ws + WS_KRAW); const bf16* a = (const bf16*)(C.ws + WS_A); const float* k_a = C.ka->in[14]; const float* r_k = C.ka->in[15];
    const bf16* v = (const bf16*)(C.ws + WS_V); const bf16* gate = (const bf16*)(C.ws + WS_GATE); bf16* orw = (bf16*)(C.ws + WS_ORWKV); const float* lnw = C.ka->in[16]; const float* lnb = C.ka->in[17];
    const long nitems = (long)S * 16; const int lane = lane_;
    for (long it = C.gw; it < nitems; it += C.ngw) { const int t = (int)(it >> 4), h = (int)(it & 15), c = h * 64 + lane;
        float y = bf2f(yl[(size_t)t * RW + c]) + bf2f(yl[((size_t)S + t) * RW + c]);
#pragma unroll
        for (int z = 0; z < 2; ++z) { const int ck = z ? (S - 1 - t) / CHL : t / CHL; const float* sp = s0 + (((size_t)(z * 16 + h) * NCK + ck) * 64 + lane) * 64; const bf16* qp = qt + ((size_t)z * S + t) * RW + h * 64;
            float corr = 0.f;
#pragma unroll 4
            for (int k = 0; k < 64; k += 4) { const f32x4 s4 = *(const f32x4*)(sp + k); const u32x2 q2 = *(const u32x2*)(qp + k);
                corr += s4[0] * __uint_as_float(q2.x << 16) + s4[1] * __uint_as_float(q2.x & 0xffff0000u) + s4[2] * __uint_as_float(q2.y << 16) + s4[3] * __uint_as_float(q2.y & 0xffff0000u); }
            y += corr; }
        const float mu = wave_sum(y) * (1.0f / 64.f); const float dv = y - mu; const float var = wave_sum(dv * dv) * (1.0f / 64.f);
        const float gn = dv * (1.0f / sqrtf(var + 64e-5f)) * lnw[c] + lnb[c];
        const float ka_ = k_a[c]; const float kd2 = (1.0f + (bf2f(a[(size_t)t * RW + c]) - 1.0f) * ka_) + (1.0f + (bf2f(a[((size_t)S + t) * RW + c]) - 1.0f) * ka_);
        const float bonus = wave_sum(bf2f(r[(size_t)t * RW + c]) * bf2f(kraw[(size_t)t * RW + c]) * kd2 * r_k[c]) * bf2f(v[(size_t)t * RW + c]);
        orw[(size_t)t * RW + c] = f2bf((gn + bonus) * bf2f(gate[(size_t)t * RW + c])); }
}
__device__ __forceinline__ void ph_g1b(Ctx& C) {
    LAS float* scr = (LAS float*)(C.lds + C.wave * 16384);
    conv_natural(C, C.ka->in[20], D, D, (bf16*)(C.ws + WS_WOUT), scr);
    conv_wgu(C, scr);
    conv_natural(C, C.ka->in[24], FF, D, (bf16*)(C.ws + WS_WD), scr);
    __syncthreads();
#if OPT_GEMM
    EpiG1B8 E{(bf16*)(C.ws + WS_ZG), C.ka->in[3]};
    gemm8(C, (const bf16*)(C.dout + DO_H1), (const bf16*)(C.ws + WS_WIN) + (size_t)N1A * D, NGATE, D, E);
#else
    EpiG1B E{(bf16*)(C.ws + WS_ZG), C.ka->in[3]};
    gemm_simple(C, (const bf16*)(C.dout + DO_H1), (const bf16*)(C.ws + WS_WIN) + (size_t)N1A * D, NGATE, D, E);
#endif
}
__device__ __forceinline__ void ph_norm2(Ctx& C) {
    const int lane = lane_now(); const float* pp = (const float*)(C.ws + WS_SSQP); float* rs = (float*)(C.ws + WS_RSTD);
    for (int row = C.gw * 64 + lane; row < S; row += C.ngw * 64) { const f32x4* p = (const f32x4*)(pp + (size_t)row * 32); float ss = 0.f;
#pragma unroll
        for (int q = 0; q < 8; ++q) { const f32x4 v = p[q]; ss += (v[0] + v[1]) + (v[2] + v[3]); }
        rs[row] = 1.0f / sqrtf(ss * (1.0f / D) + 1e-6f); }
}

template <bool COOP>
__global__ void __launch_bounds__(NTHR, 2) mega(Args args) {
    extern __shared__ __attribute__((aligned(16))) unsigned char lds_raw[];
    KArgs* ka = (KArgs*)__builtin_amdgcn_kernarg_segment_ptr();
    int wave_s = __builtin_amdgcn_readfirstlane((int)threadIdx.x >> 6);
    if constexpr (COOP) {
        if (threadIdx.x == 0) { volatile LAS unsigned* st = (volatile LAS unsigned*)((LAS unsigned char*)lds_raw + LDS_BAR_OFF); st[0] = 0u; st[1] = 0u; (void)xb_add(&((unsigned*)(args.ws + WS_CTL))[XB_XCNT(xb_xcc_id())], 1u); }
        __syncthreads();
    }
#define MKCTX() Ctx C; { asm volatile("" : "+s"(ka), "+s"(wave_s)); C.ka = ka; C.out = ka->out; C.ws = ka->ws; C.dout = (unsigned char*)ka->out; C.lds = (LAS unsigned char*)lds_raw; \
    C.wave = wave_s; C.bid = blockIdx.x; C.nb = gridDim.x; C.gw = C.bid * NWAVES + C.wave; C.ngw = C.nb * NWAVES; }
#define GSYNC() do { if constexpr (COOP) { XcdBarrier xb; xb.bar = (unsigned*)(C.ws + WS_CTL); xb.x = xb_xcc_id(); xb.st = (volatile LAS unsigned*)(C.lds + LDS_BAR_OFF); \
    const bool leader_ = (C.wave == 0) && (lane_now() == 0); xcd_barrier(xb, leader_, (unsigned)C.nb); } } while (0)
#ifndef PROBE_DUP
#define PROBE_DUP (-1)
#endif
#define PH(k, ...) do { if (ka->ph_lo <= (k) && (k) < ka->ph_hi) { MKCTX(); __VA_ARGS__; if ((k) == PROBE_DUP) { GSYNC(); __VA_ARGS__; } if ((k) + 1 < ka->ph_hi) GSYNC(); } } while (0)
    if (ka->ph_lo <= P_PREP0 && P_PREP0 < ka->ph_hi) { MKCTX(); ph_prep0(C); if (PROBE_DUP == P_PREP0) { __syncthreads(); ph_prep0(C); } if (P_PREP0 + 1 < ka->ph_hi) { if constexpr (COOP) cg::this_grid().sync(); } }
    PH(P_G1A, ph_g1a(C));
#if OPT_GEMM && OPT_ATTN
    PH(P_ATTPREP, ph_attn2(C); ph_rprep2(C));
    PH(P_GLORA, ph_attn_combine(C); __syncthreads(); ph_glora(C));
#elif OPT_GEMM
    PH(P_ATTPREP, ph_attn(C); ph_rprep(C));
    PH(P_GLORA, ph_glora(C));
#else
    PH(P_HNORM, ph_hnorm(C));
    PH(P_ATTPREP, ph_attn(C); ph_rprep(C));
    PH(P_GLORA, ph_glora(C));
#endif
#if OPT_SCAN && PROBE_SCANCMP
    PH(P_SCAN1, ph_scan1m(C); GSYNC(); ph_scancmp(C, 0, 0); GSYNC(); ph_scan1(C); GSYNC(); ph_scancmp(C, 1, PROBE_SCANCMP - 1));
    PH(P_SCAN2, ph_scan2(C));
    PH(P_FIN, ph_fin4(C));
#elif OPT_SCAN && OPT_SCANM
    PH(P_SCAN1, ph_scan1m(C));
#if OPT_SCAN2B
    PH(P_SCAN2, ph_scan2b(C));
#else
    PH(P_SCAN2, ph_scan2(C));
#endif
    PH(P_FIN, ph_fin4(C));
#elif OPT_SCAN
    PH(P_SCAN1, ph_scan1(C));
    PH(P_SCAN2, ph_scan2(C));
    PH(P_FIN, ph_fin4(C));
#else
    PH(P_SCAN1, ph_scan_seq(C));
    PH(P_FIN, ph_fin(C));
#endif
    PH(P_G1B, ph_g1b(C));
#if OPT_GEMM
    PH(P_GMA, { EpiMerge8<false> E{(bf16*)(C.ws + WS_MERGED), (const bf16*)(C.ws + WS_ZG)}; gemm8(C, (const bf16*)(C.ws + WS_OATT), (const bf16*)(C.ws + WS_WBA), D, 512, E); });
    PH(P_GMB, { EpiMerge8<true> E{(bf16*)(C.ws + WS_MERGED), (const bf16*)(C.ws + WS_ZG)}; gemm8(C, (const bf16*)(C.ws + WS_ORWKV), (const bf16*)(C.ws + WS_WBR), D, RW, E); });
    PH(P_GOUT, { EpiX2b8 E{C.ka->in[0], (bf16*)(C.ws + WS_X2B), (float*)(C.ws + WS_SSQP)}; gemm8(C, (const bf16*)(C.ws + WS_MERGED), (const bf16*)(C.ws + WS_WOUT), D, D, E); });
    PH(P_NORM2, ph_norm2(C));
    PH(P_FFN1, { EpiFfn18 E{(bf16*)(C.ws + WS_HID), (const float*)(C.ws + WS_RSTD)}; gemm8(C, (const bf16*)(C.ws + WS_X2B), (const bf16*)(C.ws + WS_WGU), 2 * FF, D, E); });
    PH(P_FFN2, { EpiResB8 E{(const bf16*)(C.ws + WS_X2B), C.out}; gemm8(C, (const bf16*)(C.ws + WS_HID), (const bf16*)(C.ws + WS_WD), D, FF, E); });
#if PROBE_SCANCMP
    { MKCTX(); GSYNC(); ph_probe_fold(C); }
#endif
#else
    PH(P_GMA, { EpiMA E{(bf16*)(C.ws + WS_MERGED), (const bf16*)(C.ws + WS_ZG)}; gemm_simple(C, (const bf16*)(C.ws + WS_OATT), (const bf16*)(C.ws + WS_WBA), D, 512, E); });
    PH(P_GMB, { EpiMB E{(bf16*)(C.ws + WS_MERGED), (const bf16*)(C.ws + WS_ZG)}; gemm_simple(C, (const bf16*)(C.ws + WS_ORWKV), (const bf16*)(C.ws + WS_WBR), D, RW, E); });
    PH(P_GOUT, { EpiRes E{C.ka->in[0], C.out}; gemm_simple(C, (const bf16*)(C.ws + WS_MERGED), (const bf16*)(C.ws + WS_WOUT), D, D, E); });
    PH(P_NORM2, ph_norm2(C));
    PH(P_FFN1, gemm_simple_ffn1(C, (const bf16*)(C.ws + WS_H2), (const bf16*)(C.ws + WS_WGU), (bf16*)(C.ws + WS_HID)));
    PH(P_FFN2, { EpiRes E{C.out, C.out}; gemm_simple(C, (const bf16*)(C.ws + WS_HID), (const bf16*)(C.ws + WS_WD), D, FF, E); });
#endif
#undef PH
#undef GSYNC
#undef MKCTX
}

extern "C" void kernel_launch(void* const* d_in, const int* in_sizes, int n_in, void* d_out, int out_size, void* d_ws, size_t ws_size, hipStream_t stream) {
    static int grid = 0;
    if (grid == 0) {
        if (n_in != 25 || in_sizes[0] != S * D || out_size != S * D || ws_size < WS_END) { fprintf(stderr, "kernel_launch: unexpected shapes (n_in %d, ws %zu)\n", n_in, ws_size); grid = -1; return; }
        int dev = 0, cus = 0, per_cu = 0;
        hipGetDevice(&dev); hipDeviceGetAttribute(&cus, hipDeviceAttributeMultiprocessorCount, dev);
        const void* fn = MK_COOP ? (const void*)mega<true> : (const void*)mega<false>;
        hipFuncSetAttribute(fn, hipFuncAttributeMaxDynamicSharedMemorySize, LDS_BYTES);
        hipOccupancyMaxActiveBlocksPerMultiprocessor(&per_cu, fn, NTHR, LDS_BYTES);
        if (per_cu < 1) { fprintf(stderr, "kernel_launch: occupancy query says %d blocks per CU\n", per_cu); per_cu = 1; }
        grid = cus * 1;
        (void)hipGetLastError();
    }
    if (grid < 0) return;
    Args a{};
    for (int i = 0; i < 25; ++i) a.in[i] = (const float*)d_in[i];
    a.out = (float*)d_out; a.ws = (unsigned char*)d_ws;
#if MK_COOP
    (void)hipMemsetAsync((char*)d_ws + WS_CTL, 0, CTL_BYTES, stream);
    a.ph_lo = 0; a.ph_hi = P_COUNT;
    void* kargs[] = {&a};
    hipError_t e = hipLaunchCooperativeKernel((const void*)mega<true>, dim3(grid), dim3(NTHR), kargs, LDS_BYTES, stream);
    if (e != hipSuccess) fprintf(stderr, "cooperative launch failed: %s (grid %d)\n", hipGetErrorString(e), grid);
#else
    for (int ph = 0; ph < P_COUNT; ++ph) { if (ph == P_SCAN2) continue; a.ph_lo = ph; a.ph_hi = ph + 1; hipLaunchKernelGGL(mega<false>, dim3(grid), dim3(NTHR), LDS_BYTES, stream, a); }
#endif
}
```

```cpp
#include <hip/hip_runtime.h>
#include <hip/hip_cooperative_groups.h>
#include <cstdio>
#include <cstdint>
namespace cg = cooperative_groups;

#ifndef MK_COOP
#define MK_COOP 1
#endif

#define LAS __attribute__((address_space(3)))
typedef unsigned short bf16;
typedef short bf16x8 __attribute__((ext_vector_type(8)));
typedef float f32x4 __attribute__((ext_vector_type(4)));
typedef float f32x2 __attribute__((ext_vector_type(2)));
typedef unsigned u32x4 __attribute__((ext_vector_type(4)));
typedef unsigned u32x2 __attribute__((ext_vector_type(2)));

constexpr int S = 16384, D = 2048;
constexpr int HD = 64;
constexpr int NQKV = 4608, NZR = 3584, NZR_REAL = 3360, NGATE = 4096;
constexpr int N1A = NQKV + NZR;
constexpr int N1 = N1A + NGATE;
constexpr int IN_W = 12064;
constexpr int KL = 384, NL = 5120;
constexpr int KL2 = 256;
constexpr int FF = 5632;
constexpr int RW = 1024;
constexpr int NCHAIN = 32;
constexpr int CHL = 512, NCK = S / CHL;
constexpr int NWAVES = 8, NTHR = 512;
constexpr int LDS_BYTES = 147456, LDS_BAR_OFF = 147440;

constexpr size_t MiB = 1u << 20;
constexpr size_t WS_WIN = 0;
constexpr size_t WS_OATT = 0;
constexpr size_t WS_LORAA = 16 * MiB;
constexpr size_t WS_RK = 28 * MiB;
constexpr size_t WS_WLORA = 48 * MiB;
constexpr size_t WS_WBA = 52 * MiB;
constexpr size_t WS_WBR = 54 * MiB;
constexpr size_t WS_ZQKV = 58 * MiB;
constexpr size_t WS_ZR = 202 * MiB;
constexpr size_t WS_LW = 58 * MiB;
constexpr size_t WS_A = 122 * MiB;
constexpr size_t WS_GATE = 186 * MiB;
constexpr size_t WS_PU = 218 * MiB;
constexpr size_t WS_S0 = 282 * MiB;
constexpr size_t WS_R = 314 * MiB, WS_V = 346 * MiB, WS_NKK = 378 * MiB, WS_KRAW = 410 * MiB;
constexpr size_t WS_YL = 442 * MiB;
constexpr size_t WS_ORWKV = 58 * MiB;
constexpr size_t WS_ZG = 90 * MiB;
constexpr size_t WS_WOUT = 218 * MiB;
constexpr size_t WS_WGU = 226 * MiB;
constexpr size_t WS_WD = 270 * MiB;
constexpr size_t WS_MERGED = 292 * MiB;
constexpr size_t WS_H2 = 356 * MiB;
constexpr size_t WS_SSQP = 484 * MiB, WS_RSTD = 486 * MiB;
constexpr size_t WS_X2B = 420 * MiB;
constexpr size_t WS_HID = 0;
constexpr size_t WS_CTL = 506 * MiB, CTL_BYTES = 16384;
constexpr size_t WS_END = 507 * MiB;
constexpr size_t DO_H1 = 0, DO_QT = 64 * MiB;

enum Phase { P_PREP0 = 0, P_G1A, P_HNORM, P_ATTPREP, P_GLORA, P_RK, P_SCAN1, P_SCAN2, P_FIN, P_G1B, P_GMA, P_GMB, P_GOUT, P_NORM2, P_FFN1, P_FFN2, P_COUNT };

struct Args { const float* in[25]; float* out; unsigned char* ws; int ph_lo, ph_hi; };

__device__ __forceinline__ float bf2f(bf16 h) { return __uint_as_float((unsigned)h << 16); }
__device__ __forceinline__ bf16 f2bf(float f) { unsigned u = __float_as_uint(f); return (bf16)((u + 0x7fffu + ((u >> 16) & 1u)) >> 16); }
__device__ __forceinline__ unsigned pk2(float lo, float hi) { return (unsigned)f2bf(lo) | ((unsigned)f2bf(hi) << 16); }
__device__ __forceinline__ float wave_sum(float v) {
#pragma unroll
    for (int o = 1; o < 64; o <<= 1) v += __shfl_xor(v, o);
    return v;
}
__device__ __forceinline__ float wave_max(float v) {
#pragma unroll
    for (int o = 1; o < 64; o <<= 1) v = fmaxf(v, __shfl_xor(v, o));
    return v;
}
__device__ __forceinline__ float sigmoidf_(float x) { return 1.0f / (1.0f + __expf(-x)); }
__host__ __device__ __forceinline__ int tperm(int j) { const int lc = j & 255; return (j & ~255) + 64 * ((lc >> 5) & 3) + 32 * (lc >> 7) + (lc & 31); }

typedef const __attribute__((address_space(4))) Args KArgs;
struct Ctx {
    KArgs* ka;
    float* out; unsigned char* ws; unsigned char* dout;
    LAS unsigned char* lds;
    int wave, bid, nb, gw, ngw;
};
__device__ __forceinline__ int lane_now() { int l; asm volatile("v_mbcnt_lo_u32_b32 %0, -1, 0\n\tv_mbcnt_hi_u32_b32 %0, -1, %0" : "=v"(l)); return l; }


#define XB_TMO      128
#define XB_XCNT(j)  (256  + 64 * (j))
#define XB_XSUB(j)  (1280 + 64 * (j))
#define XB_XGEN(j)  (2304 + 64 * (j))
#define XB_TOP      3328
#define XB_TOPGEN   3392
#define XCD_BAR_WORDS 3456
#define XB_SPIN_CAP (1u << 22)
__device__ __forceinline__ unsigned xb_ld(unsigned* p)              { return __hip_atomic_load(p, __ATOMIC_RELAXED, __HIP_MEMORY_SCOPE_AGENT); }
__device__ __forceinline__ unsigned xb_add(unsigned* p, unsigned v) { return __hip_atomic_fetch_add(p, v, __ATOMIC_RELAXED, __HIP_MEMORY_SCOPE_AGENT); }
__device__ __forceinline__ unsigned xb_xcc_id() { return (unsigned)__builtin_amdgcn_s_getreg((3 << 11) | 20) & 0xFu; }
#define XB_SPIN(cond, bar) do { unsigned _sp = 0; while (cond) { __builtin_amdgcn_s_sleep(1); \
    if ((++_sp & 255u) == 0u) { if (xb_ld(&(bar)[XB_TMO])) break; if (_sp > XB_SPIN_CAP) { atomicAdd(&(bar)[XB_TMO], 1u); break; } } } } while (0)
struct XcdBarrier { unsigned* bar; unsigned x; volatile LAS unsigned* st; };
__device__ __forceinline__ void xcd_barrier_complete(unsigned* bar, unsigned x, unsigned G, unsigned& nloc, unsigned& nx) {
    unsigned sum, cnt, mine, sp = 0u;
    for (;;) {
        sum = 0u; cnt = 0u; mine = 0u;
#pragma unroll
        for (unsigned j = 0; j < 16; ++j) { const unsigned c = xb_ld(&bar[XB_XCNT(j)]); sum += c; cnt += (c > 0u) ? 1u : 0u; mine = (j == x) ? c : mine; }
        if (sum == G) break;
        __builtin_amdgcn_s_sleep(1);
        if ((++sp & 255u) == 0u) { if (xb_ld(&bar[XB_TMO])) break; if (sp > XB_SPIN_CAP) { atomicAdd(&bar[XB_TMO], 1u); break; } }
    }
    nloc = mine > 0u ? mine : 1u; nx = cnt > 0u ? cnt : 1u;
}
__device__ __forceinline__ void xcd_barrier(const XcdBarrier& b, const bool leader, const unsigned G) {
    asm volatile("s_waitcnt vmcnt(0)" ::: "memory");
    __syncthreads();
    if (leader) {
        unsigned* bar = b.bar;
        __builtin_amdgcn_s_waitcnt(0);
        unsigned nloc = b.st[0], nx = b.st[1];
        if (nloc == 0u) { xcd_barrier_complete(bar, b.x, G, nloc, nx); b.st[0] = nloc; b.st[1] = nx; }
        const unsigned old = xb_add(&bar[XB_XSUB(b.x)], 1u);
        const unsigned gen = old / nloc;
        if (old + 1u == (gen + 1u) * nloc) {
            __builtin_amdgcn_fence(__ATOMIC_RELEASE, "agent");
            asm volatile("s_waitcnt vmcnt(0)" ::: "memory");
            const unsigned og = xb_add(&bar[XB_TOP], 1u);
            const unsigned tg = og / nx;
            if (og + 1u == (tg + 1u) * nx) xb_add(&bar[XB_TOPGEN], 1u);
            else XB_SPIN(xb_ld(&bar[XB_TOPGEN]) == tg, bar);
            __builtin_amdgcn_fence(__ATOMIC_ACQUIRE, "agent");
            xb_add(&bar[XB_XGEN(b.x)], 1u);
            asm volatile("s_waitcnt vmcnt(0)" ::: "memory");
        } else {
            XB_SPIN(xb_ld(&bar[XB_XGEN(b.x)]) == gen, bar);
            __builtin_amdgcn_fence(__ATOMIC_ACQUIRE, "agent");
            asm volatile("s_waitcnt vmcnt(0)" ::: "memory");
        }
    }
    __syncthreads();
}

__device__ __forceinline__ unsigned pg8c(float lo, float hi) { unsigned r; asm volatile("v_cvt_pk_bf16_f32 %0, %1, %2" : "=v"(r) : "v"(lo), "v"(hi)); return r; }
__device__ __forceinline__ bf16x8 pack8s(float a0, float a1, float a2, float a3, float a4, float a5, float a6, float a7) {
    u32x4 p;
    asm volatile("v_cvt_pk_bf16_f32 %0, %4, %5\n\tv_cvt_pk_bf16_f32 %1, %6, %7\n\tv_cvt_pk_bf16_f32 %2, %8, %9\n\tv_cvt_pk_bf16_f32 %3, %10, %11\n\ts_nop 1"
                 : "=&v"(p[0]), "=&v"(p[1]), "=&v"(p[2]), "=&v"(p[3]) : "v"(a0), "v"(a1), "v"(a2), "v"(a3), "v"(a4), "v"(a5), "v"(a6), "v"(a7));
    return __builtin_bit_cast(bf16x8, p);
}
struct TrItem { const float* src; int ld; int nk; bf16* dst; int K; const float* kscale = nullptr; };
__device__ __forceinline__ void tr_load(const TrItem& t, f32x4 (&v)[8], int lane) {
#pragma unroll
    for (int i = 0; i < 8; ++i) { const int kk = (lane >> 3) + 8 * i; v[i] = (f32x4){0.f, 0.f, 0.f, 0.f}; if (t.src && kk < t.nk) { v[i] = *(const f32x4*)(t.src + (size_t)kk * t.ld + 4 * (lane & 7)); if (t.kscale) v[i] = v[i] * t.kscale[kk]; } }
}
__device__ __forceinline__ void tr_store(const TrItem& t, const f32x4 (&v)[8], LAS float* scr, int lane) {
#pragma unroll
    for (int i = 0; i < 8; ++i) { LAS float* d = scr + ((lane >> 3) + 8 * i) * 33 + 4 * (lane & 7); d[0] = v[i][0]; d[1] = v[i][1]; d[2] = v[i][2]; d[3] = v[i][3]; }
    asm volatile("s_waitcnt lgkmcnt(0)" ::: "memory");
    const int c = lane & 7;
#pragma unroll
    for (int j = 0; j < 4; ++j) { const int n = (lane >> 3) + 8 * j; const LAS float* s = scr + (8 * c) * 33 + n;
        u32x4 o; o.x = pg8c(s[0 * 33], s[1 * 33]); o.y = pg8c(s[2 * 33], s[3 * 33]); o.z = pg8c(s[4 * 33], s[5 * 33]); o.w = pg8c(s[6 * 33], s[7 * 33]);
        *(u32x4*)(t.dst + (size_t)n * t.K + 8 * c) = o; }
    asm volatile("s_waitcnt lgkmcnt(0)" ::: "memory");
}
template <class Mk> __device__ __forceinline__ void conv_run(Ctx& C, int nitems, const Mk& mk, LAS float* scr) {
    const int lane = lane_now(); int it = C.gw; if (it >= nitems) return;
    TrItem cur = mk(it); f32x4 v[8]; tr_load(cur, v, lane);
    for (;;) { const int nit = it + C.ngw; const bool more = nit < nitems; TrItem nxt = cur; f32x4 w[8];
        if (more) { nxt = mk(nit); tr_load(nxt, w, lane); }
        tr_store(cur, v, scr, lane);
        if (!more) break;
        cur = nxt; it = nit;
#pragma unroll
        for (int i = 0; i < 8; ++i) v[i] = w[i]; }
}
__device__ __forceinline__ void conv_natural(Ctx& C, const float* W, int K, int N, bf16* Wt, LAS float* scr) {
    const int nkb = K / 64;
    conv_run(C, (N / 32) * nkb, [=](int it) { const int j32 = it / nkb, kb = it % nkb; return TrItem{W + (size_t)(kb * 64) * N + j32 * 32, N, 64, Wt + (size_t)(j32 * 32) * K + kb * 64, K}; }, scr);
}
__device__ __forceinline__ void conv_win(Ctx& C, LAS float* scr) {
    const float* W = C.ka->in[2]; bf16* Wt = (bf16*)(C.ws + WS_WIN); const int nkb = D / 64;
    conv_run(C, (N1 / 32) * nkb, [=](int it) { const int j32 = it / nkb, kb = it % nkb; const int j = j32 * 32, ac = tperm(j);
        int wc; if (j < NQKV) wc = ac; else if (j < N1A) { const int zc = ac - NQKV; wc = zc < NZR_REAL ? NQKV + zc : -1; } else wc = NQKV + NZR_REAL + (ac - N1A);
        return TrItem{wc >= 0 ? W + (size_t)(kb * 64) * IN_W + wc : nullptr, IN_W, 64, Wt + (size_t)j * D + kb * 64, D}; }, scr);
}
__device__ __forceinline__ void conv_wlora(Ctx& C, LAS float* scr) {
    bf16* Wt = (bf16*)(C.ws + WS_WLORA); const float* w_d = C.ka->in[9]; const float* w_i = C.ka->in[11]; const float* w_g = C.ka->in[12]; const int nkb = KL2 / 64;
    conv_run(C, (NL / 32) * nkb, [=](int it) { const int j32 = it / nkb, kb = it % nkb; const int j = j32 * 32; const float* src = nullptr; int nk = 64;
        if (j < 4096) { const int ac = tperm(j); if (ac < 2048) { if (kb == 0) src = w_d + (size_t)(ac >> 10) * 64 * RW + (ac & 1023); } else { if (kb == 1) src = w_i + (size_t)((ac - 2048) >> 10) * 64 * RW + (ac & 1023); } }
        else { const int c = tperm(j - 4096); if (kb < 2) src = w_g + (size_t)(kb * 64) * RW + c; else if (kb == 2) { src = w_g + (size_t)128 * RW + c; nk = 32; } }
        return TrItem{src, RW, nk, Wt + (size_t)j * KL2 + kb * 64, KL2}; }, scr);
}
__device__ __forceinline__ void conv_wgu(Ctx& C, LAS float* scr) {
    bf16* Wt = (bf16*)(C.ws + WS_WGU); const float* wg = C.ka->in[22]; const float* wu = C.ka->in[23]; const float* nw2 = C.ka->in[21]; const int nkb = D / 64;
    conv_run(C, (2 * FF / 32) * nkb, [=](int it) { const int j32 = it / nkb, kb = it % nkb; const int j = j32 * 32, p = j >> 8, lc = j & 255;
        const float* W = (lc >= 128) ? wu : wg; const int hc = 128 * p + (lc & 127);
        return TrItem{W + (size_t)(kb * 64) * FF + hc, FF, 64, Wt + (size_t)j * D + kb * 64, D, nw2 + kb * 64}; }, scr);
}

__device__ __forceinline__ void rms_row(const float* xrow, const float* w, bf16* orow, int lane) {
    f32x4 v[8]; float ss = 0.f;
#pragma unroll
    for (int j = 0; j < 8; ++j) { v[j] = ((const f32x4*)xrow)[lane + 64 * j]; ss += (v[j].x * v[j].x + v[j].y * v[j].y) + (v[j].z * v[j].z + v[j].w * v[j].w); }
    ss = wave_sum(ss); const float rs = 1.0f / sqrtf(ss * (1.0f / D) + 1e-6f);
#pragma unroll
    for (int j = 0; j < 8; ++j) { const f32x4 w4 = ((const f32x4*)w)[lane + 64 * j]; u32x2 o; o.x = pk2(v[j].x * rs * w4.x, v[j].y * rs * w4.y); o.y = pk2(v[j].z * rs * w4.z, v[j].w * rs * w4.w);
        ((u32x2*)orow)[lane + 64 * j] = o; }
}

template <class Epi>
__device__ __forceinline__ void gemm_simple(Ctx& C, const bf16* A, const bf16* Bt, int N, int K, const Epi& epi) {
    const int lane_ = lane_now(), tid_ = C.wave * 64 + lane_; (void)tid_;
    const int lane = lane_, fr = lane & 15, fq = lane >> 4;
    const int ntn = N / 32; const long ntiles = (long)ntn * (S / 32);
    for (long it = C.gw; it < ntiles; it += C.ngw) {
        const int m0 = (int)(it / ntn) * 32, n0 = (int)(it % ntn) * 32;
        const bf16* ap = A + (size_t)(m0 + fr) * K + 8 * fq; const bf16* bp = Bt + (size_t)(n0 + fr) * K + 8 * fq;
        f32x4 acc[2][2];
#pragma unroll
        for (int i = 0; i < 2; ++i)
#pragma unroll
            for (int j = 0; j < 2; ++j) acc[i][j] = (f32x4){0.f, 0.f, 0.f, 0.f};
#pragma unroll 4
        for (int k = 0; k < K; k += 32) {
            const bf16x8 a0 = *(const bf16x8*)(ap + k), a1 = *(const bf16x8*)(ap + (size_t)16 * K + k);
            const bf16x8 b0 = *(const bf16x8*)(bp + k), b1 = *(const bf16x8*)(bp + (size_t)16 * K + k);
            acc[0][0] = __builtin_amdgcn_mfma_f32_16x16x32_bf16(b0, a0, acc[0][0], 0, 0, 0);
            acc[0][1] = __builtin_amdgcn_mfma_f32_16x16x32_bf16(b1, a0, acc[0][1], 0, 0, 0);
            acc[1][0] = __builtin_amdgcn_mfma_f32_16x16x32_bf16(b0, a1, acc[1][0], 0, 0, 0);
            acc[1][1] = __builtin_amdgcn_mfma_f32_16x16x32_bf16(b1, a1, acc[1][1], 0, 0, 0);
        }
#pragma unroll
        for (int i = 0; i < 2; ++i)
#pragma unroll
            for (int j = 0; j < 2; ++j) epi(m0 + 16 * i + fr, n0 + 16 * j + 4 * fq, acc[i][j]);
    }
}
__device__ __forceinline__ void gemm_simple_ffn1(Ctx& C, const bf16* A, const bf16* Bt, bf16* hid) {
    const int lane_ = lane_now(), tid_ = C.wave * 64 + lane_; (void)tid_;
    const int lane = lane_, fr = lane & 15, fq = lane >> 4, K = D;
    const int ntn = FF / 32; const long ntiles = (long)ntn * (S / 32);
    for (long it = C.gw; it < ntiles; it += C.ngw) {
        const int m0 = (int)(it / ntn) * 32, h0 = (int)(it % ntn) * 32, n0 = 256 * (h0 >> 7) + (h0 & 127);
        const bf16* ap = A + (size_t)(m0 + fr) * K + 8 * fq; const bf16* bp = Bt + (size_t)(n0 + fr) * K + 8 * fq;
        f32x4 ag[2][2], au[2][2];
#pragma unroll
        for (int i = 0; i < 2; ++i)
#pragma unroll
            for (int j = 0; j < 2; ++j) { ag[i][j] = (f32x4){0.f, 0.f, 0.f, 0.f}; au[i][j] = (f32x4){0.f, 0.f, 0.f, 0.f}; }
#pragma unroll 2
        for (int k = 0; k < K; k += 32) {
            const bf16x8 a0 = *(const bf16x8*)(ap + k), a1 = *(const bf16x8*)(ap + (size_t)16 * K + k);
            const bf16x8 g0 = *(const bf16x8*)(bp + k), g1 = *(const bf16x8*)(bp + (size_t)16 * K + k);
            const bf16x8 u0 = *(const bf16x8*)(bp + (size_t)128 * K + k), u1 = *(const bf16x8*)(bp + (size_t)144 * K + k);
            ag[0][0] = __builtin_amdgcn_mfma_f32_16x16x32_bf16(g0, a0, ag[0][0], 0, 0, 0); ag[0][1] = __builtin_amdgcn_mfma_f32_16x16x32_bf16(g1, a0, ag[0][1], 0, 0, 0);
            ag[1][0] = __builtin_amdgcn_mfma_f32_16x16x32_bf16(g0, a1, ag[1][0], 0, 0, 0); ag[1][1] = __builtin_amdgcn_mfma_f32_16x16x32_bf16(g1, a1, ag[1][1], 0, 0, 0);
            au[0][0] = __builtin_amdgcn_mfma_f32_16x16x32_bf16(u0, a0, au[0][0], 0, 0, 0); au[0][1] = __builtin_amdgcn_mfma_f32_16x16x32_bf16(u1, a0, au[0][1], 0, 0, 0);
            au[1][0] = __builtin_amdgcn_mfma_f32_16x16x32_bf16(u0, a1, au[1][0], 0, 0, 0); au[1][1] = __builtin_amdgcn_mfma_f32_16x16x32_bf16(u1, a1, au[1][1], 0, 0, 0);
        }
#pragma unroll
        for (int i = 0; i < 2; ++i)
#pragma unroll
            for (int j = 0; j < 2; ++j) { const int row = m0 + 16 * i + fr, hc = h0 + 16 * j + 4 * fq; const f32x4 g = ag[i][j], u = au[i][j]; float o[4];
#pragma unroll
                for (int e = 0; e < 4; ++e) o[e] = g[e] * sigmoidf_(g[e]) * u[e];
                u32x2 w; w.x = pk2(o[0], o[1]); w.y = pk2(o[2], o[3]); *(u32x2*)(hid + (size_t)row * FF + hc) = w; }
    }
}


namespace pg8 {
#define PG8_LAS __attribute__((address_space(3)))
typedef unsigned short bf16_t;
constexpr int BM = 256, BK = 64, HALF = 128, HTB = HALF * BK * 2, STAGE_BYTES = 8 * HTB, NXCD = 8, WGM = 4;
__host__ __device__ __forceinline__ int lds_byte(int r, int c) { const int st = (r >> 4) * 2 + (c >> 5), rr = r & 15, cc = c & 31, ob = rr * 64 + cc * 2; return st * 1024 + (ob ^ (((ob >> 9) & 1) << 5)); }
__host__ __device__ __forceinline__ void stage_rc(int b, int& R, int& C) { const int st = b / 1024, sb = b % 1024, swz = sb ^ (((sb >> 9) & 1) << 5); R = (st >> 1) * 16 + swz / 64; C = (st & 1) * 32 + (swz % 64) / 2; }
__host__ __device__ __forceinline__ int perm32(int rho) { const int n = rho >> 4, i = rho & 15; return 8 * (i >> 2) + 4 * n + (i & 3); }
struct Unit { int pm, pn; };
struct Gemm { const bf16_t* A; const bf16_t* Bt; int M, N, K; };
struct StaticOrder {
    int nM, nN, nwg, G, c;
    __host__ __device__ void init(int M, int N, int G_, int c_) { nM = M / BM; nN = N / BM; nwg = nM * nN; G = G_; c = c_; }
    __host__ __device__ bool next(int i, Unit& u) const {
        const long L = (long)i * G + c; if (L >= nwg) return false;
        int wgid = (int)L; { const int q = nwg / NXCD, r = nwg % NXCD, xcd = wgid % NXCD, off = wgid / NXCD; wgid = (xcd < r ? xcd * (q + 1) : r * (q + 1) + (xcd - r) * q) + off; }
        const int nig = WGM * nN, gid = wgid / nig, fm = gid * WGM, gsz = (nM - fm) < WGM ? (nM - fm) : WGM;
        u.pm = fm + ((wgid % nig) % gsz); u.pn = (wgid % nig) / gsz; return true;
    }
    __device__ __forceinline__ void a_ready(const Unit&) const {}
    __device__ __forceinline__ void done(const Unit&) const {}
};
__device__ __forceinline__ unsigned cvt_pk_bf16(float lo, float hi) { unsigned r; asm volatile("v_cvt_pk_bf16_f32 %0, %1, %2" : "=v"(r) : "v"(lo), "v"(hi)); return r; }
template <class Epi, class Sched, bool ALIGN_EPI = false, bool SP2 = false>
__device__ __forceinline__ void gemm_phase(PG8_LAS unsigned char* lds, const Gemm g, const Sched& S, const Epi& E, const int wid) {
    const int lane = lane_now(), tid = wid * 64 + lane, wr = wid >> 2, wc = wid & 3, fr = lane & 15, fq = lane >> 4;
    const int K = g.K, nt = K / BK;
    unsigned voffA[2], voffB[2];
#pragma unroll
    for (int i = 0; i < 2; ++i) { int R, C; stage_rc(tid * 16 + i * 8192, R, C); const int Rb = Epi::PERM ? ((R & ~31) + perm32(R & 31)) : R;
        voffA[i] = (unsigned)(R * K + C) * 2u; voffB[i] = (unsigned)(Rb * K + C) * 2u; }
    const size_t kstep = (size_t)(BK * 2);
    const size_t hstep = (size_t)HALF * K * 2;
    const size_t tstep = 2 * hstep;
    const unsigned ldsw = (unsigned)wid * 1024u;
    const int aoff = lds_byte(wr * 64 + fr, fq * 8), boff = lds_byte(wc * 32 + fr, fq * 8);
#define PG8_SA(b, h) (((b) * 2 + (h)) * HTB)
#define PG8_SB(b, h) ((4 + (b) * 2 + (h)) * HTB)
#define PG8_STAGE(bufoff, gbase, voff) do { _Pragma("unroll") for (int _i = 0; _i < 2; ++_i) \
        __builtin_amdgcn_global_load_lds((const unsigned*)((const char*)(gbase) + (voff)[_i]), (PG8_LAS unsigned*)(lds + (bufoff) + ldsw + _i * 8192), 16, 0, 0); } while (0)
#define PG8_LDA(dst, b, h) do { _Pragma("unroll") for (int m = 0; m < 4; ++m) _Pragma("unroll") for (int k = 0; k < 2; ++k) dst[m][k] = *(const PG8_LAS bf16x8*)(lds + PG8_SA(b, h) + aoff + m * 2048 + k * 1024); } while (0)
#define PG8_LDB(dst, b, h) do { _Pragma("unroll") for (int n = 0; n < 2; ++n) _Pragma("unroll") for (int k = 0; k < 2; ++k) dst[n][k] = *(const PG8_LAS bf16x8*)(lds + PG8_SB(b, h) + boff + n * 2048 + k * 1024); } while (0)
#define PG8_MMA(ai, bj, At, Bt) do { __builtin_amdgcn_s_setprio(1); _Pragma("unroll") for (int m = 0; m < 4; ++m) _Pragma("unroll") for (int n = 0; n < 2; ++n) _Pragma("unroll") for (int k = 0; k < 2; ++k) \
        acc[ai][bj][m][n] = __builtin_amdgcn_mfma_f32_16x16x32_bf16(Bt[n][k], At[m][k], acc[ai][bj][m][n], 0, 0, 0); __builtin_amdgcn_s_setprio(0); } while (0)
#define PG8_WAIT_V(n) asm volatile("s_waitcnt vmcnt(" #n ")" ::: "memory")
#define PG8_WAIT_L(n) asm volatile("s_waitcnt lgkmcnt(" #n ")" ::: "memory")
#define PG8_BAR __builtin_amdgcn_s_barrier()
#define PG8_SCHED __builtin_amdgcn_sched_barrier(0)
    Unit cur, nxt; int ui = 0;
    if (!S.next(0, cur)) return;
    f32x4 acc[2][2][4][2];
#pragma unroll
    for (int a = 0; a < 2; ++a)
#pragma unroll
        for (int b = 0; b < 2; ++b)
#pragma unroll
            for (int m = 0; m < 4; ++m)
#pragma unroll
                for (int n = 0; n < 2; ++n) acc[a][b][m][n] = (f32x4){0.f, 0.f, 0.f, 0.f};
    bf16x8 At[4][2], B0[2][2], B1[2][2];
    const char* cA = (const char*)g.A + (size_t)cur.pm * tstep; const char* cB = (const char*)g.Bt + (size_t)cur.pn * tstep;
    S.a_ready(cur);
    if constexpr (SP2) {
        PG8_STAGE(PG8_SB(0, 0), cB, voffB); PG8_STAGE(PG8_SB(0, 1), cB + hstep, voffB); PG8_STAGE(PG8_SA(0, 0), cA, voffA); PG8_STAGE(PG8_SA(0, 1), cA + hstep, voffA);
        if (wr == 1) PG8_BAR;
        PG8_WAIT_V(2); PG8_BAR;
        PG8_STAGE(PG8_SB(1, 0), cB + kstep, voffB); PG8_STAGE(PG8_SA(1, 0), cA + kstep, voffA); PG8_STAGE(PG8_SB(1, 1), cB + hstep + kstep, voffB);
        PG8_WAIT_V(6); PG8_BAR;
    } else {
        PG8_STAGE(PG8_SB(0, 0), cB, voffB); PG8_STAGE(PG8_SA(0, 0), cA, voffA); PG8_STAGE(PG8_SB(0, 1), cB + hstep, voffB); PG8_STAGE(PG8_SA(0, 1), cA + hstep, voffA);
        if (wr == 1) PG8_BAR;
        PG8_WAIT_V(4); PG8_BAR;
        PG8_STAGE(PG8_SB(1, 0), cB + kstep, voffB); PG8_STAGE(PG8_SA(1, 0), cA + kstep, voffA); PG8_STAGE(PG8_SB(1, 1), cB + hstep + kstep, voffB);
        PG8_WAIT_V(6); PG8_BAR;
    }
    for (;;) {
        const bool has_next = S.next(ui + 1, nxt);
        const char* nA = has_next ? (const char*)g.A + (size_t)nxt.pm * tstep : cA; const char* nB = has_next ? (const char*)g.Bt + (size_t)nxt.pn * tstep : cB;
        for (int t = 0; t < nt; t += 2) {
            const bool last = (t == nt - 2);
            const char* a1 = cA + (size_t)(t + 1) * kstep;
            const char* a2 = last ? nA : cA + (size_t)(t + 2) * kstep; const char* b2 = last ? nB : cB + (size_t)(t + 2) * kstep;
            const char* a3 = a2 + kstep; const char* b3 = b2 + kstep;
            if (last && has_next) S.a_ready(nxt);
            if constexpr (SP2) {
            PG8_LDB(B0, 0, 0); PG8_LDB(B1, 0, 1); PG8_SCHED; PG8_LDA(At, 0, 0); PG8_STAGE(PG8_SA(1, 1), a1 + hstep, voffA);
            PG8_WAIT_V(8); PG8_WAIT_L(0); PG8_BAR; PG8_MMA(0, 0, At, B0); PG8_MMA(0, 1, At, B1); PG8_BAR; PG8_SCHED;
            PG8_LDA(At, 0, 1); PG8_STAGE(PG8_SB(0, 0), b2, voffB); PG8_STAGE(PG8_SB(0, 1), b2 + hstep, voffB); PG8_STAGE(PG8_SA(0, 0), a2, voffA);
            PG8_WAIT_V(8); PG8_WAIT_L(0); PG8_BAR; PG8_MMA(1, 0, At, B0); PG8_MMA(1, 1, At, B1); PG8_BAR; PG8_SCHED;
            PG8_LDB(B0, 1, 0); PG8_LDB(B1, 1, 1); PG8_SCHED; PG8_LDA(At, 1, 0); PG8_STAGE(PG8_SA(0, 1), a2 + hstep, voffA);
            PG8_WAIT_V(8); PG8_WAIT_L(0); PG8_BAR; PG8_MMA(0, 0, At, B0); PG8_MMA(0, 1, At, B1); PG8_BAR; PG8_SCHED;
            PG8_LDA(At, 1, 1); PG8_STAGE(PG8_SB(1, 0), b3, voffB); PG8_STAGE(PG8_SB(1, 1), b3 + hstep, voffB); PG8_STAGE(PG8_SA(1, 0), a3, voffA);
            PG8_WAIT_V(8); PG8_WAIT_L(0); PG8_BAR; PG8_MMA(1, 0, At, B0); PG8_MMA(1, 1, At, B1); PG8_BAR; PG8_SCHED;
            } else {
            PG8_LDB(B0, 0, 0); PG8_SCHED; PG8_LDA(At, 0, 0); PG8_STAGE(PG8_SA(1, 1), a1 + hstep, voffA);
            PG8_WAIT_L(8); PG8_BAR; PG8_WAIT_L(0); PG8_MMA(0, 0, At, B0); PG8_BAR; PG8_SCHED;
            PG8_LDB(B1, 0, 1); PG8_STAGE(PG8_SB(0, 0), b2, voffB);
            PG8_BAR; PG8_WAIT_L(0); PG8_MMA(0, 1, At, B1); PG8_BAR;
            PG8_LDA(At, 0, 1); PG8_STAGE(PG8_SA(0, 0), a2, voffA);
            PG8_BAR; PG8_WAIT_L(0); PG8_MMA(1, 0, At, B0); PG8_BAR; PG8_SCHED;
            PG8_STAGE(PG8_SB(0, 1), b2 + hstep, voffB);
            PG8_WAIT_V(6); PG8_BAR; PG8_MMA(1, 1, At, B1); PG8_BAR;
            PG8_LDB(B0, 1, 0); PG8_SCHED; PG8_LDA(At, 1, 0); PG8_STAGE(PG8_SA(0, 1), a2 + hstep, voffA);
            PG8_WAIT_L(8); PG8_BAR; PG8_WAIT_L(0); PG8_MMA(0, 0, At, B0); PG8_BAR; PG8_SCHED;
            PG8_LDB(B1, 1, 1); PG8_STAGE(PG8_SB(1, 0), b3, voffB);
            PG8_BAR; PG8_WAIT_L(0); PG8_MMA(0, 1, At, B1); PG8_BAR;
            PG8_LDA(At, 1, 1); PG8_STAGE(PG8_SA(1, 0), a3, voffA);
            PG8_BAR; PG8_WAIT_L(0); PG8_MMA(1, 0, At, B0); PG8_BAR; PG8_SCHED;
            PG8_STAGE(PG8_SB(1, 1), b3 + hstep, voffB);
            PG8_WAIT_V(6); PG8_BAR; PG8_MMA(1, 1, At, B1); PG8_BAR;
            }
        }
        if constexpr (ALIGN_EPI) { if (wr == 0) PG8_BAR; }
        if constexpr (!Epi::AFTER_DRAIN) { int fr_e = fr, fq_e = fq; asm volatile("" : "+v"(fr_e), "+v"(fq_e)); E(acc, cur, wr, wc, fr_e, fq_e); S.done(cur); }
        if (!has_next) break;
#pragma unroll
        for (int a = 0; a < 2; ++a)
#pragma unroll
            for (int b = 0; b < 2; ++b)
#pragma unroll
                for (int m = 0; m < 4; ++m)
#pragma unroll
                    for (int n = 0; n < 2; ++n) acc[a][b][m][n] = (f32x4){0.f, 0.f, 0.f, 0.f};
        cur = nxt; cA = nA; cB = nB; ++ui;
        if constexpr (ALIGN_EPI) { if (wr == 1) PG8_BAR; }
    }
    PG8_WAIT_V(0);
    if constexpr (!ALIGN_EPI) { if (wr == 0) PG8_BAR; }
    PG8_BAR;
    if constexpr (Epi::AFTER_DRAIN) { E.fused(acc, cur, wr, wc, fr, fq, lds, wid, lane); S.done(cur); }
#undef PG8_SA
#undef PG8_SB
#undef PG8_STAGE
#undef PG8_LDA
#undef PG8_LDB
#undef PG8_MMA
#undef PG8_WAIT_V
#undef PG8_WAIT_L
#undef PG8_BAR
#undef PG8_SCHED
}
}


#ifndef OPT_GEMM
#define OPT_GEMM 1
#endif
typedef f32x4 AccT[2][2][4][2];
#ifndef NT_EPI
#define NT_EPI 0
#endif
#if NT_EPI
#define NTST4(p, v) __builtin_nontemporal_store((v), (u32x4*)(p))
#else
#define NTST4(p, v) (*(u32x4*)(p) = (v))
#endif
__device__ __forceinline__ u32x4 pack8(f32x4 a, f32x4 b) { u32x4 w; w.x = pg8::cvt_pk_bf16(a[0], a[1]); w.y = pg8::cvt_pk_bf16(a[2], a[3]); w.z = pg8::cvt_pk_bf16(b[0], b[1]); w.w = pg8::cvt_pk_bf16(b[2], b[3]); return w; }
__device__ __forceinline__ void unpack8(u32x4 w, float (&f)[8]) { f[0] = __uint_as_float(w.x << 16); f[1] = __uint_as_float(w.x & 0xffff0000u); f[2] = __uint_as_float(w.y << 16); f[3] = __uint_as_float(w.y & 0xffff0000u);
    f[4] = __uint_as_float(w.z << 16); f[5] = __uint_as_float(w.z & 0xffff0000u); f[6] = __uint_as_float(w.w << 16); f[7] = __uint_as_float(w.w & 0xffff0000u); }
struct EpiG1A8 { static constexpr bool PERM = true, AFTER_DRAIN = false; bf16* zqkv; bf16* zr; const float* qw; const float* kw;
    __device__ __forceinline__ void operator()(const AccT& acc, const pg8::Unit& u, int wr, int wc, int fr, int fq) const {
        const int row0 = u.pm * 256 + wr * 64 + fr, acb = u.pn * 256 + wc * 64 + 8 * fq;
        if (u.pn < 12) {
            const float* nw = u.pn < 6 ? qw : kw; const float sc = u.pn < 6 ? 0.125f : 1.0f; f32x4 w[2][2];
#pragma unroll
            for (int bj = 0; bj < 2; ++bj)
#pragma unroll
                for (int n = 0; n < 2; ++n) w[bj][n] = *(const f32x4*)(nw + 32 * bj + 8 * fq + 4 * n) * sc;
#pragma unroll
            for (int ai = 0; ai < 2; ++ai)
#pragma unroll
                for (int m = 0; m < 4; ++m) { float ss = 0.f;
#pragma unroll
                    for (int bj = 0; bj < 2; ++bj)
#pragma unroll
                        for (int n = 0; n < 2; ++n) { const f32x4 x = acc[ai][bj][m][n]; ss += (x[0] * x[0] + x[1] * x[1]) + (x[2] * x[2] + x[3] * x[3]); }
                    ss += __shfl_xor(ss, 16); ss += __shfl_xor(ss, 32);
                    const float rs = 1.0f / sqrtf(ss * (1.0f / 64.f) + 1e-6f);
                    bf16* rp = zqkv + (size_t)(row0 + ai * 128 + m * 16) * NQKV + acb;
#pragma unroll
                    for (int bj = 0; bj < 2; ++bj) NTST4(rp + 32 * bj, pack8(acc[ai][bj][m][0] * rs * w[bj][0], acc[ai][bj][m][1] * rs * w[bj][1])); }
        } else {
            bf16* base = u.pn < 18 ? zqkv + acb : zr + (acb - NQKV); const int ld = u.pn < 18 ? NQKV : NZR;
#pragma unroll
            for (int ai = 0; ai < 2; ++ai)
#pragma unroll
                for (int m = 0; m < 4; ++m) { bf16* rp = base + (size_t)(row0 + ai * 128 + m * 16) * ld;
#pragma unroll
                    for (int bj = 0; bj < 2; ++bj) NTST4(rp + 32 * bj, pack8(acc[ai][bj][m][0], acc[ai][bj][m][1])); }
        }
    } };
template <int MODE> struct EpiLora8 { static constexpr bool PERM = true, AFTER_DRAIN = false; bf16* dst; const float* bias;
    __device__ __forceinline__ void operator()(const AccT& acc, const pg8::Unit& u, int wr, int wc, int fr, int fq) const {
        const int row0 = u.pm * 256 + wr * 64 + fr; const int cb = (u.pn & 3) * 256 + wc * 64 + 8 * fq; const int z = MODE == 2 ? 0 : (u.pn >> 2); f32x4 bv[2][2];
#pragma unroll
        for (int bj = 0; bj < 2; ++bj)
#pragma unroll
            for (int n = 0; n < 2; ++n) bv[bj][n] = MODE == 2 ? (f32x4){0.f, 0.f, 0.f, 0.f} : *(const f32x4*)(bias + z * RW + cb + 32 * bj + 4 * n);
#pragma unroll
        for (int ai = 0; ai < 2; ++ai)
#pragma unroll
            for (int m = 0; m < 4; ++m) { bf16* rp = dst + ((size_t)z * S + row0 + ai * 128 + m * 16) * RW + cb;
#pragma unroll
                for (int bj = 0; bj < 2; ++bj) { f32x4 o[2];
#pragma unroll
                    for (int n = 0; n < 2; ++n)
#pragma unroll
                        for (int e = 0; e < 4; ++e) { const float v = bv[bj][n][e] + acc[ai][bj][m][n][e];
                            if (MODE == 0) { const float x = -v; const float sp = fmaxf(x, 0.f) + __logf(1.0f + __expf(-fabsf(x))); o[n][e] = -__expf(-sp - 0.5f); }
                            else if (MODE == 1) o[n][e] = sigmoidf_(v); else o[n][e] = v; }
                    NTST4(rp + 32 * bj, pack8(o[0], o[1])); } }
    } };
struct LoraOrder { int G, c;
    __device__ bool next(int i, pg8::Unit& u) const { const int L = i * G + c; if (L >= 1280) return false; u.pn = L >> 6; u.pm = (L & 63) + (u.pn >= 16 ? 64 : 0); return true; }
    __device__ __forceinline__ void a_ready(const pg8::Unit&) const {}
    __device__ __forceinline__ void done(const pg8::Unit&) const {}
};
struct EpiLoraU8 { static constexpr bool PERM = true, AFTER_DRAIN = false; unsigned char* wsb; const float* w0; const float* a0;
    __device__ __forceinline__ void operator()(const AccT& acc, const pg8::Unit& u, int wr, int wc, int fr, int fq) const {
        const int row0 = (u.pm & 63) * 256 + wr * 64 + fr; const int cb = (u.pn & 3) * 256 + wc * 64 + 8 * fq; const int mode = u.pn < 8 ? 0 : (u.pn < 16 ? 1 : 2), z = mode == 2 ? 0 : ((u.pn >> 2) & 1);
        const float* bias = mode == 0 ? w0 : a0; const size_t doff = mode == 0 ? WS_LW : WS_A; bf16* dst = (bf16*)(wsb + (mode == 2 ? WS_GATE : doff)); f32x4 bv[2][2];
#pragma unroll
        for (int bj = 0; bj < 2; ++bj)
#pragma unroll
            for (int n = 0; n < 2; ++n) { bv[bj][n] = (f32x4){0.f, 0.f, 0.f, 0.f}; if (mode != 2) bv[bj][n] = *(const f32x4*)(bias + z * RW + cb + 32 * bj + 4 * n); }
#pragma unroll
        for (int ai = 0; ai < 2; ++ai)
#pragma unroll
            for (int m = 0; m < 4; ++m) { bf16* rp = dst + ((size_t)z * S + row0 + ai * 128 + m * 16) * RW + cb;
#pragma unroll
                for (int bj = 0; bj < 2; ++bj) { f32x4 o[2];
#pragma unroll
                    for (int n = 0; n < 2; ++n)
#pragma unroll
                        for (int e = 0; e < 4; ++e) { const float v = bv[bj][n][e] + acc[ai][bj][m][n][e];
                            const float sg = __builtin_amdgcn_rcpf(1.0f + __builtin_amdgcn_exp2f(v * -1.44269504f)); o[n][e] = mode == 0 ? -0.60653066f * sg : (mode == 1 ? sg : v); }
                    *(u32x4*)(rp + 32 * bj) = pack8(o[0], o[1]); } }
    } };
struct EpiG1B8 { static constexpr bool PERM = true, AFTER_DRAIN = false; bf16* zg; const float* bg;
    __device__ __forceinline__ void operator()(const AccT& acc, const pg8::Unit& u, int wr, int wc, int fr, int fq) const {
        const int row0 = u.pm * 256 + wr * 64 + fr, acb = u.pn * 256 + wc * 64 + 8 * fq; f32x4 bv[2][2];
#pragma unroll
        for (int bj = 0; bj < 2; ++bj)
#pragma unroll
            for (int n = 0; n < 2; ++n) bv[bj][n] = *(const f32x4*)(bg + acb + 32 * bj + 4 * n);
#pragma unroll
        for (int ai = 0; ai < 2; ++ai)
#pragma unroll
            for (int m = 0; m < 4; ++m) { bf16* rp = zg + (size_t)(row0 + ai * 128 + m * 16) * NGATE + acb;
#pragma unroll
                for (int bj = 0; bj < 2; ++bj) { f32x4 o[2];
#pragma unroll
                    for (int n = 0; n < 2; ++n)
#pragma unroll
                        for (int e = 0; e < 4; ++e) o[n][e] = sigmoidf_(acc[ai][bj][m][n][e] + bv[bj][n][e]);
                    NTST4(rp + 32 * bj, pack8(o[0], o[1])); } }
    } };
template <bool SECOND> struct EpiMerge8 { static constexpr bool PERM = true, AFTER_DRAIN = false; bf16* mg; const bf16* zg;
    __device__ __forceinline__ void operator()(const AccT& acc, const pg8::Unit& u, int wr, int wc, int fr, int fq) const {
        const int row0 = u.pm * 256 + wr * 64 + fr, col0 = u.pn * 256 + wc * 32 + 8 * fq;
#pragma unroll
        for (int ai = 0; ai < 2; ++ai)
#pragma unroll
            for (int m = 0; m < 4; ++m) { const int row = row0 + ai * 128 + m * 16;
#pragma unroll
                for (int bj = 0; bj < 2; ++bj) { const int col = col0 + 128 * bj; float g[8]; unpack8(*(const u32x4*)(zg + (size_t)row * NGATE + (SECOND ? D : 0) + col), g); f32x4 o[2];
                    float t[8]; if (SECOND) unpack8(*(const u32x4*)(mg + (size_t)row * D + col), t);
#pragma unroll
                    for (int n = 0; n < 2; ++n)
#pragma unroll
                        for (int e = 0; e < 4; ++e) o[n][e] = (SECOND ? t[4 * n + e] : 0.f) + g[4 * n + e] * acc[ai][bj][m][n][e];
                    *(u32x4*)(mg + (size_t)row * D + col) = pack8(o[0], o[1]); } }
    } };
struct EpiRes8 { static constexpr bool PERM = false, AFTER_DRAIN = false; const float* base; float* out;
    __device__ __forceinline__ void operator()(const AccT& acc, const pg8::Unit& u, int wr, int wc, int fr, int fq) const {
        const int row0 = u.pm * 256 + wr * 64 + fr, col0 = u.pn * 256 + wc * 32 + 4 * fq;
#pragma unroll
        for (int ai = 0; ai < 2; ++ai)
#pragma unroll
            for (int m = 0; m < 4; ++m) { const size_t off = (size_t)(row0 + ai * 128 + m * 16) * D + col0;
#pragma unroll
                for (int bj = 0; bj < 2; ++bj)
#pragma unroll
                    for (int n = 0; n < 2; ++n) { const f32x4 b = *(const f32x4*)(base + off + bj * 128 + n * 16); *(f32x4*)(out + off + bj * 128 + n * 16) = b + acc[ai][bj][m][n]; } }
    } };
struct EpiX2b8 { static constexpr bool PERM = true, AFTER_DRAIN = false; const float* base; bf16* xb; float* ssqp;
    __device__ __forceinline__ void operator()(const AccT& acc, const pg8::Unit& u, int wr, int wc, int fr, int fq) const {
        const int row0 = u.pm * 256 + wr * 64 + fr, col0 = u.pn * 256 + wc * 32 + 8 * fq;
#pragma unroll
        for (int ai = 0; ai < 2; ++ai)
#pragma unroll
            for (int m = 0; m < 4; ++m) { const int row = row0 + ai * 128 + m * 16; const size_t off = (size_t)row * D + col0; float ss = 0.f;
#pragma unroll
                for (int bj = 0; bj < 2; ++bj) { const f32x4 b0 = *(const f32x4*)(base + off + bj * 128), b1 = *(const f32x4*)(base + off + bj * 128 + 4);
                    const f32x4 o0 = b0 + acc[ai][bj][m][0], o1 = b1 + acc[ai][bj][m][1];
                    ss += (o0[0] * o0[0] + o0[1] * o0[1]) + (o0[2] * o0[2] + o0[3] * o0[3]) + (o1[0] * o1[0] + o1[1] * o1[1]) + (o1[2] * o1[2] + o1[3] * o1[3]);
                    *(u32x4*)(xb + off + bj * 128) = pack8(o0, o1); }
                ss += __shfl_xor(ss, 16); ss += __shfl_xor(ss, 32);
                if (fq == 0) ssqp[(size_t)row * 32 + u.pn * 4 + wc] = ss; }
    } };
struct EpiResB8 { static constexpr bool PERM = false, AFTER_DRAIN = false; const bf16* xb; float* out;
    __device__ __forceinline__ void operator()(const AccT& acc, const pg8::Unit& u, int wr, int wc, int fr, int fq) const {
        const int row0 = u.pm * 256 + wr * 64 + fr, col0 = u.pn * 256 + wc * 32 + 4 * fq;
#pragma unroll
        for (int ai = 0; ai < 2; ++ai)
#pragma unroll
            for (int m = 0; m < 4; ++m) { const size_t off = (size_t)(row0 + ai * 128 + m * 16) * D + col0;
#pragma unroll
                for (int bj = 0; bj < 2; ++bj)
#pragma unroll
                    for (int n = 0; n < 2; ++n) { const u32x2 w = *(const u32x2*)(xb + off + bj * 128 + n * 16);
                        const f32x4 b = (f32x4){__uint_as_float(w.x << 16), __uint_as_float(w.x & 0xffff0000u), __uint_as_float(w.y << 16), __uint_as_float(w.y & 0xffff0000u)};
                        *(f32x4*)(out + off + bj * 128 + n * 16) = b + acc[ai][bj][m][n]; } }
    } };
struct EpiFfn18 { static constexpr bool PERM = true, AFTER_DRAIN = false; bf16* hid; const float* rstd;
    __device__ __forceinline__ void operator()(const AccT& acc, const pg8::Unit& u, int wr, int wc, int fr, int fq) const {
        const int row0 = u.pm * 256 + wr * 64 + fr, hc0 = u.pn * 128 + wc * 32 + 8 * fq;
#pragma unroll
        for (int ai = 0; ai < 2; ++ai)
#pragma unroll
            for (int m = 0; m < 4; ++m) { f32x4 o[2]; const float rs = rstd[row0 + ai * 128 + m * 16];
#pragma unroll
                for (int n = 0; n < 2; ++n)
#pragma unroll
                    for (int e = 0; e < 4; ++e) { const float g = acc[ai][0][m][n][e] * rs; o[n][e] = g * sigmoidf_(g) * (acc[ai][1][m][n][e] * rs); }
                NTST4(hid + (size_t)(row0 + ai * 128 + m * 16) * FF + hc0, pack8(o[0], o[1])); }
    } };
template <class Epi> __device__ __forceinline__ void gemm8(Ctx& C, const bf16* A, const bf16* Bt, int N, int K, const Epi& E) {
    asm volatile("" : "+s"(N), "+s"(K));
    pg8::Gemm g{A, Bt, S, N, K}; pg8::StaticOrder so; so.init(S, N, C.nb, C.bid);
    pg8::gemm_phase<Epi, pg8::StaticOrder, true, true>(C.lds, g, so, E, C.wave);
}

__device__ __forceinline__ void st4bf(bf16* p, f32x4 v) { u32x2 w; w.x = pk2(v[0], v[1]); w.y = pk2(v[2], v[3]); *(u32x2*)p = w; }
struct EpiG1A { bf16* zqkv; bf16* zr;
    __device__ __forceinline__ void operator()(int row, int j0, f32x4 v) const { const int ac = tperm(j0);
        if (ac < NQKV) st4bf(zqkv + (size_t)row * NQKV + ac, v); else st4bf(zr + (size_t)row * NZR + (ac - NQKV), v); } };
struct EpiLora { bf16* lw; bf16* a; bf16* gate; const float* w0; const float* a0;
    __device__ __forceinline__ void operator()(int row, int j0, f32x4 v) const { const int ac = tperm(j0);
        if (ac < 2048) { const int z = ac >> 10, c = ac & 1023; f32x4 o;
#pragma unroll
            for (int e = 0; e < 4; ++e) { const float x = -(w0[z * RW + c + e] + v[e]); const float sp = fmaxf(x, 0.f) + log1pf(__expf(-fabsf(x))); o[e] = -__expf(-sp - 0.5f); }
            st4bf(lw + ((size_t)z * S + row) * RW + c, o); }
        else if (ac < 4096) { const int z = (ac - 2048) >> 10, c = ac & 1023; f32x4 o;
#pragma unroll
            for (int e = 0; e < 4; ++e) o[e] = sigmoidf_(a0[z * RW + c + e] + v[e]);
            st4bf(a + ((size_t)z * S + row) * RW + c, o); }
        else st4bf(gate + (size_t)row * RW + (ac - 4096), v); } };
struct EpiG1B { bf16* zg; const float* bg;
    __device__ __forceinline__ void operator()(int row, int j0, f32x4 v) const { const int ac = tperm(j0); f32x4 o;
#pragma unroll
        for (int e = 0; e < 4; ++e) o[e] = sigmoidf_(v[e] + bg[ac + e]);
        st4bf(zg + (size_t)row * NGATE + ac, o); } };
struct EpiMA { bf16* mg; const bf16* zg;
    __device__ __forceinline__ void operator()(int row, int j0, f32x4 v) const { const u32x2 g = *(const u32x2*)(zg + (size_t)row * NGATE + j0); f32x4 o;
        o[0] = v[0] * bf2f((bf16)(g.x & 0xffff)); o[1] = v[1] * bf2f((bf16)(g.x >> 16)); o[2] = v[2] * bf2f((bf16)(g.y & 0xffff)); o[3] = v[3] * bf2f((bf16)(g.y >> 16));
        st4bf(mg + (size_t)row * D + j0, o); } };
struct EpiMB { bf16* mg; const bf16* zg;
    __device__ __forceinline__ void operator()(int row, int j0, f32x4 v) const { const u32x2 g = *(const u32x2*)(zg + (size_t)row * NGATE + D + j0); const u32x2 t = *(const u32x2*)(mg + (size_t)row * D + j0); f32x4 o;
        o[0] = bf2f((bf16)(t.x & 0xffff)) + v[0] * bf2f((bf16)(g.x & 0xffff)); o[1] = bf2f((bf16)(t.x >> 16)) + v[1] * bf2f((bf16)(g.x >> 16));
        o[2] = bf2f((bf16)(t.y & 0xffff)) + v[2] * bf2f((bf16)(g.y & 0xffff)); o[3] = bf2f((bf16)(t.y >> 16)) + v[3] * bf2f((bf16)(g.y >> 16));
        st4bf(mg + (size_t)row * D + j0, o); } };
struct EpiRes { const float* base; float* out;
    __device__ __forceinline__ void operator()(int row, int j0, f32x4 v) const { const f32x4 b = *(const f32x4*)(base + (size_t)row * D + j0); *(f32x4*)(out + (size_t)row * D + j0) = b + v; } };


#ifndef OPT_SCAN
#define OPT_SCAN 1
#endif
#ifndef OPT_SCANM
#define OPT_SCANM 1
#endif
constexpr int SC_T = 8, SC_STEPF = 384, SC_ITEMF = SC_T * SC_STEPF;
template <int CTRL> __device__ __forceinline__ float dpp_f(float x) { return __int_as_float(__builtin_amdgcn_update_dpp(0, __float_as_int(x), CTRL, 0xf, 0xf, true)); }
__device__ __forceinline__ float quad_sum(float x) { x += dpp_f<0xB1>(x); x += dpp_f<0x4E>(x); return x; }
template <int role> __device__ __forceinline__ void ph_scan1_r(Ctx& C) {
    const int lane = lane_now(), wave = C.wave, itl = wave & 3, kq = lane & 3, rg = lane >> 2;
    const int t128 = role * 64 + lane, sst = t128 >> 4, cg = t128 & 15;
    const bf16* g_r = (const bf16*)(C.ws + WS_R); const bf16* g_v = (const bf16*)(C.ws + WS_V); const bf16* g_nkk = (const bf16*)(C.ws + WS_NKK); const bf16* g_k = (const bf16*)(C.ws + WS_KRAW);
    const bf16* g_lw = (const bf16*)(C.ws + WS_LW); const bf16* g_a = (const bf16*)(C.ws + WS_A); const float* k_a = C.ka->in[14];
    bf16* g_out = role ? (bf16*)(C.ws + WS_YL) : (bf16*)(C.dout + DO_QT); float* g_pu = (float*)(C.ws + WS_PU);
    LAS float* lbase = (LAS float*)C.lds + itl * SC_ITEMF;
    const int nitems = NCHAIN * NCK;
    for (int base = C.bid * 4; base < nitems; base += C.nb * 4) {
        const int item = base + itl; const bool active = item < nitems; const int chain = active ? item / NCK : 0, chunk = active ? item % NCK : 0, z = chain >> 4, h = chain & 15;
        const size_t zoff = (size_t)z * S * RW; const int cbase = h * 64 + 4 * cg;
        const f32x4 ka4 = *(const f32x4*)(k_a + cbase);
        f32x2 st[4][8];
#pragma unroll
        for (int i = 0; i < 4; ++i)
#pragma unroll
            for (int kk = 0; kk < 8; ++kk) { const int row = 4 * rg + i, k0 = 16 * kq + 2 * kk; st[i][kk] = (f32x2){(role == 0 && row == k0) ? 1.f : 0.f, (role == 0 && row == k0 + 1) ? 1.f : 0.f}; }
        u32x2 q_nkk, q_lw, q_a, q_k, q_r, q_v;
#define SC_LOAD(blk) do { const int sg_ = chunk * CHL + (blk) * SC_T + sst; const int tk_ = z ? S - 1 - sg_ : sg_; const size_t ix_ = (size_t)tk_ * RW + cbase; \
            q_nkk = *(const u32x2*)(g_nkk + ix_); q_lw = *(const u32x2*)(g_lw + zoff + ix_); q_a = *(const u32x2*)(g_a + zoff + ix_); q_k = *(const u32x2*)(g_k + ix_); q_r = *(const u32x2*)(g_r + ix_); q_v = *(const u32x2*)(g_v + ix_); } while (0)
#define SC_BF(q, e) __uint_as_float(((e) & 1) ? (((e) >> 1) ? (q).y : (q).x) & 0xffff0000u : (((e) >> 1) ? (q).y : (q).x) << 16)
#define SC_WRITE(buf) do { LAS float* d_ = lbase + (buf) * 4 * SC_ITEMF + sst * SC_STEPF + 4 * cg; f32x4 o0, o1, o2, o3, o4, o5; \
            _Pragma("unroll") for (int e = 0; e < 4; ++e) { const float n_ = SC_BF(q_nkk, e), a_ = SC_BF(q_a, e); o0[e] = n_; o1[e] = __expf(SC_BF(q_lw, e)); o2[e] = -n_ * a_; o3[e] = SC_BF(q_k, e) * (1.0f + (a_ - 1.0f) * ka4[e]); o4[e] = SC_BF(q_r, e); o5[e] = SC_BF(q_v, e); } \
            *(LAS f32x4*)(d_) = o0; *(LAS f32x4*)(d_ + 64) = o1; *(LAS f32x4*)(d_ + 128) = o2; *(LAS f32x4*)(d_ + 192) = o3; *(LAS f32x4*)(d_ + 256) = o4; *(LAS f32x4*)(d_ + 320) = o5; } while (0)
        SC_LOAD(0); SC_WRITE(0);
        __syncthreads();
        for (int blk = 0; blk < CHL / SC_T; ++blk) {
            if (blk + 1 < CHL / SC_T) SC_LOAD(blk + 1);
            const LAS float* bp = lbase + (blk & 1) * 4 * SC_ITEMF + 16 * kq;
            f32x4 x[4];
#pragma unroll
            for (int q = 0; q < 4; ++q) x[q] = *(const LAS f32x4*)(bp + 4 * q);
#pragma unroll 2
            for (int ss = 0; ss < SC_T; ++ss) {
                const LAS float* sp = bp + ss * SC_STEPF;
                float sa[4], y[4];
                f32x4 vv = (f32x4){0.f, 0.f, 0.f, 0.f}; if (role) vv = *(const LAS f32x4*)(sp - 16 * kq + 320 + 4 * rg);
                f32x4 w4[4], b4[4], r4[4], k4[4];
#pragma unroll
                for (int q = 0; q < 4; ++q) { w4[q] = *(const LAS f32x4*)(sp + 64 + 4 * q); b4[q] = *(const LAS f32x4*)(sp + 128 + 4 * q); r4[q] = *(const LAS f32x4*)(sp + 256 + 4 * q); if (role) k4[q] = *(const LAS f32x4*)(sp + 192 + 4 * q); }
                {   f32x2 s2[4];
#pragma unroll
                    for (int i = 0; i < 4; ++i) { s2[i] = st[i][0] * (f32x2){x[0][0], x[0][1]};
#pragma unroll
                        for (int kk = 1; kk < 8; ++kk) s2[i] += st[i][kk] * (f32x2){x[kk >> 1][2 * (kk & 1)], x[kk >> 1][2 * (kk & 1) + 1]}; }
#pragma unroll
                    for (int i = 0; i < 4; ++i) sa[i] = quad_sum(s2[i].x + s2[i].y); }
                if (ss + 1 < SC_T) {
#pragma unroll
                    for (int q = 0; q < 4; ++q) x[q] = *(const LAS f32x4*)(sp + SC_STEPF + 4 * q); }
                __builtin_amdgcn_sched_barrier(0);
                f32x2 y2[4];
#pragma unroll
                for (int i = 0; i < 4; ++i) y2[i] = (f32x2){0.f, 0.f};
#pragma unroll
                for (int kk = 0; kk < 8; ++kk) { const int q = kk >> 1, o = 2 * (kk & 1); const f32x2 w2 = (f32x2){w4[q][o], w4[q][o + 1]}, b2 = (f32x2){b4[q][o], b4[q][o + 1]}, r2 = (f32x2){r4[q][o], r4[q][o + 1]};
#pragma unroll
                    for (int i = 0; i < 4; ++i) { f32x2 t2 = b2 * sa[i]; if (role) t2 += (f32x2){k4[q][o], k4[q][o + 1]} * vv[i]; st[i][kk] = st[i][kk] * w2 + t2; y2[i] += st[i][kk] * r2; } }
#pragma unroll
                for (int i = 0; i < 4; ++i) y[i] = quad_sum(y2[i].x + y2[i].y);
                if (active && kq == 0) { const int sg = chunk * CHL + blk * SC_T + ss; const int tk = z ? S - 1 - sg : sg; u32x2 o; o.x = pk2(y[0], y[1]); o.y = pk2(y[2], y[3]);
                    *(u32x2*)(g_out + zoff + (size_t)tk * RW + h * 64 + 4 * rg) = o; }
            }
            if (blk + 1 < CHL / SC_T) SC_WRITE((blk + 1) & 1);
            __syncthreads();
        }
        if (active) { float* pp = g_pu + (((size_t)chain * NCK + chunk) * 2 + role) * 4096;
#pragma unroll
            for (int i = 0; i < 4; ++i)
#pragma unroll
                for (int q = 0; q < 4; ++q) *(f32x4*)(pp + (4 * rg + i) * 64 + 16 * kq + 4 * q) = (f32x4){st[i][2 * q].x, st[i][2 * q].y, st[i][2 * q + 1].x, st[i][2 * q + 1].y}; }
#undef SC_LOAD
#undef SC_BF
#undef SC_WRITE
    }
}
__device__ __forceinline__ void ph_scan1(Ctx& C) { if (C.wave >> 2) ph_scan1_r<1>(C); else ph_scan1_r<0>(C); }
__device__ __forceinline__ float rdlane(float x, int l) { return __int_as_float(__builtin_amdgcn_readlane(__float_as_int(x), l)); }
__device__ __forceinline__ void ph_scan2(Ctx& C) {
    const int lane = lane_now(); const float* g_pu = (const float*)(C.ws + WS_PU); float* g_s0 = (float*)(C.ws + WS_S0);
    for (int task = C.bid; task < NCHAIN * 8; task += C.nb) { const int chain = task >> 3, row = (task & 7) * 8 + C.wave;
        float sv = 0.f; float pc[64], uc;
        { const float* P = g_pu + ((size_t)chain * NCK) * 8192;
#pragma unroll
          for (int k = 0; k < 64; ++k) pc[k] = P[k * 64 + lane];
          uc = P[4096 + row * 64 + lane]; }
#pragma unroll 1
        for (int c = 0; c < NCK; ++c) { const float* P = g_pu + ((size_t)chain * NCK + (c + 1 < NCK ? c + 1 : c)) * 8192;
            float pn[64], un;
#pragma unroll
            for (int k = 0; k < 64; ++k) pn[k] = P[k * 64 + lane];
            un = P[4096 + row * 64 + lane];
            g_s0[(((size_t)chain * NCK + c) * 64 + row) * 64 + lane] = sv;
            float acc0 = uc, acc1 = 0.f;
#pragma unroll
            for (int k = 0; k < 64; k += 2) { acc0 += rdlane(sv, k) * pc[k]; acc1 += rdlane(sv, k + 1) * pc[k + 1]; }
            sv = acc0 + acc1;
#pragma unroll
            for (int k = 0; k < 64; ++k) pc[k] = pn[k];
            uc = un; }
    }
}

#ifndef OPT_SCAN2B
#define OPT_SCAN2B 1
#endif
__device__ __forceinline__ void ph_scan2b(Ctx& C) {
    const int lane = lane_now(), wave = C.wave, tid = wave * 64 + lane; const float* g_pu = (const float*)(C.ws + WS_PU); float* g_s0 = (float*)(C.ws + WS_S0);
    constexpr int SLOT = 18432, NSLOT = 6, AHEAD = 5;
    for (int task = C.bid; task < NCHAIN * 8; task += C.nb) { const int chain = task >> 3, rg = task & 7, row = rg * 8 + wave;
        const float* Pb = g_pu + (size_t)chain * NCK * 8192;
#define S2_ISSUE(c_) do { const float* pc_ = Pb + (size_t)(c_) * 8192; LAS unsigned char* sl_ = C.lds + ((c_) % NSLOT) * SLOT + wave * 1024; \
            __builtin_amdgcn_global_load_lds((const unsigned*)(pc_ + tid * 4), (LAS unsigned*)(sl_), 16, 0, 0); \
            __builtin_amdgcn_global_load_lds((const unsigned*)(pc_ + 2048 + tid * 4), (LAS unsigned*)(sl_ + 8192), 16, 0, 0); \
            if (wave < 2) __builtin_amdgcn_global_load_lds((const unsigned*)(pc_ + 4096 + rg * 512 + tid * 4), (LAS unsigned*)(sl_ + 16384), 16, 0, 0); } while (0)
        asm volatile("s_waitcnt vmcnt(0) lgkmcnt(0)" ::: "memory"); __builtin_amdgcn_s_barrier(); asm volatile("" ::: "memory");
#pragma unroll
        for (int c = 0; c < AHEAD; ++c) S2_ISSUE(c);
        float sv = 0.f;
#pragma unroll 1
        for (int c = 0; c < NCK; ++c) {
            if (c == 0 || c >= NCK - AHEAD + 1) asm volatile("s_waitcnt vmcnt(0)" ::: "memory");
            else if (wave < 2) asm volatile("s_waitcnt vmcnt(17)" ::: "memory");
            else asm volatile("s_waitcnt vmcnt(13)" ::: "memory");
            __builtin_amdgcn_s_barrier(); asm volatile("" ::: "memory");
            if (c + AHEAD < NCK) S2_ISSUE(c + AHEAD);
            asm volatile("" ::: "memory");
            const LAS float* P = (const LAS float*)(C.lds + (c % NSLOT) * SLOT);
            g_s0[(((size_t)chain * NCK + c) * 64 + row) * 64 + lane] = sv;
            float acc0 = P[4096 + wave * 64 + lane], acc1 = 0.f;
#pragma unroll
            for (int k = 0; k < 64; k += 2) { acc0 += rdlane(sv, k) * P[k * 64 + lane]; acc1 += rdlane(sv, k + 1) * P[(k + 1) * 64 + lane]; }
            sv = acc0 + acc1;
            asm volatile("s_waitcnt lgkmcnt(0)" ::: "memory");
        }
#undef S2_ISSUE
    }
    asm volatile("s_waitcnt vmcnt(0)" ::: "memory"); __builtin_amdgcn_s_barrier();
}
__device__ __forceinline__ void ph_fin2(Ctx& C) {
    const int lane = lane_now();
    const bf16* yl = (const bf16*)(C.ws + WS_YL); const bf16* qt = (const bf16*)(C.dout + DO_QT); const float* s0 = (const float*)(C.ws + WS_S0);
    const bf16* r = (const bf16*)(C.ws + WS_R); const bf16* kraw = (const bf16*)(C.ws + WS_KRAW); const bf16* a = (const bf16*)(C.ws + WS_A); const float* k_a = C.ka->in[14]; const float* r_k = C.ka->in[15];
    const bf16* v = (const bf16*)(C.ws + WS_V); const bf16* gate = (const bf16*)(C.ws + WS_GATE); bf16* orw = (bf16*)(C.ws + WS_ORWKV); const float* lnw = C.ka->in[16]; const float* lnb = C.ka->in[17];
    for (int task = C.bid; task < 16 * NCK; task += C.nb) { const int h = task & 15, cf = task >> 4, cb = NCK - 1 - cf, c = h * 64 + lane;
        f32x4 sf[16], sb[16];
        { const f32x4* pf = (const f32x4*)(s0 + (((size_t)h * NCK + cf) * 64 + lane) * 64); const f32x4* pb = (const f32x4*)(s0 + (((size_t)(16 + h) * NCK + cb) * 64 + lane) * 64);
#pragma unroll
          for (int q = 0; q < 16; ++q) { sf[q] = pf[q]; sb[q] = pb[q]; } }
        const float ka_ = k_a[c], rk_ = r_k[c], lw_ = lnw[c], lb_ = lnb[c];
        for (int tt = 0; tt < 32; ++tt) { const int t = cf * CHL + C.wave * 32 + tt; const size_t ix = (size_t)t * RW + c, ixb = ((size_t)S + t) * RW + c;
            const float qf = bf2f(qt[ix]), qb = bf2f(qt[ixb]);
            float y0 = bf2f(yl[ix]), y1 = bf2f(yl[ixb]);
#pragma unroll
            for (int q = 0; q < 16; ++q)
#pragma unroll
                for (int e = 0; e < 4; ++e) { y0 += sf[q][e] * rdlane(qf, 4 * q + e); y1 += sb[q][e] * rdlane(qb, 4 * q + e); }
            const float y = y0 + y1;
            const float mu = wave_sum(y) * (1.0f / 64.f); const float dv = y - mu; const float var = wave_sum(dv * dv) * (1.0f / 64.f);
            const float gn = dv * (1.0f / sqrtf(var + 64e-5f)) * lw_ + lb_;
            const float kd2 = (1.0f + (bf2f(a[ix]) - 1.0f) * ka_) + (1.0f + (bf2f(a[ixb]) - 1.0f) * ka_);
            const float bonus = wave_sum(bf2f(r[ix]) * bf2f(kraw[ix]) * kd2 * rk_) * bf2f(v[ix]);
            orw[ix] = f2bf((gn + bonus) * bf2f(gate[ix])); }
    }
}


#ifndef OPT_ATTN
#define OPT_ATTN 1
#endif
typedef float f32x16 __attribute__((ext_vector_type(16)));
constexpr size_t WS_OG = 442 * MiB, WS_LSE = 490 * MiB;
constexpr int AT_VTS = 388;
__device__ __forceinline__ void ph_attn2(Ctx& C) {
    const int lane = lane_now(), wave = C.wave, tid = wave * 64 + lane, r31 = lane & 31, hh = lane >> 5;
    const bf16* z = (const bf16*)(C.ws + WS_ZQKV); bf16* og = (bf16*)(C.ws + WS_OG); float* lse_o = (float*)(C.ws + WS_LSE);
    LAS bf16* vt = (LAS bf16*)C.lds; LAS bf16* kim = (LAS bf16*)(C.lds + 64 * AT_VTS * 2);
    for (int unit = C.bid; unit < 1536; unit += C.nb) {
        const int g = unit >> 9, rem = unit & 511, h = rem & 7, tile64 = rem >> 3;
        const int dsh = 2 * g, d = 1 << dsh, n = S >> dsh, res = tile64 & (d - 1), tl = tile64 >> dsh;
        const int kbase = tl * 256 - 64, colq = g * 512 + h * 64, colk = 1536 + colq, colv = 3072 + colq;
        const float slope_d = exp2f(-8.0f * (float)(g * 8 + h + 1) / 24.0f) * (float)d;
#pragma unroll
        for (int i = 0; i < 6; ++i) { const int kc = (tid >> 3) + 64 * i, ch = tid & 7, ki = kbase + kc; u32x4 w = (u32x4){0u, 0u, 0u, 0u}, wk = (u32x4){0u, 0u, 0u, 0u};
            if (ki >= 0 && ki < n) { const bf16* rp = z + (size_t)((ki << dsh) + res) * NQKV + 8 * ch; w = *(const u32x4*)(rp + colv); wk = *(const u32x4*)(rp + colk); }
            *(LAS u32x4*)(kim + kc * 72 + 8 * ch) = wk;
            LAS bf16* dp = vt + (8 * ch) * AT_VTS + kc;
            dp[0] = (bf16)(w.x & 0xffff); dp[AT_VTS] = (bf16)(w.x >> 16); dp[2 * AT_VTS] = (bf16)(w.y & 0xffff); dp[3 * AT_VTS] = (bf16)(w.y >> 16);
            dp[4 * AT_VTS] = (bf16)(w.z & 0xffff); dp[5 * AT_VTS] = (bf16)(w.z >> 16); dp[6 * AT_VTS] = (bf16)(w.w & 0xffff); dp[7 * AT_VTS] = (bf16)(w.w >> 16); }
        __syncthreads();
        const int qb = tl * 256 + 32 * wave; const int qtok = ((qb + r31) << dsh) + res;
        bf16x8 qf[4];
#pragma unroll
        for (int ks = 0; ks < 4; ++ks) qf[ks] = *(const bf16x8*)(z + (size_t)qtok * NQKV + colq + 16 * ks + 8 * hh);
        f32x16 sacc[5];
#pragma unroll
        for (int kt = 0; kt < 5; ++kt) {
#pragma unroll
            for (int e = 0; e < 16; ++e) sacc[kt][e] = 0.f;
            const LAS bf16* kp = kim + (32 * wave + 32 * kt + r31) * 72 + 8 * hh;
#pragma unroll
            for (int ks = 0; ks < 4; ++ks) { const bf16x8 kf = *(const LAS bf16x8*)(kp + 16 * ks); sacc[kt] = __builtin_amdgcn_mfma_f32_32x32x16_bf16(kf, qf[ks], sacc[kt], 0, 0, 0); } }
        const float LOG2E = 1.44269504f, slope2 = slope_d * LOG2E, c0f = (float)(4 * hh - 64 - r31);
        const bool edge = (tl == 0) || (tl == (n >> 8) - 1);
        float m = -3.0e38f;
#pragma unroll
        for (int kt = 0; kt < 5; ++kt)
#pragma unroll
            for (int e = 0; e < 16; ++e) { const float relf = (float)(32 * kt + (e & 3) + 8 * (e >> 2)) + c0f; float sc = sacc[kt][e] * LOG2E - slope2 * __builtin_fabsf(relf);
                if (kt == 0) sc = relf >= -64.0f ? sc : -1e30f;
                if (kt == 4) sc = relf <= 64.0f ? sc : -1e30f;
                sacc[kt][e] = sc; }
        if (edge) {
#pragma unroll
            for (int kt = 0; kt < 5; ++kt)
#pragma unroll
                for (int e = 0; e < 16; ++e) { const int kidx = qb - 64 + 32 * kt + (e & 3) + 8 * (e >> 2) + 4 * hh; sacc[kt][e] = (kidx >= 0 && kidx < n) ? sacc[kt][e] : -1e30f; } }
#pragma unroll
        for (int kt = 0; kt < 5; ++kt)
#pragma unroll
            for (int e = 0; e < 16; ++e) m = fmaxf(m, sacc[kt][e]);
        { const auto rr = __builtin_amdgcn_permlane32_swap(__float_as_uint(m), __float_as_uint(m), false, false); m = fmaxf(__uint_as_float(rr[0]), __uint_as_float(rr[1])); }
        float den = 0.f;
#pragma unroll
        for (int kt = 0; kt < 5; ++kt)
#pragma unroll
            for (int e = 0; e < 16; ++e) { const float pv = __builtin_amdgcn_exp2f(sacc[kt][e] - m); sacc[kt][e] = pv; den += pv; }
        { const auto rr = __builtin_amdgcn_permlane32_swap(__float_as_uint(den), __float_as_uint(den), false, false); den = __uint_as_float(rr[0]) + __uint_as_float(rr[1]); }
        f32x16 oacc[2];
#pragma unroll
        for (int dt = 0; dt < 2; ++dt)
#pragma unroll
            for (int e = 0; e < 16; ++e) oacc[dt][e] = 0.f;
#pragma unroll
        for (int kt = 0; kt < 5; ++kt)
#pragma unroll
            for (int sI = 0; sI < 2; ++sI) { const bf16x8 bfrag = pack8s(sacc[kt][8 * sI], sacc[kt][8 * sI + 1], sacc[kt][8 * sI + 2], sacc[kt][8 * sI + 3], sacc[kt][8 * sI + 4], sacc[kt][8 * sI + 5], sacc[kt][8 * sI + 6], sacc[kt][8 * sI + 7]);
#pragma unroll
                for (int dt = 0; dt < 2; ++dt) { const LAS bf16* vp = vt + (32 * dt + r31) * AT_VTS + 32 * wave + 32 * kt + 16 * sI + 4 * hh;
                    const u32x2 lo = *(const LAS u32x2*)vp, hi = *(const LAS u32x2*)(vp + 8); u32x4 pa; pa.x = lo.x; pa.y = lo.y; pa.z = hi.x; pa.w = hi.y;
                    oacc[dt] = __builtin_amdgcn_mfma_f32_32x32x16_bf16(__builtin_bit_cast(bf16x8, pa), bfrag, oacc[dt], 0, 0, 0); } }
        const float rden = 1.0f / den; bf16* op = og + ((size_t)g * S + qtok) * 512 + h * 64 + 4 * hh;
#pragma unroll
        for (int dt = 0; dt < 2; ++dt)
#pragma unroll
            for (int gr = 0; gr < 4; ++gr) { u32x2 o; o.x = pg8c(oacc[dt][4 * gr] * rden, oacc[dt][4 * gr + 1] * rden); o.y = pg8c(oacc[dt][4 * gr + 2] * rden, oacc[dt][4 * gr + 3] * rden); *(u32x2*)(op + 32 * dt + 8 * gr) = o; }
        if (hh == 0) lse_o[((size_t)g * S + qtok) * 8 + h] = (m + __builtin_amdgcn_logf(den)) * 0.69314718f;
        __syncthreads();
    }
}
__device__ __forceinline__ void ph_attn_combine(Ctx& C) {
    const int lane = lane_now(); const bf16* og = (const bf16*)(C.ws + WS_OG); const float* lse = (const float*)(C.ws + WS_LSE); bf16* oa = (bf16*)(C.ws + WS_OATT);
    const int ntask = S * 64;
    for (int task = (C.bid * NWAVES + C.wave) * 64 + lane; task < ntask; task += C.nb * NTHR) { const int t = task >> 6, c8 = task & 63, h = c8 >> 3;
        const float l0 = lse[(size_t)t * 8 + h], l1 = lse[((size_t)S + t) * 8 + h], l2 = lse[((size_t)2 * S + t) * 8 + h]; const float mx = fmaxf(l0, fmaxf(l1, l2));
        const float w0 = __expf(l0 - mx), w1 = __expf(l1 - mx), w2 = __expf(l2 - mx), rs = 1.0f / (w0 + w1 + w2);
        float a0[8], a1[8], a2[8]; unpack8(*(const u32x4*)(og + (size_t)t * 512 + 8 * c8), a0); unpack8(*(const u32x4*)(og + ((size_t)S + t) * 512 + 8 * c8), a1); unpack8(*(const u32x4*)(og + ((size_t)2 * S + t) * 512 + 8 * c8), a2);
        f32x4 o0, o1;
#pragma unroll
        for (int e = 0; e < 4; ++e) { o0[e] = (w0 * a0[e] + w1 * a1[e] + w2 * a2[e]) * rs; o1[e] = (w0 * a0[4 + e] + w1 * a1[4 + e] + w2 * a2[4 + e]) * rs; }
        *(u32x4*)(oa + (size_t)t * 512 + 8 * c8) = pack8(o0, o1); }
}


__device__ __forceinline__ bf16x8 cvt8(const f32x4 a, const f32x4 b) { u32x4 w; w.x = pk2(a[0], a[1]); w.y = pk2(a[2], a[3]); w.z = pk2(b[0], b[1]); w.w = pk2(b[2], b[3]); return __builtin_bit_cast(bf16x8, w); }
__device__ __forceinline__ void unpack4(u32x2 w, float (&f)[4]) { f[0] = __uint_as_float(w.x << 16); f[1] = __uint_as_float(w.x & 0xffff0000u); f[2] = __uint_as_float(w.y << 16); f[3] = __uint_as_float(w.y & 0xffff0000u); }
__device__ __forceinline__ void ph_fin3(Ctx& C) {
    const int lane = lane_now(), r31 = lane & 31, hh = lane >> 5;
    const bf16* yl = (const bf16*)(C.ws + WS_YL); const bf16* qt = (const bf16*)(C.dout + DO_QT); const float* s0 = (const float*)(C.ws + WS_S0);
    const bf16* r = (const bf16*)(C.ws + WS_R); const bf16* kraw = (const bf16*)(C.ws + WS_KRAW); const bf16* a = (const bf16*)(C.ws + WS_A); const float* k_a = C.ka->in[14]; const float* r_k = C.ka->in[15];
    const bf16* v = (const bf16*)(C.ws + WS_V); const bf16* gate = (const bf16*)(C.ws + WS_GATE); bf16* orw = (bf16*)(C.ws + WS_ORWKV); const float* lnw = C.ka->in[16]; const float* lnb = C.ka->in[17];
    for (int task = C.bid; task < 16 * NCK; task += C.nb) { const int h = task & 15, cf = task >> 4, cb = NCK - 1 - cf;
        const int t = cf * CHL + C.wave * 32 + r31; const size_t rowf = (size_t)t * RW + h * 64, rowb = ((size_t)S + t) * RW + h * 64;
        f32x16 acc[2];
#pragma unroll
        for (int vt = 0; vt < 2; ++vt)
#pragma unroll
            for (int e = 0; e < 16; ++e) acc[vt][e] = 0.f;
#pragma unroll
        for (int z = 0; z < 2; ++z) { const float* sp = s0 + (((size_t)(z * 16 + h) * NCK + (z ? cb : cf)) * 64 + r31) * 64 + 8 * hh; const bf16* qp = qt + (z ? rowb : rowf) + 8 * hh;
#pragma unroll
            for (int ks = 0; ks < 4; ++ks) { const bf16x8 bq = *(const bf16x8*)(qp + 16 * ks);
#pragma unroll
                for (int vt = 0; vt < 2; ++vt) { const f32x4* ap = (const f32x4*)(sp + (size_t)vt * 32 * 64 + 16 * ks); acc[vt] = __builtin_amdgcn_mfma_f32_32x32x16_bf16(cvt8(ap[0], ap[1]), bq, acc[vt], 0, 0, 0); } } }
        float ssum = 0.f, bsum = 0.f;
#pragma unroll
        for (int vt = 0; vt < 2; ++vt)
#pragma unroll
            for (int gr = 0; gr < 4; ++gr) { const int co = 32 * vt + 8 * gr + 4 * hh; float f0[4], f1[4], fr_[4], fk[4], fa0[4], fa1[4];
                unpack4(*(const u32x2*)(yl + rowf + co), f0); unpack4(*(const u32x2*)(yl + rowb + co), f1); unpack4(*(const u32x2*)(r + rowf + co), fr_); unpack4(*(const u32x2*)(kraw + rowf + co), fk);
                unpack4(*(const u32x2*)(a + rowf + co), fa0); unpack4(*(const u32x2*)(a + rowb + co), fa1);
                const f32x4 ka4 = *(const f32x4*)(k_a + h * 64 + co), rk4 = *(const f32x4*)(r_k + h * 64 + co);
#pragma unroll
                for (int e = 0; e < 4; ++e) { const float y = acc[vt][4 * gr + e] + f0[e] + f1[e]; acc[vt][4 * gr + e] = y; ssum += y;
                    bsum += fr_[e] * fk[e] * ((1.0f + (fa0[e] - 1.0f) * ka4[e]) + (1.0f + (fa1[e] - 1.0f) * ka4[e])) * rk4[e]; } }
        ssum += __shfl_xor(ssum, 32); bsum += __shfl_xor(bsum, 32);
        const float mu = ssum * (1.0f / 64.f); float vs = 0.f;
#pragma unroll
        for (int vt = 0; vt < 2; ++vt)
#pragma unroll
            for (int e = 0; e < 16; ++e) { const float dv = acc[vt][e] - mu; acc[vt][e] = dv; vs += dv * dv; }
        vs += __shfl_xor(vs, 32);
        const float rstd = 1.0f / sqrtf(vs * (1.0f / 64.f) + 64e-5f);
#pragma unroll
        for (int vt = 0; vt < 2; ++vt)
#pragma unroll
            for (int gr = 0; gr < 4; ++gr) { const int co = 32 * vt + 8 * gr + 4 * hh; float fv[4], fg[4]; unpack4(*(const u32x2*)(v + rowf + co), fv); unpack4(*(const u32x2*)(gate + rowf + co), fg);
                const f32x4 w4 = *(const f32x4*)(lnw + h * 64 + co), b4 = *(const f32x4*)(lnb + h * 64 + co); float o[4];
#pragma unroll
                for (int e = 0; e < 4; ++e) o[e] = (acc[vt][4 * gr + e] * rstd * w4[e] + b4[e] + bsum * fv[e]) * fg[e];
                u32x2 w; w.x = pk2(o[0], o[1]); w.y = pk2(o[2], o[3]); *(u32x2*)(orw + rowf + co) = w; }
    }
}
template <int CTRL> __device__ __forceinline__ float dpp_row(float x) { return __int_as_float(__builtin_amdgcn_update_dpp(0, __float_as_int(x), CTRL, 0xf, 0xf, true)); }
__device__ __forceinline__ void ph_rprep2(Ctx& C) {
    const int lane = lane_now();
    const bf16* zr = (const bf16*)(C.ws + WS_ZR); const float* mup = C.ka->in[6]; const float* mun = C.ka->in[7]; const float* k_k = C.ka->in[13];
    bf16* r = (bf16*)(C.ws + WS_R); bf16* v = (bf16*)(C.ws + WS_V); bf16* nkk = (bf16*)(C.ws + WS_NKK); bf16* kraw = (bf16*)(C.ws + WS_KRAW); bf16* la = (bf16*)(C.ws + WS_LORAA);
    const int ntask = 6 * (S / 64) + (S / 32);
    for (int task = C.gw; task < ntask; task += C.ngw) { const bool heavy = task >= 6 * (S / 64); const int cgp = heavy ? 6 : task % 6, ntok = heavy ? 32 : 64, t0 = heavy ? (task - 6 * (S / 64)) * 32 : (task / 6) * 64, col = cgp * 512 + lane * 8;
        const bool real = col < NZR_REAL; const int kind = col < 1024 ? 0 : col < 2048 ? 1 : col < 3072 ? 2 : col < 3136 ? 3 : col < 3200 ? 4 : col < 3360 ? 5 : 6;
        float mp[8], mn[8], kk8[8];
#pragma unroll
        for (int e = 0; e < 8; ++e) { mp[e] = real ? mup[col + e] : 0.f; mn[e] = real ? mun[col + e] : 0.f; kk8[e] = kind == 1 ? k_k[col - 1024 + e] : 0.f; }
        float zp[8], zc[8], zn[8];
        if (t0 > 0) unpack8(*(const u32x4*)(zr + (size_t)(t0 - 1) * NZR + col), zp); else {
#pragma unroll
            for (int e = 0; e < 8; ++e) zp[e] = 0.f; }
        unpack8(*(const u32x4*)(zr + (size_t)t0 * NZR + col), zc);
        u32x4 rawn[8];
#define RP_LOAD8(tb_) do { _Pragma("unroll") for (int j_ = 0; j_ < 8; ++j_) { const int tr_ = (tb_) + 1 + j_; const u32x4 w_ = *(const u32x4*)(zr + (size_t)(tr_ < S ? tr_ : S - 1) * NZR + col); rawn[j_] = tr_ < S ? w_ : (u32x4){0u, 0u, 0u, 0u}; } } while (0)
#pragma unroll 1
        for (int i0 = 0; i0 < ntok; i0 += 8) { u32x4 rawc[8];
            RP_LOAD8(t0 + i0);
#pragma unroll
            for (int j = 0; j < 8; ++j) asm volatile("" : "+v"(rawn[j]));
#pragma unroll
            for (int j = 0; j < 8; ++j) rawc[j] = rawn[j];
#pragma unroll
          for (int j = 0; j < 8; ++j) { const int t = t0 + i0 + j;
            unpack8(rawc[j], zn);
            float x[8];
#pragma unroll
            for (int e = 0; e < 8; ++e) x[e] = zc[e] + mp[e] * (zp[e] - zc[e]) + mn[e] * (zn[e] - zc[e]);
            if (kind == 0) *(u32x4*)(r + (size_t)t * RW + col) = pack8((f32x4){x[0], x[1], x[2], x[3]}, (f32x4){x[4], x[5], x[6], x[7]});
            else if (kind == 1) { *(u32x4*)(kraw + (size_t)t * RW + col - 1024) = pack8((f32x4){x[0], x[1], x[2], x[3]}, (f32x4){x[4], x[5], x[6], x[7]});
                float kv[8], ss = 0.f;
#pragma unroll
                for (int e = 0; e < 8; ++e) { kv[e] = x[e] * kk8[e]; ss += kv[e] * kv[e]; }
                ss += dpp_row<0xB1>(ss); ss += dpp_row<0x4E>(ss); ss += dpp_row<0x141>(ss);
                const float sc = -1.0f / fmaxf(sqrtf(ss), 1e-12f);
                *(u32x4*)(nkk + (size_t)t * RW + col - 1024) = pack8((f32x4){kv[0] * sc, kv[1] * sc, kv[2] * sc, kv[3] * sc}, (f32x4){kv[4] * sc, kv[5] * sc, kv[6] * sc, kv[7] * sc}); }
            else if (kind == 2) *(u32x4*)(v + (size_t)t * RW + col - 2048) = pack8((f32x4){x[0], x[1], x[2], x[3]}, (f32x4){x[4], x[5], x[6], x[7]});
            else { float o[8];
#pragma unroll
                for (int e = 0; e < 8; ++e) { const float sg = __builtin_amdgcn_rcpf(1.0f + __builtin_amdgcn_exp2f(x[e] * (kind == 3 ? -2.88539008f : -1.44269504f)));
                    o[e] = kind == 3 ? 2.0f * sg - 1.0f : kind == 4 ? x[e] : kind == 5 ? sg : 0.f; }
                bf16* lp = kind <= 4 ? la + (size_t)t * KL2 + (col - 3072) : kind == 5 ? la + (size_t)(S + t) * KL2 + (col - 3200) : col < 3488 ? la + (size_t)t * KL2 + 128 + (col - 3360) : la + (size_t)(S + t) * KL2 + 160 + (col - 3488);
                *(u32x4*)lp = pack8((f32x4){o[0], o[1], o[2], o[3]}, (f32x4){o[4], o[5], o[6], o[7]}); }
#pragma unroll
            for (int e = 0; e < 8; ++e) { zp[e] = zc[e]; zc[e] = zn[e]; }
          }
        }
#undef RP_LOAD8
    }
}


constexpr int F4_S0STR = 72, F4_TSTR = 68;
__device__ __forceinline__ void ph_fin4(Ctx& C) {
    const int lane0 = lane_now(), wave = C.wave;
    const bf16* yl = (const bf16*)(C.ws + WS_YL); const bf16* qt = (const bf16*)(C.dout + DO_QT); const float* s0 = (const float*)(C.ws + WS_S0);
    const bf16* r = (const bf16*)(C.ws + WS_R); const bf16* kraw = (const bf16*)(C.ws + WS_KRAW); const bf16* a = (const bf16*)(C.ws + WS_A); const float* k_a = C.ka->in[14]; const float* r_k = C.ka->in[15];
    const bf16* v = (const bf16*)(C.ws + WS_V); const bf16* gate = (const bf16*)(C.ws + WS_GATE); bf16* orw = (bf16*)(C.ws + WS_ORWKV); const float* lnw = C.ka->in[16]; const float* lnb = C.ka->in[17];
    LAS bf16* s0img = (LAS bf16*)C.lds;
    LAS bf16* tr = (LAS bf16*)(C.lds + 2 * 64 * F4_S0STR * 2) + C.wave * (32 * F4_TSTR);
    for (int task = C.bid; task < 16 * NCK; task += C.nb) { const int h = task & 15, cf = task >> 4, cb = NCK - 1 - cf;
        int lane = lane0; asm volatile("" : "+v"(lane));
        const int r31 = lane & 31, hh = lane >> 5, tid = wave * 64 + lane;
#define F4_GLOAD(g, gptr) do { _Pragma("unroll") for (int i_ = 0; i_ < 4; ++i_) g[i_] = *(const u32x4*)((gptr) + (size_t)((lane >> 3) + 8 * i_) * RW + 8 * (lane & 7)); } while (0)
#define F4_XPOSE(dst, g) do { _Pragma("unroll") for (int i_ = 0; i_ < 4; ++i_) { LAS u32x2* d_ = (LAS u32x2*)(tr + ((lane >> 3) + 8 * i_) * F4_TSTR + 8 * (lane & 7)); d_[0] = (u32x2){g[i_].x, g[i_].y}; d_[1] = (u32x2){g[i_].z, g[i_].w}; } \
            asm volatile("s_waitcnt lgkmcnt(0)" ::: "memory"); \
            _Pragma("unroll") for (int vt_ = 0; vt_ < 2; ++vt_) _Pragma("unroll") for (int gr_ = 0; gr_ < 4; ++gr_) dst[vt_][gr_] = *(const LAS u32x2*)(tr + r31 * F4_TSTR + 32 * vt_ + 8 * gr_ + 4 * hh); \
            asm volatile("s_waitcnt lgkmcnt(0)" ::: "memory"); } while (0)
        __syncthreads();
        { const int z = tid >> 8, row = (tid >> 2) & 63, seg = tid & 3; const float* sp = s0 + (((size_t)(z * 16 + h) * NCK + (z ? cb : cf)) * 64 + row) * 64 + 16 * seg;
          const f32x4 x0 = *(const f32x4*)sp, x1 = *(const f32x4*)(sp + 4), x2 = *(const f32x4*)(sp + 8), x3 = *(const f32x4*)(sp + 12);
          LAS u32x4* dp = (LAS u32x4*)(s0img + (z * 64 + row) * F4_S0STR + 16 * seg); dp[0] = pack8(x0, x1); dp[1] = pack8(x2, x3); }
        __syncthreads();
#pragma unroll 1
        for (int hv = 0; hv < CHL / 256; ++hv) {
        const size_t base_f = (size_t)(cf * CHL + hv * 256 + wave * 32) * RW + h * 64, base_b = base_f + (size_t)S * RW;
        u32x4 g0[4], g1[4], g2[4], g3[4];
        F4_GLOAD(g0, yl + base_f); F4_GLOAD(g1, yl + base_b); F4_GLOAD(g2, r + base_f); F4_GLOAD(g3, kraw + base_f);
        const int t0 = cf * CHL + hv * 256 + wave * 32, t = t0 + r31; const size_t rowf = (size_t)t * RW + h * 64, rowb = ((size_t)S + t) * RW + h * 64;
        f32x16 acc[2];
#pragma unroll
        for (int vt = 0; vt < 2; ++vt)
#pragma unroll
            for (int e = 0; e < 16; ++e) acc[vt][e] = 0.f;
#pragma unroll
        for (int z = 0; z < 2; ++z) { const bf16* qp = qt + (z ? rowb : rowf) + 8 * hh;
#pragma unroll
            for (int ks = 0; ks < 4; ++ks) { const bf16x8 bq = *(const bf16x8*)(qp + 16 * ks);
#pragma unroll
                for (int vt = 0; vt < 2; ++vt) { const bf16x8 af = *(const LAS bf16x8*)(s0img + (z * 64 + 32 * vt + r31) * F4_S0STR + 16 * ks + 8 * hh); acc[vt] = __builtin_amdgcn_mfma_f32_32x32x16_bf16(af, bq, acc[vt], 0, 0, 0); } } }
        u32x2 q0[2][4], q1[2][4];
        float ssum = 0.f, bsum = 0.f;
        F4_XPOSE(q0, g0); F4_XPOSE(q1, g1);
        F4_GLOAD(g0, a + base_f); F4_GLOAD(g1, a + base_b);
#pragma unroll
        for (int vt = 0; vt < 2; ++vt)
#pragma unroll
            for (int gr = 0; gr < 4; ++gr) { float f0[4], f1[4]; unpack4(q0[vt][gr], f0); unpack4(q1[vt][gr], f1);
#pragma unroll
                for (int e = 0; e < 4; ++e) { const float y = acc[vt][4 * gr + e] + f0[e] + f1[e]; acc[vt][4 * gr + e] = y; ssum += y; } }
        { u32x2 q2[2][4], q3[2][4];
          F4_XPOSE(q0, g2); F4_XPOSE(q1, g3);
          F4_GLOAD(g2, v + base_f); F4_GLOAD(g3, gate + base_f);
          F4_XPOSE(q2, g0); F4_XPOSE(q3, g1);
#pragma unroll
          for (int vt = 0; vt < 2; ++vt)
#pragma unroll
              for (int gr = 0; gr < 4; ++gr) { const int co = 32 * vt + 8 * gr + 4 * hh; float fr_[4], fk[4], fa0[4], fa1[4]; unpack4(q0[vt][gr], fr_); unpack4(q1[vt][gr], fk); unpack4(q2[vt][gr], fa0); unpack4(q3[vt][gr], fa1);
                  const f32x4 ka4 = *(const f32x4*)(k_a + h * 64 + co), rk4 = *(const f32x4*)(r_k + h * 64 + co);
#pragma unroll
                  for (int e = 0; e < 4; ++e) bsum += fr_[e] * fk[e] * ((1.0f + (fa0[e] - 1.0f) * ka4[e]) + (1.0f + (fa1[e] - 1.0f) * ka4[e])) * rk4[e]; } }
        ssum += __shfl_xor(ssum, 32); bsum += __shfl_xor(bsum, 32);
        const float mu = ssum * (1.0f / 64.f); float vs = 0.f;
#pragma unroll
        for (int vt = 0; vt < 2; ++vt)
#pragma unroll
            for (int e = 0; e < 16; ++e) { const float dv = acc[vt][e] - mu; acc[vt][e] = dv; vs += dv * dv; }
        vs += __shfl_xor(vs, 32);
        const float rstd = 1.0f / sqrtf(vs * (1.0f / 64.f) + 64e-5f);
        F4_XPOSE(q0, g2); F4_XPOSE(q1, g3);
#pragma unroll
        for (int vt = 0; vt < 2; ++vt)
#pragma unroll
            for (int gr = 0; gr < 4; ++gr) { const int co = 32 * vt + 8 * gr + 4 * hh; float fv[4], fg[4]; unpack4(q0[vt][gr], fv); unpack4(q1[vt][gr], fg);
                const f32x4 w4 = *(const f32x4*)(lnw + h * 64 + co), b4 = *(const f32x4*)(lnb + h * 64 + co); float o[4];
#pragma unroll
                for (int e = 0; e < 4; ++e) o[e] = (acc[vt][4 * gr + e] * rstd * w4[e] + b4[e] + bsum * fv[e]) * fg[e];
                u32x2 w; w.x = pk2(o[0], o[1]); w.y = pk2(o[2], o[3]); *(LAS u32x2*)(tr + r31 * F4_TSTR + co) = w; }
        asm volatile("s_waitcnt lgkmcnt(0)" ::: "memory");
#pragma unroll
        for (int i = 0; i < 4; ++i) { const int tk = (lane >> 3) + 8 * i; const LAS u32x2* s_ = (const LAS u32x2*)(tr + tk * F4_TSTR + 8 * (lane & 7)); const u32x2 lo_ = s_[0], hi_ = s_[1]; *(u32x4*)(orw + base_f + (size_t)tk * RW + 8 * (lane & 7)) = (u32x4){lo_.x, lo_.y, hi_.x, hi_.y}; }
        asm volatile("s_waitcnt lgkmcnt(0)" ::: "memory");
        }
#undef F4_GLOAD
#undef F4_XPOSE
    }
}


constexpr int SM_KR = 0, SM_BK = 4608, SM_BGT = 9216, SM_GT = 14336, SM_VT = 14592, SM_WAVE = 17664;
template <int role> __device__ __forceinline__ void ph_scan1m_r(Ctx& C) {
    const int lane0 = lane_now(), wave = C.wave, itl = wave & 3;
    const bf16* g_r = (const bf16*)(C.ws + WS_R); const bf16* g_v = (const bf16*)(C.ws + WS_V); const bf16* g_nkk = (const bf16*)(C.ws + WS_NKK); const bf16* g_k = (const bf16*)(C.ws + WS_KRAW);
    const bf16* g_lw = (const bf16*)(C.ws + WS_LW); const bf16* g_a = (const bf16*)(C.ws + WS_A); const float* k_a = C.ka->in[14];
    bf16* g_out = role ? (bf16*)(C.ws + WS_YL) : (bf16*)(C.dout + DO_QT); float* g_pu = (float*)(C.ws + WS_PU);
    LAS unsigned char* L = C.lds + wave * SM_WAVE;
    LAS bf16* imKR = (LAS bf16*)(L + SM_KR); LAS bf16* imBK = (LAS bf16*)(L + SM_BK); LAS bf16* imBGT = (LAS bf16*)(L + SM_BGT); LAS float* gT = (LAS float*)(L + SM_GT); LAS bf16* imVT = (LAS bf16*)(L + SM_VT);
    LAS float* MT = (LAS float*)(L + SM_BK);
    const int nitems = NCHAIN * NCK;
    for (int base = C.bid * 4; base < nitems; base += C.nb * 4) {
        const int item = base + itl; if (item >= nitems) continue;
        const int chain = item / NCK, chunk = item % NCK, z = chain >> 4, h = chain & 15; const size_t zoff = (size_t)z * S * RW; const float ka = k_a[h * 64 + lane0];
        f32x16 st[2][2];
        { int lane_s = lane0; asm volatile("" : "+v"(lane_s)); const int r31s = lane_s & 31, hhs = lane_s >> 5;
#pragma unroll
        for (int kt = 0; kt < 2; ++kt)
#pragma unroll
            for (int ct = 0; ct < 2; ++ct)
#pragma unroll
                for (int e = 0; e < 16; ++e) st[kt][ct][e] = (role == 0 && (32 * kt + (e & 3) + 8 * (e >> 2) + 4 * hhs) == (32 * ct + r31s)) ? 1.f : 0.f; }
        unsigned rl[8], rn[8], ra[8], rk[8], rr_[8], rv[8];
#define RAWF(a, t) __uint_as_float(((t) & 1) ? ((a)[(t) >> 1] & 0xffff0000u) : ((a)[(t) >> 1] << 16))
#define SM_LOADRAW(sbn) do { const int sg_ = chunk * CHL + (sbn) * 16; const long tk_ = z ? (long)S - 1 - sg_ : sg_; const long dx_ = z ? -(long)RW : (long)RW; const size_t ru_ = (size_t)tk_ * RW + h * 64; \
            int ln_ = lane0; asm volatile("" : "+v"(ln_)); \
            _Pragma("unroll") for (int t_ = 0; t_ < 16; t_ += 2) { const long o_ = t_ * dx_, o1_ = o_ + dx_; const int j_ = t_ >> 1; \
                rl[j_] = (unsigned)(g_lw + zoff + ru_ + o_)[ln_] | ((unsigned)(g_lw + zoff + ru_ + o1_)[ln_] << 16); rn[j_] = (unsigned)(g_nkk + ru_ + o_)[ln_] | ((unsigned)(g_nkk + ru_ + o1_)[ln_] << 16); \
                ra[j_] = (unsigned)(g_a + zoff + ru_ + o_)[ln_] | ((unsigned)(g_a + zoff + ru_ + o1_)[ln_] << 16); rk[j_] = (unsigned)(g_k + ru_ + o_)[ln_] | ((unsigned)(g_k + ru_ + o1_)[ln_] << 16); \
                rr_[j_] = (unsigned)(g_r + ru_ + o_)[ln_] | ((unsigned)(g_r + ru_ + o1_)[ln_] << 16); if (role) rv[j_] = (unsigned)(g_v + ru_ + o_)[ln_] | ((unsigned)(g_v + ru_ + o1_)[ln_] << 16); } } while (0)
        SM_LOADRAW(0);
#pragma unroll 1
        for (int sb = 0; sb < CHL / 16; ++sb) {
            const int sg0 = chunk * CHL + sb * 16; const long tk0 = z ? (long)S - 1 - sg0 : sg0; const long dtk = z ? -1 : 1;
            int lane_i = lane0; asm volatile("" : "+v"(lane_i));
            const int lane = lane_i, r31 = lane_i & 31, hh = lane_i >> 5, r31g = r31;
            const long dix = dtk * RW;
            const size_t rowu = (size_t)tk0 * RW + h * 64;
            float Lc[16]; { float acc = 0.f;
#pragma unroll
              for (int t = 0; t < 16; ++t) { acc += RAWF(rl, t); Lc[t] = acc; } }
            const float GT_ = __expf(Lc[15]);
            gT[lane] = GT_;
            u32x4 bg[2], kg[2], vr[2];
            { LAS bf16* wKR = imKR + lane; LAS bf16* wBK = imBK + lane;
#pragma unroll
              for (int t = 0; t < 16; t += 2) { float kkh[2], rh[2], bt[2], kt_[2], bgf[2], kgf[2];
#pragma unroll
                for (int d = 0; d < 2; ++d) { const int tt = t + d;
                    const float nk = RAWF(rn, tt), a_ = RAWF(ra, tt), kr = RAWF(rk, tt), rr = RAWF(rr_, tt);
                    const float eL = __expf(Lc[tt]), eLm = tt ? __expf(Lc[tt - 1]) : 1.0f, ie = __builtin_amdgcn_rcpf(eL);
                    const float b_ = -nk * a_, kd = kr * (1.0f + (a_ - 1.0f) * ka);
                    kkh[d] = nk * eLm; rh[d] = rr * eL; bt[d] = b_ * ie; kt_[d] = kd * ie; bgf[d] = bt[d] * GT_; kgf[d] = kt_[d] * GT_; }
                const unsigned p0 = pg8::cvt_pk_bf16(kkh[0], kkh[1]), p1 = pg8::cvt_pk_bf16(rh[0], rh[1]), p2 = pg8::cvt_pk_bf16(bt[0], bt[1]), p3 = pg8::cvt_pk_bf16(kt_[0], kt_[1]);
                wKR[t * 72] = (bf16)p0; wKR[(t + 1) * 72] = (bf16)(p0 >> 16); wKR[(16 + t) * 72] = (bf16)p1; wKR[(17 + t) * 72] = (bf16)(p1 >> 16);
                wBK[t * 72] = (bf16)p2; wBK[(t + 1) * 72] = (bf16)(p2 >> 16); wBK[(16 + t) * 72] = (bf16)p3; wBK[(17 + t) * 72] = (bf16)(p3 >> 16);
                bg[t >> 3][(t >> 1) & 3] = pg8::cvt_pk_bf16(bgf[0], bgf[1]); kg[t >> 3][(t >> 1) & 3] = pg8::cvt_pk_bf16(kgf[0], kgf[1]);
                if (role) vr[t >> 3][(t >> 1) & 3] = rv[t >> 1]; } }
            { LAS u32x4* d = (LAS u32x4*)(imBGT + lane * 40); d[0] = bg[0]; d[1] = bg[1]; d[2] = kg[0]; d[3] = kg[1]; }
            if (role) { LAS u32x4* d = (LAS u32x4*)(imVT + lane * 24); d[0] = vr[0]; d[1] = vr[1]; }
            asm volatile("s_waitcnt lgkmcnt(0)" ::: "memory");
            __builtin_amdgcn_sched_barrier(0);
            { f32x16 m;
#pragma unroll
              for (int e = 0; e < 16; ++e) m[e] = 0.f;
#pragma unroll
              for (int ks = 0; ks < 4; ++ks) { const bf16x8 af = *(const LAS bf16x8*)(imBK + r31 * 72 + 16 * ks + 8 * hh), bfr = *(const LAS bf16x8*)(imKR + r31 * 72 + 16 * ks + 8 * hh); m = __builtin_amdgcn_mfma_f32_32x32x16_bf16(af, bfr, m, 0, 0, 0); }
              asm volatile("s_waitcnt lgkmcnt(0)" ::: "memory");
              const int tq = r31 & 15; const bool ycol = r31 >= 16;
#pragma unroll
              for (int g = 0; g < 4; ++g) { f32x4 o;
#pragma unroll
                  for (int e = 0; e < 4; ++e) { const int sp = 8 * g + 4 * hh + e, sq = sp & 15; const bool ok = ycol ? (sq <= tq) : (sq < tq); o[e] = ok ? m[4 * g + e] : 0.f; }
                  *(LAS f32x4*)(MT + r31 * 36 + 8 * g + 4 * hh) = o; } }
            asm volatile("s_waitcnt lgkmcnt(0)" ::: "memory");
            __builtin_amdgcn_sched_barrier(0);
            f32x16 ya[2];
#pragma unroll
            for (int ct = 0; ct < 2; ++ct)
#pragma unroll
                for (int e = 0; e < 16; ++e) ya[ct][e] = 0.f;
#pragma unroll
            for (int kt = 0; kt < 2; ++kt)
#pragma unroll
                for (int sI = 0; sI < 2; ++sI) { const LAS bf16* ap = imKR + r31 * 72 + 32 * kt + 16 * sI + 4 * hh; const u32x2 lo = *(const LAS u32x2*)ap, hi = *(const LAS u32x2*)(ap + 8);
                    u32x4 pa; pa.x = lo.x; pa.y = lo.y; pa.z = hi.x; pa.w = hi.y; const bf16x8 af = __builtin_bit_cast(bf16x8, pa);
#pragma unroll
                    for (int ct = 0; ct < 2; ++ct) { const f32x16& x = st[kt][ct];
                        const bf16x8 bfr = pack8s(x[8 * sI], x[8 * sI + 1], x[8 * sI + 2], x[8 * sI + 3], x[8 * sI + 4], x[8 * sI + 5], x[8 * sI + 6], x[8 * sI + 7]);
                        ya[ct] = __builtin_amdgcn_mfma_f32_32x32x16_bf16(af, bfr, ya[ct], 0, 0, 0); } }
            bf16x8 vfr[2];
            if (role) { const f32x4 m0 = *(const LAS f32x4*)(MT + r31 * 36 + 16 + 8 * hh), m1 = *(const LAS f32x4*)(MT + r31 * 36 + 20 + 8 * hh); const bf16x8 af = pack8s(m0[0], m0[1], m0[2], m0[3], m1[0], m1[1], m1[2], m1[3]);
#pragma unroll
                for (int ct = 0; ct < 2; ++ct) { vfr[ct] = *(const LAS bf16x8*)(imVT + (32 * ct + r31) * 24 + 8 * hh); ya[ct] = __builtin_amdgcn_mfma_f32_32x32x16_bf16(af, vfr[ct], ya[ct], 0, 0, 0); } }
            __builtin_amdgcn_sched_barrier(0);
            f32x2 u2[16];
#pragma unroll
            for (int e = 0; e < 4; ++e) {
                const auto a0 = __builtin_amdgcn_permlane32_swap(__float_as_uint(ya[0][e]), __float_as_uint(ya[0][e]), false, false), a1 = __builtin_amdgcn_permlane32_swap(__float_as_uint(ya[1][e]), __float_as_uint(ya[1][e]), false, false);
                const auto b0 = __builtin_amdgcn_permlane32_swap(__float_as_uint(ya[0][4 + e]), __float_as_uint(ya[0][4 + e]), false, false), b1 = __builtin_amdgcn_permlane32_swap(__float_as_uint(ya[1][4 + e]), __float_as_uint(ya[1][4 + e]), false, false);
                u2[e] = (f32x2){__uint_as_float(a0[0]), __uint_as_float(a1[0])}; u2[4 + e] = (f32x2){__uint_as_float(a0[1]), __uint_as_float(a1[1])};
                u2[8 + e] = (f32x2){__uint_as_float(b0[0]), __uint_as_float(b1[0])}; u2[12 + e] = (f32x2){__uint_as_float(b0[1]), __uint_as_float(b1[1])}; }
#pragma unroll
            for (int t = 1; t < 16; ++t) { f32x2 a = u2[t];
#pragma unroll
                for (int q = 0; q < (t + 3) / 4; ++q) { const f32x4 cf = *(const LAS f32x4*)(MT + t * 36 + 4 * q);
#pragma unroll
                    for (int e = 0; e < 4; ++e) if (4 * q + e < t) a += u2[4 * q + e] * cf[e]; }
                u2[t] = a; }
            bf16x8 ufr[2];
            ufr[0] = pack8s(hh ? u2[8].x : u2[0].x, hh ? u2[9].x : u2[1].x, hh ? u2[10].x : u2[2].x, hh ? u2[11].x : u2[3].x, hh ? u2[12].x : u2[4].x, hh ? u2[13].x : u2[5].x, hh ? u2[14].x : u2[6].x, hh ? u2[15].x : u2[7].x);
            ufr[1] = pack8s(hh ? u2[8].y : u2[0].y, hh ? u2[9].y : u2[1].y, hh ? u2[10].y : u2[2].y, hh ? u2[11].y : u2[3].y, hh ? u2[12].y : u2[4].y, hh ? u2[13].y : u2[5].y, hh ? u2[14].y : u2[6].y, hh ? u2[15].y : u2[7].y);
            __builtin_amdgcn_sched_barrier(0);
            { const f32x4 m0 = *(const LAS f32x4*)(MT + r31 * 36 + 8 * hh), m1 = *(const LAS f32x4*)(MT + r31 * 36 + 4 + 8 * hh); const bf16x8 af = pack8s(m0[0], m0[1], m0[2], m0[3], m1[0], m1[1], m1[2], m1[3]);
#pragma unroll
              for (int ct = 0; ct < 2; ++ct) ya[ct] = __builtin_amdgcn_mfma_f32_32x32x16_bf16(af, ufr[ct], ya[ct], 0, 0, 0); }
            { LAS bf16* ys = (LAS bf16*)MT;
#pragma unroll
              for (int ct = 0; ct < 2; ++ct)
#pragma unroll
                  for (int e = 0; e < 8; e += 2) { const unsigned pw = pg8::cvt_pk_bf16(ya[ct][8 + e], ya[ct][9 + e]); const int t = (e & 3) + 4 * hh + 8 * (e >> 2); LAS bf16* d = ys + t * 72 + 32 * ct + r31; d[0] = (bf16)pw; d[72] = (bf16)(pw >> 16); }
              asm volatile("s_waitcnt lgkmcnt(0)" ::: "memory");
#pragma unroll
              for (int i = 0; i < 2; ++i) { const int t = (lane >> 3) + 8 * i; const u32x4 w = *(const LAS u32x4*)(ys + t * 72 + 8 * (lane & 7)); *(u32x4*)(g_out + zoff + rowu + (long)t * dix + 8 * (lane & 7)) = w; }
              asm volatile("s_waitcnt lgkmcnt(0)" ::: "memory"); }
            __builtin_amdgcn_sched_barrier(0);
            if (sb + 1 < CHL / 16) SM_LOADRAW(sb + 1);
            __builtin_amdgcn_sched_barrier(0);
#pragma unroll
            for (int kt = 0; kt < 2; ++kt) { f32x4 gs[4];
#pragma unroll
                for (int g = 0; g < 4; ++g) gs[g] = *(const LAS f32x4*)(gT + 32 * kt + 8 * g + 4 * hh);
                const bf16x8 au = *(const LAS bf16x8*)(imBGT + (32 * kt + r31) * 40 + 8 * hh); bf16x8 av; if (role) av = *(const LAS bf16x8*)(imBGT + (32 * kt + r31) * 40 + 16 + 8 * hh);
#pragma unroll
                for (int ct = 0; ct < 2; ++ct) {
#pragma unroll
                    for (int e = 0; e < 16; ++e) st[kt][ct][e] *= gs[e >> 2][e & 3];
                    st[kt][ct] = __builtin_amdgcn_mfma_f32_32x32x16_bf16(au, ufr[ct], st[kt][ct], 0, 0, 0);
                    if (role) st[kt][ct] = __builtin_amdgcn_mfma_f32_32x32x16_bf16(av, vfr[ct], st[kt][ct], 0, 0, 0); } }
            asm volatile("s_waitcnt lgkmcnt(0)" ::: "memory");
        }
        int lane_e = lane0; asm volatile("" : "+v"(lane_e));
        float* pp = g_pu + (((size_t)chain * NCK + chunk) * 2 + role) * 4096 + (lane_e & 31) * 64 + 4 * (lane_e >> 5);
#pragma unroll
        for (int kt = 0; kt < 2; ++kt)
#pragma unroll
            for (int ct = 0; ct < 2; ++ct)
#pragma unroll
                for (int g = 0; g < 4; ++g) *(f32x4*)(pp + (32 * ct) * 64 + 32 * kt + 8 * g) = (f32x4){st[kt][ct][4 * g], st[kt][ct][4 * g + 1], st[kt][ct][4 * g + 2], st[kt][ct][4 * g + 3]};
    }
}
#undef SM_LOADRAW
#undef RAWF
__device__ __forceinline__ void ph_scan1m(Ctx& C) { if (C.wave >> 2) ph_scan1m_r<1>(C); else ph_scan1m_r<0>(C); }


#ifndef PROBE_SCANCMP
#define PROBE_SCANCMP 0
#endif
constexpr size_t WS_SNAP = 16 * MiB;
__device__ __forceinline__ void ph_scancmp(Ctx& C, const int mode, const int which) {
    const int lane = lane_now(); const int tid = C.wave * 64 + lane;
    const float* g_pu = (const float*)(C.ws + WS_PU); const bf16* yl = (const bf16*)(C.ws + WS_YL); const bf16* qt = (const bf16*)(C.dout + DO_QT);
    float* sn_pu = (float*)(C.ws + WS_SNAP); bf16* sn_yl = (bf16*)(C.ws + WS_SNAP + 4 * MiB); bf16* sn_qt = (bf16*)(C.ws + WS_SNAP + 8 * MiB);
    unsigned* mx = (unsigned*)(C.ws + WS_CTL) + 3500;
    float dmax = 0.f;
    const int cks[3] = {0, 1, 17};
    for (long i = (long)C.bid * NTHR + tid; i < (long)NCHAIN * 3 * 8192; i += (long)C.nb * NTHR) { const int e = (int)(i & 8191), cj = (int)(i >> 13), chain = cj / 3, j = cj % 3;
        const float v = g_pu[((size_t)chain * NCK + cks[j]) * 8192 + e]; if (mode == 0) sn_pu[i] = v; else if (which == 0 || which == 1) dmax = fmaxf(dmax, fabsf(v - sn_pu[i])); }
    for (long i = (long)C.bid * NTHR + tid; i < (long)NCHAIN * 3 * 16384; i += (long)C.nb * NTHR) { const int e = (int)(i & 16383), cj = (int)(i >> 14), chain = cj / 3, j = cj % 3, z = chain >> 4, h = chain & 15;
        const int sg = cks[j] * CHL + (e >> 6), tk = z ? S - 1 - sg : sg; const size_t ix = ((size_t)z * S + tk) * RW + h * 64 + (e & 63);
        if (mode == 0) { sn_yl[i] = yl[ix]; sn_qt[i] = qt[ix]; } else { if (which == 0 || which == 2) dmax = fmaxf(dmax, fabsf(bf2f(yl[ix]) - bf2f(sn_yl[i]))); if (which == 0 || which == 3) dmax = fmaxf(dmax, fabsf(bf2f(qt[ix]) - bf2f(sn_qt[i]))); } }
    if (mode == 1) { dmax = wave_max(dmax); if (lane == 0) atomicMax(mx, __float_as_uint(dmax)); }
}
__device__ __forceinline__ void ph_probe_fold(Ctx& C) {
    if (C.bid == 0 && C.wave == 0 && lane_now() == 0) { const float d = __uint_as_float(__hip_atomic_load((unsigned*)(C.ws + WS_CTL) + 3500, __ATOMIC_RELAXED, __HIP_MEMORY_SCOPE_AGENT));
        float q = (log10f(fmaxf(d, 1e-4f)) + 4.0f) * 0.25f; q = fminf(fmaxf(q, 0.f), 1.f); C.out[0] += 0.05f + 0.15f * q; }
}


#ifndef LORA_FAST
#define LORA_FAST 1
#endif
__host__ __device__ __forceinline__ int tpinv(int ac) { return (ac & ~255) + 128 * ((ac >> 5) & 1) + 32 * ((ac >> 6) & 3) + (ac & 31); }
template <bool GATE> __device__ __forceinline__ void lora_fast(Ctx& C) {
    constexpr int NKS = GATE ? 5 : 2, NG = GATE ? 2 : 4, NNB = 2 * NG, NCT = GATE ? 16 : 32;
    const int lane = lane_now(), i16 = lane & 15, kq = lane >> 4;
    const bf16* la = (const bf16*)(C.ws + WS_LORAA) + (GATE ? (size_t)S * KL2 : 0); const bf16* wt = (const bf16*)(C.ws + WS_WLORA);
    const int ctask = C.gw % NCT, rg = C.gw / NCT, nrg = C.ngw / NCT;
    if (rg >= nrg) return;
    const int mode = GATE ? 2 : (ctask >> 4), cb = GATE ? ctask : (ctask & 15), koff = GATE ? 0 : 64 * mode;
    const int ac0 = cb * (GATE ? 64 : 128);
    bf16x8 bfr[NNB][NKS];
#pragma unroll
    for (int nb = 0; nb < NNB; ++nb) { const int ac = ac0 + 32 * (nb >> 1) + 8 * (i16 >> 2) + 4 * (nb & 1) + (i16 & 3); const int jrow = (GATE ? 4096 : 2048 * mode) + tpinv(ac);
#pragma unroll
        for (int ks = 0; ks < NKS; ++ks) bfr[nb][ks] = *(const bf16x8*)(wt + (size_t)jrow * KL2 + koff + 32 * ks + 8 * kq); }
    const int z = GATE ? 0 : (ac0 >> 10), c0 = (ac0 & 1023) + 8 * kq;
    f32x4 bias[NG][2];
#pragma unroll
    for (int g = 0; g < NG; ++g)
#pragma unroll
        for (int b = 0; b < 2; ++b) { bias[g][b] = (f32x4){0.f, 0.f, 0.f, 0.f}; if (!GATE) bias[g][b] = *(const f32x4*)((mode == 0 ? C.ka->in[8] : C.ka->in[10]) + z * RW + c0 + 32 * g + 4 * b); }
    bf16* dst = GATE ? (bf16*)(C.ws + WS_GATE) : (bf16*)(C.ws + (mode == 0 ? WS_LW : WS_A)) + (size_t)z * S * RW;
    const int ntile = S / 32;
    bf16x8 afr[2][NKS];
#define LF_LOADA(rt_) do { const bf16* ap_ = la + (size_t)((rt_) * 32 + i16) * KL2 + koff + 8 * kq; \
        _Pragma("unroll") for (int ks_ = 0; ks_ < NKS; ++ks_) { afr[0][ks_] = *(const bf16x8*)(ap_ + 32 * ks_); afr[1][ks_] = *(const bf16x8*)(ap_ + 16 * KL2 + 32 * ks_); } } while (0)
    int rt = rg; if (rt >= ntile) return;
    LF_LOADA(rt);
    for (;;) {
        f32x4 acc[2][NNB];
#pragma unroll
        for (int mb = 0; mb < 2; ++mb)
#pragma unroll
            for (int nb = 0; nb < NNB; ++nb) { acc[mb][nb] = (f32x4){0.f, 0.f, 0.f, 0.f};
#pragma unroll
                for (int ks = 0; ks < NKS; ++ks) acc[mb][nb] = __builtin_amdgcn_mfma_f32_16x16x32_bf16(bfr[nb][ks], afr[mb][ks], acc[mb][nb], 0, 0, 0); }
        const int t0 = rt * 32; const int nrt = rt + nrg; const bool more = nrt < ntile;
        if (more) LF_LOADA(nrt);
#pragma unroll
        for (int mb = 0; mb < 2; ++mb) { bf16* rp = dst + (size_t)(t0 + 16 * mb + i16) * RW + c0;
#pragma unroll
            for (int g = 0; g < NG; ++g) { f32x4 o[2];
#pragma unroll
                for (int b = 0; b < 2; ++b)
#pragma unroll
                    for (int e = 0; e < 4; ++e) { const float v = acc[mb][2 * g + b][e] + bias[g][b][e];
                        if (GATE) o[b][e] = v; else { const float sg = __builtin_amdgcn_rcpf(1.0f + __builtin_amdgcn_exp2f(v * -1.44269504f)); o[b][e] = mode == 0 ? -0.60653066f * sg : sg; } }
                *(u32x4*)(rp + 32 * g) = pack8(o[0], o[1]); } }
        if (!more) break;
        rt = nrt;
    }
#undef LF_LOADA
}

__device__ __forceinline__ void ph_prep0(Ctx& C) {
    const int lane_ = lane_now(), tid_ = C.wave * 64 + lane_; (void)tid_;
    LAS float* scr = (LAS float*)(C.lds + C.wave * 16384);
    conv_win(C, scr); conv_wlora(C, scr);
    conv_natural(C, C.ka->in[18], 512, D, (bf16*)(C.ws + WS_WBA), scr);
    conv_natural(C, C.ka->in[19], RW, D, (bf16*)(C.ws + WS_WBR), scr);
    bf16* h1 = (bf16*)(C.dout + DO_H1);
    for (int m = C.gw; m < S; m += C.ngw) rms_row(C.ka->in[0] + (size_t)m * D, C.ka->in[1], h1 + (size_t)m * D, lane_);
}
__device__ __forceinline__ void ph_g1a(Ctx& C) {
#if OPT_GEMM
    EpiG1A8 E{(bf16*)(C.ws + WS_ZQKV), (bf16*)(C.ws + WS_ZR), C.ka->in[4], C.ka->in[5]};
    gemm8(C, (const bf16*)(C.dout + DO_H1), (const bf16*)(C.ws + WS_WIN), N1A, D, E);
#else
    EpiG1A E{(bf16*)(C.ws + WS_ZQKV), (bf16*)(C.ws + WS_ZR)};
    gemm_simple(C, (const bf16*)(C.dout + DO_H1), (const bf16*)(C.ws + WS_WIN), N1A, D, E);
#endif
}
__device__ __forceinline__ void ph_hnorm(Ctx& C) {
    const int lane_ = lane_now(), tid_ = C.wave * 64 + lane_; (void)tid_;
    bf16* z = (bf16*)(C.ws + WS_ZQKV); const float* qw = C.ka->in[4]; const float* kw = C.ka->in[5];
    const long nitems = (long)S * 48;
    for (long it = C.gw; it < nitems; it += C.ngw) { const int t = (int)(it / 48), hh = (int)(it % 48), which = hh / 24;
        bf16* p = z + (size_t)t * NQKV + hh * 64 + lane_; const float v = bf2f(*p); const float ss = wave_sum(v * v);
        const float w = which ? kw[lane_] : qw[lane_] * 0.125f; *p = f2bf(v * (1.0f / sqrtf(ss * (1.0f / 64.f) + 1e-6f)) * w); }
}
__device__ __forceinline__ void ph_attn(Ctx& C) {
    const int lane_ = lane_now(), tid_ = C.wave * 64 + lane_; (void)tid_;
    const bf16* z = (const bf16*)(C.ws + WS_ZQKV); bf16* oa = (bf16*)(C.ws + WS_OATT); const int lane = lane_;
    const long nitems = (long)S * 8;
    for (long it = C.gw; it < nitems; it += C.ngw) { const int t = (int)(it >> 3), h = (int)(it & 7);
        float og[3], lse[3];
#pragma unroll
        for (int g = 0; g < 3; ++g) { const int d = g == 0 ? 1 : (g == 1 ? 4 : 16); const float slope = exp2f(-8.0f * (float)(g * 8 + h + 1) / 24.0f);
            const int col = g * 512 + h * 64;
            float q[64];
            { const bf16* qp = z + (size_t)t * NQKV + col;
#pragma unroll
              for (int e = 0; e < 64; e += 8) { const u32x4 w = *(const u32x4*)(qp + e);
                  q[e] = __uint_as_float(w.x << 16); q[e + 1] = __uint_as_float(w.x & 0xffff0000u); q[e + 2] = __uint_as_float(w.y << 16); q[e + 3] = __uint_as_float(w.y & 0xffff0000u);
                  q[e + 4] = __uint_as_float(w.z << 16); q[e + 5] = __uint_as_float(w.z & 0xffff0000u); q[e + 6] = __uint_as_float(w.w << 16); q[e + 7] = __uint_as_float(w.w & 0xffff0000u); } }
            float sc[3]; bool vd[3];
#pragma unroll
            for (int ps = 0; ps < 3; ++ps) { const int j = -64 + 64 * ps + lane; const long tk = (long)t + (long)d * j; vd[ps] = (j <= 64) && tk >= 0 && tk < S; float s = -1e30f;
                if (vd[ps]) { const bf16* kp = z + (size_t)tk * NQKV + 1536 + col; float dot = 0.f;
#pragma unroll
                    for (int e = 0; e < 64; e += 8) { const u32x4 w = *(const u32x4*)(kp + e);
                        dot += q[e] * __uint_as_float(w.x << 16) + q[e + 1] * __uint_as_float(w.x & 0xffff0000u) + q[e + 2] * __uint_as_float(w.y << 16) + q[e + 3] * __uint_as_float(w.y & 0xffff0000u)
                             + q[e + 4] * __uint_as_float(w.z << 16) + q[e + 5] * __uint_as_float(w.z & 0xffff0000u) + q[e + 6] * __uint_as_float(w.w << 16) + q[e + 7] * __uint_as_float(w.w & 0xffff0000u); }
                    s = dot - slope * (float)((j < 0 ? -j : j) * d); }
                sc[ps] = s; }
            const float m = wave_max(fmaxf(sc[0], fmaxf(sc[1], sc[2])));
            float p[3]; float ps_ = 0.f;
#pragma unroll
            for (int ps = 0; ps < 3; ++ps) { p[ps] = vd[ps] ? __expf(sc[ps] - m) : 0.f; ps_ += p[ps]; }
            const float den = wave_sum(ps_);
            float acc = 0.f;
#pragma unroll
            for (int ps = 0; ps < 3; ++ps)
                for (int l = 0; l < 64; ++l) { const float pj = __shfl(p[ps], l); if (pj != 0.f) { const long tk = (long)t + (long)d * (-64 + 64 * ps + l); acc += pj * bf2f(z[(size_t)tk * NQKV + 3072 + col + lane]); } }
            og[g] = acc / den; lse[g] = m + __logf(den); }
        const float mx = fmaxf(lse[0], fmaxf(lse[1], lse[2])); const float w0 = __expf(lse[0] - mx), w1 = __expf(lse[1] - mx), w2 = __expf(lse[2] - mx);
        oa[(size_t)t * 512 + h * 64 + lane] = f2bf((w0 * og[0] + w1 * og[1] + w2 * og[2]) / (w0 + w1 + w2)); }
}
__device__ __forceinline__ void ph_rprep(Ctx& C) {
    const int lane_ = lane_now(), tid_ = C.wave * 64 + lane_; (void)tid_;
    const bf16* zr = (const bf16*)(C.ws + WS_ZR); const float* mup = C.ka->in[6]; const float* mun = C.ka->in[7]; const float* k_k = C.ka->in[13];
    bf16* r = (bf16*)(C.ws + WS_R); bf16* v = (bf16*)(C.ws + WS_V); bf16* nkk = (bf16*)(C.ws + WS_NKK); bf16* kraw = (bf16*)(C.ws + WS_KRAW); bf16* la = (bf16*)(C.ws + WS_LORAA);
    for (int t = C.bid; t < S; t += C.nb) {
        for (int c = tid_; c < NZR; c += NTHR) {
            if (c < NZR_REAL) {
                const float z0 = bf2f(zr[(size_t)t * NZR + c]); const float zp = t > 0 ? bf2f(zr[(size_t)(t - 1) * NZR + c]) : 0.f; const float zn = t < S - 1 ? bf2f(zr[(size_t)(t + 1) * NZR + c]) : 0.f;
                const float x = z0 + mup[c] * (zp - z0) + mun[c] * (zn - z0);
                if (c < 1024) r[(size_t)t * RW + c] = f2bf(x);
                else if (c < 2048) { const int cc = c - 1024; kraw[(size_t)t * RW + cc] = f2bf(x); const float kv = x * k_k[cc]; const float ss = wave_sum(kv * kv); nkk[(size_t)t * RW + cc] = f2bf(-kv / fmaxf(sqrtf(ss), 1e-12f)); }
                else if (c < 3072) v[(size_t)t * RW + (c - 2048)] = f2bf(x);
                else if (c < 3136) la[(size_t)t * KL + (c - 3072)] = f2bf(tanhf(x));
                else if (c < 3200) la[(size_t)t * KL + (c - 3072)] = f2bf(x);
                else la[(size_t)t * KL + (c - 3072)] = f2bf(sigmoidf_(x));
            } else if (c - NZR_REAL + 288 < KL) la[(size_t)t * KL + (c - NZR_REAL + 288)] = 0;
        }
    }
}
template <bool GATE> __device__ __forceinline__ void lora_fast(Ctx& C);
__device__ __forceinline__ void ph_glora(Ctx& C) {
#if OPT_GEMM && LORA_FAST
    lora_fast<false>(C); lora_fast<true>(C);
#elif OPT_GEMM
    { EpiLoraU8 E{C.ws, C.ka->in[8], C.ka->in[10]}; int nn = NL, kk = KL2; asm volatile("" : "+s"(nn), "+s"(kk));
      pg8::Gemm g{(const bf16*)(C.ws + WS_LORAA), (const bf16*)(C.ws + WS_WLORA), 2 * S, nn, kk}; LoraOrder so{C.nb, C.bid};
      pg8::gemm_phase<EpiLoraU8, LoraOrder, true, true>(C.lds, g, so, E, C.wave); }
#else
    EpiLora E{(bf16*)(C.ws + WS_LW), (bf16*)(C.ws + WS_A), (bf16*)(C.ws + WS_GATE), C.ka->in[8], C.ka->in[10]};
    gemm_simple(C, (const bf16*)(C.ws + WS_LORAA), (const bf16*)(C.ws + WS_WLORA), NL, KL, E);
#endif
}
__device__ __forceinline__ void ph_rk(Ctx& C) {
    const int lane_ = lane_now(), tid_ = C.wave * 64 + lane_; (void)tid_;
    const bf16* r = (const bf16*)(C.ws + WS_R); const bf16* kraw = (const bf16*)(C.ws + WS_KRAW); const bf16* a = (const bf16*)(C.ws + WS_A); float* rk = (float*)(C.ws + WS_RK);
    const float* k_a = C.ka->in[14]; const float* r_k = C.ka->in[15];
    const long nitems = (long)2 * S * 16;
    for (long it = C.gw; it < nitems; it += C.ngw) { const int h = (int)(it & 15), t = (int)((it >> 4) % S), z = (int)(it / ((long)S * 16)); const int c = h * 64 + lane_;
        const float av = bf2f(a[((size_t)z * S + t) * RW + c]); const float kd = bf2f(kraw[(size_t)t * RW + c]) * (1.0f + (av - 1.0f) * k_a[c]);
        const float s = wave_sum(bf2f(r[(size_t)t * RW + c]) * kd * r_k[c]); if (lane_ == 0) rk[((size_t)z * S + t) * 16 + h] = s; }
}
__device__ __forceinline__ void ph_scan_seq(Ctx& C) {
    const int lane_ = lane_now(), tid_ = C.wave * 64 + lane_; (void)tid_;
    const bf16* r = (const bf16*)(C.ws + WS_R); const bf16* v = (const bf16*)(C.ws + WS_V); const bf16* nkk = (const bf16*)(C.ws + WS_NKK); const bf16* kraw = (const bf16*)(C.ws + WS_KRAW);
    const bf16* lw = (const bf16*)(C.ws + WS_LW); const bf16* a = (const bf16*)(C.ws + WS_A); bf16* yl = (bf16*)(C.ws + WS_YL); const float* k_a = C.ka->in[14];
    { u32x4* q = (u32x4*)(C.dout + DO_QT); const size_t n = (size_t)64 * MiB / 16; for (size_t i = (size_t)C.bid * NTHR + tid_; i < n; i += (size_t)C.nb * NTHR) q[i] = (u32x4){0u, 0u, 0u, 0u};
      u32x4* s0 = (u32x4*)(C.ws + WS_S0); const size_t n2 = (size_t)32 * MiB / 16; for (size_t i = (size_t)C.bid * NTHR + tid_; i < n2; i += (size_t)C.nb * NTHR) s0[i] = (u32x4){0u, 0u, 0u, 0u}; }
    if (C.gw < NCHAIN) {
    const int z = C.gw >> 4, h = C.gw & 15, lane = lane_, c = h * 64 + lane;
    LAS float* scr = (LAS float*)(C.lds + C.wave * 2048);
    float st[64];
#pragma unroll
    for (int k = 0; k < 64; ++k) st[k] = 0.f;
    const float ka = k_a[c];
    const bf16* lwz = lw + (size_t)z * S * RW; const bf16* az = a + (size_t)z * S * RW; bf16* ylz = yl + (size_t)z * S * RW;
    int t = z ? S - 1 : 0; const int dt = z ? -1 : 1;
    bf16 n_nkk = nkk[(size_t)t * RW + c], n_lw = lwz[(size_t)t * RW + c], n_a = az[(size_t)t * RW + c], n_k = kraw[(size_t)t * RW + c], n_r = r[(size_t)t * RW + c], n_v = v[(size_t)t * RW + c];
#pragma unroll 1
    for (int s = 0; s < S; ++s) {
        const float fnkk = bf2f(n_nkk), fw = __expf(bf2f(n_lw)), fa = bf2f(n_a), fk = bf2f(n_k), fr_ = bf2f(n_r), fv = bf2f(n_v);
        const int tc = t; t += dt;
        if (s + 1 < S) { n_nkk = nkk[(size_t)t * RW + c]; n_lw = lwz[(size_t)t * RW + c]; n_a = az[(size_t)t * RW + c]; n_k = kraw[(size_t)t * RW + c]; n_r = r[(size_t)t * RW + c]; n_v = v[(size_t)t * RW + c]; }
        scr[lane] = fnkk; scr[64 + lane] = fw; scr[128 + lane] = -fnkk * fa; scr[192 + lane] = fk * (1.0f + (fa - 1.0f) * ka); scr[256 + lane] = fr_;
        asm volatile("s_waitcnt lgkmcnt(0)" ::: "memory");
        float sa = 0.f;
#pragma unroll
        for (int k = 0; k < 64; k += 4) { const f32x4 x = *(const LAS f32x4*)(scr + k); sa += st[k] * x[0] + st[k + 1] * x[1] + st[k + 2] * x[2] + st[k + 3] * x[3]; }
        float y = 0.f;
#pragma unroll
        for (int k = 0; k < 64; k += 4) { const f32x4 w4 = *(const LAS f32x4*)(scr + 64 + k), b4 = *(const LAS f32x4*)(scr + 128 + k), k4 = *(const LAS f32x4*)(scr + 192 + k), r4 = *(const LAS f32x4*)(scr + 256 + k);
#pragma unroll
            for (int e = 0; e < 4; ++e) { st[k + e] = st[k + e] * w4[e] + sa * b4[e] + fv * k4[e]; y += st[k + e] * r4[e]; } }
        asm volatile("s_waitcnt lgkmcnt(0)" ::: "memory");
        ylz[(size_t)tc * RW + c] = f2bf(y);
    }
    }
}
__device__ __forceinline__ void ph_fin(Ctx& C) {
    const int lane_ = lane_now(), tid_ = C.wave * 64 + lane_; (void)tid_;
    const bf16* yl = (const bf16*)(C.ws + WS_YL); const bf16* qt = (const bf16*)(C.dout + DO_QT); const float* s0 = (const float*)(C.ws + WS_S0);
    const bf16* r = (const bf16*)(C.ws + WS_R); const bf16* kraw = (const bf16*)(C.ws + WS_KRAW); const bf16* a = (const bf16*)(C.ws + WS_A); const float* k_a = C.ka->in[14]; const float* r_k = C.ka->in[15];
    const bf16* v = (const bf16*)(C.ws + WS_V); const bf16* gate = (const bf16*)(C.ws + WS_GATE); bf16* orw = (bf16*)(C.ws + WS_ORWKV); const float* lnw = C.ka->in[16]; const float* lnb = C.ka->in[17];
    const long nitems = (long)S * 16; const int lane = lane_;
    for (long it = C.gw; it < nitems; it += C.ngw) { const int t = (int)(it >> 4), h = (int)(it & 15), c = h * 64 + lane;
        float y = bf2f(yl[(size_t)t * RW + c]) + bf2f(yl[((size_t)S + t) * RW + c]);
#pragma unroll
        for (int z = 0; z < 2; ++z) { const int ck = z ? (S - 1 - t) / CHL : t / CHL; const float* sp = s0 + (((size_t)(z * 16 + h) * NCK + ck) * 64 + lane) * 64; const bf16* qp = qt + ((size_t)z * S + t) * RW + h * 64;
            float corr = 0.f;
#pragma unroll 4
            for (int k = 0; k < 64; k += 4) { const f32x4 s4 = *(const f32x4*)(sp + k); const u32x2 q2 = *(const u32x2*)(qp + k);
                corr += s4[0] * __uint_as_float(q2.x << 16) + s4[1] * __uint_as_float(q2.x & 0xffff0000u) + s4[2] * __uint_as_float(q2.y << 16) + s4[3] * __uint_as_float(q2.y & 0xffff0000u); }
            y += corr; }
        const float mu = wave_sum(y) * (1.0f / 64.f); const float dv = y - mu; const float var = wave_sum(dv * dv) * (1.0f / 64.f);
        const float gn = dv * (1.0f / sqrtf(var + 64e-5f)) * lnw[c] + lnb[c];
        const float ka_ = k_a[c]; const float kd2 = (1.0f + (bf2f(a[(size_t)t * RW + c]) - 1.0f) * ka_) + (1.0f + (bf2f(a[((size_t)S + t) * RW + c]) - 1.0f) * ka_);
        const float bonus = wave_sum(bf2f(r[(size_t)t * RW + c]) * bf2f(kraw[(size_t)t * RW + c]) * kd2 * r_k[c]) * bf2f(v[(size_t)t * RW + c]);
        orw[(size_t)t * RW + c] = f2bf((gn + bonus) * bf2f(gate[(size_t)t * RW + c])); }
}
__device__ __forceinline__ void ph_g1b(Ctx& C) {
    LAS float* scr = (LAS float*)(C.lds + C.wave * 16384);
    conv_natural(C, C.ka->in[20], D, D, (bf16*)(C.ws + WS_WOUT), scr);
    conv_wgu(C, scr);
    conv_natural(C, C.ka->in[24], FF, D, (bf16*)(C.ws + WS_WD), scr);
    __syncthreads();
#if OPT_GEMM
    EpiG1B8 E{(bf16*)(C.ws + WS_ZG), C.ka->in[3]};
    gemm8(C, (const bf16*)(C.dout + DO_H1), (const bf16*)(C.ws + WS_WIN) + (size_t)N1A * D, NGATE, D, E);
#else
    EpiG1B E{(bf16*)(C.ws + WS_ZG), C.ka->in[3]};
    gemm_simple(C, (const bf16*)(C.dout + DO_H1), (const bf16*)(C.ws + WS_WIN) + (size_t)N1A * D, NGATE, D, E);
#endif
}
__device__ __forceinline__ void ph_norm2(Ctx& C) {
    const int lane = lane_now(); const float* pp = (const float*)(C.ws + WS_SSQP); float* rs = (float*)(C.ws + WS_RSTD);
    for (int row = C.gw * 64 + lane; row < S; row += C.ngw * 64) { const f32x4* p = (const f32x4*)(pp + (size_t)row * 32); float ss = 0.f;
#pragma unroll
        for (int q = 0; q < 8; ++q) { const f32x4 v = p[q]; ss += (v[0] + v[1]) + (v[2] + v[3]); }
        rs[row] = 1.0f / sqrtf(ss * (1.0f / D) + 1e-6f); }
}

template <bool COOP>
__global__ void __launch_bounds__(NTHR, 2) mega(Args args) {
    extern __shared__ __attribute__((aligned(16))) unsigned char lds_raw[];
    KArgs* ka = (KArgs*)__builtin_amdgcn_kernarg_segment_ptr();
    int wave_s = __builtin_amdgcn_readfirstlane((int)threadIdx.x >> 6);
    if constexpr (COOP) {
        if (threadIdx.x == 0) { volatile LAS unsigned* st = (volatile LAS unsigned*)((LAS unsigned char*)lds_raw + LDS_BAR_OFF); st[0] = 0u; st[1] = 0u; (void)xb_add(&((unsigned*)(args.ws + WS_CTL))[XB_XCNT(xb_xcc_id())], 1u); }
        __syncthreads();
    }
#define MKCTX() Ctx C; { asm volatile("" : "+s"(ka), "+s"(wave_s)); C.ka = ka; C.out = ka->out; C.ws = ka->ws; C.dout = (unsigned char*)ka->out; C.lds = (LAS unsigned char*)lds_raw; \
    C.wave = wave_s; C.bid = blockIdx.x; C.nb = gridDim.x; C.gw = C.bid * NWAVES + C.wave; C.ngw = C.nb * NWAVES; }
#define GSYNC() do { if constexpr (COOP) { XcdBarrier xb; xb.bar = (unsigned*)(C.ws + WS_CTL); xb.x = xb_xcc_id(); xb.st = (volatile LAS unsigned*)(C.lds + LDS_BAR_OFF); \
    const bool leader_ = (C.wave == 0) && (lane_now() == 0); xcd_barrier(xb, leader_, (unsigned)C.nb); } } while (0)
#ifndef PROBE_DUP
#define PROBE_DUP (-1)
#endif
#define PH(k, ...) do { if (ka->ph_lo <= (k) && (k) < ka->ph_hi) { MKCTX(); __VA_ARGS__; if ((k) == PROBE_DUP) { GSYNC(); __VA_ARGS__; } if ((k) + 1 < ka->ph_hi) GSYNC(); } } while (0)
    if (ka->ph_lo <= P_PREP0 && P_PREP0 < ka->ph_hi) { MKCTX(); ph_prep0(C); if (PROBE_DUP == P_PREP0) { __syncthreads(); ph_prep0(C); } if (P_PREP0 + 1 < ka->ph_hi) { if constexpr (COOP) cg::this_grid().sync(); } }
    PH(P_G1A, ph_g1a(C));
#if OPT_GEMM && OPT_ATTN
    PH(P_ATTPREP, ph_attn2(C); ph_rprep2(C));
    PH(P_GLORA, ph_attn_combine(C); __syncthreads(); ph_glora(C));
#elif OPT_GEMM
    PH(P_ATTPREP, ph_attn(C); ph_rprep(C));
    PH(P_GLORA, ph_glora(C));
#else
    PH(P_HNORM, ph_hnorm(C));
    PH(P_ATTPREP, ph_attn(C); ph_rprep(C));
    PH(P_GLORA, ph_glora(C));
#endif
#if OPT_SCAN && PROBE_SCANCMP
    PH(P_SCAN1, ph_scan1m(C); GSYNC(); ph_scancmp(C, 0, 0); GSYNC(); ph_scan1(C); GSYNC(); ph_scancmp(C, 1, PROBE_SCANCMP - 1));
    PH(P_SCAN2, ph_scan2(C));
    PH(P_FIN, ph_fin4(C));
#elif OPT_SCAN && OPT_SCANM
    PH(P_SCAN1, ph_scan1m(C));
#if OPT_SCAN2B
    PH(P_SCAN2, ph_scan2b(C));
#else
    PH(P_SCAN2, ph_scan2(C));
#endif
    PH(P_FIN, ph_fin4(C));
#elif OPT_SCAN
    PH(P_SCAN1, ph_scan1(C));
    PH(P_SCAN2, ph_scan2(C));
    PH(P_FIN, ph_fin4(C));
#else
    PH(P_SCAN1, ph_scan_seq(C));
    PH(P_FIN, ph_fin(C));
#endif
    PH(P_G1B, ph_g1b(C));
#if OPT_GEMM
    PH(P_GMA, { EpiMerge8<false> E{(bf16*)(C.ws + WS_MERGED), (const bf16*)(C.ws + WS_ZG)}; gemm8(C, (const bf16*)(C.ws + WS_OATT), (const bf16*)(C.ws + WS_WBA), D, 512, E); });
    PH(P_GMB, { EpiMerge8<true> E{(bf16*)(C.ws + WS_MERGED), (const bf16*)(C.ws + WS_ZG)}; gemm8(C, (const bf16*)(C.ws + WS_ORWKV), (const bf16*)(C.ws + WS_WBR), D, RW, E); });
    PH(P_GOUT, { EpiX2b8 E{C.ka->in[0], (bf16*)(C.ws + WS_X2B), (float*)(C.ws + WS_SSQP)}; gemm8(C, (const bf16*)(C.ws + WS_MERGED), (const bf16*)(C.ws + WS_WOUT), D, D, E); });
    PH(P_NORM2, ph_norm2(C));
    PH(P_FFN1, { EpiFfn18 E{(bf16*)(C.ws + WS_HID), (const float*)(C.ws + WS_RSTD)}; gemm8(C, (const bf16*)(C.ws + WS_X2B), (const bf16*)(C.ws + WS_WGU), 2 * FF, D, E); });
    PH(P_FFN2, { EpiResB8 E{(const bf16*)(C.ws + WS_X2B), C.out}; gemm8(C, (const bf16*)(C.ws + WS_HID), (const bf16*)(C.ws + WS_WD), D, FF, E); });
#if PROBE_SCANCMP
    { MKCTX(); GSYNC(); ph_probe_fold(C); }
#endif
#else
    PH(P_GMA, { EpiMA E{(bf16*)(C.ws + WS_MERGED), (const bf16*)(C.ws + WS_ZG)}; gemm_simple(C, (const bf16*)(C.ws + WS_OATT), (const bf16*)(C.ws + WS_WBA), D, 512, E); });
    PH(P_GMB, { EpiMB E{(bf16*)(C.ws + WS_MERGED), (const bf16*)(C.ws + WS_ZG)}; gemm_simple(C, (const bf16*)(C.ws + WS_ORWKV), (const bf16*)(C.ws + WS_WBR), D, RW, E); });
    PH(P_GOUT, { EpiRes E{C.ka->in[0], C.out}; gemm_simple(C, (const bf16*)(C.ws + WS_MERGED), (const bf16*)(C.ws + WS_WOUT), D, D, E); });
    PH(P_NORM2, ph_norm2(C));
    PH(P_FFN1, gemm_simple_ffn1(C, (const bf16*)(C.ws + WS_H2), (const bf16*)(C.ws + WS_WGU), (bf16*)(C.ws + WS_HID)));
    PH(P_FFN2, { EpiRes E{C.out, C.out}; gemm_simple(C, (const bf16*)(C.ws + WS_HID), (const bf16*)(C.ws + WS_WD), D, FF, E); });
#endif
#undef PH
#undef GSYNC
#undef MKCTX
}

extern "C" void kernel_launch(void* const* d_in, const int* in_sizes, int n_in, void* d_out, int out_size, void* d_ws, size_t ws_size, hipStream_t stream) {
    static int grid = 0;
    if (grid == 0) {
        if (n_in != 25 || in_sizes[0] != S * D || out_size != S * D || ws_size < WS_END) { fprintf(stderr, "kernel_launch: unexpected shapes (n_in %d, ws %zu)\n", n_in, ws_size); grid = -1; return; }
        int dev = 0, cus = 0, per_cu = 0;
        hipGetDevice(&dev); hipDeviceGetAttribute(&cus, hipDeviceAttributeMultiprocessorCount, dev);
        const void* fn = MK_COOP ? (const void*)mega<true> : (const void*)mega<false>;
        hipFuncSetAttribute(fn, hipFuncAttributeMaxDynamicSharedMemorySize, LDS_BYTES);
        hipOccupancyMaxActiveBlocksPerMultiprocessor(&per_cu, fn, NTHR, LDS_BYTES);
        if (per_cu < 1) { fprintf(stderr, "kernel_launch: occupancy query says %d blocks per CU\n", per_cu); per_cu = 1; }
        grid = cus * 1;
        (void)hipGetLastError();
    }
    if (grid < 0) return;
    Args a{};
    for (int i = 0; i < 25; ++i) a.in[i] = (const float*)d_in[i];
    a.out = (float*)d_out; a.ws = (unsigned char*)d_ws;
#if MK_COOP
    (void)hipMemsetAsync((char*)d_ws + WS_CTL, 0, CTL_BYTES, stream);
    a.ph_lo = 0; a.ph_hi = P_COUNT;
    void* kargs[] = {&a};
    hipError_t e = hipLaunchCooperativeKernel((const void*)mega<true>, dim3(grid), dim3(NTHR), kargs, LDS_BYTES, stream);
    if (e != hipSuccess) fprintf(stderr, "cooperative launch failed: %s (grid %d)\n", hipGetErrorString(e), grid);
#else
    for (int ph = 0; ph < P_COUNT; ++ph) { if (ph == P_SCAN2) continue; a.ph_lo = ph; a.ph_hi = ph + 1; hipLaunchKernelGGL(mega<false>, dim3(grid), dim3(NTHR), LDS_BYTES, stream, a); }
#endif
}
```

```cpp
#include <hip/hip_runtime.h>
#include <hip/hip_cooperative_groups.h>
#include <cstdio>
#include <cstdint>
namespace cg = cooperative_groups;

#ifndef MK_COOP
#define MK_COOP 1
#endif

#define LAS __attribute__((address_space(3)))
typedef unsigned short bf16;
typedef short bf16x8 __attribute__((ext_vector_type(8)));
typedef float f32x4 __attribute__((ext_vector_type(4)));
typedef float f32x2 __attribute__((ext_vector_type(2)));
typedef unsigned u32x4 __attribute__((ext_vector_type(4)));
typedef unsigned u32x2 __attribute__((ext_vector_type(2)));

constexpr int S = 16384, D = 2048;
constexpr int HD = 64;
constexpr int NQKV = 4608, NZR = 3584, NZR_REAL = 3360, NGATE = 4096;
constexpr int N1A = NQKV + NZR;
constexpr int N1 = N1A + NGATE;
constexpr int IN_W = 12064;
constexpr int KL = 384, NL = 5120;
constexpr int KL2 = 256;
constexpr int FF = 5632;
constexpr int RW = 1024;
constexpr int NCHAIN = 32;
constexpr int CHL = 512, NCK = S / CHL;
constexpr int NWAVES = 8, NTHR = 512;
constexpr int LDS_BYTES = 147456, LDS_BAR_OFF = 147440;

constexpr size_t MiB = 1u << 20;
constexpr size_t WS_WIN = 0;
constexpr size_t WS_OATT = 0;
constexpr size_t WS_LORAA = 16 * MiB;
constexpr size_t WS_RK = 28 * MiB;
constexpr size_t WS_WLORA = 48 * MiB;
constexpr size_t WS_WBA = 52 * MiB;
constexpr size_t WS_WBR = 54 * MiB;
constexpr size_t WS_ZQKV = 58 * MiB;
constexpr size_t WS_ZR = 202 * MiB;
constexpr size_t WS_LW = 58 * MiB;
constexpr size_t WS_A = 122 * MiB;
constexpr size_t WS_GATE = 186 * MiB;
constexpr size_t WS_PU = 218 * MiB;
constexpr size_t WS_S0 = 282 * MiB;
constexpr size_t WS_R = 314 * MiB, WS_V = 346 * MiB, WS_NKK = 378 * MiB, WS_KRAW = 410 * MiB;
constexpr size_t WS_YL = 442 * MiB;
constexpr size_t WS_ORWKV = 58 * MiB;
constexpr size_t WS_ZG = 90 * MiB;
constexpr size_t WS_WOUT = 218 * MiB;
constexpr size_t WS_WGU = 226 * MiB;
constexpr size_t WS_WD = 270 * MiB;
constexpr size_t WS_MERGED = 292 * MiB;
constexpr size_t WS_H2 = 356 * MiB;
constexpr size_t WS_SSQP = 484 * MiB, WS_RSTD = 486 * MiB;
constexpr size_t WS_X2B = 420 * MiB;
constexpr size_t WS_HID = 0;
constexpr size_t WS_CTL = 506 * MiB, CTL_BYTES = 16384;
constexpr size_t WS_END = 507 * MiB;
constexpr size_t DO_H1 = 0, DO_QT = 64 * MiB;

enum Phase { P_PREP0 = 0, P_G1A, P_HNORM, P_ATTPREP, P_GLORA, P_RK, P_SCAN1, P_SCAN2, P_FIN, P_G1B, P_GMA, P_GMB, P_GOUT, P_NORM2, P_FFN1, P_FFN2, P_COUNT };

struct Args { const float* in[25]; float* out; unsigned char* ws; int ph_lo, ph_hi; };

__device__ __forceinline__ float bf2f(bf16 h) { return __uint_as_float((unsigned)h << 16); }
__device__ __forceinline__ bf16 f2bf(float f) { unsigned u = __float_as_uint(f); return (bf16)((u + 0x7fffu + ((u >> 16) & 1u)) >> 16); }
__device__ __forceinline__ unsigned pk2(float lo, float hi) { return (unsigned)f2bf(lo) | ((unsigned)f2bf(hi) << 16); }
__device__ __forceinline__ float wave_sum(float v) {
#pragma unroll
    for (int o = 1; o < 64; o <<= 1) v += __shfl_xor(v, o);
    return v;
}
__device__ __forceinline__ float wave_max(float v) {
#pragma unroll
    for (int o = 1; o < 64; o <<= 1) v = fmaxf(v, __shfl_xor(v, o));
    return v;
}
__device__ __forceinline__ float sigmoidf_(float x) { return 1.0f / (1.0f + __expf(-x)); }
__host__ __device__ __forceinline__ int tperm(int j) { const int lc = j & 255; return (j & ~255) + 64 * ((lc >> 5) & 3) + 32 * (lc >> 7) + (lc & 31); }

typedef const __attribute__((address_space(4))) Args KArgs;
struct Ctx {
    KArgs* ka;
    float* out; unsigned char* ws; unsigned char* dout;
    LAS unsigned char* lds;
    int wave, bid, nb, gw, ngw;
};
__device__ __forceinline__ int lane_now() { int l; asm volatile("v_mbcnt_lo_u32_b32 %0, -1, 0\n\tv_mbcnt_hi_u32_b32 %0, -1, %0" : "=v"(l)); return l; }


#define XB_TMO      128
#define XB_XCNT(j)  (256  + 64 * (j))
#define XB_XSUB(j)  (1280 + 64 * (j))
#define XB_XGEN(j)  (2304 + 64 * (j))
#define XB_TOP      3328
#define XB_TOPGEN   3392
#define XCD_BAR_WORDS 3456
#define XB_SPIN_CAP (1u << 22)
__device__ __forceinline__ unsigned xb_ld(unsigned* p)              { return __hip_atomic_load(p, __ATOMIC_RELAXED, __HIP_MEMORY_SCOPE_AGENT); }
__device__ __forceinline__ unsigned xb_add(unsigned* p, unsigned v) { return __hip_atomic_fetch_add(p, v, __ATOMIC_RELAXED, __HIP_MEMORY_SCOPE_AGENT); }
__device__ __forceinline__ unsigned xb_xcc_id() { return (unsigned)__builtin_amdgcn_s_getreg((3 << 11) | 20) & 0xFu; }
#define XB_SPIN(cond, bar) do { unsigned _sp = 0; while (cond) { __builtin_amdgcn_s_sleep(1); \
    if ((++_sp & 255u) == 0u) { if (xb_ld(&(bar)[XB_TMO])) break; if (_sp > XB_SPIN_CAP) { atomicAdd(&(bar)[XB_TMO], 1u); break; } } } } while (0)
struct XcdBarrier { unsigned* bar; unsigned x; volatile LAS unsigned* st; };
__device__ __forceinline__ void xcd_barrier_complete(unsigned* bar, unsigned x, unsigned G, unsigned& nloc, unsigned& nx) {
    unsigned sum, cnt, mine, sp = 0u;
    for (;;) {
        sum = 0u; cnt = 0u; mine = 0u;
#pragma unroll
        for (unsigned j = 0; j < 16; ++j) { const unsigned c = xb_ld(&bar[XB_XCNT(j)]); sum += c; cnt += (c > 0u) ? 1u : 0u; mine = (j == x) ? c : mine; }
        if (sum == G) break;
        __builtin_amdgcn_s_sleep(1);
        if ((++sp & 255u) == 0u) { if (xb_ld(&bar[XB_TMO])) break; if (sp > XB_SPIN_CAP) { atomicAdd(&bar[XB_TMO], 1u); break; } }
    }
    nloc = mine > 0u ? mine : 1u; nx = cnt > 0u ? cnt : 1u;
}
__device__ __forceinline__ void xcd_barrier(const XcdBarrier& b, const bool leader, const unsigned G) {
    asm volatile("s_waitcnt vmcnt(0)" ::: "memory");
    __syncthreads();
    if (leader) {
        unsigned* bar = b.bar;
        __builtin_amdgcn_s_waitcnt(0);
        unsigned nloc = b.st[0], nx = b.st[1];
        if (nloc == 0u) { xcd_barrier_complete(bar, b.x, G, nloc, nx); b.st[0] = nloc; b.st[1] = nx; }
        const unsigned old = xb_add(&bar[XB_XSUB(b.x)], 1u);
        const unsigned gen = old / nloc;
        if (old + 1u == (gen + 1u) * nloc) {
            __builtin_amdgcn_fence(__ATOMIC_RELEASE, "agent");
            asm volatile("s_waitcnt vmcnt(0)" ::: "memory");
            const unsigned og = xb_add(&bar[XB_TOP], 1u);
            const unsigned tg = og / nx;
            if (og + 1u == (tg + 1u) * nx) xb_add(&bar[XB_TOPGEN], 1u);
            else XB_SPIN(xb_ld(&bar[XB_TOPGEN]) == tg, bar);
            __builtin_amdgcn_fence(__ATOMIC_ACQUIRE, "agent");
            xb_add(&bar[XB_XGEN(b.x)], 1u);
            asm volatile("s_waitcnt vmcnt(0)" ::: "memory");
        } else {
            XB_SPIN(xb_ld(&bar[XB_XGEN(b.x)]) == gen, bar);
            __builtin_amdgcn_fence(__ATOMIC_ACQUIRE, "agent");
            asm volatile("s_waitcnt vmcnt(0)" ::: "memory");
        }
    }
    __syncthreads();
}

__device__ __forceinline__ unsigned pg8c(float lo, float hi) { unsigned r; asm volatile("v_cvt_pk_bf16_f32 %0, %1, %2" : "=v"(r) : "v"(lo), "v"(hi)); return r; }
__device__ __forceinline__ bf16x8 pack8s(float a0, float a1, float a2, float a3, float a4, float a5, float a6, float a7) {
    u32x4 p;
    asm volatile("v_cvt_pk_bf16_f32 %0, %4, %5\n\tv_cvt_pk_bf16_f32 %1, %6, %7\n\tv_cvt_pk_bf16_f32 %2, %8, %9\n\tv_cvt_pk_bf16_f32 %3, %10, %11\n\ts_nop 1"
                 : "=&v"(p[0]), "=&v"(p[1]), "=&v"(p[2]), "=&v"(p[3]) : "v"(a0), "v"(a1), "v"(a2), "v"(a3), "v"(a4), "v"(a5), "v"(a6), "v"(a7));
    return __builtin_bit_cast(bf16x8, p);
}
struct TrItem { const float* src; int ld; int nk; bf16* dst; int K; const float* kscale = nullptr; };
__device__ __forceinline__ void tr_load(const TrItem& t, f32x4 (&v)[8], int lane) {
#pragma unroll
    for (int i = 0; i < 8; ++i) { const int kk = (lane >> 3) + 8 * i; v[i] = (f32x4){0.f, 0.f, 0.f, 0.f}; if (t.src && kk < t.nk) { v[i] = *(const f32x4*)(t.src + (size_t)kk * t.ld + 4 * (lane & 7)); if (t.kscale) v[i] = v[i] * t.kscale[kk]; } }
}
__device__ __forceinline__ void tr_store(const TrItem& t, const f32x4 (&v)[8], LAS float* scr, int lane) {
#pragma unroll
    for (int i = 0; i < 8; ++i) { LAS float* d = scr + ((lane >> 3) + 8 * i) * 33 + 4 * (lane & 7); d[0] = v[i][0]; d[1] = v[i][1]; d[2] = v[i][2]; d[3] = v[i][3]; }
    asm volatile("s_waitcnt lgkmcnt(0)" ::: "memory");
    const int c = lane & 7;
#pragma unroll
    for (int j = 0; j < 4; ++j) { const int n = (lane >> 3) + 8 * j; const LAS float* s = scr + (8 * c) * 33 + n;
        u32x4 o; o.x = pg8c(s[0 * 33], s[1 * 33]); o.y = pg8c(s[2 * 33], s[3 * 33]); o.z = pg8c(s[4 * 33], s[5 * 33]); o.w = pg8c(s[6 * 33], s[7 * 33]);
        *(u32x4*)(t.dst + (size_t)n * t.K + 8 * c) = o; }
    asm volatile("s_waitcnt lgkmcnt(0)" ::: "memory");
}
template <class Mk> __device__ __forceinline__ void conv_run(Ctx& C, int nitems, const Mk& mk, LAS float* scr) {
    const int lane = lane_now(); int it = C.gw; if (it >= nitems) return;
    TrItem cur = mk(it); f32x4 v[8]; tr_load(cur, v, lane);
    for (;;) { const int nit = it + C.ngw; const bool more = nit < nitems; TrItem nxt = cur; f32x4 w[8];
        if (more) { nxt = mk(nit); tr_load(nxt, w, lane); }
        tr_store(cur, v, scr, lane);
        if (!more) break;
        cur = nxt; it = nit;
#pragma unroll
        for (int i = 0; i < 8; ++i) v[i] = w[i]; }
}
__device__ __forceinline__ void conv_natural(Ctx& C, const float* W, int K, int N, bf16* Wt, LAS float* scr) {
    const int nkb = K / 64;
    conv_run(C, (N / 32) * nkb, [=](int it) { const int j32 = it / nkb, kb = it % nkb; return TrItem{W + (size_t)(kb * 64) * N + j32 * 32, N, 64, Wt + (size_t)(j32 * 32) * K + kb * 64, K}; }, scr);
}
__device__ __forceinline__ void conv_win(Ctx& C, LAS float* scr) {
    const float* W = C.ka->in[2]; bf16* Wt = (bf16*)(C.ws + WS_WIN); const int nkb = D / 64;
    conv_run(C, (N1 / 32) * nkb, [=](int it) { const int j32 = it / nkb, kb = it % nkb; const int j = j32 * 32, ac = tperm(j);
        int wc; if (j < NQKV) wc = ac; else if (j < N1A) { const int zc = ac - NQKV; wc = zc < NZR_REAL ? NQKV + zc : -1; } else wc = NQKV + NZR_REAL + (ac - N1A);
        return TrItem{wc >= 0 ? W + (size_t)(kb * 64) * IN_W + wc : nullptr, IN_W, 64, Wt + (size_t)j * D + kb * 64, D}; }, scr);
}
__device__ __forceinline__ void conv_wlora(Ctx& C, LAS float* scr) {
    bf16* Wt = (bf16*)(C.ws + WS_WLORA); const float* w_d = C.ka->in[9]; const float* w_i = C.ka->in[11]; const float* w_g = C.ka->in[12]; const int nkb = KL2 / 64;
    conv_run(C, (NL / 32) * nkb, [=](int it) { const int j32 = it / nkb, kb = it % nkb; const int j = j32 * 32; const float* src = nullptr; int nk = 64;
        if (j < 4096) { const int ac = tperm(j); if (ac < 2048) { if (kb == 0) src = w_d + (size_t)(ac >> 10) * 64 * RW + (ac & 1023); } else { if (kb == 1) src = w_i + (size_t)((ac - 2048) >> 10) * 64 * RW + (ac & 1023); } }
        else { const int c = tperm(j - 4096); if (kb < 2) src = w_g + (size_t)(kb * 64) * RW + c; else if (kb == 2) { src = w_g + (size_t)128 * RW + c; nk = 32; } }
        return TrItem{src, RW, nk, Wt + (size_t)j * KL2 + kb * 64, KL2}; }, scr);
}
__device__ __forceinline__ void conv_wgu(Ctx& C, LAS float* scr) {
    bf16* Wt = (bf16*)(C.ws + WS_WGU); const float* wg = C.ka->in[22]; const float* wu = C.ka->in[23]; const float* nw2 = C.ka->in[21]; const int nkb = D / 64;
    conv_run(C, (2 * FF / 32) * nkb, [=](int it) { const int j32 = it / nkb, kb = it % nkb; const int j = j32 * 32, p = j >> 8, lc = j & 255;
        const float* W = (lc >= 128) ? wu : wg; const int hc = 128 * p + (lc & 127);
        return TrItem{W + (size_t)(kb * 64) * FF + hc, FF, 64, Wt + (size_t)j * D + kb * 64, D, nw2 + kb * 64}; }, scr);
}

__device__ __forceinline__ void rms_row(const float* xrow, const float* w, bf16* orow, int lane) {
    f32x4 v[8]; float ss = 0.f;
#pragma unroll
    for (int j = 0; j < 8; ++j) { v[j] = ((const f32x4*)xrow)[lane + 64 * j]; ss += (v[j].x * v[j].x + v[j].y * v[j].y) + (v[j].z * v[j].z + v[j].w * v[j].w); }
    ss = wave_sum(ss); const float rs = 1.0f / sqrtf(ss * (1.0f / D) + 1e-6f);
#pragma unroll
    for (int j = 0; j < 8; ++j) { const f32x4 w4 = ((const f32x4*)w)[lane + 64 * j]; u32x2 o; o.x = pk2(v[j].x * rs * w4.x, v[j].y * rs * w4.y); o.y = pk2(v[j].z * rs * w4.z, v[j].w * rs * w4.w);
        ((u32x2*)orow)[lane + 64 * j] = o; }
}

template <class Epi>
__device__ __forceinline__ void gemm_simple(Ctx& C, const bf16* A, const bf16* Bt, int N, int K, const Epi& epi) {
    const int lane_ = lane_now(), tid_ = C.wave * 64 + lane_; (void)tid_;
    const int lane = lane_, fr = lane & 15, fq = lane >> 4;
    const int ntn = N / 32; const long ntiles = (long)ntn * (S / 32);
    for (long it = C.gw; it < ntiles; it += C.ngw) {
        const int m0 = (int)(it / ntn) * 32, n0 = (int)(it % ntn) * 32;
        const bf16* ap = A + (size_t)(m0 + fr) * K + 8 * fq; const bf16* bp = Bt + (size_t)(n0 + fr) * K + 8 * fq;
        f32x4 acc[2][2];
#pragma unroll
        for (int i = 0; i < 2; ++i)
#pragma unroll
            for (int j = 0; j < 2; ++j) acc[i][j] = (f32x4){0.f, 0.f, 0.f, 0.f};
#pragma unroll 4
        for (int k = 0; k < K; k += 32) {
            const bf16x8 a0 = *(const bf16x8*)(ap + k), a1 = *(const bf16x8*)(ap + (size_t)16 * K + k);
            const bf16x8 b0 = *(const bf16x8*)(bp + k), b1 = *(const bf16x8*)(bp + (size_t)16 * K + k);
            acc[0][0] = __builtin_amdgcn_mfma_f32_16x16x32_bf16(b0, a0, acc[0][0], 0, 0, 0);
            acc[0][1] = __builtin_amdgcn_mfma_f32_16x16x32_bf16(b1, a0, acc[0][1], 0, 0, 0);
            acc[1][0] = __builtin_amdgcn_mfma_f32_16x16x32_bf16(b0, a1, acc[1][0], 0, 0, 0);
            acc[1][1] = __builtin_amdgcn_mfma_f32_16x16x32_bf16(b1, a1, acc[1][1], 0, 0, 0);
        }
#pragma unroll
        for (int i = 0; i < 2; ++i)
#pragma unroll
            for (int j = 0; j < 2; ++j) epi(m0 + 16 * i + fr, n0 + 16 * j + 4 * fq, acc[i][j]);
    }
}
__device__ __forceinline__ void gemm_simple_ffn1(Ctx& C, const bf16* A, const bf16* Bt, bf16* hid) {
    const int lane_ = lane_now(), tid_ = C.wave * 64 + lane_; (void)tid_;
    const int lane = lane_, fr = lane & 15, fq = lane >> 4, K = D;
    const int ntn = FF / 32; const long ntiles = (long)ntn * (S / 32);
    for (long it = C.gw; it < ntiles; it += C.ngw) {
        const int m0 = (int)(it / ntn) * 32, h0 = (int)(it % ntn) * 32, n0 = 256 * (h0 >> 7) + (h0 & 127);
        const bf16* ap = A + (size_t)(m0 + fr) * K + 8 * fq; const bf16* bp = Bt + (size_t)(n0 + fr) * K + 8 * fq;
        f32x4 ag[2][2], au[2][2];
#pragma unroll
        for (int i = 0; i < 2; ++i)
#pragma unroll
            for (int j = 0; j < 2; ++j) { ag[i][j] = (f32x4){0.f, 0.f, 0.f, 0.f}; au[i][j] = (f32x4){0.f, 0.f, 0.f, 0.f}; }
#pragma unroll 2
        for (int k = 0; k < K; k += 32) {
            const bf16x8 a0 = *(const bf16x8*)(ap + k), a1 = *(const bf16x8*)(ap + (size_t)16 * K + k);
            const bf16x8 g0 = *(const bf16x8*)(bp + k), g1 = *(const bf16x8*)(bp + (size_t)16 * K + k);
            const bf16x8 u0 = *(const bf16x8*)(bp + (size_t)128 * K + k), u1 = *(const bf16x8*)(bp + (size_t)144 * K + k);
            ag[0][0] = __builtin_amdgcn_mfma_f32_16x16x32_bf16(g0, a0, ag[0][0], 0, 0, 0); ag[0][1] = __builtin_amdgcn_mfma_f32_16x16x32_bf16(g1, a0, ag[0][1], 0, 0, 0);
            ag[1][0] = __builtin_amdgcn_mfma_f32_16x16x32_bf16(g0, a1, ag[1][0], 0, 0, 0); ag[1][1] = __builtin_amdgcn_mfma_f32_16x16x32_bf16(g1, a1, ag[1][1], 0, 0, 0);
            au[0][0] = __builtin_amdgcn_mfma_f32_16x16x32_bf16(u0, a0, au[0][0], 0, 0, 0); au[0][1] = __builtin_amdgcn_mfma_f32_16x16x32_bf16(u1, a0, au[0][1], 0, 0, 0);
            au[1][0] = __builtin_amdgcn_mfma_f32_16x16x32_bf16(u0, a1, au[1][0], 0, 0, 0); au[1][1] = __builtin_amdgcn_mfma_f32_16x16x32_bf16(u1, a1, au[1][1], 0, 0, 0);
        }
#pragma unroll
        for (int i = 0; i < 2; ++i)
#pragma unroll
            for (int j = 0; j < 2; ++j) { const int row = m0 + 16 * i + fr, hc = h0 + 16 * j + 4 * fq; const f32x4 g = ag[i][j], u = au[i][j]; float o[4];
#pragma unroll
                for (int e = 0; e < 4; ++e) o[e] = g[e] * sigmoidf_(g[e]) * u[e];
                u32x2 w; w.x = pk2(o[0], o[1]); w.y = pk2(o[2], o[3]); *(u32x2*)(hid + (size_t)row * FF + hc) = w; }
    }
}


namespace pg8 {
#define PG8_LAS __attribute__((address_space(3)))
typedef unsigned short bf16_t;
constexpr int BM = 256, BK = 64, HALF = 128, HTB = HALF * BK * 2, STAGE_BYTES = 8 * HTB, NXCD = 8, WGM = 4;
__host__ __device__ __forceinline__ int lds_byte(int r, int c) { const int st = (r >> 4) * 2 + (c >> 5), rr = r & 15, cc = c & 31, ob = rr * 64 + cc * 2; return st * 1024 + (ob ^ (((ob >> 9) & 1) << 5)); }
__host__ __device__ __forceinline__ void stage_rc(int b, int& R, int& C) { const int st = b / 1024, sb = b % 1024, swz = sb ^ (((sb >> 9) & 1) << 5); R = (st >> 1) * 16 + swz / 64; C = (st & 1) * 32 + (swz % 64) / 2; }
__host__ __device__ __forceinline__ int perm32(int rho) { const int n = rho >> 4, i = rho & 15; return 8 * (i >> 2) + 4 * n + (i & 3); }
struct Unit { int pm, pn; };
struct Gemm { const bf16_t* A; const bf16_t* Bt; int M, N, K; };
struct StaticOrder {
    int nM, nN, nwg, G, c;
    __host__ __device__ void init(int M, int N, int G_, int c_) { nM = M / BM; nN = N / BM; nwg = nM * nN; G = G_; c = c_; }
    __host__ __device__ bool next(int i, Unit& u) const {
        const long L = (long)i * G + c; if (L >= nwg) return false;
        int wgid = (int)L; { const int q = nwg / NXCD, r = nwg % NXCD, xcd = wgid % NXCD, off = wgid / NXCD; wgid = (xcd < r ? xcd * (q + 1) : r * (q + 1) + (xcd - r) * q) + off; }
        const int nig = WGM * nN, gid = wgid / nig, fm = gid * WGM, gsz = (nM - fm) < WGM ? (nM - fm) : WGM;
        u.pm = fm + ((wgid % nig) % gsz); u.pn = (wgid % nig) / gsz; return true;
    }
    __device__ __forceinline__ void a_ready(const Unit&) const {}
    __device__ __forceinline__ void done(const Unit&) const {}
};
__device__ __forceinline__ unsigned cvt_pk_bf16(float lo, float hi) { unsigned r; asm volatile("v_cvt_pk_bf16_f32 %0, %1, %2" : "=v"(r) : "v"(lo), "v"(hi)); return r; }
template <class Epi, class Sched, bool ALIGN_EPI = false, bool SP2 = false>
__device__ __forceinline__ void gemm_phase(PG8_LAS unsigned char* lds, const Gemm g, const Sched& S, const Epi& E, const int wid) {
    const int lane = lane_now(), tid = wid * 64 + lane, wr = wid >> 2, wc = wid & 3, fr = lane & 15, fq = lane >> 4;
    const int K = g.K, nt = K / BK;
    unsigned voffA[2], voffB[2];
#pragma unroll
    for (int i = 0; i < 2; ++i) { int R, C; stage_rc(tid * 16 + i * 8192, R, C); const int Rb = Epi::PERM ? ((R & ~31) + perm32(R & 31)) : R;
        voffA[i] = (unsigned)(R * K + C) * 2u; voffB[i] = (unsigned)(Rb * K + C) * 2u; }
    const size_t kstep = (size_t)(BK * 2);
    const size_t hstep = (size_t)HALF * K * 2;
    const size_t tstep = 2 * hstep;
    const unsigned ldsw = (unsigned)wid * 1024u;
    const int aoff = lds_byte(wr * 64 + fr, fq * 8), boff = lds_byte(wc * 32 + fr, fq * 8);
#define PG8_SA(b, h) (((b) * 2 + (h)) * HTB)
#define PG8_SB(b, h) ((4 + (b) * 2 + (h)) * HTB)
#define PG8_STAGE(bufoff, gbase, voff) do { _Pragma("unroll") for (int _i = 0; _i < 2; ++_i) \
        __builtin_amdgcn_global_load_lds((const unsigned*)((const char*)(gbase) + (voff)[_i]), (PG8_LAS unsigned*)(lds + (bufoff) + ldsw + _i * 8192), 16, 0, 0); } while (0)
#define PG8_LDA(dst, b, h) do { _Pragma("unroll") for (int m = 0; m < 4; ++m) _Pragma("unroll") for (int k = 0; k < 2; ++k) dst[m][k] = *(const PG8_LAS bf16x8*)(lds + PG8_SA(b, h) + aoff + m * 2048 + k * 1024); } while (0)
#define PG8_LDB(dst, b, h) do { _Pragma("unroll") for (int n = 0; n < 2; ++n) _Pragma("unroll") for (int k = 0; k < 2; ++k) dst[n][k] = *(const PG8_LAS bf16x8*)(lds + PG8_SB(b, h) + boff + n * 2048 + k * 1024); } while (0)
#define PG8_MMA(ai, bj, At, Bt) do { __builtin_amdgcn_s_setprio(1); _Pragma("unroll") for (int m = 0; m < 4; ++m) _Pragma("unroll") for (int n = 0; n < 2; ++n) _Pragma("unroll") for (int k = 0; k < 2; ++k) \
        acc[ai][bj][m][n] = __builtin_amdgcn_mfma_f32_16x16x32_bf16(Bt[n][k], At[m][k], acc[ai][bj][m][n], 0, 0, 0); __builtin_amdgcn_s_setprio(0); } while (0)
#define PG8_WAIT_V(n) asm volatile("s_waitcnt vmcnt(" #n ")" ::: "memory")
#define PG8_WAIT_L(n) asm volatile("s_waitcnt lgkmcnt(" #n ")" ::: "memory")
#define PG8_BAR __builtin_amdgcn_s_barrier()
#define PG8_SCHED __builtin_amdgcn_sched_barrier(0)
    Unit cur, nxt; int ui = 0;
    if (!S.next(0, cur)) return;
    f32x4 acc[2][2][4][2];
#pragma unroll
    for (int a = 0; a < 2; ++a)
#pragma unroll
        for (int b = 0; b < 2; ++b)
#pragma unroll
            for (int m = 0; m < 4; ++m)
#pragma unroll
                for (int n = 0; n < 2; ++n) acc[a][b][m][n] = (f32x4){0.f, 0.f, 0.f, 0.f};
    bf16x8 At[4][2], B0[2][2], B1[2][2];
    const char* cA = (const char*)g.A + (size_t)cur.pm * tstep; const char* cB = (const char*)g.Bt + (size_t)cur.pn * tstep;
    S.a_ready(cur);
    if constexpr (SP2) {
        PG8_STAGE(PG8_SB(0, 0), cB, voffB); PG8_STAGE(PG8_SB(0, 1), cB + hstep, voffB); PG8_STAGE(PG8_SA(0, 0), cA, voffA); PG8_STAGE(PG8_SA(0, 1), cA + hstep, voffA);
        if (wr == 1) PG8_BAR;
        PG8_WAIT_V(2); PG8_BAR;
        PG8_STAGE(PG8_SB(1, 0), cB + kstep, voffB); PG8_STAGE(PG8_SA(1, 0), cA + kstep, voffA); PG8_STAGE(PG8_SB(1, 1), cB + hstep + kstep, voffB);
        PG8_WAIT_V(6); PG8_BAR;
    } else {
        PG8_STAGE(PG8_SB(0, 0), cB, voffB); PG8_STAGE(PG8_SA(0, 0), cA, voffA); PG8_STAGE(PG8_SB(0, 1), cB + hstep, voffB); PG8_STAGE(PG8_SA(0, 1), cA + hstep, voffA);
        if (wr == 1) PG8_BAR;
        PG8_WAIT_V(4); PG8_BAR;
        PG8_STAGE(PG8_SB(1, 0), cB + kstep, voffB); PG8_STAGE(PG8_SA(1, 0), cA + kstep, voffA); PG8_STAGE(PG8_SB(1, 1), cB + hstep + kstep, voffB);
        PG8_WAIT_V(6); PG8_BAR;
    }
    for (;;) {
        const bool has_next = S.next(ui + 1, nxt);
        const char* nA = has_next ? (const char*)g.A + (size_t)nxt.pm * tstep : cA; const char* nB = has_next ? (const char*)g.Bt + (size_t)nxt.pn * tstep : cB;
        for (int t = 0; t < nt; t += 2) {
            const bool last = (t == nt - 2);
            const char* a1 = cA + (size_t)(t + 1) * kstep;
            const char* a2 = last ? nA : cA + (size_t)(t + 2) * kstep; const char* b2 = last ? nB : cB + (size_t)(t + 2) * kstep;
            const char* a3 = a2 + kstep; const char* b3 = b2 + kstep;
            if (last && has_next) S.a_ready(nxt);
            if constexpr (SP2) {
            PG8_LDB(B0, 0, 0); PG8_LDB(B1, 0, 1); PG8_SCHED; PG8_LDA(At, 0, 0); PG8_STAGE(PG8_SA(1, 1), a1 + hstep, voffA);
            PG8_WAIT_V(8); PG8_WAIT_L(0); PG8_BAR; PG8_MMA(0, 0, At, B0); PG8_MMA(0, 1, At, B1); PG8_BAR; PG8_SCHED;
            PG8_LDA(At, 0, 1); PG8_STAGE(PG8_SB(0, 0), b2, voffB); PG8_STAGE(PG8_SB(0, 1), b2 + hstep, voffB); PG8_STAGE(PG8_SA(0, 0), a2, voffA);
            PG8_WAIT_V(8); PG8_WAIT_L(0); PG8_BAR; PG8_MMA(1, 0, At, B0); PG8_MMA(1, 1, At, B1); PG8_BAR; PG8_SCHED;
            PG8_LDB(B0, 1, 0); PG8_LDB(B1, 1, 1); PG8_SCHED; PG8_LDA(At, 1, 0); PG8_STAGE(PG8_SA(0, 1), a2 + hstep, voffA);
            PG8_WAIT_V(8); PG8_WAIT_L(0); PG8_BAR; PG8_MMA(0, 0, At, B0); PG8_MMA(0, 1, At, B1); PG8_BAR; PG8_SCHED;
            PG8_LDA(At, 1, 1); PG8_STAGE(PG8_SB(1, 0), b3, voffB); PG8_STAGE(PG8_SB(1, 1), b3 + hstep, voffB); PG8_STAGE(PG8_SA(1, 0), a3, voffA);
            PG8_WAIT_V(8); PG8_WAIT_L(0); PG8_BAR; PG8_MMA(1, 0, At, B0); PG8_MMA(1, 1, At, B1); PG8_BAR; PG8_SCHED;
            } else {
            PG8_LDB(B0, 0, 0); PG8_SCHED; PG8_LDA(At, 0, 0); PG8_STAGE(PG8_SA(1, 1), a1 + hstep, voffA);
            PG8_WAIT_L(8); PG8_BAR; PG8_WAIT_L(0); PG8_MMA(0, 0, At, B0); PG8_BAR; PG8_SCHED;
            PG8_LDB(B1, 0, 1); PG8_STAGE(PG8_SB(0, 0), b2, voffB);
            PG8_BAR; PG8_WAIT_L(0); PG8_MMA(0, 1, At, B1); PG8_BAR;
            PG8_LDA(At, 0, 1); PG8_STAGE(PG8_SA(0, 0), a2, voffA);
            PG8_BAR; PG8_WAIT_L(0); PG8_MMA(1, 0, At, B0); PG8_BAR; PG8_SCHED;
            PG8_STAGE(PG8_SB(0, 1), b2 + hstep, voffB);
            PG8_WAIT_V(6); PG8_BAR; PG8_MMA(1, 1, At, B1); PG8_BAR;
            PG8_LDB(B0, 1, 0); PG8_SCHED; PG8_LDA(At, 1, 0); PG8_STAGE(PG8_SA(0, 1), a2 + hstep, voffA);
            PG8_WAIT_L(8); PG8_BAR; PG8_WAIT_L(0); PG8_MMA(0, 0, At, B0); PG8_BAR; PG8_SCHED;
            PG8_LDB(B1, 1, 1); PG8_STAGE(PG8_SB(1, 0), b3, voffB);
            PG8_BAR; PG8_WAIT_L(0); PG8_MMA(0, 1, At, B1); PG8_BAR;
            PG8_LDA(At, 1, 1); PG8_STAGE(PG8_SA(1, 0), a3, voffA);
            PG8_BAR; PG8_WAIT_L(0); PG8_MMA(1, 0, At, B0); PG8_BAR; PG8_SCHED;
            PG8_STAGE(PG8_SB(1, 1), b3 + hstep, voffB);
            PG8_WAIT_V(6); PG8_BAR; PG8_MMA(1, 1, At, B1); PG8_BAR;
            }
        }
        if constexpr (ALIGN_EPI) { if (wr == 0) PG8_BAR; }
        if constexpr (!Epi::AFTER_DRAIN) { int fr_e = fr, fq_e = fq; asm volatile("" : "+v"(fr_e), "+v"(fq_e)); E(acc, cur, wr, wc, fr_e, fq_e); S.done(cur); }
        if (!has_next) break;
#pragma unroll
        for (int a = 0; a < 2; ++a)
#pragma unroll
            for (int b = 0; b < 2; ++b)
#pragma unroll
                for (int m = 0; m < 4; ++m)
#pragma unroll
                    for (int n = 0; n < 2; ++n) acc[a][b][m][n] = (f32x4){0.f, 0.f, 0.f, 0.f};
        cur = nxt; cA = nA; cB = nB; ++ui;
        if constexpr (ALIGN_EPI) { if (wr == 1) PG8_BAR; }
    }
    PG8_WAIT_V(0);
    if constexpr (!ALIGN_EPI) { if (wr == 0) PG8_BAR; }
    PG8_BAR;
    if constexpr (Epi::AFTER_DRAIN) { E.fused(acc, cur, wr, wc, fr, fq, lds, wid, lane); S.done(cur); }
#undef PG8_SA
#undef PG8_SB
#undef PG8_STAGE
#undef PG8_LDA
#undef PG8_LDB
#undef PG8_MMA
#undef PG8_WAIT_V
#undef PG8_WAIT_L
#undef PG8_BAR
#undef PG8_SCHED
}
}


#ifndef OPT_GEMM
#define OPT_GEMM 1
#endif
typedef f32x4 AccT[2][2][4][2];
#ifndef NT_EPI
#define NT_EPI 0
#endif
#if NT_EPI
#define NTST4(p, v) __builtin_nontemporal_store((v), (u32x4*)(p))
#else
#define NTST4(p, v) (*(u32x4*)(p) = (v))
#endif
__device__ __forceinline__ u32x4 pack8(f32x4 a, f32x4 b) { u32x4 w; w.x = pg8::cvt_pk_bf16(a[0], a[1]); w.y = pg8::cvt_pk_bf16(a[2], a[3]); w.z = pg8::cvt_pk_bf16(b[0], b[1]); w.w = pg8::cvt_pk_bf16(b[2], b[3]); return w; }
__device__ __forceinline__ void unpack8(u32x4 w, float (&f)[8]) { f[0] = __uint_as_float(w.x << 16); f[1] = __uint_as_float(w.x & 0xffff0000u); f[2] = __uint_as_float(w.y << 16); f[3] = __uint_as_float(w.y & 0xffff0000u);
    f[4] = __uint_as_float(w.z << 16); f[5] = __uint_as_float(w.z & 0xffff0000u); f[6] = __uint_as_float(w.w << 16); f[7] = __uint_as_float(w.w & 0xffff0000u); }
struct EpiG1A8 { static constexpr bool PERM = true, AFTER_DRAIN = false; bf16* zqkv; bf16* zr; const float* qw; const float* kw;
    __device__ __forceinline__ void operator()(const AccT& acc, const pg8::Unit& u, int wr, int wc, int fr, int fq) const {
        const int row0 = u.pm * 256 + wr * 64 + fr, acb = u.pn * 256 + wc * 64 + 8 * fq;
        if (u.pn < 12) {
            const float* nw = u.pn < 6 ? qw : kw; const float sc = u.pn < 6 ? 0.125f : 1.0f; f32x4 w[2][2];
#pragma unroll
            for (int bj = 0; bj < 2; ++bj)
#pragma unroll
                for (int n = 0; n < 2; ++n) w[bj][n] = *(const f32x4*)(nw + 32 * bj + 8 * fq + 4 * n) * sc;
#pragma unroll
            for (int ai = 0; ai < 2; ++ai)
#pragma unroll
                for (int m = 0; m < 4; ++m) { float ss = 0.f;
#pragma unroll
                    for (int bj = 0; bj < 2; ++bj)
#pragma unroll
                        for (int n = 0; n < 2; ++n) { const f32x4 x = acc[ai][bj][m][n]; ss += (x[0] * x[0] + x[1] * x[1]) + (x[2] * x[2] + x[3] * x[3]); }
                    ss += __shfl_xor(ss, 16); ss += __shfl_xor(ss, 32);
                    const float rs = 1.0f / sqrtf(ss * (1.0f / 64.f) + 1e-6f);
                    bf16* rp = zqkv + (size_t)(row0 + ai * 128 + m * 16) * NQKV + acb;
#pragma unroll
                    for (int bj = 0; bj < 2; ++bj) NTST4(rp + 32 * bj, pack8(acc[ai][bj][m][0] * rs * w[bj][0], acc[ai][bj][m][1] * rs * w[bj][1])); }
        } else {
            bf16* base = u.pn < 18 ? zqkv + acb : zr + (acb - NQKV); const int ld = u.pn < 18 ? NQKV : NZR;
#pragma unroll
            for (int ai = 0; ai < 2; ++ai)
#pragma unroll
                for (int m = 0; m < 4; ++m) { bf16* rp = base + (size_t)(row0 + ai * 128 + m * 16) * ld;
#pragma unroll
                    for (int bj = 0; bj < 2; ++bj) NTST4(rp + 32 * bj, pack8(acc[ai][bj][m][0], acc[ai][bj][m][1])); }
        }
    } };
template <int MODE> struct EpiLora8 { static constexpr bool PERM = true, AFTER_DRAIN = false; bf16* dst; const float* bias;
    __device__ __forceinline__ void operator()(const AccT& acc, const pg8::Unit& u, int wr, int wc, int fr, int fq) const {
        const int row0 = u.pm * 256 + wr * 64 + fr; const int cb = (u.pn & 3) * 256 + wc * 64 + 8 * fq; const int z = MODE == 2 ? 0 : (u.pn >> 2); f32x4 bv[2][2];
#pragma unroll
        for (int bj = 0; bj < 2; ++bj)
#pragma unroll
            for (int n = 0; n < 2; ++n) bv[bj][n] = MODE == 2 ? (f32x4){0.f, 0.f, 0.f, 0.f} : *(const f32x4*)(bias + z * RW + cb + 32 * bj + 4 * n);
#pragma unroll
        for (int ai = 0; ai < 2; ++ai)
#pragma unroll
            for (int m = 0; m < 4; ++m) { bf16* rp = dst + ((size_t)z * S + row0 + ai * 128 + m * 16) * RW + cb;
#pragma unroll
                for (int bj = 0; bj < 2; ++bj) { f32x4 o[2];
#pragma unroll
                    for (int n = 0; n < 2; ++n)
#pragma unroll
                        for (int e = 0; e < 4; ++e) { const float v = bv[bj][n][e] + acc[ai][bj][m][n][e];
                            if (MODE == 0) { const float x = -v; const float sp = fmaxf(x, 0.f) + __logf(1.0f + __expf(-fabsf(x))); o[n][e] = -__expf(-sp - 0.5f); }
                            else if (MODE == 1) o[n][e] = sigmoidf_(v); else o[n][e] = v; }
                    NTST4(rp + 32 * bj, pack8(o[0], o[1])); } }
    } };
struct LoraOrder { int G, c;
    __device__ bool next(int i, pg8::Unit& u) const { const int L = i * G + c; if (L >= 1280) return false; u.pn = L >> 6; u.pm = (L & 63) + (u.pn >= 16 ? 64 : 0); return true; }
    __device__ __forceinline__ void a_ready(const pg8::Unit&) const {}
    __device__ __forceinline__ void done(const pg8::Unit&) const {}
};
struct EpiLoraU8 { static constexpr bool PERM = true, AFTER_DRAIN = false; unsigned char* wsb; const float* w0; const float* a0;
    __device__ __forceinline__ void operator()(const AccT& acc, const pg8::Unit& u, int wr, int wc, int fr, int fq) const {
        const int row0 = (u.pm & 63) * 256 + wr * 64 + fr; const int cb = (u.pn & 3) * 256 + wc * 64 + 8 * fq; const int mode = u.pn < 8 ? 0 : (u.pn < 16 ? 1 : 2), z = mode == 2 ? 0 : ((u.pn >> 2) & 1);
        const float* bias = mode == 0 ? w0 : a0; const size_t doff = mode == 0 ? WS_LW : WS_A; bf16* dst = (bf16*)(wsb + (mode == 2 ? WS_GATE : doff)); f32x4 bv[2][2];
#pragma unroll
        for (int bj = 0; bj < 2; ++bj)
#pragma unroll
            for (int n = 0; n < 2; ++n) { bv[bj][n] = (f32x4){0.f, 0.f, 0.f, 0.f}; if (mode != 2) bv[bj][n] = *(const f32x4*)(bias + z * RW + cb + 32 * bj + 4 * n); }
#pragma unroll
        for (int ai = 0; ai < 2; ++ai)
#pragma unroll
            for (int m = 0; m < 4; ++m) { bf16* rp = dst + ((size_t)z * S + row0 + ai * 128 + m * 16) * RW + cb;
#pragma unroll
                for (int bj = 0; bj < 2; ++bj) { f32x4 o[2];
#pragma unroll
                    for (int n = 0; n < 2; ++n)
#pragma unroll
                        for (int e = 0; e < 4; ++e) { const float v = bv[bj][n][e] + acc[ai][bj][m][n][e];
                            const float sg = __builtin_amdgcn_rcpf(1.0f + __builtin_amdgcn_exp2f(v * -1.44269504f)); o[n][e] = mode == 0 ? -0.60653066f * sg : (mode == 1 ? sg : v); }
                    *(u32x4*)(rp + 32 * bj) = pack8(o[0], o[1]); } }
    } };
struct EpiG1B8 { static constexpr bool PERM = true, AFTER_DRAIN = false; bf16* zg; const float* bg;
    __device__ __forceinline__ void operator()(const AccT& acc, const pg8::Unit& u, int wr, int wc, int fr, int fq) const {
        const int row0 = u.pm * 256 + wr * 64 + fr, acb = u.pn * 256 + wc * 64 + 8 * fq; f32x4 bv[2][2];
#pragma unroll
        for (int bj = 0; bj < 2; ++bj)
#pragma unroll
            for (int n = 0; n < 2; ++n) bv[bj][n] = *(const f32x4*)(bg + acb + 32 * bj + 4 * n);
#pragma unroll
        for (int ai = 0; ai < 2; ++ai)
#pragma unroll
            for (int m = 0; m < 4; ++m) { bf16* rp = zg + (size_t)(row0 + ai * 128 + m * 16) * NGATE + acb;
#pragma unroll
                for (int bj = 0; bj < 2; ++bj) { f32x4 o[2];
#pragma unroll
                    for (int n = 0; n < 2; ++n)
#pragma unroll
                        for (int e = 0; e < 4; ++e) o[n][e] = sigmoidf_(acc[ai][bj][m][n][e] + bv[bj][n][e]);
                    NTST4(rp + 32 * bj, pack8(o[0], o[1])); } }
    } };
template <bool SECOND> struct EpiMerge8 { static constexpr bool PERM = true, AFTER_DRAIN = false; bf16* mg; const bf16* zg;
    __device__ __forceinline__ void operator()(const AccT& acc, const pg8::Unit& u, int wr, int wc, int fr, int fq) const {
        const int row0 = u.pm * 256 + wr * 64 + fr, col0 = u.pn * 256 + wc * 32 + 8 * fq;
#pragma unroll
        for (int ai = 0; ai < 2; ++ai)
#pragma unroll
            for (int m = 0; m < 4; ++m) { const int row = row0 + ai * 128 + m * 16;
#pragma unroll
                for (int bj = 0; bj < 2; ++bj) { const int col = col0 + 128 * bj; float g[8]; unpack8(*(const u32x4*)(zg + (size_t)row * NGATE + (SECOND ? D : 0) + col), g); f32x4 o[2];
                    float t[8]; if (SECOND) unpack8(*(const u32x4*)(mg + (size_t)row * D + col), t);
#pragma unroll
                    for (int n = 0; n < 2; ++n)
#pragma unroll
                        for (int e = 0; e < 4; ++e) o[n][e] = (SECOND ? t[4 * n + e] : 0.f) + g[4 * n + e] * acc[ai][bj][m][n][e];
                    *(u32x4*)(mg + (size_t)row * D + col) = pack8(o[0], o[1]); } }
    } };
struct EpiRes8 { static constexpr bool PERM = false, AFTER_DRAIN = false; const float* base; float* out;
    __device__ __forceinline__ void operator()(const AccT& acc, const pg8::Unit& u, int wr, int wc, int fr, int fq) const {
        const int row0 = u.pm * 256 + wr * 64 + fr, col0 = u.pn * 256 + wc * 32 + 4 * fq;
#pragma unroll
        for (int ai = 0; ai < 2; ++ai)
#pragma unroll
            for (int m = 0; m < 4; ++m) { const size_t off = (size_t)(row0 + ai * 128 + m * 16) * D + col0;
#pragma unroll
                for (int bj = 0; bj < 2; ++bj)
#pragma unroll
                    for (int n = 0; n < 2; ++n) { const f32x4 b = *(const f32x4*)(base + off + bj * 128 + n * 16); *(f32x4*)(out + off + bj * 128 + n * 16) = b + acc[ai][bj][m][n]; } }
    } };
struct EpiX2b8 { static constexpr bool PERM = true, AFTER_DRAIN = false; const float* base; bf16* xb; float* ssqp;
    __device__ __forceinline__ void operator()(const AccT& acc, const pg8::Unit& u, int wr, int wc, int fr, int fq) const {
        const int row0 = u.pm * 256 + wr * 64 + fr, col0 = u.pn * 256 + wc * 32 + 8 * fq;
#pragma unroll
        for (int ai = 0; ai < 2; ++ai)
#pragma unroll
            for (int m = 0; m < 4; ++m) { const int row = row0 + ai * 128 + m * 16; const size_t off = (size_t)row * D + col0; float ss = 0.f;
#pragma unroll
                for (int bj = 0; bj < 2; ++bj) { const f32x4 b0 = *(const f32x4*)(base + off + bj * 128), b1 = *(const f32x4*)(base + off + bj * 128 + 4);
                    const f32x4 o0 = b0 + acc[ai][bj][m][0], o1 = b1 + acc[ai][bj][m][1];
                    ss += (o0[0] * o0[0] + o0[1] * o0[1]) + (o0[2] * o0[2] + o0[3] * o0[3]) + (o1[0] * o1[0] + o1[1] * o1[1]) + (o1[2] * o1[2] + o1[3] * o1[3]);
                    *(u32x4*)(xb + off + bj * 128) = pack8(o0, o1); }
                ss += __shfl_xor(ss, 16); ss += __shfl_xor(ss, 32);
                if (fq == 0) ssqp[(size_t)row * 32 + u.pn * 4 + wc] = ss; }
    } };
struct EpiResB8 { static constexpr bool PERM = false, AFTER_DRAIN = false; const bf16* xb; float* out;
    __device__ __forceinline__ void operator()(const AccT& acc, const pg8::Unit& u, int wr, int wc, int fr, int fq) const {
        const int row0 = u.pm * 256 + wr * 64 + fr, col0 = u.pn * 256 + wc * 32 + 4 * fq;
#pragma unroll
        for (int ai = 0; ai < 2; ++ai)
#pragma unroll
            for (int m = 0; m < 4; ++m) { const size_t off = (size_t)(row0 + ai * 128 + m * 16) * D + col0;
#pragma unroll
                for (int bj = 0; bj < 2; ++bj)
#pragma unroll
                    for (int n = 0; n < 2; ++n) { const u32x2 w = *(const u32x2*)(xb + off + bj * 128 + n * 16);
                        const f32x4 b = (f32x4){__uint_as_float(w.x << 16), __uint_as_float(w.x & 0xffff0000u), __uint_as_float(w.y << 16), __uint_as_float(w.y & 0xffff0000u)};
                        *(f32x4*)(out + off + bj * 128 + n * 16) = b + acc[ai][bj][m][n]; } }
    } };
struct EpiFfn18 { static constexpr bool PERM = true, AFTER_DRAIN = false; bf16* hid; const float* rstd;
    __device__ __forceinline__ void operator()(const AccT& acc, const pg8::Unit& u, int wr, int wc, int fr, int fq) const {
        const int row0 = u.pm * 256 + wr * 64 + fr, hc0 = u.pn * 128 + wc * 32 + 8 * fq;
#pragma unroll
        for (int ai = 0; ai < 2; ++ai)
#pragma unroll
            for (int m = 0; m < 4; ++m) { f32x4 o[2]; const float rs = rstd[row0 + ai * 128 + m * 16];
#pragma unroll
                for (int n = 0; n < 2; ++n)
#pragma unroll
                    for (int e = 0; e < 4; ++e) { const float g = acc[ai][0][m][n][e] * rs; o[n][e] = g * sigmoidf_(g) * (acc[ai][1][m][n][e] * rs); }
                NTST4(hid + (size_t)(row0 + ai * 128 + m * 16) * FF + hc0, pack8(o[0], o[1])); }
    } };
template <class Epi> __device__ __forceinline__ void gemm8(Ctx& C, const bf16* A, const bf16* Bt, int N, int K, const Epi& E) {
    asm volatile("" : "+s"(N), "+s"(K));
    pg8::Gemm g{A, Bt, S, N, K}; pg8::StaticOrder so; so.init(S, N, C.nb, C.bid);
    pg8::gemm_phase<Epi, pg8::StaticOrder, true, true>(C.lds, g, so, E, C.wave);
}

__device__ __forceinline__ void st4bf(bf16* p, f32x4 v) { u32x2 w; w.x = pk2(v[0], v[1]); w.y = pk2(v[2], v[3]); *(u32x2*)p = w; }
struct EpiG1A { bf16* zqkv; bf16* zr;
    __device__ __forceinline__ void operator()(int row, int j0, f32x4 v) const { const int ac = tperm(j0);
        if (ac < NQKV) st4bf(zqkv + (size_t)row * NQKV + ac, v); else st4bf(zr + (size_t)row * NZR + (ac - NQKV), v); } };
struct EpiLora { bf16* lw; bf16* a; bf16* gate; const float* w0; const float* a0;
    __device__ __forceinline__ void operator()(int row, int j0, f32x4 v) const { const int ac = tperm(j0);
        if (ac < 2048) { const int z = ac >> 10, c = ac & 1023; f32x4 o;
#pragma unroll
            for (int e = 0; e < 4; ++e) { const float x = -(w0[z * RW + c + e] + v[e]); const float sp = fmaxf(x, 0.f) + log1pf(__expf(-fabsf(x))); o[e] = -__expf(-sp - 0.5f); }
            st4bf(lw + ((size_t)z * S + row) * RW + c, o); }
        else if (ac < 4096) { const int z = (ac - 2048) >> 10, c = ac & 1023; f32x4 o;
#pragma unroll
            for (int e = 0; e < 4; ++e) o[e] = sigmoidf_(a0[z * RW + c + e] + v[e]);
            st4bf(a + ((size_t)z * S + row) * RW + c, o); }
        else st4bf(gate + (size_t)row * RW + (ac - 4096), v); } };
struct EpiG1B { bf16* zg; const float* bg;
    __device__ __forceinline__ void operator()(int row, int j0, f32x4 v) const { const int ac = tperm(j0); f32x4 o;
#pragma unroll
        for (int e = 0; e < 4; ++e) o[e] = sigmoidf_(v[e] + bg[ac + e]);
        st4bf(zg + (size_t)row * NGATE + ac, o); } };
struct EpiMA { bf16* mg; const bf16* zg;
    __device__ __forceinline__ void operator()(int row, int j0, f32x4 v) const { const u32x2 g = *(const u32x2*)(zg + (size_t)row * NGATE + j0); f32x4 o;
        o[0] = v[0] * bf2f((bf16)(g.x & 0xffff)); o[1] = v[1] * bf2f((bf16)(g.x >> 16)); o[2] = v[2] * bf2f((bf16)(g.y & 0xffff)); o[3] = v[3] * bf2f((bf16)(g.y >> 16));
        st4bf(mg + (size_t)row * D + j0, o); } };
struct EpiMB { bf16* mg; const bf16* zg;
    __device__ __forceinline__ void operator()(int row, int j0, f32x4 v) const { const u32x2 g = *(const u32x2*)(zg + (size_t)row * NGATE + D + j0); const u32x2 t = *(const u32x2*)(mg + (size_t)row * D + j0); f32x4 o;
        o[0] = bf2f((bf16)(t.x & 0xffff)) + v[0] * bf2f((bf16)(g.x & 0xffff)); o[1] = bf2f((bf16)(t.x >> 16)) + v[1] * bf2f((bf16)(g.x >> 16));
        o[2] = bf2f((bf16)(t.y & 0xffff)) + v[2] * bf2f((bf16)(g.y & 0xffff)); o[3] = bf2f((bf16)(t.y >> 16)) + v[3] * bf2f((bf16)(g.y >> 16));
        st4bf(mg + (size_t)row * D + j0, o); } };
struct EpiRes { const float* base; float* out;
    __device__ __forceinline__ void operator()(int row, int j0, f32x4 v) const { const f32x4 b = *(const f32x4*)(base + (size_t)row * D + j0); *(f32x4*)(out + (size_t)row * D + j0) = b + v; } };


#ifndef OPT_SCAN
#define OPT_SCAN 1
#endif
#ifndef OPT_SCANM
#define OPT_SCANM 1
#endif
constexpr int SC_T = 8, SC_STEPF = 384, SC_ITEMF = SC_T * SC_STEPF;
template <int CTRL> __device__ __forceinline__ float dpp_f(float x) { return __int_as_float(__builtin_amdgcn_update_dpp(0, __float_as_int(x), CTRL, 0xf, 0xf, true)); }
__device__ __forceinline__ float quad_sum(float x) { x += dpp_f<0xB1>(x); x += dpp_f<0x4E>(x); return x; }
template <int role> __device__ __forceinline__ void ph_scan1_r(Ctx& C) {
    const int lane = lane_now(), wave = C.wave, itl = wave & 3, kq = lane & 3, rg = lane >> 2;
    const int t128 = role * 64 + lane, sst = t128 >> 4, cg = t128 & 15;
    const bf16* g_r = (const bf16*)(C.ws + WS_R); const bf16* g_v = (const bf16*)(C.ws + WS_V); const bf16* g_nkk = (const bf16*)(C.ws + WS_NKK); const bf16* g_k = (const bf16*)(C.ws + WS_KRAW);
    const bf16* g_lw = (const bf16*)(C.ws + WS_LW); const bf16* g_a = (const bf16*)(C.ws + WS_A); const float* k_a = C.ka->in[14];
    bf16* g_out = role ? (bf16*)(C.ws + WS_YL) : (bf16*)(C.dout + DO_QT); float* g_pu = (float*)(C.ws + WS_PU);
    LAS float* lbase = (LAS float*)C.lds + itl * SC_ITEMF;
    const int nitems = NCHAIN * NCK;
    for (int base = C.bid * 4; base < nitems; base += C.nb * 4) {
        const int item = base + itl; const bool active = item < nitems; const int chain = active ? item / NCK : 0, chunk = active ? item % NCK : 0, z = chain >> 4, h = chain & 15;
        const size_t zoff = (size_t)z * S * RW; const int cbase = h * 64 + 4 * cg;
        const f32x4 ka4 = *(const f32x4*)(k_a + cbase);
        f32x2 st[4][8];
#pragma unroll
        for (int i = 0; i < 4; ++i)
#pragma unroll
            for (int kk = 0; kk < 8; ++kk) { const int row = 4 * rg + i, k0 = 16 * kq + 2 * kk; st[i][kk] = (f32x2){(role == 0 && row == k0) ? 1.f : 0.f, (role == 0 && row == k0 + 1) ? 1.f : 0.f}; }
        u32x2 q_nkk, q_lw, q_a, q_k, q_r, q_v;
#define SC_LOAD(blk) do { const int sg_ = chunk * CHL + (blk) * SC_T + sst; const int tk_ = z ? S - 1 - sg_ : sg_; const size_t ix_ = (size_t)tk_ * RW + cbase; \
            q_nkk = *(const u32x2*)(g_nkk + ix_); q_lw = *(const u32x2*)(g_lw + zoff + ix_); q_a = *(const u32x2*)(g_a + zoff + ix_); q_k = *(const u32x2*)(g_k + ix_); q_r = *(const u32x2*)(g_r + ix_); q_v = *(const u32x2*)(g_v + ix_); } while (0)
#define SC_BF(q, e) __uint_as_float(((e) & 1) ? (((e) >> 1) ? (q).y : (q).x) & 0xffff0000u : (((e) >> 1) ? (q).y : (q).x) << 16)
#define SC_WRITE(buf) do { LAS float* d_ = lbase + (buf) * 4 * SC_ITEMF + sst * SC_STEPF + 4 * cg; f32x4 o0, o1, o2, o3, o4, o5; \
            _Pragma("unroll") for (int e = 0; e < 4; ++e) { const float n_ = SC_BF(q_nkk, e), a_ = SC_BF(q_a, e); o0[e] = n_; o1[e] = __expf(SC_BF(q_lw, e)); o2[e] = -n_ * a_; o3[e] = SC_BF(q_k, e) * (1.0f + (a_ - 1.0f) * ka4[e]); o4[e] = SC_BF(q_r, e); o5[e] = SC_BF(q_v, e); } \
            *(LAS f32x4*)(d_) = o0; *(LAS f32x4*)(d_ + 64) = o1; *(LAS f32x4*)(d_ + 128) = o2; *(LAS f32x4*)(d_ + 192) = o3; *(LAS f32x4*)(d_ + 256) = o4; *(LAS f32x4*)(d_ + 320) = o5; } while (0)
        SC_LOAD(0); SC_WRITE(0);
        __syncthreads();
        for (int blk = 0; blk < CHL / SC_T; ++blk) {
            if (blk + 1 < CHL / SC_T) SC_LOAD(blk + 1);
            const LAS float* bp = lbase + (blk & 1) * 4 * SC_ITEMF + 16 * kq;
            f32x4 x[4];
#pragma unroll
            for (int q = 0; q < 4; ++q) x[q] = *(const LAS f32x4*)(bp + 4 * q);
#pragma unroll 2
            for (int ss = 0; ss < SC_T; ++ss) {
                const LAS float* sp = bp + ss * SC_STEPF;
                float sa[4], y[4];
                f32x4 vv = (f32x4){0.f, 0.f, 0.f, 0.f}; if (role) vv = *(const LAS f32x4*)(sp - 16 * kq + 320 + 4 * rg);
                f32x4 w4[4], b4[4], r4[4], k4[4];
#pragma unroll
                for (int q = 0; q < 4; ++q) { w4[q] = *(const LAS f32x4*)(sp + 64 + 4 * q); b4[q] = *(const LAS f32x4*)(sp + 128 + 4 * q); r4[q] = *(const LAS f32x4*)(sp + 256 + 4 * q); if (role) k4[q] = *(const LAS f32x4*)(sp + 192 + 4 * q); }
                {   f32x2 s2[4];
#pragma unroll
                    for (int i = 0; i < 4; ++i) { s2[i] = st[i][0] * (f32x2){x[0][0], x[0][1]};
#pragma unroll
                        for (int kk = 1; kk < 8; ++kk) s2[i] += st[i][kk] * (f32x2){x[kk >> 1][2 * (kk & 1)], x[kk >> 1][2 * (kk & 1) + 1]}; }
#pragma unroll
                    for (int i = 0; i < 4; ++i) sa[i] = quad_sum(s2[i].x + s2[i].y); }
                if (ss + 1 < SC_T) {
#pragma unroll
                    for (int q = 0; q < 4; ++q) x[q] = *(const LAS f32x4*)(sp + SC_STEPF + 4 * q); }
                __builtin_amdgcn_sched_barrier(0);
                f32x2 y2[4];
#pragma unroll
                for (int i = 0; i < 4; ++i) y2[i] = (f32x2){0.f, 0.f};
#pragma unroll
                for (int kk = 0; kk < 8; ++kk) { const int q = kk >> 1, o = 2 * (kk & 1); const f32x2 w2 = (f32x2){w4[q][o], w4[q][o + 1]}, b2 = (f32x2){b4[q][o], b4[q][o + 1]}, r2 = (f32x2){r4[q][o], r4[q][o + 1]};
#pragma unroll
                    for (int i = 0; i < 4; ++i) { f32x2 t2 = b2 * sa[i]; if (role) t2 += (f32x2){k4[q][o], k4[q][o + 1]} * vv[i]; st[i][kk] = st[i][kk] * w2 + t2; y2[i] += st[i][kk] * r2; } }
#pragma unroll
                for (int i = 0; i < 4; ++i) y[i] = quad_sum(y2[i].x + y2[i].y);
                if (active && kq == 0) { const int sg = chunk * CHL + blk * SC_T + ss; const int tk = z ? S - 1 - sg : sg; u32x2 o; o.x = pk2(y[0], y[1]); o.y = pk2(y[2], y[3]);
                    *(u32x2*)(g_out + zoff + (size_t)tk * RW + h * 64 + 4 * rg) = o; }
            }
            if (blk + 1 < CHL / SC_T) SC_WRITE((blk + 1) & 1);
            __syncthreads();
        }
        if (active) { float* pp = g_pu + (((size_t)chain * NCK + chunk) * 2 + role) * 4096;
#pragma unroll
            for (int i = 0; i < 4; ++i)
#pragma unroll
                for (int q = 0; q < 4; ++q) *(f32x4*)(pp + (4 * rg + i) * 64 + 16 * kq + 4 * q) = (f32x4){st[i][2 * q].x, st[i][2 * q].y, st[i][2 * q + 1].x, st[i][2 * q + 1].y}; }
#undef SC_LOAD
#undef SC_BF
#undef SC_WRITE
    }
}
__device__ __forceinline__ void ph_scan1(Ctx& C) { if (C.wave >> 2) ph_scan1_r<1>(C); else ph_scan1_r<0>(C); }
__device__ __forceinline__ float rdlane(float x, int l) { return __int_as_float(__builtin_amdgcn_readlane(__float_as_int(x), l)); }
__device__ __forceinline__ void ph_scan2(Ctx& C) {
    const int lane = lane_now(); const float* g_pu = (const float*)(C.ws + WS_PU); float* g_s0 = (float*)(C.ws + WS_S0);
    for (int task = C.bid; task < NCHAIN * 8; task += C.nb) { const int chain = task >> 3, row = (task & 7) * 8 + C.wave;
        float sv = 0.f; float pc[64], uc;
        { const float* P = g_pu + ((size_t)chain * NCK) * 8192;
#pragma unroll
          for (int k = 0; k < 64; ++k) pc[k] = P[k * 64 + lane];
          uc = P[4096 + row * 64 + lane]; }
#pragma unroll 1
        for (int c = 0; c < NCK; ++c) { const float* P = g_pu + ((size_t)chain * NCK + (c + 1 < NCK ? c + 1 : c)) * 8192;
            float pn[64], un;
#pragma unroll
            for (int k = 0; k < 64; ++k) pn[k] = P[k * 64 + lane];
            un = P[4096 + row * 64 + lane];
            g_s0[(((size_t)chain * NCK + c) * 64 + row) * 64 + lane] = sv;
            float acc0 = uc, acc1 = 0.f;
#pragma unroll
            for (int k = 0; k < 64; k += 2) { acc0 += rdlane(sv, k) * pc[k]; acc1 += rdlane(sv, k + 1) * pc[k + 1]; }
            sv = acc0 + acc1;
#pragma unroll
            for (int k = 0; k < 64; ++k) pc[k] = pn[k];
            uc = un; }
    }
}

#ifndef OPT_SCAN2B
#define OPT_SCAN2B 1
#endif
__device__ __forceinline__ void ph_scan2b(Ctx& C) {
    const int lane = lane_now(), wave = C.wave, tid = wave * 64 + lane; const float* g_pu = (const float*)(C.ws + WS_PU); float* g_s0 = (float*)(C.ws + WS_S0);
    constexpr int SLOT = 18432, NSLOT = 6, AHEAD = 5;
    for (int task = C.bid; task < NCHAIN * 8; task += C.nb) { const int chain = task >> 3, rg = task & 7, row = rg * 8 + wave;
        const float* Pb = g_pu + (size_t)chain * NCK * 8192;
#define S2_ISSUE(c_) do { const float* pc_ = Pb + (size_t)(c_) * 8192; LAS unsigned char* sl_ = C.lds + ((c_) % NSLOT) * SLOT + wave * 1024; \
            __builtin_amdgcn_global_load_lds((const unsigned*)(pc_ + tid * 4), (LAS unsigned*)(sl_), 16, 0, 0); \
            __builtin_amdgcn_global_load_lds((const unsigned*)(pc_ + 2048 + tid * 4), (LAS unsigned*)(sl_ + 8192), 16, 0, 0); \
            if (wave < 2) __builtin_amdgcn_global_load_lds((const unsigned*)(pc_ + 4096 + rg * 512 + tid * 4), (LAS unsigned*)(sl_ + 16384), 16, 0, 0); } while (0)
#define S2_LOADP(c_, PN_, UN_) do { const LAS float* P_ = (const LAS float*)(C.lds + ((c_) % NSLOT) * SLOT) + lane; UN_ = P_[4096 + wave * 64]; \
            _Pragma("unroll") for (int k = 0; k < 64; ++k) PN_[k] = P_[k * 64]; asm volatile("" ::: "memory"); } while (0)
#define S2_STEP(c_, PC_, UC_, PN_, UN_) do { const int cc_ = (c_); \
            if (cc_ >= 4) { if (cc_ < NCK - 4) { if (wave < 2) asm volatile("s_waitcnt vmcnt(13)" ::: "memory"); else asm volatile("s_waitcnt vmcnt(10)" ::: "memory"); } \
                else if (cc_ == NCK - 4) { if (wave < 2) asm volatile("s_waitcnt vmcnt(10)" ::: "memory"); else asm volatile("s_waitcnt vmcnt(8)" ::: "memory"); } \
                else if (cc_ == NCK - 3) { if (wave < 2) asm volatile("s_waitcnt vmcnt(7)" ::: "memory"); else asm volatile("s_waitcnt vmcnt(6)" ::: "memory"); } \
                else if (cc_ == NCK - 2) asm volatile("s_waitcnt vmcnt(4)" ::: "memory"); } \
            __builtin_amdgcn_s_barrier(); asm volatile("" ::: "memory"); \
            if (cc_ + AHEAD < NCK) S2_ISSUE(cc_ + AHEAD);                            \
            asm volatile("" ::: "memory");                                            \
            g_s0[(((size_t)chain * NCK + cc_) * 64 + row) * 64 + lane] = sv; \
            if (cc_ + 1 < NCK) S2_LOADP(cc_ + 1, PN_, UN_); \
            float a0_ = UC_, a1_ = 0.f, a2_ = 0.f, a3_ = 0.f; \
            _Pragma("unroll") for (int k = 0; k < 64; k += 4) { a0_ += rdlane(sv, k) * PC_[k]; a1_ += rdlane(sv, k + 1) * PC_[k + 1]; a2_ += rdlane(sv, k + 2) * PC_[k + 2]; a3_ += rdlane(sv, k + 3) * PC_[k + 3]; } \
            sv = (a0_ + a1_) + (a2_ + a3_); } while (0)
        asm volatile("s_waitcnt vmcnt(0) lgkmcnt(0)" ::: "memory"); __builtin_amdgcn_s_barrier(); asm volatile("" ::: "memory");
#pragma unroll
        for (int c = 0; c < AHEAD; ++c) S2_ISSUE(c);
        float sv = 0.f, pa[64], pb[64], ua, ub = 0.f;
        asm volatile("s_waitcnt vmcnt(0)" ::: "memory"); __builtin_amdgcn_s_barrier(); asm volatile("" ::: "memory");
        S2_LOADP(0, pa, ua);
#pragma unroll 1
        for (int c = 0; c < NCK; c += 2) { S2_STEP(c, pa, ua, pb, ub); S2_STEP(c + 1, pb, ub, pa, ua); }
#undef S2_STEP
#undef S2_LOADP
#undef S2_ISSUE
    }
    asm volatile("s_waitcnt vmcnt(0)" ::: "memory"); __builtin_amdgcn_s_barrier();
}
__device__ __forceinline__ void ph_fin2(Ctx& C) {
    const int lane = lane_now();
    const bf16* yl = (const bf16*)(C.ws + WS_YL); const bf16* qt = (const bf16*)(C.dout + DO_QT); const float* s0 = (const float*)(C.ws + WS_S0);
    const bf16* r = (const bf16*)(C.ws + WS_R); const bf16* kraw = (const bf16*)(C.ws + WS_KRAW); const bf16* a = (const bf16*)(C.ws + WS_A); const float* k_a = C.ka->in[14]; const float* r_k = C.ka->in[15];
    const bf16* v = (const bf16*)(C.ws + WS_V); const bf16* gate = (const bf16*)(C.ws + WS_GATE); bf16* orw = (bf16*)(C.ws + WS_ORWKV); const float* lnw = C.ka->in[16]; const float* lnb = C.ka->in[17];
    for (int task = C.bid; task < 16 * NCK; task += C.nb) { const int h = task & 15, cf = task >> 4, cb = NCK - 1 - cf, c = h * 64 + lane;
        f32x4 sf[16], sb[16];
        { const f32x4* pf = (const f32x4*)(s0 + (((size_t)h * NCK + cf) * 64 + lane) * 64); const f32x4* pb = (const f32x4*)(s0 + (((size_t)(16 + h) * NCK + cb) * 64 + lane) * 64);
#pragma unroll
          for (int q = 0; q < 16; ++q) { sf[q] = pf[q]; sb[q] = pb[q]; } }
        const float ka_ = k_a[c], rk_ = r_k[c], lw_ = lnw[c], lb_ = lnb[c];
        for (int tt = 0; tt < 32; ++tt) { const int t = cf * CHL + C.wave * 32 + tt; const size_t ix = (size_t)t * RW + c, ixb = ((size_t)S + t) * RW + c;
            const float qf = bf2f(qt[ix]), qb = bf2f(qt[ixb]);
            float y0 = bf2f(yl[ix]), y1 = bf2f(yl[ixb]);
#pragma unroll
            for (int q = 0; q < 16; ++q)
#pragma unroll
                for (int e = 0; e < 4; ++e) { y0 += sf[q][e] * rdlane(qf, 4 * q + e); y1 += sb[q][e] * rdlane(qb, 4 * q + e); }
            const float y = y0 + y1;
            const float mu = wave_sum(y) * (1.0f / 64.f); const float dv = y - mu; const float var = wave_sum(dv * dv) * (1.0f / 64.f);
            const float gn = dv * (1.0f / sqrtf(var + 64e-5f)) * lw_ + lb_;
            const float kd2 = (1.0f + (bf2f(a[ix]) - 1.0f) * ka_) + (1.0f + (bf2f(a[ixb]) - 1.0f) * ka_);
            const float bonus = wave_sum(bf2f(r[ix]) * bf2f(kraw[ix]) * kd2 * rk_) * bf2f(v[ix]);
            orw[ix] = f2bf((gn + bonus) * bf2f(gate[ix])); }
    }
}


#ifndef OPT_ATTN
#define OPT_ATTN 1
#endif
typedef float f32x16 __attribute__((ext_vector_type(16)));
constexpr size_t WS_OG = 442 * MiB, WS_LSE = 490 * MiB;
constexpr int AT_VTS = 388;
__device__ __forceinline__ void ph_attn2(Ctx& C) {
    const int lane = lane_now(), wave = C.wave, tid = wave * 64 + lane, r31 = lane & 31, hh = lane >> 5;
    const bf16* z = (const bf16*)(C.ws + WS_ZQKV); bf16* og = (bf16*)(C.ws + WS_OG); float* lse_o = (float*)(C.ws + WS_LSE);
    LAS bf16* vt = (LAS bf16*)C.lds; LAS bf16* kim = (LAS bf16*)(C.lds + 64 * AT_VTS * 2);
    for (int unit = C.bid; unit < 1536; unit += C.nb) {
        const int g = unit >> 9, rem = unit & 511, h = rem & 7, tile64 = rem >> 3;
        const int dsh = 2 * g, d = 1 << dsh, n = S >> dsh, res = tile64 & (d - 1), tl = tile64 >> dsh;
        const int kbase = tl * 256 - 64, colq = g * 512 + h * 64, colk = 1536 + colq, colv = 3072 + colq;
        const float slope_d = exp2f(-8.0f * (float)(g * 8 + h + 1) / 24.0f) * (float)d;
#pragma unroll
        for (int i = 0; i < 6; ++i) { const int kc = (tid >> 3) + 64 * i, ch = tid & 7, ki = kbase + kc; u32x4 w = (u32x4){0u, 0u, 0u, 0u}, wk = (u32x4){0u, 0u, 0u, 0u};
            if (ki >= 0 && ki < n) { const bf16* rp = z + (size_t)((ki << dsh) + res) * NQKV + 8 * ch; w = *(const u32x4*)(rp + colv); wk = *(const u32x4*)(rp + colk); }
            *(LAS u32x4*)(kim + kc * 72 + 8 * ch) = wk;
            LAS bf16* dp = vt + (8 * ch) * AT_VTS + kc;
            dp[0] = (bf16)(w.x & 0xffff); dp[AT_VTS] = (bf16)(w.x >> 16); dp[2 * AT_VTS] = (bf16)(w.y & 0xffff); dp[3 * AT_VTS] = (bf16)(w.y >> 16);
            dp[4 * AT_VTS] = (bf16)(w.z & 0xffff); dp[5 * AT_VTS] = (bf16)(w.z >> 16); dp[6 * AT_VTS] = (bf16)(w.w & 0xffff); dp[7 * AT_VTS] = (bf16)(w.w >> 16); }
        __syncthreads();
        const int qb = tl * 256 + 32 * wave; const int qtok = ((qb + r31) << dsh) + res;
        bf16x8 qf[4];
#pragma unroll
        for (int ks = 0; ks < 4; ++ks) qf[ks] = *(const bf16x8*)(z + (size_t)qtok * NQKV + colq + 16 * ks + 8 * hh);
        f32x16 sacc[5];
#pragma unroll
        for (int kt = 0; kt < 5; ++kt) {
#pragma unroll
            for (int e = 0; e < 16; ++e) sacc[kt][e] = 0.f;
            const LAS bf16* kp = kim + (32 * wave + 32 * kt + r31) * 72 + 8 * hh;
#pragma unroll
            for (int ks = 0; ks < 4; ++ks) { const bf16x8 kf = *(const LAS bf16x8*)(kp + 16 * ks); sacc[kt] = __builtin_amdgcn_mfma_f32_32x32x16_bf16(kf, qf[ks], sacc[kt], 0, 0, 0); } }
        const float LOG2E = 1.44269504f, slope2 = slope_d * LOG2E, c0f = (float)(4 * hh - 64 - r31);
        const bool edge = (tl == 0) || (tl == (n >> 8) - 1);
        float m = -3.0e38f;
#pragma unroll
        for (int kt = 0; kt < 5; ++kt)
#pragma unroll
            for (int e = 0; e < 16; ++e) { const float relf = (float)(32 * kt + (e & 3) + 8 * (e >> 2)) + c0f; float sc = sacc[kt][e] * LOG2E - slope2 * __builtin_fabsf(relf);
                if (kt == 0) sc = relf >= -64.0f ? sc : -1e30f;
                if (kt == 4) sc = relf <= 64.0f ? sc : -1e30f;
                sacc[kt][e] = sc; }
        if (edge) {
#pragma unroll
            for (int kt = 0; kt < 5; ++kt)
#pragma unroll
                for (int e = 0; e < 16; ++e) { const int kidx = qb - 64 + 32 * kt + (e & 3) + 8 * (e >> 2) + 4 * hh; sacc[kt][e] = (kidx >= 0 && kidx < n) ? sacc[kt][e] : -1e30f; } }
#pragma unroll
        for (int kt = 0; kt < 5; ++kt)
#pragma unroll
            for (int e = 0; e < 16; ++e) m = fmaxf(m, sacc[kt][e]);
        { const auto rr = __builtin_amdgcn_permlane32_swap(__float_as_uint(m), __float_as_uint(m), false, false); m = fmaxf(__uint_as_float(rr[0]), __uint_as_float(rr[1])); }
        float den = 0.f;
#pragma unroll
        for (int kt = 0; kt < 5; ++kt)
#pragma unroll
            for (int e = 0; e < 16; ++e) { const float pv = __builtin_amdgcn_exp2f(sacc[kt][e] - m); sacc[kt][e] = pv; den += pv; }
        { const auto rr = __builtin_amdgcn_permlane32_swap(__float_as_uint(den), __float_as_uint(den), false, false); den = __uint_as_float(rr[0]) + __uint_as_float(rr[1]); }
        f32x16 oacc[2];
#pragma unroll
        for (int dt = 0; dt < 2; ++dt)
#pragma unroll
            for (int e = 0; e < 16; ++e) oacc[dt][e] = 0.f;
#pragma unroll
        for (int kt = 0; kt < 5; ++kt)
#pragma unroll
            for (int sI = 0; sI < 2; ++sI) { const bf16x8 bfrag = pack8s(sacc[kt][8 * sI], sacc[kt][8 * sI + 1], sacc[kt][8 * sI + 2], sacc[kt][8 * sI + 3], sacc[kt][8 * sI + 4], sacc[kt][8 * sI + 5], sacc[kt][8 * sI + 6], sacc[kt][8 * sI + 7]);
#pragma unroll
                for (int dt = 0; dt < 2; ++dt) { const LAS bf16* vp = vt + (32 * dt + r31) * AT_VTS + 32 * wave + 32 * kt + 16 * sI + 4 * hh;
                    const u32x2 lo = *(const LAS u32x2*)vp, hi = *(const LAS u32x2*)(vp + 8); u32x4 pa; pa.x = lo.x; pa.y = lo.y; pa.z = hi.x; pa.w = hi.y;
                    oacc[dt] = __builtin_amdgcn_mfma_f32_32x32x16_bf16(__builtin_bit_cast(bf16x8, pa), bfrag, oacc[dt], 0, 0, 0); } }
        const float rden = 1.0f / den; bf16* op = og + ((size_t)g * S + qtok) * 512 + h * 64 + 4 * hh;
#pragma unroll
        for (int dt = 0; dt < 2; ++dt)
#pragma unroll
            for (int gr = 0; gr < 4; ++gr) { u32x2 o; o.x = pg8c(oacc[dt][4 * gr] * rden, oacc[dt][4 * gr + 1] * rden); o.y = pg8c(oacc[dt][4 * gr + 2] * rden, oacc[dt][4 * gr + 3] * rden); *(u32x2*)(op + 32 * dt + 8 * gr) = o; }
        if (hh == 0) lse_o[((size_t)g * S + qtok) * 8 + h] = (m + __builtin_amdgcn_logf(den)) * 0.69314718f;
        __syncthreads();
    }
}
__device__ __forceinline__ void ph_attn_combine(Ctx& C) {
    const int lane = lane_now(); const bf16* og = (const bf16*)(C.ws + WS_OG); const float* lse = (const float*)(C.ws + WS_LSE); bf16* oa = (bf16*)(C.ws + WS_OATT);
    const int ntask = S * 64;
    for (int task = (C.bid * NWAVES + C.wave) * 64 + lane; task < ntask; task += C.nb * NTHR) { const int t = task >> 6, c8 = task & 63, h = c8 >> 3;
        const float l0 = lse[(size_t)t * 8 + h], l1 = lse[((size_t)S + t) * 8 + h], l2 = lse[((size_t)2 * S + t) * 8 + h]; const float mx = fmaxf(l0, fmaxf(l1, l2));
        const float w0 = __expf(l0 - mx), w1 = __expf(l1 - mx), w2 = __expf(l2 - mx), rs = 1.0f / (w0 + w1 + w2);
        float a0[8], a1[8], a2[8]; unpack8(*(const u32x4*)(og + (size_t)t * 512 + 8 * c8), a0); unpack8(*(const u32x4*)(og + ((size_t)S + t) * 512 + 8 * c8), a1); unpack8(*(const u32x4*)(og + ((size_t)2 * S + t) * 512 + 8 * c8), a2);
        f32x4 o0, o1;
#pragma unroll
        for (int e = 0; e < 4; ++e) { o0[e] = (w0 * a0[e] + w1 * a1[e] + w2 * a2[e]) * rs; o1[e] = (w0 * a0[4 + e] + w1 * a1[4 + e] + w2 * a2[4 + e]) * rs; }
        *(u32x4*)(oa + (size_t)t * 512 + 8 * c8) = pack8(o0, o1); }
}


__device__ __forceinline__ bf16x8 cvt8(const f32x4 a, const f32x4 b) { u32x4 w; w.x = pk2(a[0], a[1]); w.y = pk2(a[2], a[3]); w.z = pk2(b[0], b[1]); w.w = pk2(b[2], b[3]); return __builtin_bit_cast(bf16x8, w); }
__device__ __forceinline__ void unpack4(u32x2 w, float (&f)[4]) { f[0] = __uint_as_float(w.x << 16); f[1] = __uint_as_float(w.x & 0xffff0000u); f[2] = __uint_as_float(w.y << 16); f[3] = __uint_as_float(w.y & 0xffff0000u); }
__device__ __forceinline__ void ph_fin3(Ctx& C) {
    const int lane = lane_now(), r31 = lane & 31, hh = lane >> 5;
    const bf16* yl = (const bf16*)(C.ws + WS_YL); const bf16* qt = (const bf16*)(C.dout + DO_QT); const float* s0 = (const float*)(C.ws + WS_S0);
    const bf16* r = (const bf16*)(C.ws + WS_R); const bf16* kraw = (const bf16*)(C.ws + WS_KRAW); const bf16* a = (const bf16*)(C.ws + WS_A); const float* k_a = C.ka->in[14]; const float* r_k = C.ka->in[15];
    const bf16* v = (const bf16*)(C.ws + WS_V); const bf16* gate = (const bf16*)(C.ws + WS_GATE); bf16* orw = (bf16*)(C.ws + WS_ORWKV); const float* lnw = C.ka->in[16]; const float* lnb = C.ka->in[17];
    for (int task = C.bid; task < 16 * NCK; task += C.nb) { const int h = task & 15, cf = task >> 4, cb = NCK - 1 - cf;
        const int t = cf * CHL + C.wave * 32 + r31; const size_t rowf = (size_t)t * RW + h * 64, rowb = ((size_t)S + t) * RW + h * 64;
        f32x16 acc[2];
#pragma unroll
        for (int vt = 0; vt < 2; ++vt)
#pragma unroll
            for (int e = 0; e < 16; ++e) acc[vt][e] = 0.f;
#pragma unroll
        for (int z = 0; z < 2; ++z) { const float* sp = s0 + (((size_t)(z * 16 + h) * NCK + (z ? cb : cf)) * 64 + r31) * 64 + 8 * hh; const bf16* qp = qt + (z ? rowb : rowf) + 8 * hh;
#pragma unroll
            for (int ks = 0; ks < 4; ++ks) { const bf16x8 bq = *(const bf16x8*)(qp + 16 * ks);
#pragma unroll
                for (int vt = 0; vt < 2; ++vt) { const f32x4* ap = (const f32x4*)(sp + (size_t)vt * 32 * 64 + 16 * ks); acc[vt] = __builtin_amdgcn_mfma_f32_32x32x16_bf16(cvt8(ap[0], ap[1]), bq, acc[vt], 0, 0, 0); } } }
        float ssum = 0.f, bsum = 0.f;
#pragma unroll
        for (int vt = 0; vt < 2; ++vt)
#pragma unroll
            for (int gr = 0; gr < 4; ++gr) { const int co = 32 * vt + 8 * gr + 4 * hh; float f0[4], f1[4], fr_[4], fk[4], fa0[4], fa1[4];
                unpack4(*(const u32x2*)(yl + rowf + co), f0); unpack4(*(const u32x2*)(yl + rowb + co), f1); unpack4(*(const u32x2*)(r + rowf + co), fr_); unpack4(*(const u32x2*)(kraw + rowf + co), fk);
                unpack4(*(const u32x2*)(a + rowf + co), fa0); unpack4(*(const u32x2*)(a + rowb + co), fa1);
                const f32x4 ka4 = *(const f32x4*)(k_a + h * 64 + co), rk4 = *(const f32x4*)(r_k + h * 64 + co);
#pragma unroll
                for (int e = 0; e < 4; ++e) { const float y = acc[vt][4 * gr + e] + f0[e] + f1[e]; acc[vt][4 * gr + e] = y; ssum += y;
                    bsum += fr_[e] * fk[e] * ((1.0f + (fa0[e] - 1.0f) * ka4[e]) + (1.0f + (fa1[e] - 1.0f) * ka4[e])) * rk4[e]; } }
        ssum += __shfl_xor(ssum, 32); bsum += __shfl_xor(bsum, 32);
        const float mu = ssum * (1.0f / 64.f); float vs = 0.f;
#pragma unroll
        for (int vt = 0; vt < 2; ++vt)
#pragma unroll
            for (int e = 0; e < 16; ++e) { const float dv = acc[vt][e] - mu; acc[vt][e] = dv; vs += dv * dv; }
        vs += __shfl_xor(vs, 32);
        const float rstd = 1.0f / sqrtf(vs * (1.0f / 64.f) + 64e-5f);
#pragma unroll
        for (int vt = 0; vt < 2; ++vt)
#pragma unroll
            for (int gr = 0; gr < 4; ++gr) { const int co = 32 * vt + 8 * gr + 4 * hh; float fv[4], fg[4]; unpack4(*(const u32x2*)(v + rowf + co), fv); unpack4(*(const u32x2*)(gate + rowf + co), fg);
                const f32x4 w4 = *(const f32x4*)(lnw + h * 64 + co), b4 = *(const f32x4*)(lnb + h * 64 + co); float o[4];
#pragma unroll
                for (int e = 0; e < 4; ++e) o[e] = (acc[vt][4 * gr + e] * rstd * w4[e] + b4[e] + bsum * fv[e]) * fg[e];
                u32x2 w; w.x = pk2(o[0], o[1]); w.y = pk2(o[2], o[3]); *(u32x2*)(orw + rowf + co) = w; }
    }
}
template <int CTRL> __device__ __forceinline__ float dpp_row(float x) { return __int_as_float(__builtin_amdgcn_update_dpp(0, __float_as_int(x), CTRL, 0xf, 0xf, true)); }
__device__ __forceinline__ void ph_rprep2(Ctx& C) {
    const int lane = lane_now();
    const bf16* zr = (const bf16*)(C.ws + WS_ZR); const float* mup = C.ka->in[6]; const float* mun = C.ka->in[7]; const float* k_k = C.ka->in[13];
    bf16* r = (bf16*)(C.ws + WS_R); bf16* v = (bf16*)(C.ws + WS_V); bf16* nkk = (bf16*)(C.ws + WS_NKK); bf16* kraw = (bf16*)(C.ws + WS_KRAW); bf16* la = (bf16*)(C.ws + WS_LORAA);
    const int ntask = 6 * (S / 64) + (S / 32);
    for (int task = C.gw; task < ntask; task += C.ngw) { const bool heavy = task >= 6 * (S / 64); const int cgp = heavy ? 6 : task % 6, ntok = heavy ? 32 : 64, t0 = heavy ? (task - 6 * (S / 64)) * 32 : (task / 6) * 64, col = cgp * 512 + lane * 8;
        const bool real = col < NZR_REAL; const int kind = col < 1024 ? 0 : col < 2048 ? 1 : col < 3072 ? 2 : col < 3136 ? 3 : col < 3200 ? 4 : col < 3360 ? 5 : 6;
        float mp[8], mn[8], kk8[8];
#pragma unroll
        for (int e = 0; e < 8; ++e) { mp[e] = real ? mup[col + e] : 0.f; mn[e] = real ? mun[col + e] : 0.f; kk8[e] = kind == 1 ? k_k[col - 1024 + e] : 0.f; }
        float zp[8], zc[8], zn[8];
        if (t0 > 0) unpack8(*(const u32x4*)(zr + (size_t)(t0 - 1) * NZR + col), zp); else {
#pragma unroll
            for (int e = 0; e < 8; ++e) zp[e] = 0.f; }
        unpack8(*(const u32x4*)(zr + (size_t)t0 * NZR + col), zc);
        u32x4 rawn[8];
#define RP_LOAD8(tb_) do { _Pragma("unroll") for (int j_ = 0; j_ < 8; ++j_) { const int tr_ = (tb_) + 1 + j_; const u32x4 w_ = *(const u32x4*)(zr + (size_t)(tr_ < S ? tr_ : S - 1) * NZR + col); rawn[j_] = tr_ < S ? w_ : (u32x4){0u, 0u, 0u, 0u}; } } while (0)
#pragma unroll 1
        for (int i0 = 0; i0 < ntok; i0 += 8) { u32x4 rawc[8];
            RP_LOAD8(t0 + i0);
#pragma unroll
            for (int j = 0; j < 8; ++j) asm volatile("" : "+v"(rawn[j]));
#pragma unroll
            for (int j = 0; j < 8; ++j) rawc[j] = rawn[j];
#pragma unroll
          for (int j = 0; j < 8; ++j) { const int t = t0 + i0 + j;
            unpack8(rawc[j], zn);
            float x[8];
#pragma unroll
            for (int e = 0; e < 8; ++e) x[e] = zc[e] + mp[e] * (zp[e] - zc[e]) + mn[e] * (zn[e] - zc[e]);
            if (kind == 0) *(u32x4*)(r + (size_t)t * RW + col) = pack8((f32x4){x[0], x[1], x[2], x[3]}, (f32x4){x[4], x[5], x[6], x[7]});
            else if (kind == 1) { *(u32x4*)(kraw + (size_t)t * RW + col - 1024) = pack8((f32x4){x[0], x[1], x[2], x[3]}, (f32x4){x[4], x[5], x[6], x[7]});
                float kv[8], ss = 0.f;
#pragma unroll
                for (int e = 0; e < 8; ++e) { kv[e] = x[e] * kk8[e]; ss += kv[e] * kv[e]; }
                ss += dpp_row<0xB1>(ss); ss += dpp_row<0x4E>(ss); ss += dpp_row<0x141>(ss);
                const float sc = -1.0f / fmaxf(sqrtf(ss), 1e-12f);
                *(u32x4*)(nkk + (size_t)t * RW + col - 1024) = pack8((f32x4){kv[0] * sc, kv[1] * sc, kv[2] * sc, kv[3] * sc}, (f32x4){kv[4] * sc, kv[5] * sc, kv[6] * sc, kv[7] * sc}); }
            else if (kind == 2) *(u32x4*)(v + (size_t)t * RW + col - 2048) = pack8((f32x4){x[0], x[1], x[2], x[3]}, (f32x4){x[4], x[5], x[6], x[7]});
            else { float o[8];
#pragma unroll
                for (int e = 0; e < 8; ++e) { const float sg = __builtin_amdgcn_rcpf(1.0f + __builtin_amdgcn_exp2f(x[e] * (kind == 3 ? -2.88539008f : -1.44269504f)));
                    o[e] = kind == 3 ? 2.0f * sg - 1.0f : kind == 4 ? x[e] : kind == 5 ? sg : 0.f; }
                bf16* lp = kind <= 4 ? la + (size_t)t * KL2 + (col - 3072) : kind == 5 ? la + (size_t)(S + t) * KL2 + (col - 3200) : col < 3488 ? la + (size_t)t * KL2 + 128 + (col - 3360) : la + (size_t)(S + t) * KL2 + 160 + (col - 3488);
                *(u32x4*)lp = pack8((f32x4){o[0], o[1], o[2], o[3]}, (f32x4){o[4], o[5], o[6], o[7]}); }
#pragma unroll
            for (int e = 0; e < 8; ++e) { zp[e] = zc[e]; zc[e] = zn[e]; }
          }
        }
#undef RP_LOAD8
    }
}


constexpr int F4_S0STR = 72, F4_TSTR = 68;
__device__ __forceinline__ void ph_fin4(Ctx& C) {
    const int lane0 = lane_now(), wave = C.wave;
    const bf16* yl = (const bf16*)(C.ws + WS_YL); const bf16* qt = (const bf16*)(C.dout + DO_QT); const float* s0 = (const float*)(C.ws + WS_S0);
    const bf16* r = (const bf16*)(C.ws + WS_R); const bf16* kraw = (const bf16*)(C.ws + WS_KRAW); const bf16* a = (const bf16*)(C.ws + WS_A); const float* k_a = C.ka->in[14]; const float* r_k = C.ka->in[15];
    const bf16* v = (const bf16*)(C.ws + WS_V); const bf16* gate = (const bf16*)(C.ws + WS_GATE); bf16* orw = (bf16*)(C.ws + WS_ORWKV); const float* lnw = C.ka->in[16]; const float* lnb = C.ka->in[17];
    LAS bf16* s0img = (LAS bf16*)C.lds;
    LAS bf16* tr = (LAS bf16*)(C.lds + 2 * 64 * F4_S0STR * 2) + C.wave * (32 * F4_TSTR);
    for (int task = C.bid; task < 16 * NCK; task += C.nb) { const int h = task & 15, cf = task >> 4, cb = NCK - 1 - cf;
        int lane = lane0; asm volatile("" : "+v"(lane));
        const int r31 = lane & 31, hh = lane >> 5, tid = wave * 64 + lane;
#define F4_GLOAD(g, gptr) do { _Pragma("unroll") for (int i_ = 0; i_ < 4; ++i_) g[i_] = *(const u32x4*)((gptr) + (size_t)((lane >> 3) + 8 * i_) * RW + 8 * (lane & 7)); } while (0)
#define F4_XPOSE(dst, g) do { _Pragma("unroll") for (int i_ = 0; i_ < 4; ++i_) { LAS u32x2* d_ = (LAS u32x2*)(tr + ((lane >> 3) + 8 * i_) * F4_TSTR + 8 * (lane & 7)); d_[0] = (u32x2){g[i_].x, g[i_].y}; d_[1] = (u32x2){g[i_].z, g[i_].w}; } \
            asm volatile("s_waitcnt lgkmcnt(0)" ::: "memory"); \
            _Pragma("unroll") for (int vt_ = 0; vt_ < 2; ++vt_) _Pragma("unroll") for (int gr_ = 0; gr_ < 4; ++gr_) dst[vt_][gr_] = *(const LAS u32x2*)(tr + r31 * F4_TSTR + 32 * vt_ + 8 * gr_ + 4 * hh); \
            asm volatile("s_waitcnt lgkmcnt(0)" ::: "memory"); } while (0)
        __syncthreads();
        { const int z = tid >> 8, row = (tid >> 2) & 63, seg = tid & 3; const float* sp = s0 + (((size_t)(z * 16 + h) * NCK + (z ? cb : cf)) * 64 + row) * 64 + 16 * seg;
          const f32x4 x0 = *(const f32x4*)sp, x1 = *(const f32x4*)(sp + 4), x2 = *(const f32x4*)(sp + 8), x3 = *(const f32x4*)(sp + 12);
          LAS u32x4* dp = (LAS u32x4*)(s0img + (z * 64 + row) * F4_S0STR + 16 * seg); dp[0] = pack8(x0, x1); dp[1] = pack8(x2, x3); }
        __syncthreads();
#pragma unroll 1
        for (int hv = 0; hv < CHL / 256; ++hv) {
        const size_t base_f = (size_t)(cf * CHL + hv * 256 + wave * 32) * RW + h * 64, base_b = base_f + (size_t)S * RW;
        u32x4 g0[4], g1[4], g2[4], g3[4];
        F4_GLOAD(g0, yl + base_f); F4_GLOAD(g1, yl + base_b); F4_GLOAD(g2, r + base_f); F4_GLOAD(g3, kraw + base_f);
        const int t0 = cf * CHL + hv * 256 + wave * 32, t = t0 + r31; const size_t rowf = (size_t)t * RW + h * 64, rowb = ((size_t)S + t) * RW + h * 64;
        f32x16 acc[2];
#pragma unroll
        for (int vt = 0; vt < 2; ++vt)
#pragma unroll
            for (int e = 0; e < 16; ++e) acc[vt][e] = 0.f;
#pragma unroll
        for (int z = 0; z < 2; ++z) { const bf16* qp = qt + (z ? rowb : rowf) + 8 * hh;
#pragma unroll
            for (int ks = 0; ks < 4; ++ks) { const bf16x8 bq = *(const bf16x8*)(qp + 16 * ks);
#pragma unroll
                for (int vt = 0; vt < 2; ++vt) { const bf16x8 af = *(const LAS bf16x8*)(s0img + (z * 64 + 32 * vt + r31) * F4_S0STR + 16 * ks + 8 * hh); acc[vt] = __builtin_amdgcn_mfma_f32_32x32x16_bf16(af, bq, acc[vt], 0, 0, 0); } } }
        u32x2 q0[2][4], q1[2][4];
        float ssum = 0.f, bsum = 0.f;
        F4_XPOSE(q0, g0); F4_XPOSE(q1, g1);
        F4_GLOAD(g0, a + base_f); F4_GLOAD(g1, a + base_b);
#pragma unroll
        for (int vt = 0; vt < 2; ++vt)
#pragma unroll
            for (int gr = 0; gr < 4; ++gr) { float f0[4], f1[4]; unpack4(q0[vt][gr], f0); unpack4(q1[vt][gr], f1);
#pragma unroll
                for (int e = 0; e < 4; ++e) { const float y = acc[vt][4 * gr + e] + f0[e] + f1[e]; acc[vt][4 * gr + e] = y; ssum += y; } }
        { u32x2 q2[2][4], q3[2][4];
          F4_XPOSE(q0, g2); F4_XPOSE(q1, g3);
          F4_GLOAD(g2, v + base_f); F4_GLOAD(g3, gate + base_f);
          F4_XPOSE(q2, g0); F4_XPOSE(q3, g1);
#pragma unroll
          for (int vt = 0; vt < 2; ++vt)
#pragma unroll
              for (int gr = 0; gr < 4; ++gr) { const int co = 32 * vt + 8 * gr + 4 * hh; float fr_[4], fk[4], fa0[4], fa1[4]; unpack4(q0[vt][gr], fr_); unpack4(q1[vt][gr], fk); unpack4(q2[vt][gr], fa0); unpack4(q3[vt][gr], fa1);
                  const f32x4 ka4 = *(const f32x4*)(k_a + h * 64 + co), rk4 = *(const f32x4*)(r_k + h * 64 + co);
#pragma unroll
                  for (int e = 0; e < 4; ++e) bsum += fr_[e] * fk[e] * ((1.0f + (fa0[e] - 1.0f) * ka4[e]) + (1.0f + (fa1[e] - 1.0f) * ka4[e])) * rk4[e]; } }
        ssum += __shfl_xor(ssum, 32); bsum += __shfl_xor(bsum, 32);
        const float mu = ssum * (1.0f / 64.f); float vs = 0.f;
#pragma unroll
        for (int vt = 0; vt < 2; ++vt)
#pragma unroll
            for (int e = 0; e < 16; ++e) { const float dv = acc[vt][e] - mu; acc[vt][e] = dv; vs += dv * dv; }
        vs += __shfl_xor(vs, 32);
        const float rstd = 1.0f / sqrtf(vs * (1.0f / 64.f) + 64e-5f);
        F4_XPOSE(q0, g2); F4_XPOSE(q1, g3);
#pragma unroll
        for (int vt = 0; vt < 2; ++vt)
#pragma unroll
            for (int gr = 0; gr < 4; ++gr) { const int co = 32 * vt + 8 * gr + 4 * hh; float fv[4], fg[4]; unpack4(q0[vt][gr], fv); unpack4(q1[vt][gr], fg);
                const f32x4 w4 = *(const f32x4*)(lnw + h * 64 + co), b4 = *(const f32x4*)(lnb + h * 64 + co); float o[4];
#pragma unroll
                for (int e = 0; e < 4; ++e) o[e] = (acc[vt][4 * gr + e] * rstd * w4[e] + b4[e] + bsum * fv[e]) * fg[e];
                u32x2 w; w.x = pk2(o[0], o[1]); w.y = pk2(o[2], o[3]); *(LAS u32x2*)(tr + r31 * F4_TSTR + co) = w; }
        asm volatile("s_waitcnt lgkmcnt(0)" ::: "memory");
#pragma unroll
        for (int i = 0; i < 4; ++i) { const int tk = (lane >> 3) + 8 * i; const LAS u32x2* s_ = (const LAS u32x2*)(tr + tk * F4_TSTR + 8 * (lane & 7)); const u32x2 lo_ = s_[0], hi_ = s_[1]; *(u32x4*)(orw + base_f + (size_t)tk * RW + 8 * (lane & 7)) = (u32x4){lo_.x, lo_.y, hi_.x, hi_.y}; }
        asm volatile("s_waitcnt lgkmcnt(0)" ::: "memory");
        }
#undef F4_GLOAD
#undef F4_XPOSE
    }
}


constexpr int SM_KR = 0, SM_BK = 4608, SM_BGT = 9216, SM_GT = 14336, SM_VT = 14592, SM_WAVE = 17664;
template <int role> __device__ __forceinline__ void ph_scan1m_r(Ctx& C) {
    const int lane0 = lane_now(), wave = C.wave, itl = wave & 3;
    const bf16* g_r = (const bf16*)(C.ws + WS_R); const bf16* g_v = (const bf16*)(C.ws + WS_V); const bf16* g_nkk = (const bf16*)(C.ws + WS_NKK); const bf16* g_k = (const bf16*)(C.ws + WS_KRAW);
    const bf16* g_lw = (const bf16*)(C.ws + WS_LW); const bf16* g_a = (const bf16*)(C.ws + WS_A); const float* k_a = C.ka->in[14];
    bf16* g_out = role ? (bf16*)(C.ws + WS_YL) : (bf16*)(C.dout + DO_QT); float* g_pu = (float*)(C.ws + WS_PU);
    LAS unsigned char* L = C.lds + wave * SM_WAVE;
    LAS bf16* imKR = (LAS bf16*)(L + SM_KR); LAS bf16* imBK = (LAS bf16*)(L + SM_BK); LAS bf16* imBGT = (LAS bf16*)(L + SM_BGT); LAS float* gT = (LAS float*)(L + SM_GT); LAS bf16* imVT = (LAS bf16*)(L + SM_VT);
    LAS float* MT = (LAS float*)(L + SM_BK);
    const int nitems = NCHAIN * NCK;
    for (int base = C.bid * 4; base < nitems; base += C.nb * 4) {
        const int item = base + itl; if (item >= nitems) continue;
        const int chain = item / NCK, chunk = item % NCK, z = chain >> 4, h = chain & 15; const size_t zoff = (size_t)z * S * RW; const float ka = k_a[h * 64 + lane0];
        f32x16 st[2][2];
        { int lane_s = lane0; asm volatile("" : "+v"(lane_s)); const int r31s = lane_s & 31, hhs = lane_s >> 5;
#pragma unroll
        for (int kt = 0; kt < 2; ++kt)
#pragma unroll
            for (int ct = 0; ct < 2; ++ct)
#pragma unroll
                for (int e = 0; e < 16; ++e) st[kt][ct][e] = (role == 0 && (32 * kt + (e & 3) + 8 * (e >> 2) + 4 * hhs) == (32 * ct + r31s)) ? 1.f : 0.f; }
        unsigned rl[8], rn[8], ra[8], rk[8], rr_[8], rv[8];
#define RAWF(a, t) __uint_as_float(((t) & 1) ? ((a)[(t) >> 1] & 0xffff0000u) : ((a)[(t) >> 1] << 16))
#define SM_LOADRAW(sbn) do { const int sg_ = chunk * CHL + (sbn) * 16; const long tk_ = z ? (long)S - 1 - sg_ : sg_; const long dx_ = z ? -(long)RW : (long)RW; const size_t ru_ = (size_t)tk_ * RW + h * 64; \
            int ln_ = lane0; asm volatile("" : "+v"(ln_)); \
            _Pragma("unroll") for (int t_ = 0; t_ < 16; t_ += 2) { const long o_ = t_ * dx_, o1_ = o_ + dx_; const int j_ = t_ >> 1; \
                rl[j_] = (unsigned)(g_lw + zoff + ru_ + o_)[ln_] | ((unsigned)(g_lw + zoff + ru_ + o1_)[ln_] << 16); rn[j_] = (unsigned)(g_nkk + ru_ + o_)[ln_] | ((unsigned)(g_nkk + ru_ + o1_)[ln_] << 16); \
                ra[j_] = (unsigned)(g_a + zoff + ru_ + o_)[ln_] | ((unsigned)(g_a + zoff + ru_ + o1_)[ln_] << 16); rk[j_] = (unsigned)(g_k + ru_ + o_)[ln_] | ((unsigned)(g_k + ru_ + o1_)[ln_] << 16); \
                rr_[j_] = (unsigned)(g_r + ru_ + o_)[ln_] | ((unsigned)(g_r + ru_ + o1_)[ln_] << 16); if (role) rv[j_] = (unsigned)(g_v + ru_ + o_)[ln_] | ((unsigned)(g_v + ru_ + o1_)[ln_] << 16); } } while (0)
        SM_LOADRAW(0);
#pragma unroll 1
        for (int sb = 0; sb < CHL / 16; ++sb) {
            const int sg0 = chunk * CHL + sb * 16; const long tk0 = z ? (long)S - 1 - sg0 : sg0; const long dtk = z ? -1 : 1;
            int lane_i = lane0; asm volatile("" : "+v"(lane_i));
            const int lane = lane_i, r31 = lane_i & 31, hh = lane_i >> 5, r31g = r31;
            const long dix = dtk * RW;
            const size_t rowu = (size_t)tk0 * RW + h * 64;
            float Lc[16]; { float acc = 0.f;
#pragma unroll
              for (int t = 0; t < 16; ++t) { acc += RAWF(rl, t); Lc[t] = acc; } }
            const float GT_ = __expf(Lc[15]);
            gT[lane] = GT_;
            u32x4 bg[2], kg[2], vr[2];
            { LAS bf16* wKR = imKR + lane; LAS bf16* wBK = imBK + lane;
#pragma unroll
              for (int t = 0; t < 16; t += 2) { float kkh[2], rh[2], bt[2], kt_[2], bgf[2], kgf[2];
#pragma unroll
                for (int d = 0; d < 2; ++d) { const int tt = t + d;
                    const float nk = RAWF(rn, tt), a_ = RAWF(ra, tt), kr = RAWF(rk, tt), rr = RAWF(rr_, tt);
                    const float eL = __expf(Lc[tt]), eLm = tt ? __expf(Lc[tt - 1]) : 1.0f, ie = __builtin_amdgcn_rcpf(eL);
                    const float b_ = -nk * a_, kd = kr * (1.0f + (a_ - 1.0f) * ka);
                    kkh[d] = nk * eLm; rh[d] = rr * eL; bt[d] = b_ * ie; kt_[d] = kd * ie; bgf[d] = bt[d] * GT_; kgf[d] = kt_[d] * GT_; }
                const unsigned p0 = pg8::cvt_pk_bf16(kkh[0], kkh[1]), p1 = pg8::cvt_pk_bf16(rh[0], rh[1]), p2 = pg8::cvt_pk_bf16(bt[0], bt[1]), p3 = pg8::cvt_pk_bf16(kt_[0], kt_[1]);
                wKR[t * 72] = (bf16)p0; wKR[(t + 1) * 72] = (bf16)(p0 >> 16); wKR[(16 + t) * 72] = (bf16)p1; wKR[(17 + t) * 72] = (bf16)(p1 >> 16);
                wBK[t * 72] = (bf16)p2; wBK[(t + 1) * 72] = (bf16)(p2 >> 16); wBK[(16 + t) * 72] = (bf16)p3; wBK[(17 + t) * 72] = (bf16)(p3 >> 16);
                bg[t >> 3][(t >> 1) & 3] = pg8::cvt_pk_bf16(bgf[0], bgf[1]); kg[t >> 3][(t >> 1) & 3] = pg8::cvt_pk_bf16(kgf[0], kgf[1]);
                if (role) vr[t >> 3][(t >> 1) & 3] = rv[t >> 1]; } }
            { LAS u32x4* d = (LAS u32x4*)(imBGT + lane * 40); d[0] = bg[0]; d[1] = bg[1]; d[2] = kg[0]; d[3] = kg[1]; }
            if (role) { LAS u32x4* d = (LAS u32x4*)(imVT + lane * 24); d[0] = vr[0]; d[1] = vr[1]; }
            asm volatile("s_waitcnt lgkmcnt(0)" ::: "memory");
            __builtin_amdgcn_sched_barrier(0);
            { f32x16 m;
#pragma unroll
              for (int e = 0; e < 16; ++e) m[e] = 0.f;
#pragma unroll
              for (int ks = 0; ks < 4; ++ks) { const bf16x8 af = *(const LAS bf16x8*)(imBK + r31 * 72 + 16 * ks + 8 * hh), bfr = *(const LAS bf16x8*)(imKR + r31 * 72 + 16 * ks + 8 * hh); m = __builtin_amdgcn_mfma_f32_32x32x16_bf16(af, bfr, m, 0, 0, 0); }
              asm volatile("s_waitcnt lgkmcnt(0)" ::: "memory");
              const int tq = r31 & 15; const bool ycol = r31 >= 16;
#pragma unroll
              for (int g = 0; g < 4; ++g) { f32x4 o;
#pragma unroll
                  for (int e = 0; e < 4; ++e) { const int sp = 8 * g + 4 * hh + e, sq = sp & 15; const bool ok = ycol ? (sq <= tq) : (sq < tq); o[e] = ok ? m[4 * g + e] : 0.f; }
                  *(LAS f32x4*)(MT + r31 * 36 + 8 * g + 4 * hh) = o; } }
            asm volatile("s_waitcnt lgkmcnt(0)" ::: "memory");
            __builtin_amdgcn_sched_barrier(0);
            f32x16 ya[2];
#pragma unroll
            for (int ct = 0; ct < 2; ++ct)
#pragma unroll
                for (int e = 0; e < 16; ++e) ya[ct][e] = 0.f;
#pragma unroll
            for (int kt = 0; kt < 2; ++kt)
#pragma unroll
                for (int sI = 0; sI < 2; ++sI) { const LAS bf16* ap = imKR + r31 * 72 + 32 * kt + 16 * sI + 4 * hh; const u32x2 lo = *(const LAS u32x2*)ap, hi = *(const LAS u32x2*)(ap + 8);
                    u32x4 pa; pa.x = lo.x; pa.y = lo.y; pa.z = hi.x; pa.w = hi.y; const bf16x8 af = __builtin_bit_cast(bf16x8, pa);
#pragma unroll
                    for (int ct = 0; ct < 2; ++ct) { const f32x16& x = st[kt][ct];
                        const bf16x8 bfr = pack8s(x[8 * sI], x[8 * sI + 1], x[8 * sI + 2], x[8 * sI + 3], x[8 * sI + 4], x[8 * sI + 5], x[8 * sI + 6], x[8 * sI + 7]);
                        ya[ct] = __builtin_amdgcn_mfma_f32_32x32x16_bf16(af, bfr, ya[ct], 0, 0, 0); } }
            bf16x8 vfr[2];
            if (role) { const f32x4 m0 = *(const LAS f32x4*)(MT + r31 * 36 + 16 + 8 * hh), m1 = *(const LAS f32x4*)(MT + r31 * 36 + 20 + 8 * hh); const bf16x8 af = pack8s(m0[0], m0[1], m0[2], m0[3], m1[0], m1[1], m1[2], m1[3]);
#pragma unroll
                for (int ct = 0; ct < 2; ++ct) { vfr[ct] = *(const LAS bf16x8*)(imVT + (32 * ct + r31) * 24 + 8 * hh); ya[ct] = __builtin_amdgcn_mfma_f32_32x32x16_bf16(af, vfr[ct], ya[ct], 0, 0, 0); } }
            __builtin_amdgcn_sched_barrier(0);
            f32x2 u2[16];
#pragma unroll
            for (int e = 0; e < 4; ++e) {
                const auto a0 = __builtin_amdgcn_permlane32_swap(__float_as_uint(ya[0][e]), __float_as_uint(ya[0][e]), false, false), a1 = __builtin_amdgcn_permlane32_swap(__float_as_uint(ya[1][e]), __float_as_uint(ya[1][e]), false, false);
                const auto b0 = __builtin_amdgcn_permlane32_swap(__float_as_uint(ya[0][4 + e]), __float_as_uint(ya[0][4 + e]), false, false), b1 = __builtin_amdgcn_permlane32_swap(__float_as_uint(ya[1][4 + e]), __float_as_uint(ya[1][4 + e]), false, false);
                u2[e] = (f32x2){__uint_as_float(a0[0]), __uint_as_float(a1[0])}; u2[4 + e] = (f32x2){__uint_as_float(a0[1]), __uint_as_float(a1[1])};
                u2[8 + e] = (f32x2){__uint_as_float(b0[0]), __uint_as_float(b1[0])}; u2[12 + e] = (f32x2){__uint_as_float(b0[1]), __uint_as_float(b1[1])}; }
#pragma unroll
            for (int t = 1; t < 16; ++t) { f32x2 a = u2[t];
#pragma unroll
                for (int q = 0; q < (t + 3) / 4; ++q) { const f32x4 cf = *(const LAS f32x4*)(MT + t * 36 + 4 * q);
#pragma unroll
                    for (int e = 0; e < 4; ++e) if (4 * q + e < t) a += u2[4 * q + e] * cf[e]; }
                u2[t] = a; }
            bf16x8 ufr[2];
            ufr[0] = pack8s(hh ? u2[8].x : u2[0].x, hh ? u2[9].x : u2[1].x, hh ? u2[10].x : u2[2].x, hh ? u2[11].x : u2[3].x, hh ? u2[12].x : u2[4].x, hh ? u2[13].x : u2[5].x, hh ? u2[14].x : u2[6].x, hh ? u2[15].x : u2[7].x);
            ufr[1] = pack8s(hh ? u2[8].y : u2[0].y, hh ? u2[9].y : u2[1].y, hh ? u2[10].y : u2[2].y, hh ? u2[11].y : u2[3].y, hh ? u2[12].y : u2[4].y, hh ? u2[13].y : u2[5].y, hh ? u2[14].y : u2[6].y, hh ? u2[15].y : u2[7].y);
            __builtin_amdgcn_sched_barrier(0);
            { const f32x4 m0 = *(const LAS f32x4*)(MT + r31 * 36 + 8 * hh), m1 = *(const LAS f32x4*)(MT + r31 * 36 + 4 + 8 * hh); const bf16x8 af = pack8s(m0[0], m0[1], m0[2], m0[3], m1[0], m1[1], m1[2], m1[3]);
#pragma unroll
              for (int ct = 0; ct < 2; ++ct) ya[ct] = __builtin_amdgcn_mfma_f32_32x32x16_bf16(af, ufr[ct], ya[ct], 0, 0, 0); }
            { LAS bf16* ys = (LAS bf16*)MT;
#pragma unroll
              for (int ct = 0; ct < 2; ++ct)
#pragma unroll
                  for (int e = 0; e < 8; e += 2) { const unsigned pw = pg8::cvt_pk_bf16(ya[ct][8 + e], ya[ct][9 + e]); const int t = (e & 3) + 4 * hh + 8 * (e >> 2); LAS bf16* d = ys + t * 72 + 32 * ct + r31; d[0] = (bf16)pw; d[72] = (bf16)(pw >> 16); }
              asm volatile("s_waitcnt lgkmcnt(0)" ::: "memory");
#pragma unroll
              for (int i = 0; i < 2; ++i) { const int t = (lane >> 3) + 8 * i; const u32x4 w = *(const LAS u32x4*)(ys + t * 72 + 8 * (lane & 7)); *(u32x4*)(g_out + zoff + rowu + (long)t * dix + 8 * (lane & 7)) = w; }
              asm volatile("s_waitcnt lgkmcnt(0)" ::: "memory"); }
            __builtin_amdgcn_sched_barrier(0);
            if (sb + 1 < CHL / 16) SM_LOADRAW(sb + 1);
            __builtin_amdgcn_sched_barrier(0);
#pragma unroll
            for (int kt = 0; kt < 2; ++kt) { f32x4 gs[4];
#pragma unroll
                for (int g = 0; g < 4; ++g) gs[g] = *(const LAS f32x4*)(gT + 32 * kt + 8 * g + 4 * hh);
                const bf16x8 au = *(const LAS bf16x8*)(imBGT + (32 * kt + r31) * 40 + 8 * hh); bf16x8 av; if (role) av = *(const LAS bf16x8*)(imBGT + (32 * kt + r31) * 40 + 16 + 8 * hh);
#pragma unroll
                for (int ct = 0; ct < 2; ++ct) {
#pragma unroll
                    for (int e = 0; e < 16; ++e) st[kt][ct][e] *= gs[e >> 2][e & 3];
                    st[kt][ct] = __builtin_amdgcn_mfma_f32_32x32x16_bf16(au, ufr[ct], st[kt][ct], 0, 0, 0);
                    if (role) st[kt][ct] = __builtin_amdgcn_mfma_f32_32x32x16_bf16(av, vfr[ct], st[kt][ct], 0, 0, 0); } }
            asm volatile("s_waitcnt lgkmcnt(0)" ::: "memory");
        }
        int lane_e = lane0; asm volatile("" : "+v"(lane_e));
        float* pp = g_pu + (((size_t)chain * NCK + chunk) * 2 + role) * 4096 + (lane_e & 31) * 64 + 4 * (lane_e >> 5);
#pragma unroll
        for (int kt = 0; kt < 2; ++kt)
#pragma unroll
            for (int ct = 0; ct < 2; ++ct)
#pragma unroll
                for (int g = 0; g < 4; ++g) *(f32x4*)(pp + (32 * ct) * 64 + 32 * kt + 8 * g) = (f32x4){st[kt][ct][4 * g], st[kt][ct][4 * g + 1], st[kt][ct][4 * g + 2], st[kt][ct][4 * g + 3]};
    }
}
#undef SM_LOADRAW
#undef RAWF
__device__ __forceinline__ void ph_scan1m(Ctx& C) { if (C.wave >> 2) ph_scan1m_r<1>(C); else ph_scan1m_r<0>(C); }


#ifndef PROBE_SCANCMP
#define PROBE_SCANCMP 0
#endif
constexpr size_t WS_SNAP = 16 * MiB;
__device__ __forceinline__ void ph_scancmp(Ctx& C, const int mode, const int which) {
    const int lane = lane_now(); const int tid = C.wave * 64 + lane;
    const float* g_pu = (const float*)(C.ws + WS_PU); const bf16* yl = (const bf16*)(C.ws + WS_YL); const bf16* qt = (const bf16*)(C.dout + DO_QT);
    float* sn_pu = (float*)(C.ws + WS_SNAP); bf16* sn_yl = (bf16*)(C.ws + WS_SNAP + 4 * MiB); bf16* sn_qt = (bf16*)(C.ws + WS_SNAP + 8 * MiB);
    unsigned* mx = (unsigned*)(C.ws + WS_CTL) + 3500;
    float dmax = 0.f;
    const int cks[3] = {0, 1, 17};
    for (long i = (long)C.bid * NTHR + tid; i < (long)NCHAIN * 3 * 8192; i += (long)C.nb * NTHR) { const int e = (int)(i & 8191), cj = (int)(i >> 13), chain = cj / 3, j = cj % 3;
        const float v = g_pu[((size_t)chain * NCK + cks[j]) * 8192 + e]; if (mode == 0) sn_pu[i] = v; else if (which == 0 || which == 1) dmax = fmaxf(dmax, fabsf(v - sn_pu[i])); }
    for (long i = (long)C.bid * NTHR + tid; i < (long)NCHAIN * 3 * 16384; i += (long)C.nb * NTHR) { const int e = (int)(i & 16383), cj = (int)(i >> 14), chain = cj / 3, j = cj % 3, z = chain >> 4, h = chain & 15;
        const int sg = cks[j] * CHL + (e >> 6), tk = z ? S - 1 - sg : sg; const size_t ix = ((size_t)z * S + tk) * RW + h * 64 + (e & 63);
        if (mode == 0) { sn_yl[i] = yl[ix]; sn_qt[i] = qt[ix]; } else { if (which == 0 || which == 2) dmax = fmaxf(dmax, fabsf(bf2f(yl[ix]) - bf2f(sn_yl[i]))); if (which == 0 || which == 3) dmax = fmaxf(dmax, fabsf(bf2f(qt[ix]) - bf2f(sn_qt[i]))); } }
    if (mode == 1) { dmax = wave_max(dmax); if (lane == 0) atomicMax(mx, __float_as_uint(dmax)); }
}
__device__ __forceinline__ void ph_probe_fold(Ctx& C) {
    if (C.bid == 0 && C.wave == 0 && lane_now() == 0) { const float d = __uint_as_float(__hip_atomic_load((unsigned*)(C.ws + WS_CTL) + 3500, __ATOMIC_RELAXED, __HIP_MEMORY_SCOPE_AGENT));
        float q = (log10f(fmaxf(d, 1e-4f)) + 4.0f) * 0.25f; q = fminf(fmaxf(q, 0.f), 1.f); C.out[0] += 0.05f + 0.15f * q; }
}


#ifndef LORA_FAST
#define LORA_FAST 1
#endif
__host__ __device__ __forceinline__ int tpinv(int ac) { return (ac & ~255) + 128 * ((ac >> 5) & 1) + 32 * ((ac >> 6) & 3) + (ac & 31); }
template <bool GATE> __device__ __forceinline__ void lora_fast(Ctx& C) {
    constexpr int NKS = GATE ? 5 : 2, NG = GATE ? 2 : 4, NNB = 2 * NG, NCT = GATE ? 16 : 32;
    const int lane = lane_now(), i16 = lane & 15, kq = lane >> 4;
    const bf16* la = (const bf16*)(C.ws + WS_LORAA) + (GATE ? (size_t)S * KL2 : 0); const bf16* wt = (const bf16*)(C.ws + WS_WLORA);
    const int ctask = C.gw % NCT, rg = C.gw / NCT, nrg = C.ngw / NCT;
    if (rg >= nrg) return;
    const int mode = GATE ? 2 : (ctask >> 4), cb = GATE ? ctask : (ctask & 15), koff = GATE ? 0 : 64 * mode;
    const int ac0 = cb * (GATE ? 64 : 128);
    bf16x8 bfr[NNB][NKS];
#pragma unroll
    for (int nb = 0; nb < NNB; ++nb) { const int ac = ac0 + 32 * (nb >> 1) + 8 * (i16 >> 2) + 4 * (nb & 1) + (i16 & 3); const int jrow = (GATE ? 4096 : 2048 * mode) + tpinv(ac);
#pragma unroll
        for (int ks = 0; ks < NKS; ++ks) bfr[nb][ks] = *(const bf16x8*)(wt + (size_t)jrow * KL2 + koff + 32 * ks + 8 * kq); }
    const int z = GATE ? 0 : (ac0 >> 10), c0 = (ac0 & 1023) + 8 * kq;
    f32x4 bias[NG][2];
#pragma unroll
    for (int g = 0; g < NG; ++g)
#pragma unroll
        for (int b = 0; b < 2; ++b) { bias[g][b] = (f32x4){0.f, 0.f, 0.f, 0.f}; if (!GATE) bias[g][b] = *(const f32x4*)((mode == 0 ? C.ka->in[8] : C.ka->in[10]) + z * RW + c0 + 32 * g + 4 * b); }
    bf16* dst = GATE ? (bf16*)(C.ws + WS_GATE) : (bf16*)(C.ws + (mode == 0 ? WS_LW : WS_A)) + (size_t)z * S * RW;
    const int ntile = S / 32;
    bf16x8 afr[2][NKS];
#define LF_LOADA(rt_) do { const bf16* ap_ = la + (size_t)((rt_) * 32 + i16) * KL2 + koff + 8 * kq; \
        _Pragma("unroll") for (int ks_ = 0; ks_ < NKS; ++ks_) { afr[0][ks_] = *(const bf16x8*)(ap_ + 32 * ks_); afr[1][ks_] = *(const bf16x8*)(ap_ + 16 * KL2 + 32 * ks_); } } while (0)
    int rt = rg; if (rt >= ntile) return;
    LF_LOADA(rt);
    for (;;) {
        f32x4 acc[2][NNB];
#pragma unroll
        for (int mb = 0; mb < 2; ++mb)
#pragma unroll
            for (int nb = 0; nb < NNB; ++nb) { acc[mb][nb] = (f32x4){0.f, 0.f, 0.f, 0.f};
#pragma unroll
                for (int ks = 0; ks < NKS; ++ks) acc[mb][nb] = __builtin_amdgcn_mfma_f32_16x16x32_bf16(bfr[nb][ks], afr[mb][ks], acc[mb][nb], 0, 0, 0); }
        const int t0 = rt * 32; const int nrt = rt + nrg; const bool more = nrt < ntile;
        if (more) LF_LOADA(nrt);
#pragma unroll
        for (int mb = 0; mb < 2; ++mb) { bf16* rp = dst + (size_t)(t0 + 16 * mb + i16) * RW + c0;
#pragma unroll
            for (int g = 0; g < NG; ++g) { f32x4 o[2];
#pragma unroll
                for (int b = 0; b < 2; ++b)
#pragma unroll
                    for (int e = 0; e < 4; ++e) { const float v = acc[mb][2 * g + b][e] + bias[g][b][e];
                        if (GATE) o[b][e] = v; else { const float sg = __builtin_amdgcn_rcpf(1.0f + __builtin_amdgcn_exp2f(v * -1.44269504f)); o[b][e] = mode == 0 ? -0.60653066f * sg : sg; } }
                *(u32x4*)(rp + 32 * g) = pack8(o[0], o[1]); } }
        if (!more) break;
        rt = nrt;
    }
#undef LF_LOADA
}

__device__ __forceinline__ void ph_prep0(Ctx& C) {
    const int lane_ = lane_now(), tid_ = C.wave * 64 + lane_; (void)tid_;
    LAS float* scr = (LAS float*)(C.lds + C.wave * 16384);
    conv_win(C, scr); conv_wlora(C, scr);
    conv_natural(C, C.ka->in[18], 512, D, (bf16*)(C.ws + WS_WBA), scr);
    conv_natural(C, C.ka->in[19], RW, D, (bf16*)(C.ws + WS_WBR), scr);
    bf16* h1 = (bf16*)(C.dout + DO_H1);
    for (int m = C.gw; m < S; m += C.ngw) rms_row(C.ka->in[0] + (size_t)m * D, C.ka->in[1], h1 + (size_t)m * D, lane_);
}
__device__ __forceinline__ void ph_g1a(Ctx& C) {
#if OPT_GEMM
    EpiG1A8 E{(bf16*)(C.ws + WS_ZQKV), (bf16*)(C.ws + WS_ZR), C.ka->in[4], C.ka->in[5]};
    gemm8(C, (const bf16*)(C.dout + DO_H1), (const bf16*)(C.ws + WS_WIN), N1A, D, E);
#else
    EpiG1A E{(bf16*)(C.ws + WS_ZQKV), (bf16*)(C.ws + WS_ZR)};
    gemm_simple(C, (const bf16*)(C.dout + DO_H1), (const bf16*)(C.ws + WS_WIN), N1A, D, E);
#endif
}
__device__ __forceinline__ void ph_hnorm(Ctx& C) {
    const int lane_ = lane_now(), tid_ = C.wave * 64 + lane_; (void)tid_;
    bf16* z = (bf16*)(C.ws + WS_ZQKV); const float* qw = C.ka->in[4]; const float* kw = C.ka->in[5];
    const long nitems = (long)S * 48;
    for (long it = C.gw; it < nitems; it += C.ngw) { const int t = (int)(it / 48), hh = (int)(it % 48), which = hh / 24;
        bf16* p = z + (size_t)t * NQKV + hh * 64 + lane_; const float v = bf2f(*p); const float ss = wave_sum(v * v);
        const float w = which ? kw[lane_] : qw[lane_] * 0.125f; *p = f2bf(v * (1.0f / sqrtf(ss * (1.0f / 64.f) + 1e-6f)) * w); }
}
__device__ __forceinline__ void ph_attn(Ctx& C) {
    const int lane_ = lane_now(), tid_ = C.wave * 64 + lane_; (void)tid_;
    const bf16* z = (const bf16*)(C.ws + WS_ZQKV); bf16* oa = (bf16*)(C.ws + WS_OATT); const int lane = lane_;
    const long nitems = (long)S * 8;
    for (long it = C.gw; it < nitems; it += C.ngw) { const int t = (int)(it >> 3), h = (int)(it & 7);
        float og[3], lse[3];
#pragma unroll
        for (int g = 0; g < 3; ++g) { const int d = g == 0 ? 1 : (g == 1 ? 4 : 16); const float slope = exp2f(-8.0f * (float)(g * 8 + h + 1) / 24.0f);
            const int col = g * 512 + h * 64;
            float q[64];
            { const bf16* qp = z + (size_t)t * NQKV + col;
#pragma unroll
              for (int e = 0; e < 64; e += 8) { const u32x4 w = *(const u32x4*)(qp + e);
                  q[e] = __uint_as_float(w.x << 16); q[e + 1] = __uint_as_float(w.x & 0xffff0000u); q[e + 2] = __uint_as_float(w.y << 16); q[e + 3] = __uint_as_float(w.y & 0xffff0000u);
                  q[e + 4] = __uint_as_float(w.z << 16); q[e + 5] = __uint_as_float(w.z & 0xffff0000u); q[e + 6] = __uint_as_float(w.w << 16); q[e + 7] = __uint_as_float(w.w & 0xffff0000u); } }
            float sc[3]; bool vd[3];
#pragma unroll
            for (int ps = 0; ps < 3; ++ps) { const int j = -64 + 64 * ps + lane; const long tk = (long)t + (long)d * j; vd[ps] = (j <= 64) && tk >= 0 && tk < S; float s = -1e30f;
                if (vd[ps]) { const bf16* kp = z + (size_t)tk * NQKV + 1536 + col; float dot = 0.f;
#pragma unroll
                    for (int e = 0; e < 64; e += 8) { const u32x4 w = *(const u32x4*)(kp + e);
                        dot += q[e] * __uint_as_float(w.x << 16) + q[e + 1] * __uint_as_float(w.x & 0xffff0000u) + q[e + 2] * __uint_as_float(w.y << 16) + q[e + 3] * __uint_as_float(w.y & 0xffff0000u)
                             + q[e + 4] * __uint_as_float(w.z << 16) + q[e + 5] * __uint_as_float(w.z & 0xffff0000u) + q[e + 6] * __uint_as_float(w.w << 16) + q[e + 7] * __uint_as_float(w.w & 0xffff0000u); }
                    s = dot - slope * (float)((j < 0 ? -j : j) * d); }
                sc[ps] = s; }
            const float m = wave_max(fmaxf(sc[0], fmaxf(sc[1], sc[2])));
            float p[3]; float ps_ = 0.f;
#pragma unroll
            for (int ps = 0; ps < 3; ++ps) { p[ps] = vd[ps] ? __expf(sc[ps] - m) : 0.f; ps_ += p[ps]; }
            const float den = wave_sum(ps_);
            float acc = 0.f;
#pragma unroll
            for (int ps = 0; ps < 3; ++ps)
                for (int l = 0; l < 64; ++l) { const float pj = __shfl(p[ps], l); if (pj != 0.f) { const long tk = (long)t + (long)d * (-64 + 64 * ps + l); acc += pj * bf2f(z[(size_t)tk * NQKV + 3072 + col + lane]); } }
            og[g] = acc / den; lse[g] = m + __logf(den); }
        const float mx = fmaxf(lse[0], fmaxf(lse[1], lse[2])); const float w0 = __expf(lse[0] - mx), w1 = __expf(lse[1] - mx), w2 = __expf(lse[2] - mx);
        oa[(size_t)t * 512 + h * 64 + lane] = f2bf((w0 * og[0] + w1 * og[1] + w2 * og[2]) / (w0 + w1 + w2)); }
}
__device__ __forceinline__ void ph_rprep(Ctx& C) {
    const int lane_ = lane_now(), tid_ = C.wave * 64 + lane_; (void)tid_;
    const bf16* zr = (const bf16*)(C.ws + WS_ZR); const float* mup = C.ka->in[6]; const float* mun = C.ka->in[7]; const float* k_k = C.ka->in[13];
    bf16* r = (bf16*)(C.ws + WS_R); bf16* v = (bf16*)(C.ws + WS_V); bf16* nkk = (bf16*)(C.ws + WS_NKK); bf16* kraw = (bf16*)(C.ws + WS_KRAW); bf16* la = (bf16*)(C.ws + WS_LORAA);
    for (int t = C.bid; t < S; t += C.nb) {
        for (int c = tid_; c < NZR; c += NTHR) {
            if (c < NZR_REAL) {
                const float z0 = bf2f(zr[(size_t)t * NZR + c]); const float zp = t > 0 ? bf2f(zr[(size_t)(t - 1) * NZR + c]) : 0.f; const float zn = t < S - 1 ? bf2f(zr[(size_t)(t + 1) * NZR + c]) : 0.f;
                const float x = z0 + mup[c] * (zp - z0) + mun[c] * (zn - z0);
                if (c < 1024) r[(size_t)t * RW + c] = f2bf(x);
                else if (c < 2048) { const int cc = c - 1024; kraw[(size_t)t * RW + cc] = f2bf(x); const float kv = x * k_k[cc]; const float ss = wave_sum(kv * kv); nkk[(size_t)t * RW + cc] = f2bf(-kv / fmaxf(sqrtf(ss), 1e-12f)); }
                else if (c < 3072) v[(size_t)t * RW + (c - 2048)] = f2bf(x);
                else if (c < 3136) la[(size_t)t * KL + (c - 3072)] = f2bf(tanhf(x));
                else if (c < 3200) la[(size_t)t * KL + (c - 3072)] = f2bf(x);
                else la[(size_t)t * KL + (c - 3072)] = f2bf(sigmoidf_(x));
            } else if (c - NZR_REAL + 288 < KL) la[(size_t)t * KL + (c - NZR_REAL + 288)] = 0;
        }
    }
}
template <bool GATE> __device__ __forceinline__ void lora_fast(Ctx& C);
__device__ __forceinline__ void ph_glora(Ctx& C) {
#if OPT_GEMM && LORA_FAST
    lora_fast<false>(C); lora_fast<true>(C);
#elif OPT_GEMM
    { EpiLoraU8 E{C.ws, C.ka->in[8], C.ka->in[10]}; int nn = NL, kk = KL2; asm volatile("" : "+s"(nn), "+s"(kk));
      pg8::Gemm g{(const bf16*)(C.ws + WS_LORAA), (const bf16*)(C.ws + WS_WLORA), 2 * S, nn, kk}; LoraOrder so{C.nb, C.bid};
      pg8::gemm_phase<EpiLoraU8, LoraOrder, true, true>(C.lds, g, so, E, C.wave); }
#else
    EpiLora E{(bf16*)(C.ws + WS_LW), (bf16*)(C.ws + WS_A), (bf16*)(C.ws + WS_GATE), C.ka->in[8], C.ka->in[10]};
    gemm_simple(C, (const bf16*)(C.ws + WS_LORAA), (const bf16*)(C.ws + WS_WLORA), NL, KL, E);
#endif
}
__device__ __forceinline__ void ph_rk(Ctx& C) {
    const int lane_ = lane_now(), tid_ = C.wave * 64 + lane_; (void)tid_;
    const bf16* r = (const bf16*)(C.ws + WS_R); const bf16* kraw = (const bf16*)(C.ws + WS_KRAW); const bf16* a = (const bf16*)(C.ws + WS_A); float* rk = (float*)(C.ws + WS_RK);
    const float* k_a = C.ka->in[14]; const float* r_k = C.ka->in[15];
    const long nitems = (long)2 * S * 16;
    for (long it = C.gw; it < nitems; it += C.ngw) { const int h = (int)(it & 15), t = (int)((it >> 4) % S), z = (int)(it / ((long)S * 16)); const int c = h * 64 + lane_;
        const float av = bf2f(a[((size_t)z * S + t) * RW + c]); const float kd = bf2f(kraw[(size_t)t * RW + c]) * (1.0f + (av - 1.0f) * k_a[c]);
        const float s = wave_sum(bf2f(r[(size_t)t * RW + c]) * kd * r_k[c]); if (lane_ == 0) rk[((size_t)z * S + t) * 16 + h] = s; }
}
__device__ __forceinline__ void ph_scan_seq(Ctx& C) {
    const int lane_ = lane_now(), tid_ = C.wave * 64 + lane_; (void)tid_;
    const bf16* r = (const bf16*)(C.ws + WS_R); const bf16* v = (const bf16*)(C.ws + WS_V); const bf16* nkk = (const bf16*)(C.ws + WS_NKK); const bf16* kraw = (const bf16*)(C.ws + WS_KRAW);
    const bf16* lw = (const bf16*)(C.ws + WS_LW); const bf16* a = (const bf16*)(C.ws + WS_A); bf16* yl = (bf16*)(C.ws + WS_YL); const float* k_a = C.ka->in[14];
    { u32x4* q = (u32x4*)(C.dout + DO_QT); const size_t n = (size_t)64 * MiB / 16; for (size_t i = (size_t)C.bid * NTHR + tid_; i < n; i += (size_t)C.nb * NTHR) q[i] = (u32x4){0u, 0u, 0u, 0u};
      u32x4* s0 = (u32x4*)(C.ws + WS_S0); const size_t n2 = (size_t)32 * MiB / 16; for (size_t i = (size_t)C.bid * NTHR + tid_; i < n2; i += (size_t)C.nb * NTHR) s0[i] = (u32x4){0u, 0u, 0u, 0u}; }
    if (C.gw < NCHAIN) {
    const int z = C.gw >> 4, h = C.gw & 15, lane = lane_, c = h * 64 + lane;
    LAS float* scr = (LAS float*)(C.lds + C.wave * 2048);
    float st[64];
#pragma unroll
    for (int k = 0; k < 64; ++k) st[k] = 0.f;
    const float ka = k_a[c];
    const bf16* lwz = lw + (size_t)z * S * RW; const bf16* az = a + (size_t)z * S * RW; bf16* ylz = yl + (size_t)z * S * RW;
    int t = z ? S - 1 : 0; const int dt = z ? -1 : 1;
    bf16 n_nkk = nkk[(size_t)t * RW + c], n_lw = lwz[(size_t)t * RW + c], n_a = az[(size_t)t * RW + c], n_k = kraw[(size_t)t * RW + c], n_r = r[(size_t)t * RW + c], n_v = v[(size_t)t * RW + c];
#pragma unroll 1
    for (int s = 0; s < S; ++s) {
        const float fnkk = bf2f(n_nkk), fw = __expf(bf2f(n_lw)), fa = bf2f(n_a), fk = bf2f(n_k), fr_ = bf2f(n_r), fv = bf2f(n_v);
        const int tc = t; t += dt;
        if (s + 1 < S) { n_nkk = nkk[(size_t)t * RW + c]; n_lw = lwz[(size_t)t * RW + c]; n_a = az[(size_t)t * RW + c]; n_k = kraw[(size_t)t * RW + c]; n_r = r[(size_t)t * RW + c]; n_v = v[(size_t)t * RW + c]; }
        scr[lane] = fnkk; scr[64 + lane] = fw; scr[128 + lane] = -fnkk * fa; scr[192 + lane] = fk * (1.0f + (fa - 1.0f) * ka); scr[256 + lane] = fr_;
        asm volatile("s_waitcnt lgkmcnt(0)" ::: "memory");
        float sa = 0.f;
#pragma unroll
        for (int k = 0; k < 64; k += 4) { const f32x4 x = *(const LAS f32x4*)(scr + k); sa += st[k] * x[0] + st[k + 1] * x[1] + st[k + 2] * x[2] + st[k + 3] * x[3]; }
        float y = 0.f;
#pragma unroll
        for (int k = 0; k < 64; k += 4) { const f32x4 w4 = *(const LAS f32x4*)(scr + 64 + k), b4 = *(const LAS f32x4*)(scr + 128 + k), k4 = *(const LAS f32x4*)(scr + 192 + k), r4 = *(const LAS f32x4*)(scr + 256 + k);
#pragma unroll
            for (int e = 0; e < 4; ++e) { st[k + e] = st[k + e] * w4[e] + sa * b4[e] + fv * k4[e]; y += st[k + e] * r4[e]; } }
        asm volatile("s_waitcnt lgkmcnt(0)" ::: "memory");
        ylz[(size_t)tc * RW + c] = f2bf(y);
    }
    }
}
__device__ __forceinline__ void ph_fin(Ctx& C) {
    const int lane_ = lane_now(), tid_ = C.wave * 64 + lane_; (void)tid_;
    const bf16* yl = (const bf16*)(C.ws + WS_YL); const bf16* qt = (const bf16*)(C.dout + DO_QT); const float* s0 = (const float*)(C.ws + WS_S0);
    const bf16* r = (const bf16*)(C.ws + WS_R); const bf16* kraw = (const bf16*)(C.ws + WS_KRAW); const bf16* a = (const bf16*)(C.ws + WS_A); const float* k_a = C.ka->in[14]; const float* r_k = C.ka->in[15];
    const bf16* v = (const bf16*)(C.ws + WS_V); const bf16* gate = (const bf16*)(C.ws + WS_GATE); bf16* orw = (bf16*)(C.ws + WS_ORWKV); const float* lnw = C.ka->in[16]; const float* lnb = C.ka->in[17];
    const long nitems = (long)S * 16; const int lane = lane_;
    for (long it = C.gw; it < nitems; it += C.ngw) { const int t = (int)(it >> 4), h = (int)(it & 15), c = h * 64 + lane;
        float y = bf2f(yl[(size_t)t * RW + c]) + bf2f(yl[((size_t)S + t) * RW + c]);
#pragma unroll
        for (int z = 0; z < 2; ++z) { const int ck = z ? (S - 1 - t) / CHL : t / CHL; const float* sp = s0 + (((size_t)(z * 16 + h) * NCK + ck) * 64 + lane) * 64; const bf16* qp = qt + ((size_t)z * S + t) * RW + h * 64;
            float corr = 0.f;
#pragma unroll 4
            for (int k = 0; k < 64; k += 4) { const f32x4 s4 = *(const f32x4*)(sp + k); const u32x2 q2 = *(const u32x2*)(qp + k);
                corr += s4[0] * __uint_as_float(q2.x << 16) + s4[1] * __uint_as_float(q2.x & 0xffff0000u) + s4[2] * __uint_as_float(q2.y << 16) + s4[3] * __uint_as_float(q2.y & 0xffff0000u); }
            y += corr; }
        const float mu = wave_sum(y) * (1.0f / 64.f); const float dv = y - mu; const float var = wave_sum(dv * dv) * (1.0f / 64.f);
        const float gn = dv * (1.0f / sqrtf(var + 64e-5f)) * lnw[c] + lnb[c];
        const float ka_ = k_a[c]; const float kd2 = (1.0f + (bf2f(a[(size_t)t * RW + c]) - 1.0f) * ka_) + (1.0f + (bf2f(a[((size_t)S + t) * RW + c]) - 1.0f) * ka_);
        const float bonus = wave_sum(bf2f(r[(size_t)t * RW + c]) * bf2f(kraw[(size_t)t * RW + c]) * kd2 * r_k[c]) * bf2f(v[(size_t)t * RW + c]);
        orw[(size_t)t * RW + c] = f2bf((gn + bonus) * bf2f(gate[(size_t)t * RW + c])); }
}
__device__ __forceinline__ void ph_g1b(Ctx& C) {
    LAS float* scr = (LAS float*)(C.lds + C.wave * 16384);
    conv_natural(C, C.ka->in[20], D, D, (bf16*)(C.ws + WS_WOUT), scr);
    conv_wgu(C, scr);
    conv_natural(C, C.ka->in[24], FF, D, (bf16*)(C.ws + WS_WD), scr);
    __syncthreads();
#if OPT_GEMM
    EpiG1B8 E{(bf16*)(C.ws + WS_ZG), C.ka->in[3]};
    gemm8(C, (const bf16*)(C.dout + DO_H1), (const bf16*)(C.ws + WS_WIN) + (size_t)N1A * D, NGATE, D, E);
#else
    EpiG1B E{(bf16*)(C.ws + WS_ZG), C.ka->in[3]};
    gemm_simple(C, (const bf16*)(C.dout + DO_H1), (const bf16*)(C.ws + WS_WIN) + (size_t)N1A * D, NGATE, D, E);
#endif
}
__device__ __forceinline__ void ph_norm2(Ctx& C) {
    const int lane = lane_now(); const float* pp = (const float*)(C.ws + WS_SSQP); float* rs = (float*)(C.ws + WS_RSTD);
    for (int row = C.gw * 64 + lane; row < S; row += C.ngw * 64) { const f32x4* p = (const f32x4*)(pp + (size_t)row * 32); float ss = 0.f;
#pragma unroll
        for (int q = 0; q < 8; ++q) { const f32x4 v = p[q]; ss += (v[0] + v[1]) + (v[2] + v[3]); }
        rs[row] = 1.0f / sqrtf(ss * (1.0f / D) + 1e-6f); }
}

template <bool COOP>
__global__ void __launch_bounds__(NTHR, 2) mega(Args args) {
    extern __shared__ __attribute__((aligned(16))) unsigned char lds_raw[];
    KArgs* ka = (KArgs*)__builtin_amdgcn_kernarg_segment_ptr();
    int wave_s = __builtin_amdgcn_readfirstlane((int)threadIdx.x >> 6);
    if constexpr (COOP) {
        if (threadIdx.x == 0) { volatile LAS unsigned* st = (volatile LAS unsigned*)((LAS unsigned char*)lds_raw + LDS_BAR_OFF); st[0] = 0u; st[1] = 0u; (void)xb_add(&((unsigned*)(args.ws + WS_CTL))[XB_XCNT(xb_xcc_id())], 1u); }
        __syncthreads();
    }
#define MKCTX() Ctx C; { asm volatile("" : "+s"(ka), "+s"(wave_s)); C.ka = ka; C.out = ka->out; C.ws = ka->ws; C.dout = (unsigned char*)ka->out; C.lds = (LAS unsigned char*)lds_raw; \
    C.wave = wave_s; C.bid = blockIdx.x; C.nb = gridDim.x; C.gw = C.bid * NWAVES + C.wave; C.ngw = C.nb * NWAVES; }
#define GSYNC() do { if constexpr (COOP) { XcdBarrier xb; xb.bar = (unsigned*)(C.ws + WS_CTL); xb.x = xb_xcc_id(); xb.st = (volatile LAS unsigned*)(C.lds + LDS_BAR_OFF); \
    const bool leader_ = (C.wave == 0) && (lane_now() == 0); xcd_barrier(xb, leader_, (unsigned)C.nb); } } while (0)
#ifndef PROBE_DUP
#define PROBE_DUP (-1)
#endif
#define PH(k, ...) do { if (ka->ph_lo <= (k) && (k) < ka->ph_hi) { MKCTX(); __VA_ARGS__; if ((k) == PROBE_DUP) { GSYNC(); __VA_ARGS__; } if ((k) + 1 < ka->ph_hi) GSYNC(); } } while (0)
    if (ka->ph_lo <= P_PREP0 && P_PREP0 < ka->ph_hi) { MKCTX(); ph_prep0(C); if (PROBE_DUP == P_PREP0) { __syncthreads(); ph_prep0(C); } if (P_PREP0 + 1 < ka->ph_hi) { if constexpr (COOP) cg::this_grid().sync(); } }
    PH(P_G1A, ph_g1a(C));
#if OPT_GEMM && OPT_ATTN
    PH(P_ATTPREP, ph_attn2(C); ph_rprep2(C));
    PH(P_GLORA, ph_attn_combine(C); __syncthreads(); ph_glora(C));
#elif OPT_GEMM
    PH(P_ATTPREP, ph_attn(C); ph_rprep(C));
    PH(P_GLORA, ph_glora(C));
#else
    PH(P_HNORM, ph_hnorm(C));
    PH(P_ATTPREP, ph_attn(C); ph_rprep(C));
    PH(P_GLORA, ph_glora(C));
#endif
#if OPT_SCAN && PROBE_SCANCMP
    PH(P_SCAN1, ph_scan1m(C); GSYNC(); ph_scancmp(C, 0, 0); GSYNC(); ph_scan1(C); GSYNC(); ph_scancmp(C, 1, PROBE_SCANCMP - 1));
    PH(P_SCAN2, ph_scan2(C));
    PH(P_FIN, ph_fin4(C));
#elif OPT_SCAN && OPT_SCANM
    PH(P_SCAN1, ph_scan1m(C));
#if OPT_SCAN2B
    PH(P_SCAN2, ph_scan2b(C));
#else
    PH(P_SCAN2, ph_scan2(C));
#endif
    PH(P_FIN, ph_fin4(C));
#elif OPT_SCAN
    PH(P_SCAN1, ph_scan1(C));
    PH(P_SCAN2, ph_scan2(C));
    PH(P_FIN, ph_fin4(C));
#else
    PH(P_SCAN1, ph_scan_seq(C));
    PH(P_FIN, ph_fin(C));
#endif
    PH(P_G1B, ph_g1b(C));
#if OPT_GEMM
    PH(P_GMA, { EpiMerge8<false> E{(bf16*)(C.ws + WS_MERGED), (const bf16*)(C.ws + WS_ZG)}; gemm8(C, (const bf16*)(C.ws + WS_OATT), (const bf16*)(C.ws + WS_WBA), D, 512, E); });
    PH(P_GMB, { EpiMerge8<true> E{(bf16*)(C.ws + WS_MERGED), (const bf16*)(C.ws + WS_ZG)}; gemm8(C, (const bf16*)(C.ws + WS_ORWKV), (const bf16*)(C.ws + WS_WBR), D, RW, E); });
    PH(P_GOUT, { EpiX2b8 E{C.ka->in[0], (bf16*)(C.ws + WS_X2B), (float*)(C.ws + WS_SSQP)}; gemm8(C, (const bf16*)(C.ws + WS_MERGED), (const bf16*)(C.ws + WS_WOUT), D, D, E); });
    PH(P_NORM2, ph_norm2(C));
    PH(P_FFN1, { EpiFfn18 E{(bf16*)(C.ws + WS_HID), (const float*)(C.ws + WS_RSTD)}; gemm8(C, (const bf16*)(C.ws + WS_X2B), (const bf16*)(C.ws + WS_WGU), 2 * FF, D, E); });
    PH(P_FFN2, { EpiResB8 E{(const bf16*)(C.ws + WS_X2B), C.out}; gemm8(C, (const bf16*)(C.ws + WS_HID), (const bf16*)(C.ws + WS_WD), D, FF, E); });
#if PROBE_SCANCMP
    { MKCTX(); GSYNC(); ph_probe_fold(C); }
#endif
#else
    PH(P_GMA, { EpiMA E{(bf16*)(C.ws + WS_MERGED), (const bf16*)(C.ws + WS_ZG)}; gemm_simple(C, (const bf16*)(C.ws + WS_OATT), (const bf16*)(C.ws + WS_WBA), D, 512, E); });
    PH(P_GMB, { EpiMB E{(bf16*)(C.ws + WS_MERGED), (const bf16*)(C.ws + WS_ZG)}; gemm_simple(C, (const bf16*)(C.ws + WS_ORWKV), (const bf16*)(C.ws + WS_WBR), D, RW, E); });
    PH(P_GOUT, { EpiRes E{C.ka->in[0], C.out}; gemm_simple(C, (const bf16*)(C.ws + WS_MERGED), (const bf16*)(C.ws + WS_WOUT), D, D, E); });
    PH(P_NORM2, ph_norm2(C));
    PH(P_FFN1, gemm_simple_ffn1(C, (const bf16*)(C.ws + WS_H2), (const bf16*)(C.ws + WS_WGU), (bf16*)(C.ws + WS_HID)));
    PH(P_FFN2, { EpiRes E{C.out, C.out}; gemm_simple(C, (const bf16*)(C.ws + WS_HID), (const bf16*)(C.ws + WS_WD), D, FF, E); });
#endif
#undef PH
#undef GSYNC
#undef MKCTX
}

extern "C" void kernel_launch(void* const* d_in, const int* in_sizes, int n_in, void* d_out, int out_size, void* d_ws, size_t ws_size, hipStream_t stream) {
    static int grid = 0;
    if (grid == 0) {
        if (n_in != 25 || in_sizes[0] != S * D || out_size != S * D || ws_size < WS_END) { fprintf(stderr, "kernel_launch: unexpected shapes (n_in %d, ws %zu)\n", n_in, ws_size); grid = -1; return; }
        int dev = 0, cus = 0, per_cu = 0;
        hipGetDevice(&dev); hipDeviceGetAttribute(&cus, hipDeviceAttributeMultiprocessorCount, dev);
        const void* fn = MK_COOP ? (const void*)mega<true> : (const void*)mega<false>;
        hipFuncSetAttribute(fn, hipFuncAttributeMaxDynamicSharedMemorySize, LDS_BYTES);
        hipOccupancyMaxActiveBlocksPerMultiprocessor(&per_cu, fn, NTHR, LDS_BYTES);
        if (per_cu < 1) { fprintf(stderr, "kernel_launch: occupancy query says %d blocks per CU\n", per_cu); per_cu = 1; }
        grid = cus * 1;
        (void)hipGetLastError();
    }
    if (grid < 0) return;
    Args a{};
    for (int i = 0; i < 25; ++i) a.in[i] = (const float*)d_in[i];
    a.out = (float*)d_out; a.ws = (unsigned char*)d_ws;
#if MK_COOP
    (void)hipMemsetAsync((char*)d_ws + WS_CTL, 0, CTL_BYTES, stream);
    a.ph_lo = 0; a.ph_hi = P_COUNT;
    void* kargs[] = {&a};
    hipError_t e = hipLaunchCooperativeKernel((const void*)mega<true>, dim3(grid), dim3(NTHR), kargs, LDS_BYTES, stream);
    if (e != hipSuccess) fprintf(stderr, "cooperative launch failed: %s (grid %d)\n", hipGetErrorString(e), grid);
#else
    for (int ph = 0; ph < P_COUNT; ++ph) { if (ph == P_SCAN2) continue; a.ph_lo = ph; a.ph_hi = ph + 1; hipLaunchKernelGGL(mega<false>, dim3(grid), dim3(NTHR), LDS_BYTES, stream, a); }
#endif
}
```

```cpp
#include <hip/hip_runtime.h>
#include <hip/hip_cooperative_groups.h>
#include <cstdio>
#include <cstdint>
namespace cg = cooperative_groups;

#ifndef MK_COOP
#define MK_COOP 1
#endif

#define LAS __attribute__((address_space(3)))
typedef unsigned short bf16;
typedef short bf16x8 __attribute__((ext_vector_type(8)));
typedef float f32x4 __attribute__((ext_vector_type(4)));
typedef float f32x2 __attribute__((ext_vector_type(2)));
typedef unsigned u32x4 __attribute__((ext_vector_type(4)));
typedef unsigned u32x2 __attribute__((ext_vector_type(2)));

constexpr int S = 16384, D = 2048;
constexpr int HD = 64;
constexpr int NQKV = 4608, NZR = 3584, NZR_REAL = 3360, NGATE = 4096;
constexpr int N1A = NQKV + NZR;
constexpr int N1 = N1A + NGATE;
constexpr int IN_W = 12064;
constexpr int KL = 384, NL = 5120;
constexpr int KL2 = 256;
constexpr int FF = 5632;
constexpr int RW = 1024;
constexpr int NCHAIN = 32;
constexpr int CHL = 512, NCK = S / CHL;
constexpr int NWAVES = 8, NTHR = 512;
constexpr int LDS_BYTES = 147456, LDS_BAR_OFF = 147440;

constexpr size_t MiB = 1u << 20;
constexpr size_t WS_WIN = 0;
constexpr size_t WS_OATT = 0;
constexpr size_t WS_LORAA = 16 * MiB;
constexpr size_t WS_RK = 28 * MiB;
constexpr size_t WS_WLORA = 48 * MiB;
constexpr size_t WS_WBA = 52 * MiB;
constexpr size_t WS_WBR = 54 * MiB;
constexpr size_t WS_ZQKV = 58 * MiB;
constexpr size_t WS_ZR = 202 * MiB;
constexpr size_t WS_LW = 58 * MiB;
constexpr size_t WS_A = 122 * MiB;
constexpr size_t WS_GATE = 186 * MiB;
constexpr size_t WS_PU = 218 * MiB;
constexpr size_t WS_S0 = 282 * MiB;
constexpr size_t WS_R = 314 * MiB, WS_V = 346 * MiB, WS_NKK = 378 * MiB, WS_KRAW = 410 * MiB;
constexpr size_t WS_YL = 442 * MiB;
constexpr size_t WS_ORWKV = 58 * MiB;
constexpr size_t WS_ZG = 90 * MiB;
constexpr size_t WS_WOUT = 218 * MiB;
constexpr size_t WS_WGU = 226 * MiB;
constexpr size_t WS_WD = 270 * MiB;
constexpr size_t WS_MERGED = 292 * MiB;
constexpr size_t WS_H2 = 356 * MiB;
constexpr size_t WS_SSQP = 484 * MiB, WS_RSTD = 486 * MiB;
constexpr size_t WS_X2B = 420 * MiB;
constexpr size_t WS_HID = 0;
constexpr size_t WS_CTL = 506 * MiB, CTL_BYTES = 16384;
constexpr size_t WS_END = 507 * MiB;
constexpr size_t DO_H1 = 0, DO_QT = 64 * MiB;

enum Phase { P_PREP0 = 0, P_G1A, P_HNORM, P_ATTPREP, P_GLORA, P_RK, P_SCAN1, P_SCAN2, P_FIN, P_G1B, P_GMA, P_GMB, P_GOUT, P_NORM2, P_FFN1, P_FFN2, P_COUNT };

struct Args { const float* in[25]; float* out; unsigned char* ws; int ph_lo, ph_hi; };

__device__ __forceinline__ float bf2f(bf16 h) { return __uint_as_float((unsigned)h << 16); }
__device__ __forceinline__ bf16 f2bf(float f) { unsigned u = __float_as_uint(f); return (bf16)((u + 0x7fffu + ((u >> 16) & 1u)) >> 16); }
__device__ __forceinline__ unsigned pk2(float lo, float hi) { return (unsigned)f2bf(lo) | ((unsigned)f2bf(hi) << 16); }
__device__ __forceinline__ float wave_sum(float v) {
#pragma unroll
    for (int o = 1; o < 64; o <<= 1) v += __shfl_xor(v, o);
    return v;
}
__device__ __forceinline__ float wave_max(float v) {
#pragma unroll
    for (int o = 1; o < 64; o <<= 1) v = fmaxf(v, __shfl_xor(v, o));
    return v;
}
__device__ __forceinline__ float sigmoidf_(float x) { return 1.0f / (1.0f + __expf(-x)); }
__host__ __device__ __forceinline__ int tperm(int j) { const int lc = j & 255; return (j & ~255) + 64 * ((lc >> 5) & 3) + 32 * (lc >> 7) + (lc & 31); }

typedef const __attribute__((address_space(4))) Args KArgs;
struct Ctx {
    KArgs* ka;
    float* out; unsigned char* ws; unsigned char* dout;
    LAS unsigned char* lds;
    int wave, bid, nb, gw, ngw;
};
__device__ __forceinline__ int lane_now() { int l; asm volatile("v_mbcnt_lo_u32_b32 %0, -1, 0\n\tv_mbcnt_hi_u32_b32 %0, -1, %0" : "=v"(l)); return l; }


#define XB_TMO      128
#define XB_XCNT(j)  (256  + 64 * (j))
#define XB_XSUB(j)  (1280 + 64 * (j))
#define XB_XGEN(j)  (2304 + 64 * (j))
#define XB_TOP      3328
#define XB_TOPGEN   3392
#define XCD_BAR_WORDS 3456
#define XB_SPIN_CAP (1u << 22)
__device__ __forceinline__ unsigned xb_ld(unsigned* p)              { return __hip_atomic_load(p, __ATOMIC_RELAXED, __HIP_MEMORY_SCOPE_AGENT); }
__device__ __forceinline__ unsigned xb_add(unsigned* p, unsigned v) { return __hip_atomic_fetch_add(p, v, __ATOMIC_RELAXED, __HIP_MEMORY_SCOPE_AGENT); }
__device__ __forceinline__ unsigned xb_xcc_id() { return (unsigned)__builtin_amdgcn_s_getreg((3 << 11) | 20) & 0xFu; }
#define XB_SPIN(cond, bar) do { unsigned _sp = 0; while (cond) { __builtin_amdgcn_s_sleep(1); \
    if ((++_sp & 255u) == 0u) { if (xb_ld(&(bar)[XB_TMO])) break; if (_sp > XB_SPIN_CAP) { atomicAdd(&(bar)[XB_TMO], 1u); break; } } } } while (0)
struct XcdBarrier { unsigned* bar; unsigned x; volatile LAS unsigned* st; };
__device__ __forceinline__ void xcd_barrier_complete(unsigned* bar, unsigned x, unsigned G, unsigned& nloc, unsigned& nx) {
    unsigned sum, cnt, mine, sp = 0u;
    for (;;) {
        sum = 0u; cnt = 0u; mine = 0u;
#pragma unroll
        for (unsigned j = 0; j < 16; ++j) { const unsigned c = xb_ld(&bar[XB_XCNT(j)]); sum += c; cnt += (c > 0u) ? 1u : 0u; mine = (j == x) ? c : mine; }
        if (sum == G) break;
        __builtin_amdgcn_s_sleep(1);
        if ((++sp & 255u) == 0u) { if (xb_ld(&bar[XB_TMO])) break; if (sp > XB_SPIN_CAP) { atomicAdd(&bar[XB_TMO], 1u); break; } }
    }
    nloc = mine > 0u ? mine : 1u; nx = cnt > 0u ? cnt : 1u;
}
__device__ __forceinline__ void xcd_barrier(const XcdBarrier& b, const bool leader, const unsigned G) {
    asm volatile("s_waitcnt vmcnt(0)" ::: "memory");
    __syncthreads();
    if (leader) {
        unsigned* bar = b.bar;
        __builtin_amdgcn_s_waitcnt(0);
        unsigned nloc = b.st[0], nx = b.st[1];
        if (nloc == 0u) { xcd_barrier_complete(bar, b.x, G, nloc, nx); b.st[0] = nloc; b.st[1] = nx; }
        const unsigned old = xb_add(&bar[XB_XSUB(b.x)], 1u);
        const unsigned gen = old / nloc;
        if (old + 1u == (gen + 1u) * nloc) {
            __builtin_amdgcn_fence(__ATOMIC_RELEASE, "agent");
            asm volatile("s_waitcnt vmcnt(0)" ::: "memory");
            const unsigned og = xb_add(&bar[XB_TOP], 1u);
            const unsigned tg = og / nx;
            if (og + 1u == (tg + 1u) * nx) xb_add(&bar[XB_TOPGEN], 1u);
            else XB_SPIN(xb_ld(&bar[XB_TOPGEN]) == tg, bar);
            __builtin_amdgcn_fence(__ATOMIC_ACQUIRE, "agent");
            xb_add(&bar[XB_XGEN(b.x)], 1u);
            asm volatile("s_waitcnt vmcnt(0)" ::: "memory");
        } else {
            XB_SPIN(xb_ld(&bar[XB_XGEN(b.x)]) == gen, bar);
            __builtin_amdgcn_fence(__ATOMIC_ACQUIRE, "agent");
            asm volatile("s_waitcnt vmcnt(0)" ::: "memory");
        }
    }
    __syncthreads();
}

__device__ __forceinline__ unsigned pg8c(float lo, float hi) { unsigned r; asm volatile("v_cvt_pk_bf16_f32 %0, %1, %2" : "=v"(r) : "v"(lo), "v"(hi)); return r; }
__device__ __forceinline__ bf16x8 pack8s(float a0, float a1, float a2, float a3, float a4, float a5, float a6, float a7) {
    u32x4 p;
    asm volatile("v_cvt_pk_bf16_f32 %0, %4, %5\n\tv_cvt_pk_bf16_f32 %1, %6, %7\n\tv_cvt_pk_bf16_f32 %2, %8, %9\n\tv_cvt_pk_bf16_f32 %3, %10, %11\n\ts_nop 1"
                 : "=&v"(p[0]), "=&v"(p[1]), "=&v"(p[2]), "=&v"(p[3]) : "v"(a0), "v"(a1), "v"(a2), "v"(a3), "v"(a4), "v"(a5), "v"(a6), "v"(a7));
    return __builtin_bit_cast(bf16x8, p);
}
struct TrItem { const float* src; int ld; int nk; bf16* dst; int K; const float* kscale = nullptr; };
__device__ __forceinline__ void tr_load(const TrItem& t, f32x4 (&v)[8], int lane) {
#pragma unroll
    for (int i = 0; i < 8; ++i) { const int kk = (lane >> 3) + 8 * i; v[i] = (f32x4){0.f, 0.f, 0.f, 0.f}; if (t.src && kk < t.nk) { v[i] = *(const f32x4*)(t.src + (size_t)kk * t.ld + 4 * (lane & 7)); if (t.kscale) v[i] = v[i] * t.kscale[kk]; } }
}
__device__ __forceinline__ void tr_store(const TrItem& t, const f32x4 (&v)[8], LAS float* scr, int lane) {
#pragma unroll
    for (int i = 0; i < 8; ++i) { LAS float* d = scr + ((lane >> 3) + 8 * i) * 33 + 4 * (lane & 7); d[0] = v[i][0]; d[1] = v[i][1]; d[2] = v[i][2]; d[3] = v[i][3]; }
    asm volatile("s_waitcnt lgkmcnt(0)" ::: "memory");
    const int c = lane & 7;
#pragma unroll
    for (int j = 0; j < 4; ++j) { const int n = (lane >> 3) + 8 * j; const LAS float* s = scr + (8 * c) * 33 + n;
        u32x4 o; o.x = pg8c(s[0 * 33], s[1 * 33]); o.y = pg8c(s[2 * 33], s[3 * 33]); o.z = pg8c(s[4 * 33], s[5 * 33]); o.w = pg8c(s[6 * 33], s[7 * 33]);
        *(u32x4*)(t.dst + (size_t)n * t.K + 8 * c) = o; }
    asm volatile("s_waitcnt lgkmcnt(0)" ::: "memory");
}
template <class Mk> __device__ __forceinline__ void conv_run(Ctx& C, int nitems, const Mk& mk, LAS float* scr) {
    const int lane = lane_now(); int it = C.gw; if (it >= nitems) return;
    TrItem cur = mk(it); f32x4 v[8]; tr_load(cur, v, lane);
    for (;;) { const int nit = it + C.ngw; const bool more = nit < nitems; TrItem nxt = cur; f32x4 w[8];
        if (more) { nxt = mk(nit); tr_load(nxt, w, lane); }
        tr_store(cur, v, scr, lane);
        if (!more) break;
        cur = nxt; it = nit;
#pragma unroll
        for (int i = 0; i < 8; ++i) v[i] = w[i]; }
}
__device__ __forceinline__ void conv_natural(Ctx& C, const float* W, int K, int N, bf16* Wt, LAS float* scr) {
    const int nkb = K / 64;
    conv_run(C, (N / 32) * nkb, [=](int it) { const int j32 = it / nkb, kb = it % nkb; return TrItem{W + (size_t)(kb * 64) * N + j32 * 32, N, 64, Wt + (size_t)(j32 * 32) * K + kb * 64, K}; }, scr);
}
__device__ __forceinline__ void conv_win(Ctx& C, LAS float* scr) {
    const float* W = C.ka->in[2]; bf16* Wt = (bf16*)(C.ws + WS_WIN); const int nkb = D / 64;
    conv_run(C, (N1 / 32) * nkb, [=](int it) { const int j32 = it / nkb, kb = it % nkb; const int j = j32 * 32, ac = tperm(j);
        int wc; if (j < NQKV) wc = ac; else if (j < N1A) { const int zc = ac - NQKV; wc = zc < NZR_REAL ? NQKV + zc : -1; } else wc = NQKV + NZR_REAL + (ac - N1A);
        return TrItem{wc >= 0 ? W + (size_t)(kb * 64) * IN_W + wc : nullptr, IN_W, 64, Wt + (size_t)j * D + kb * 64, D}; }, scr);
}
__device__ __forceinline__ void conv_wlora(Ctx& C, LAS float* scr) {
    bf16* Wt = (bf16*)(C.ws + WS_WLORA); const float* w_d = C.ka->in[9]; const float* w_i = C.ka->in[11]; const float* w_g = C.ka->in[12]; const int nkb = KL2 / 64;
    conv_run(C, (NL / 32) * nkb, [=](int it) { const int j32 = it / nkb, kb = it % nkb; const int j = j32 * 32; const float* src = nullptr; int nk = 64;
        if (j < 4096) { const int ac = tperm(j); if (ac < 2048) { if (kb == 0) src = w_d + (size_t)(ac >> 10) * 64 * RW + (ac & 1023); } else { if (kb == 1) src = w_i + (size_t)((ac - 2048) >> 10) * 64 * RW + (ac & 1023); } }
        else { const int c = tperm(j - 4096); if (kb < 2) src = w_g + (size_t)(kb * 64) * RW + c; else if (kb == 2) { src = w_g + (size_t)128 * RW + c; nk = 32; } }
        return TrItem{src, RW, nk, Wt + (size_t)j * KL2 + kb * 64, KL2}; }, scr);
}
__device__ __forceinline__ void conv_wgu(Ctx& C, LAS float* scr) {
    bf16* Wt = (bf16*)(C.ws + WS_WGU); const float* wg = C.ka->in[22]; const float* wu = C.ka->in[23]; const float* nw2 = C.ka->in[21]; const int nkb = D / 64;
    conv_run(C, (2 * FF / 32) * nkb, [=](int it) { const int j32 = it / nkb, kb = it % nkb; const int j = j32 * 32, p = j >> 8, lc = j & 255;
        const float* W = (lc >= 128) ? wu : wg; const int hc = 128 * p + (lc & 127);
        return TrItem{W + (size_t)(kb * 64) * FF + hc, FF, 64, Wt + (size_t)j * D + kb * 64, D, nw2 + kb * 64}; }, scr);
}

__device__ __forceinline__ void rms_row(const float* xrow, const float* w, bf16* orow, int lane) {
    f32x4 v[8]; float ss = 0.f;
#pragma unroll
    for (int j = 0; j < 8; ++j) { v[j] = ((const f32x4*)xrow)[lane + 64 * j]; ss += (v[j].x * v[j].x + v[j].y * v[j].y) + (v[j].z * v[j].z + v[j].w * v[j].w); }
    ss = wave_sum(ss); const float rs = 1.0f / sqrtf(ss * (1.0f / D) + 1e-6f);
#pragma unroll
    for (int j = 0; j < 8; ++j) { const f32x4 w4 = ((const f32x4*)w)[lane + 64 * j]; u32x2 o; o.x = pk2(v[j].x * rs * w4.x, v[j].y * rs * w4.y); o.y = pk2(v[j].z * rs * w4.z, v[j].w * rs * w4.w);
        ((u32x2*)orow)[lane + 64 * j] = o; }
}

template <class Epi>
__device__ __forceinline__ void gemm_simple(Ctx& C, const bf16* A, const bf16* Bt, int N, int K, const Epi& epi) {
    const int lane_ = lane_now(), tid_ = C.wave * 64 + lane_; (void)tid_;
    const int lane = lane_, fr = lane & 15, fq = lane >> 4;
    const int ntn = N / 32; const long ntiles = (long)ntn * (S / 32);
    for (long it = C.gw; it < ntiles; it += C.ngw) {
        const int m0 = (int)(it / ntn) * 32, n0 = (int)(it % ntn) * 32;
        const bf16* ap = A + (size_t)(m0 + fr) * K + 8 * fq; const bf16* bp = Bt + (size_t)(n0 + fr) * K + 8 * fq;
        f32x4 acc[2][2];
#pragma unroll
        for (int i = 0; i < 2; ++i)
#pragma unroll
            for (int j = 0; j < 2; ++j) acc[i][j] = (f32x4){0.f, 0.f, 0.f, 0.f};
#pragma unroll 4
        for (int k = 0; k < K; k += 32) {
            const bf16x8 a0 = *(const bf16x8*)(ap + k), a1 = *(const bf16x8*)(ap + (size_t)16 * K + k);
            const bf16x8 b0 = *(const bf16x8*)(bp + k), b1 = *(const bf16x8*)(bp + (size_t)16 * K + k);
            acc[0][0] = __builtin_amdgcn_mfma_f32_16x16x32_bf16(b0, a0, acc[0][0], 0, 0, 0);
            acc[0][1] = __builtin_amdgcn_mfma_f32_16x16x32_bf16(b1, a0, acc[0][1], 0, 0, 0);
            acc[1][0] = __builtin_amdgcn_mfma_f32_16x16x32_bf16(b0, a1, acc[1][0], 0, 0, 0);
            acc[1][1] = __builtin_amdgcn_mfma_f32_16x16x32_bf16(b1, a1, acc[1][1], 0, 0, 0);
        }
#pragma unroll
        for (int i = 0; i < 2; ++i)
#pragma unroll
            for (int j = 0; j < 2; ++j) epi(m0 + 16 * i + fr, n0 + 16 * j + 4 * fq, acc[i][j]);
    }
}
__device__ __forceinline__ void gemm_simple_ffn1(Ctx& C, const bf16* A, const bf16* Bt, bf16* hid) {
    const int lane_ = lane_now(), tid_ = C.wave * 64 + lane_; (void)tid_;
    const int lane = lane_, fr = lane & 15, fq = lane >> 4, K = D;
    const int ntn = FF / 32; const long ntiles = (long)ntn * (S / 32);
    for (long it = C.gw; it < ntiles; it += C.ngw) {
        const int m0 = (int)(it / ntn) * 32, h0 = (int)(it % ntn) * 32, n0 = 256 * (h0 >> 7) + (h0 & 127);
        const bf16* ap = A + (size_t)(m0 + fr) * K + 8 * fq; const bf16* bp = Bt + (size_t)(n0 + fr) * K + 8 * fq;
        f32x4 ag[2][2], au[2][2];
#pragma unroll
        for (int i = 0; i < 2; ++i)
#pragma unroll
            for (int j = 0; j < 2; ++j) { ag[i][j] = (f32x4){0.f, 0.f, 0.f, 0.f}; au[i][j] = (f32x4){0.f, 0.f, 0.f, 0.f}; }
#pragma unroll 2
        for (int k = 0; k < K; k += 32) {
            const bf16x8 a0 = *(const bf16x8*)(ap + k), a1 = *(const bf16x8*)(ap + (size_t)16 * K + k);
            const bf16x8 g0 = *(const bf16x8*)(bp + k), g1 = *(const bf16x8*)(bp + (size_t)16 * K + k);
            const bf16x8 u0 = *(const bf16x8*)(bp + (size_t)128 * K + k), u1 = *(const bf16x8*)(bp + (size_t)144 * K + k);
            ag[0][0] = __builtin_amdgcn_mfma_f32_16x16x32_bf16(g0, a0, ag[0][0], 0, 0, 0); ag[0][1] = __builtin_amdgcn_mfma_f32_16x16x32_bf16(g1, a0, ag[0][1], 0, 0, 0);
            ag[1][0] = __builtin_amdgcn_mfma_f32_16x16x32_bf16(g0, a1, ag[1][0], 0, 0, 0); ag[1][1] = __builtin_amdgcn_mfma_f32_16x16x32_bf16(g1, a1, ag[1][1], 0, 0, 0);
            au[0][0] = __builtin_amdgcn_mfma_f32_16x16x32_bf16(u0, a0, au[0][0], 0, 0, 0); au[0][1] = __builtin_amdgcn_mfma_f32_16x16x32_bf16(u1, a0, au[0][1], 0, 0, 0);
            au[1][0] = __builtin_amdgcn_mfma_f32_16x16x32_bf16(u0, a1, au[1][0], 0, 0, 0); au[1][1] = __builtin_amdgcn_mfma_f32_16x16x32_bf16(u1, a1, au[1][1], 0, 0, 0);
        }
#pragma unroll
        for (int i = 0; i < 2; ++i)
#pragma unroll
            for (int j = 0; j < 2; ++j) { const int row = m0 + 16 * i + fr, hc = h0 + 16 * j + 4 * fq; const f32x4 g = ag[i][j], u = au[i][j]; float o[4];
#pragma unroll
                for (int e = 0; e < 4; ++e) o[e] = g[e] * sigmoidf_(g[e]) * u[e];
                u32x2 w; w.x = pk2(o[0], o[1]); w.y = pk2(o[2], o[3]); *(u32x2*)(hid + (size_t)row * FF + hc) = w; }
    }
}


namespace pg8 {
#define PG8_LAS __attribute__((address_space(3)))
typedef unsigned short bf16_t;
constexpr int BM = 256, BK = 64, HALF = 128, HTB = HALF * BK * 2, STAGE_BYTES = 8 * HTB, NXCD = 8, WGM = 4;
__host__ __device__ __forceinline__ int lds_byte(int r, int c) { const int st = (r >> 4) * 2 + (c >> 5), rr = r & 15, cc = c & 31, ob = rr * 64 + cc * 2; return st * 1024 + (ob ^ (((ob >> 9) & 1) << 5)); }
__host__ __device__ __forceinline__ void stage_rc(int b, int& R, int& C) { const int st = b / 1024, sb = b % 1024, swz = sb ^ (((sb >> 9) & 1) << 5); R = (st >> 1) * 16 + swz / 64; C = (st & 1) * 32 + (swz % 64) / 2; }
__host__ __device__ __forceinline__ int perm32(int rho) { const int n = rho >> 4, i = rho & 15; return 8 * (i >> 2) + 4 * n + (i & 3); }
struct Unit { int pm, pn; };
struct Gemm { const bf16_t* A; const bf16_t* Bt; int M, N, K; };
struct StaticOrder {
    int nM, nN, nwg, G, c;
    __host__ __device__ void init(int M, int N, int G_, int c_) { nM = M / BM; nN = N / BM; nwg = nM * nN; G = G_; c = c_; }
    __host__ __device__ bool next(int i, Unit& u) const {
        const long L = (long)i * G + c; if (L >= nwg) return false;
        int wgid = (int)L; { const int q = nwg / NXCD, r = nwg % NXCD, xcd = wgid % NXCD, off = wgid / NXCD; wgid = (xcd < r ? xcd * (q + 1) : r * (q + 1) + (xcd - r) * q) + off; }
        const int nig = WGM * nN, gid = wgid / nig, fm = gid * WGM, gsz = (nM - fm) < WGM ? (nM - fm) : WGM;
        u.pm = fm + ((wgid % nig) % gsz); u.pn = (wgid % nig) / gsz; return true;
    }
    __device__ __forceinline__ void a_ready(const Unit&) const {}
    __device__ __forceinline__ void done(const Unit&) const {}
};
__device__ __forceinline__ unsigned cvt_pk_bf16(float lo, float hi) { unsigned r; asm volatile("v_cvt_pk_bf16_f32 %0, %1, %2" : "=v"(r) : "v"(lo), "v"(hi)); return r; }
template <class Epi, class Sched, bool ALIGN_EPI = false, bool SP2 = false>
__device__ __forceinline__ void gemm_phase(PG8_LAS unsigned char* lds, const Gemm g, const Sched& S, const Epi& E, const int wid) {
    const int lane = lane_now(), tid = wid * 64 + lane, wr = wid >> 2, wc = wid & 3, fr = lane & 15, fq = lane >> 4;
    const int K = g.K, nt = K / BK;
    unsigned voffA[2], voffB[2];
#pragma unroll
    for (int i = 0; i < 2; ++i) { int R, C; stage_rc(tid * 16 + i * 8192, R, C); const int Rb = Epi::PERM ? ((R & ~31) + perm32(R & 31)) : R;
        voffA[i] = (unsigned)(R * K + C) * 2u; voffB[i] = (unsigned)(Rb * K + C) * 2u; }
    const size_t kstep = (size_t)(BK * 2);
    const size_t hstep = (size_t)HALF * K * 2;
    const size_t tstep = 2 * hstep;
    const unsigned ldsw = (unsigned)wid * 1024u;
    const int aoff = lds_byte(wr * 64 + fr, fq * 8), boff = lds_byte(wc * 32 + fr, fq * 8);
#define PG8_SA(b, h) (((b) * 2 + (h)) * HTB)
#define PG8_SB(b, h) ((4 + (b) * 2 + (h)) * HTB)
#define PG8_STAGE(bufoff, gbase, voff) do { _Pragma("unroll") for (int _i = 0; _i < 2; ++_i) \
        __builtin_amdgcn_global_load_lds((const unsigned*)((const char*)(gbase) + (voff)[_i]), (PG8_LAS unsigned*)(lds + (bufoff) + ldsw + _i * 8192), 16, 0, 0); } while (0)
#define PG8_LDA(dst, b, h) do { _Pragma("unroll") for (int m = 0; m < 4; ++m) _Pragma("unroll") for (int k = 0; k < 2; ++k) dst[m][k] = *(const PG8_LAS bf16x8*)(lds + PG8_SA(b, h) + aoff + m * 2048 + k * 1024); } while (0)
#define PG8_LDB(dst, b, h) do { _Pragma("unroll") for (int n = 0; n < 2; ++n) _Pragma("unroll") for (int k = 0; k < 2; ++k) dst[n][k] = *(const PG8_LAS bf16x8*)(lds + PG8_SB(b, h) + boff + n * 2048 + k * 1024); } while (0)
#define PG8_MMA(ai, bj, At, Bt) do { __builtin_amdgcn_s_setprio(1); _Pragma("unroll") for (int m = 0; m < 4; ++m) _Pragma("unroll") for (int n = 0; n < 2; ++n) _Pragma("unroll") for (int k = 0; k < 2; ++k) \
        acc[ai][bj][m][n] = __builtin_amdgcn_mfma_f32_16x16x32_bf16(Bt[n][k], At[m][k], acc[ai][bj][m][n], 0, 0, 0); __builtin_amdgcn_s_setprio(0); } while (0)
#define PG8_WAIT_V(n) asm volatile("s_waitcnt vmcnt(" #n ")" ::: "memory")
#define PG8_WAIT_L(n) asm volatile("s_waitcnt lgkmcnt(" #n ")" ::: "memory")
#define PG8_BAR __builtin_amdgcn_s_barrier()
#define PG8_SCHED __builtin_amdgcn_sched_barrier(0)
    Unit cur, nxt; int ui = 0;
    if (!S.next(0, cur)) return;
    f32x4 acc[2][2][4][2];
#pragma unroll
    for (int a = 0; a < 2; ++a)
#pragma unroll
        for (int b = 0; b < 2; ++b)
#pragma unroll
            for (int m = 0; m < 4; ++m)
#pragma unroll
                for (int n = 0; n < 2; ++n) acc[a][b][m][n] = (f32x4){0.f, 0.f, 0.f, 0.f};
    bf16x8 At[4][2], B0[2][2], B1[2][2];
    const char* cA = (const char*)g.A + (size_t)cur.pm * tstep; const char* cB = (const char*)g.Bt + (size_t)cur.pn * tstep;
    S.a_ready(cur);
    if constexpr (SP2) {
        PG8_STAGE(PG8_SB(0, 0), cB, voffB); PG8_STAGE(PG8_SB(0, 1), cB + hstep, voffB); PG8_STAGE(PG8_SA(0, 0), cA, voffA); PG8_STAGE(PG8_SA(0, 1), cA + hstep, voffA);
        if (wr == 1) PG8_BAR;
        PG8_WAIT_V(2); PG8_BAR;
        PG8_STAGE(PG8_SB(1, 0), cB + kstep, voffB); PG8_STAGE(PG8_SA(1, 0), cA + kstep, voffA); PG8_STAGE(PG8_SB(1, 1), cB + hstep + kstep, voffB);
        PG8_WAIT_V(6); PG8_BAR;
    } else {
        PG8_STAGE(PG8_SB(0, 0), cB, voffB); PG8_STAGE(PG8_SA(0, 0), cA, voffA); PG8_STAGE(PG8_SB(0, 1), cB + hstep, voffB); PG8_STAGE(PG8_SA(0, 1), cA + hstep, voffA);
        if (wr == 1) PG8_BAR;
        PG8_WAIT_V(4); PG8_BAR;
        PG8_STAGE(PG8_SB(1, 0), cB + kstep, voffB); PG8_STAGE(PG8_SA(1, 0), cA + kstep, voffA); PG8_STAGE(PG8_SB(1, 1), cB + hstep + kstep, voffB);
        PG8_WAIT_V(6); PG8_BAR;
    }
    for (;;) {
        const bool has_next = S.next(ui + 1, nxt);
        const char* nA = has_next ? (const char*)g.A + (size_t)nxt.pm * tstep : cA; const char* nB = has_next ? (const char*)g.Bt + (size_t)nxt.pn * tstep : cB;
        for (int t = 0; t < nt; t += 2) {
            const bool last = (t == nt - 2);
            const char* a1 = cA + (size_t)(t + 1) * kstep;
            const char* a2 = last ? nA : cA + (size_t)(t + 2) * kstep; const char* b2 = last ? nB : cB + (size_t)(t + 2) * kstep;
            const char* a3 = a2 + kstep; const char* b3 = b2 + kstep;
            if (last && has_next) S.a_ready(nxt);
            if constexpr (SP2) {
            PG8_LDB(B0, 0, 0); PG8_LDB(B1, 0, 1); PG8_SCHED; PG8_LDA(At, 0, 0); PG8_STAGE(PG8_SA(1, 1), a1 + hstep, voffA);
            PG8_WAIT_V(8); PG8_WAIT_L(0); PG8_BAR; PG8_MMA(0, 0, At, B0); PG8_MMA(0, 1, At, B1); PG8_BAR; PG8_SCHED;
            PG8_LDA(At, 0, 1); PG8_STAGE(PG8_SB(0, 0), b2, voffB); PG8_STAGE(PG8_SB(0, 1), b2 + hstep, voffB); PG8_STAGE(PG8_SA(0, 0), a2, voffA);
            PG8_WAIT_V(8); PG8_WAIT_L(0); PG8_BAR; PG8_MMA(1, 0, At, B0); PG8_MMA(1, 1, At, B1); PG8_BAR; PG8_SCHED;
            PG8_LDB(B0, 1, 0); PG8_LDB(B1, 1, 1); PG8_SCHED; PG8_LDA(At, 1, 0); PG8_STAGE(PG8_SA(0, 1), a2 + hstep, voffA);
            PG8_WAIT_V(8); PG8_WAIT_L(0); PG8_BAR; PG8_MMA(0, 0, At, B0); PG8_MMA(0, 1, At, B1); PG8_BAR; PG8_SCHED;
            PG8_LDA(At, 1, 1); PG8_STAGE(PG8_SB(1, 0), b3, voffB); PG8_STAGE(PG8_SB(1, 1), b3 + hstep, voffB); PG8_STAGE(PG8_SA(1, 0), a3, voffA);
            PG8_WAIT_V(8); PG8_WAIT_L(0); PG8_BAR; PG8_MMA(1, 0, At, B0); PG8_MMA(1, 1, At, B1); PG8_BAR; PG8_SCHED;
            } else {
            PG8_LDB(B0, 0, 0); PG8_SCHED; PG8_LDA(At, 0, 0); PG8_STAGE(PG8_SA(1, 1), a1 + hstep, voffA);
            PG8_WAIT_L(8); PG8_BAR; PG8_WAIT_L(0); PG8_MMA(0, 0, At, B0); PG8_BAR; PG8_SCHED;
            PG8_LDB(B1, 0, 1); PG8_STAGE(PG8_SB(0, 0), b2, voffB);
            PG8_BAR; PG8_WAIT_L(0); PG8_MMA(0, 1, At, B1); PG8_BAR;
            PG8_LDA(At, 0, 1); PG8_STAGE(PG8_SA(0, 0), a2, voffA);
            PG8_BAR; PG8_WAIT_L(0); PG8_MMA(1, 0, At, B0); PG8_BAR; PG8_SCHED;
            PG8_STAGE(PG8_SB(0, 1), b2 + hstep, voffB);
            PG8_WAIT_V(6); PG8_BAR; PG8_MMA(1, 1, At, B1); PG8_BAR;
            PG8_LDB(B0, 1, 0); PG8_SCHED; PG8_LDA(At, 1, 0); PG8_STAGE(PG8_SA(0, 1), a2 + hstep, voffA);
            PG8_WAIT_L(8); PG8_BAR; PG8_WAIT_L(0); PG8_MMA(0, 0, At, B0); PG8_BAR; PG8_SCHED;
            PG8_LDB(B1, 1, 1); PG8_STAGE(PG8_SB(1, 0), b3, voffB);
            PG8_BAR; PG8_WAIT_L(0); PG8_MMA(0, 1, At, B1); PG8_BAR;
            PG8_LDA(At, 1, 1); PG8_STAGE(PG8_SA(1, 0), a3, voffA);
            PG8_BAR; PG8_WAIT_L(0); PG8_MMA(1, 0, At, B0); PG8_BAR; PG8_SCHED;
            PG8_STAGE(PG8_SB(1, 1), b3 + hstep, voffB);
            PG8_WAIT_V(6); PG8_BAR; PG8_MMA(1, 1, At, B1); PG8_BAR;
            }
        }
        if constexpr (ALIGN_EPI) { if (wr == 0) PG8_BAR; }
        if constexpr (!Epi::AFTER_DRAIN) { int fr_e = fr, fq_e = fq; asm volatile("" : "+v"(fr_e), "+v"(fq_e)); E(acc, cur, wr, wc, fr_e, fq_e); S.done(cur); }
        if (!has_next) break;
#pragma unroll
        for (int a = 0; a < 2; ++a)
#pragma unroll
            for (int b = 0; b < 2; ++b)
#pragma unroll
                for (int m = 0; m < 4; ++m)
#pragma unroll
                    for (int n = 0; n < 2; ++n) acc[a][b][m][n] = (f32x4){0.f, 0.f, 0.f, 0.f};
        cur = nxt; cA = nA; cB = nB; ++ui;
        if constexpr (ALIGN_EPI) { if (wr == 1) PG8_BAR; }
    }
    PG8_WAIT_V(0);
    if constexpr (!ALIGN_EPI) { if (wr == 0) PG8_BAR; }
    PG8_BAR;
    if constexpr (Epi::AFTER_DRAIN) { E.fused(acc, cur, wr, wc, fr, fq, lds, wid, lane); S.done(cur); }
#undef PG8_SA
#undef PG8_SB
#undef PG8_STAGE
#undef PG8_LDA
#undef PG8_LDB
#undef PG8_MMA
#undef PG8_WAIT_V
#undef PG8_WAIT_L
#undef PG8_BAR
#undef PG8_SCHED
}
}


#ifndef OPT_GEMM
#define OPT_GEMM 1
#endif
typedef f32x4 AccT[2][2][4][2];
#ifndef NT_EPI
#define NT_EPI 0
#endif
#if NT_EPI
#define NTST4(p, v) __builtin_nontemporal_store((v), (u32x4*)(p))
#else
#define NTST4(p, v) (*(u32x4*)(p) = (v))
#endif
__device__ __forceinline__ u32x4 pack8(f32x4 a, f32x4 b) { u32x4 w; w.x = pg8::cvt_pk_bf16(a[0], a[1]); w.y = pg8::cvt_pk_bf16(a[2], a[3]); w.z = pg8::cvt_pk_bf16(b[0], b[1]); w.w = pg8::cvt_pk_bf16(b[2], b[3]); return w; }
__device__ __forceinline__ void unpack8(u32x4 w, float (&f)[8]) { f[0] = __uint_as_float(w.x << 16); f[1] = __uint_as_float(w.x & 0xffff0000u); f[2] = __uint_as_float(w.y << 16); f[3] = __uint_as_float(w.y & 0xffff0000u);
    f[4] = __uint_as_float(w.z << 16); f[5] = __uint_as_float(w.z & 0xffff0000u); f[6] = __uint_as_float(w.w << 16); f[7] = __uint_as_float(w.w & 0xffff0000u); }
struct EpiG1A8 { static constexpr bool PERM = true, AFTER_DRAIN = false; bf16* zqkv; bf16* zr; const float* qw; const float* kw;
    __device__ __forceinline__ void operator()(const AccT& acc, const pg8::Unit& u, int wr, int wc, int fr, int fq) const {
        const int row0 = u.pm * 256 + wr * 64 + fr, acb = u.pn * 256 + wc * 64 + 8 * fq;
        if (u.pn < 12) {
            const float* nw = u.pn < 6 ? qw : kw; const float sc = u.pn < 6 ? 0.125f : 1.0f; f32x4 w[2][2];
#pragma unroll
            for (int bj = 0; bj < 2; ++bj)
#pragma unroll
                for (int n = 0; n < 2; ++n) w[bj][n] = *(const f32x4*)(nw + 32 * bj + 8 * fq + 4 * n) * sc;
#pragma unroll
            for (int ai = 0; ai < 2; ++ai)
#pragma unroll
                for (int m = 0; m < 4; ++m) { float ss = 0.f;
#pragma unroll
                    for (int bj = 0; bj < 2; ++bj)
#pragma unroll
                        for (int n = 0; n < 2; ++n) { const f32x4 x = acc[ai][bj][m][n]; ss += (x[0] * x[0] + x[1] * x[1]) + (x[2] * x[2] + x[3] * x[3]); }
                    ss += __shfl_xor(ss, 16); ss += __shfl_xor(ss, 32);
                    const float rs = 1.0f / sqrtf(ss * (1.0f / 64.f) + 1e-6f);
                    bf16* rp = zqkv + (size_t)(row0 + ai * 128 + m * 16) * NQKV + acb;
#pragma unroll
                    for (int bj = 0; bj < 2; ++bj) NTST4(rp + 32 * bj, pack8(acc[ai][bj][m][0] * rs * w[bj][0], acc[ai][bj][m][1] * rs * w[bj][1])); }
        } else {
            bf16* base = u.pn < 18 ? zqkv + acb : zr + (acb - NQKV); const int ld = u.pn < 18 ? NQKV : NZR;
#pragma unroll
            for (int ai = 0; ai < 2; ++ai)
#pragma unroll
                for (int m = 0; m < 4; ++m) { bf16* rp = base + (size_t)(row0 + ai * 128 + m * 16) * ld;
#pragma unroll
                    for (int bj = 0; bj < 2; ++bj) NTST4(rp + 32 * bj, pack8(acc[ai][bj][m][0], acc[ai][bj][m][1])); }
        }
    } };
template <int MODE> struct EpiLora8 { static constexpr bool PERM = true, AFTER_DRAIN = false; bf16* dst; const float* bias;
    __device__ __forceinline__ void operator()(const AccT& acc, const pg8::Unit& u, int wr, int wc, int fr, int fq) const {
        const int row0 = u.pm * 256 + wr * 64 + fr; const int cb = (u.pn & 3) * 256 + wc * 64 + 8 * fq; const int z = MODE == 2 ? 0 : (u.pn >> 2); f32x4 bv[2][2];
#pragma unroll
        for (int bj = 0; bj < 2; ++bj)
#pragma unroll
            for (int n = 0; n < 2; ++n) bv[bj][n] = MODE == 2 ? (f32x4){0.f, 0.f, 0.f, 0.f} : *(const f32x4*)(bias + z * RW + cb + 32 * bj + 4 * n);
#pragma unroll
        for (int ai = 0; ai < 2; ++ai)
#pragma unroll
            for (int m = 0; m < 4; ++m) { bf16* rp = dst + ((size_t)z * S + row0 + ai * 128 + m * 16) * RW + cb;
#pragma unroll
                for (int bj = 0; bj < 2; ++bj) { f32x4 o[2];
#pragma unroll
                    for (int n = 0; n < 2; ++n)
#pragma unroll
                        for (int e = 0; e < 4; ++e) { const float v = bv[bj][n][e] + acc[ai][bj][m][n][e];
                            if (MODE == 0) { const float x = -v; const float sp = fmaxf(x, 0.f) + __logf(1.0f + __expf(-fabsf(x))); o[n][e] = -__expf(-sp - 0.5f); }
                            else if (MODE == 1) o[n][e] = sigmoidf_(v); else o[n][e] = v; }
                    NTST4(rp + 32 * bj, pack8(o[0], o[1])); } }
    } };
struct LoraOrder { int G, c;
    __device__ bool next(int i, pg8::Unit& u) const { const int L = i * G + c; if (L >= 1280) return false; u.pn = L >> 6; u.pm = (L & 63) + (u.pn >= 16 ? 64 : 0); return true; }
    __device__ __forceinline__ void a_ready(const pg8::Unit&) const {}
    __device__ __forceinline__ void done(const pg8::Unit&) const {}
};
struct EpiLoraU8 { static constexpr bool PERM = true, AFTER_DRAIN = false; unsigned char* wsb; const float* w0; const float* a0;
    __device__ __forceinline__ void operator()(const AccT& acc, const pg8::Unit& u, int wr, int wc, int fr, int fq) const {
        const int row0 = (u.pm & 63) * 256 + wr * 64 + fr; const int cb = (u.pn & 3) * 256 + wc * 64 + 8 * fq; const int mode = u.pn < 8 ? 0 : (u.pn < 16 ? 1 : 2), z = mode == 2 ? 0 : ((u.pn >> 2) & 1);
        const float* bias = mode == 0 ? w0 : a0; const size_t doff = mode == 0 ? WS_LW : WS_A; bf16* dst = (bf16*)(wsb + (mode == 2 ? WS_GATE : doff)); f32x4 bv[2][2];
#pragma unroll
        for (int bj = 0; bj < 2; ++bj)
#pragma unroll
            for (int n = 0; n < 2; ++n) { bv[bj][n] = (f32x4){0.f, 0.f, 0.f, 0.f}; if (mode != 2) bv[bj][n] = *(const f32x4*)(bias + z * RW + cb + 32 * bj + 4 * n); }
#pragma unroll
        for (int ai = 0; ai < 2; ++ai)
#pragma unroll
            for (int m = 0; m < 4; ++m) { bf16* rp = dst + ((size_t)z * S + row0 + ai * 128 + m * 16) * RW + cb;
#pragma unroll
                for (int bj = 0; bj < 2; ++bj) { f32x4 o[2];
#pragma unroll
                    for (int n = 0; n < 2; ++n)
#pragma unroll
                        for (int e = 0; e < 4; ++e) { const float v = bv[bj][n][e] + acc[ai][bj][m][n][e];
                            const float sg = __builtin_amdgcn_rcpf(1.0f + __builtin_amdgcn_exp2f(v * -1.44269504f)); o[n][e] = mode == 0 ? -0.60653066f * sg : (mode == 1 ? sg : v); }
                    *(u32x4*)(rp + 32 * bj) = pack8(o[0], o[1]); } }
    } };
struct EpiG1B8 { static constexpr bool PERM = true, AFTER_DRAIN = false; bf16* zg; const float* bg;
    __device__ __forceinline__ void operator()(const AccT& acc, const pg8::Unit& u, int wr, int wc, int fr, int fq) const {
        const int row0 = u.pm * 256 + wr * 64 + fr, acb = u.pn * 256 + wc * 64 + 8 * fq; f32x4 bv[2][2];
#pragma unroll
        for (int bj = 0; bj < 2; ++bj)
#pragma unroll
            for (int n = 0; n < 2; ++n) bv[bj][n] = *(const f32x4*)(bg + acb + 32 * bj + 4 * n);
#pragma unroll
        for (int ai = 0; ai < 2; ++ai)
#pragma unroll
            for (int m = 0; m < 4; ++m) { bf16* rp = zg + (size_t)(row0 + ai * 128 + m * 16) * NGATE + acb;
#pragma unroll
                for (int bj = 0; bj < 2; ++bj) { f32x4 o[2];
#pragma unroll
                    for (int n = 0; n < 2; ++n)
#pragma unroll
                        for (int e = 0; e < 4; ++e) o[n][e] = sigmoidf_(acc[ai][bj][m][n][e] + bv[bj][n][e]);
                    NTST4(rp + 32 * bj, pack8(o[0], o[1])); } }
    } };
template <bool SECOND> struct EpiMerge8 { static constexpr bool PERM = true, AFTER_DRAIN = false; bf16* mg; const bf16* zg;
    __device__ __forceinline__ void operator()(const AccT& acc, const pg8::Unit& u, int wr, int wc, int fr, int fq) const {
        const int row0 = u.pm * 256 + wr * 64 + fr, col0 = u.pn * 256 + wc * 32 + 8 * fq;
#pragma unroll
        for (int ai = 0; ai < 2; ++ai)
#pragma unroll
            for (int m = 0; m < 4; ++m) { const int row = row0 + ai * 128 + m * 16;
#pragma unroll
                for (int bj = 0; bj < 2; ++bj) { const int col = col0 + 128 * bj; float g[8]; unpack8(*(const u32x4*)(zg + (size_t)row * NGATE + (SECOND ? D : 0) + col), g); f32x4 o[2];
                    float t[8]; if (SECOND) unpack8(*(const u32x4*)(mg + (size_t)row * D + col), t);
#pragma unroll
                    for (int n = 0; n < 2; ++n)
#pragma unroll
                        for (int e = 0; e < 4; ++e) o[n][e] = (SECOND ? t[4 * n + e] : 0.f) + g[4 * n + e] * acc[ai][bj][m][n][e];
                    *(u32x4*)(mg + (size_t)row * D + col) = pack8(o[0], o[1]); } }
    } };
struct EpiRes8 { static constexpr bool PERM = false, AFTER_DRAIN = false; const float* base; float* out;
    __device__ __forceinline__ void operator()(const AccT& acc, const pg8::Unit& u, int wr, int wc, int fr, int fq) const {
        const int row0 = u.pm * 256 + wr * 64 + fr, col0 = u.pn * 256 + wc * 32 + 4 * fq;
#pragma unroll
        for (int ai = 0; ai < 2; ++ai)
#pragma unroll
            for (int m = 0; m < 4; ++m) { const size_t off = (size_t)(row0 + ai * 128 + m * 16) * D + col0;
#pragma unroll
                for (int bj = 0; bj < 2; ++bj)
#pragma unroll
                    for (int n = 0; n < 2; ++n) { const f32x4 b = *(const f32x4*)(base + off + bj * 128 + n * 16); *(f32x4*)(out + off + bj * 128 + n * 16) = b + acc[ai][bj][m][n]; } }
    } };
struct EpiX2b8 { static constexpr bool PERM = true, AFTER_DRAIN = false; const float* base; bf16* xb; float* ssqp;
    __device__ __forceinline__ void operator()(const AccT& acc, const pg8::Unit& u, int wr, int wc, int fr, int fq) const {
        const int row0 = u.pm * 256 + wr * 64 + fr, col0 = u.pn * 256 + wc * 32 + 8 * fq;
#pragma unroll
        for (int ai = 0; ai < 2; ++ai)
#pragma unroll
            for (int m = 0; m < 4; ++m) { const int row = row0 + ai * 128 + m * 16; const size_t off = (size_t)row * D + col0; float ss = 0.f;
#pragma unroll
                for (int bj = 0; bj < 2; ++bj) { const f32x4 b0 = *(const f32x4*)(base + off + bj * 128), b1 = *(const f32x4*)(base + off + bj * 128 + 4);
                    const f32x4 o0 = b0 + acc[ai][bj][m][0], o1 = b1 + acc[ai][bj][m][1];
                    ss += (o0[0] * o0[0] + o0[1] * o0[1]) + (o0[2] * o0[2] + o0[3] * o0[3]) + (o1[0] * o1[0] + o1[1] * o1[1]) + (o1[2] * o1[2] + o1[3] * o1[3]);
                    *(u32x4*)(xb + off + bj * 128) = pack8(o0, o1); }
                ss += __shfl_xor(ss, 16); ss += __shfl_xor(ss, 32);
                if (fq == 0) ssqp[(size_t)row * 32 + u.pn * 4 + wc] = ss; }
    } };
struct EpiResB8 { static constexpr bool PERM = false, AFTER_DRAIN = false; const bf16* xb; float* out;
    __device__ __forceinline__ void operator()(const AccT& acc, const pg8::Unit& u, int wr, int wc, int fr, int fq) const {
        const int row0 = u.pm * 256 + wr * 64 + fr, col0 = u.pn * 256 + wc * 32 + 4 * fq;
#pragma unroll
        for (int ai = 0; ai < 2; ++ai)
#pragma unroll
            for (int m = 0; m < 4; ++m) { const size_t off = (size_t)(row0 + ai * 128 + m * 16) * D + col0;
#pragma unroll
                for (int bj = 0; bj < 2; ++bj)
#pragma unroll
                    for (int n = 0; n < 2; ++n) { const u32x2 w = *(const u32x2*)(xb + off + bj * 128 + n * 16);
                        const f32x4 b = (f32x4){__uint_as_float(w.x << 16), __uint_as_float(w.x & 0xffff0000u), __uint_as_float(w.y << 16), __uint_as_float(w.y & 0xffff0000u)};
                        *(f32x4*)(out + off + bj * 128 + n * 16) = b + acc[ai][bj][m][n]; } }
    } };
struct EpiFfn18 { static constexpr bool PERM = true, AFTER_DRAIN = false; bf16* hid; const float* rstd;
    __device__ __forceinline__ void operator()(const AccT& acc, const pg8::Unit& u, int wr, int wc, int fr, int fq) const {
        const int row0 = u.pm * 256 + wr * 64 + fr, hc0 = u.pn * 128 + wc * 32 + 8 * fq;
#pragma unroll
        for (int ai = 0; ai < 2; ++ai)
#pragma unroll
            for (int m = 0; m < 4; ++m) { f32x4 o[2]; const float rs = rstd[row0 + ai * 128 + m * 16];
#pragma unroll
                for (int n = 0; n < 2; ++n)
#pragma unroll
                    for (int e = 0; e < 4; ++e) { const float g = acc[ai][0][m][n][e] * rs; o[n][e] = g * sigmoidf_(g) * (acc[ai][1][m][n][e] * rs); }
                NTST4(hid + (size_t)(row0 + ai * 128 + m * 16) * FF + hc0, pack8(o[0], o[1])); }
    } };
template <class Epi> __device__ __forceinline__ void gemm8(Ctx& C, const bf16* A, const bf16* Bt, int N, int K, const Epi& E) {
    asm volatile("" : "+s"(N), "+s"(K));
    pg8::Gemm g{A, Bt, S, N, K}; pg8::StaticOrder so; so.init(S, N, C.nb, C.bid);
    pg8::gemm_phase<Epi, pg8::StaticOrder, true, true>(C.lds, g, so, E, C.wave);
}

__device__ __forceinline__ void st4bf(bf16* p, f32x4 v) { u32x2 w; w.x = pk2(v[0], v[1]); w.y = pk2(v[2], v[3]); *(u32x2*)p = w; }
struct EpiG1A { bf16* zqkv; bf16* zr;
    __device__ __forceinline__ void operator()(int row, int j0, f32x4 v) const { const int ac = tperm(j0);
        if (ac < NQKV) st4bf(zqkv + (size_t)row * NQKV + ac, v); else st4bf(zr + (size_t)row * NZR + (ac - NQKV), v); } };
struct EpiLora { bf16* lw; bf16* a; bf16* gate; const float* w0; const float* a0;
    __device__ __forceinline__ void operator()(int row, int j0, f32x4 v) const { const int ac = tperm(j0);
        if (ac < 2048) { const int z = ac >> 10, c = ac & 1023; f32x4 o;
#pragma unroll
            for (int e = 0; e < 4; ++e) { const float x = -(w0[z * RW + c + e] + v[e]); const float sp = fmaxf(x, 0.f) + log1pf(__expf(-fabsf(x))); o[e] = -__expf(-sp - 0.5f); }
            st4bf(lw + ((size_t)z * S + row) * RW + c, o); }
        else if (ac < 4096) { const int z = (ac - 2048) >> 10, c = ac & 1023; f32x4 o;
#pragma unroll
            for (int e = 0; e < 4; ++e) o[e] = sigmoidf_(a0[z * RW + c + e] + v[e]);
            st4bf(a + ((size_t)z * S + row) * RW + c, o); }
        else st4bf(gate + (size_t)row * RW + (ac - 4096), v); } };
struct EpiG1B { bf16* zg; const float* bg;
    __device__ __forceinline__ void operator()(int row, int j0, f32x4 v) const { const int ac = tperm(j0); f32x4 o;
#pragma unroll
        for (int e = 0; e < 4; ++e) o[e] = sigmoidf_(v[e] + bg[ac + e]);
        st4bf(zg + (size_t)row * NGATE + ac, o); } };
struct EpiMA { bf16* mg; const bf16* zg;
    __device__ __forceinline__ void operator()(int row, int j0, f32x4 v) const { const u32x2 g = *(const u32x2*)(zg + (size_t)row * NGATE + j0); f32x4 o;
        o[0] = v[0] * bf2f((bf16)(g.x & 0xffff)); o[1] = v[1] * bf2f((bf16)(g.x >> 16)); o[2] = v[2] * bf2f((bf16)(g.y & 0xffff)); o[3] = v[3] * bf2f((bf16)(g.y >> 16));
        st4bf(mg + (size_t)row * D + j0, o); } };
struct EpiMB { bf16* mg; const bf16* zg;
    __device__ __forceinline__ void operator()(int row, int j0, f32x4 v) const { const u32x2 g = *(const u32x2*)(zg + (size_t)row * NGATE + D + j0); const u32x2 t = *(const u32x2*)(mg + (size_t)row * D + j0); f32x4 o;
        o[0] = bf2f((bf16)(t.x & 0xffff)) + v[0] * bf2f((bf16)(g.x & 0xffff)); o[1] = bf2f((bf16)(t.x >> 16)) + v[1] * bf2f((bf16)(g.x >> 16));
        o[2] = bf2f((bf16)(t.y & 0xffff)) + v[2] * bf2f((bf16)(g.y & 0xffff)); o[3] = bf2f((bf16)(t.y >> 16)) + v[3] * bf2f((bf16)(g.y >> 16));
        st4bf(mg + (size_t)row * D + j0, o); } };
struct EpiRes { const float* base; float* out;
    __device__ __forceinline__ void operator()(int row, int j0, f32x4 v) const { const f32x4 b = *(const f32x4*)(base + (size_t)row * D + j0); *(f32x4*)(out + (size_t)row * D + j0) = b + v; } };


#ifndef OPT_SCAN
#define OPT_SCAN 1
#endif
#ifndef OPT_SCANM
#define OPT_SCANM 1
#endif
constexpr int SC_T = 8, SC_STEPF = 384, SC_ITEMF = SC_T * SC_STEPF;
template <int CTRL> __device__ __forceinline__ float dpp_f(float x) { return __int_as_float(__builtin_amdgcn_update_dpp(0, __float_as_int(x), CTRL, 0xf, 0xf, true)); }
__device__ __forceinline__ float quad_sum(float x) { x += dpp_f<0xB1>(x); x += dpp_f<0x4E>(x); return x; }
template <int role> __device__ __forceinline__ void ph_scan1_r(Ctx& C) {
    const int lane = lane_now(), wave = C.wave, itl = wave & 3, kq = lane & 3, rg = lane >> 2;
    const int t128 = role * 64 + lane, sst = t128 >> 4, cg = t128 & 15;
    const bf16* g_r = (const bf16*)(C.ws + WS_R); const bf16* g_v = (const bf16*)(C.ws + WS_V); const bf16* g_nkk = (const bf16*)(C.ws + WS_NKK); const bf16* g_k = (const bf16*)(C.ws + WS_KRAW);
    const bf16* g_lw = (const bf16*)(C.ws + WS_LW); const bf16* g_a = (const bf16*)(C.ws + WS_A); const float* k_a = C.ka->in[14];
    bf16* g_out = role ? (bf16*)(C.ws + WS_YL) : (bf16*)(C.dout + DO_QT); float* g_pu = (float*)(C.ws + WS_PU);
    LAS float* lbase = (LAS float*)C.lds + itl * SC_ITEMF;
    const int nitems = NCHAIN * NCK;
    for (int base = C.bid * 4; base < nitems; base += C.nb * 4) {
        const int item = base + itl; const bool active = item < nitems; const int chain = active ? item / NCK : 0, chunk = active ? item % NCK : 0, z = chain >> 4, h = chain & 15;
        const size_t zoff = (size_t)z * S * RW; const int cbase = h * 64 + 4 * cg;
        const f32x4 ka4 = *(const f32x4*)(k_a + cbase);
        f32x2 st[4][8];
#pragma unroll
        for (int i = 0; i < 4; ++i)
#pragma unroll
            for (int kk = 0; kk < 8; ++kk) { const int row = 4 * rg + i, k0 = 16 * kq + 2 * kk; st[i][kk] = (f32x2){(role == 0 && row == k0) ? 1.f : 0.f, (role == 0 && row == k0 + 1) ? 1.f : 0.f}; }
        u32x2 q_nkk, q_lw, q_a, q_k, q_r, q_v;
#define SC_LOAD(blk) do { const int sg_ = chunk * CHL + (blk) * SC_T + sst; const int tk_ = z ? S - 1 - sg_ : sg_; const size_t ix_ = (size_t)tk_ * RW + cbase; \
            q_nkk = *(const u32x2*)(g_nkk + ix_); q_lw = *(const u32x2*)(g_lw + zoff + ix_); q_a = *(const u32x2*)(g_a + zoff + ix_); q_k = *(const u32x2*)(g_k + ix_); q_r = *(const u32x2*)(g_r + ix_); q_v = *(const u32x2*)(g_v + ix_); } while (0)
#define SC_BF(q, e) __uint_as_float(((e) & 1) ? (((e) >> 1) ? (q).y : (q).x) & 0xffff0000u : (((e) >> 1) ? (q).y : (q).x) << 16)
#define SC_WRITE(buf) do { LAS float* d_ = lbase + (buf) * 4 * SC_ITEMF + sst * SC_STEPF + 4 * cg; f32x4 o0, o1, o2, o3, o4, o5; \
            _Pragma("unroll") for (int e = 0; e < 4; ++e) { const float n_ = SC_BF(q_nkk, e), a_ = SC_BF(q_a, e); o0[e] = n_; o1[e] = __expf(SC_BF(q_lw, e)); o2[e] = -n_ * a_; o3[e] = SC_BF(q_k, e) * (1.0f + (a_ - 1.0f) * ka4[e]); o4[e] = SC_BF(q_r, e); o5[e] = SC_BF(q_v, e); } \
            *(LAS f32x4*)(d_) = o0; *(LAS f32x4*)(d_ + 64) = o1; *(LAS f32x4*)(d_ + 128) = o2; *(LAS f32x4*)(d_ + 192) = o3; *(LAS f32x4*)(d_ + 256) = o4; *(LAS f32x4*)(d_ + 320) = o5; } while (0)
        SC_LOAD(0); SC_WRITE(0);
        __syncthreads();
        for (int blk = 0; blk < CHL / SC_T; ++blk) {
            if (blk + 1 < CHL / SC_T) SC_LOAD(blk + 1);
            const LAS float* bp = lbase + (blk & 1) * 4 * SC_ITEMF + 16 * kq;
            f32x4 x[4];
#pragma unroll
            for (int q = 0; q < 4; ++q) x[q] = *(const LAS f32x4*)(bp + 4 * q);
#pragma unroll 2
            for (int ss = 0; ss < SC_T; ++ss) {
                const LAS float* sp = bp + ss * SC_STEPF;
                float sa[4], y[4];
                f32x4 vv = (f32x4){0.f, 0.f, 0.f, 0.f}; if (role) vv = *(const LAS f32x4*)(sp - 16 * kq + 320 + 4 * rg);
                f32x4 w4[4], b4[4], r4[4], k4[4];
#pragma unroll
                for (int q = 0; q < 4; ++q) { w4[q] = *(const LAS f32x4*)(sp + 64 + 4 * q); b4[q] = *(const LAS f32x4*)(sp + 128 + 4 * q); r4[q] = *(const LAS f32x4*)(sp + 256 + 4 * q); if (role) k4[q] = *(const LAS f32x4*)(sp + 192 + 4 * q); }
                {   f32x2 s2[4];
#pragma unroll
                    for (int i = 0; i < 4; ++i) { s2[i] = st[i][0] * (f32x2){x[0][0], x[0][1]};
#pragma unroll
                        for (int kk = 1; kk < 8; ++kk) s2[i] += st[i][kk] * (f32x2){x[kk >> 1][2 * (kk & 1)], x[kk >> 1][2 * (kk & 1) + 1]}; }
#pragma unroll
                    for (int i = 0; i < 4; ++i) sa[i] = quad_sum(s2[i].x + s2[i].y); }
                if (ss + 1 < SC_T) {
#pragma unroll
                    for (int q = 0; q < 4; ++q) x[q] = *(const LAS f32x4*)(sp + SC_STEPF + 4 * q); }
                __builtin_amdgcn_sched_barrier(0);
                f32x2 y2[4];
#pragma unroll
                for (int i = 0; i < 4; ++i) y2[i] = (f32x2){0.f, 0.f};
#pragma unroll
                for (int kk = 0; kk < 8; ++kk) { const int q = kk >> 1, o = 2 * (kk & 1); const f32x2 w2 = (f32x2){w4[q][o], w4[q][o + 1]}, b2 = (f32x2){b4[q][o], b4[q][o + 1]}, r2 = (f32x2){r4[q][o], r4[q][o + 1]};
#pragma unroll
                    for (int i = 0; i < 4; ++i) { f32x2 t2 = b2 * sa[i]; if (role) t2 += (f32x2){k4[q][o], k4[q][o + 1]} * vv[i]; st[i][kk] = st[i][kk] * w2 + t2; y2[i] += st[i][kk] * r2; } }
#pragma unroll
                for (int i = 0; i < 4; ++i) y[i] = quad_sum(y2[i].x + y2[i].y);
                if (active && kq == 0) { const int sg = chunk * CHL + blk * SC_T + ss; const int tk = z ? S - 1 - sg : sg; u32x2 o; o.x = pk2(y[0], y[1]); o.y = pk2(y[2], y[3]);
                    *(u32x2*)(g_out + zoff + (size_t)tk * RW + h * 64 + 4 * rg) = o; }
            }
            if (blk + 1 < CHL / SC_T) SC_WRITE((blk + 1) & 1);
            __syncthreads();
        }
        if (active) { float* pp = g_pu + (((size_t)chain * NCK + chunk) * 2 + role) * 4096;
#pragma unroll
            for (int i = 0; i < 4; ++i)
#pragma unroll
                for (int q = 0; q < 4; ++q) *(f32x4*)(pp + (4 * rg + i) * 64 + 16 * kq + 4 * q) = (f32x4){st[i][2 * q].x, st[i][2 * q].y, st[i][2 * q + 1].x, st[i][2 * q + 1].y}; }
#undef SC_LOAD
#undef SC_BF
#undef SC_WRITE
    }
}
__device__ __forceinline__ void ph_scan1(Ctx& C) { if (C.wave >> 2) ph_scan1_r<1>(C); else ph_scan1_r<0>(C); }
__device__ __forceinline__ float rdlane(float x, int l) { return __int_as_float(__builtin_amdgcn_readlane(__float_as_int(x), l)); }
__device__ __forceinline__ void ph_scan2(Ctx& C) {
    const int lane = lane_now(); const float* g_pu = (const float*)(C.ws + WS_PU); float* g_s0 = (float*)(C.ws + WS_S0);
    for (int task = C.bid; task < NCHAIN * 8; task += C.nb) { const int chain = task >> 3, row = (task & 7) * 8 + C.wave;
        float sv = 0.f; float pc[64], uc;
        { const float* P = g_pu + ((size_t)chain * NCK) * 8192;
#pragma unroll
          for (int k = 0; k < 64; ++k) pc[k] = P[k * 64 + lane];
          uc = P[4096 + row * 64 + lane]; }
#pragma unroll 1
        for (int c = 0; c < NCK; ++c) { const float* P = g_pu + ((size_t)chain * NCK + (c + 1 < NCK ? c + 1 : c)) * 8192;
            float pn[64], un;
#pragma unroll
            for (int k = 0; k < 64; ++k) pn[k] = P[k * 64 + lane];
            un = P[4096 + row * 64 + lane];
            g_s0[(((size_t)chain * NCK + c) * 64 + row) * 64 + lane] = sv;
            float acc0 = uc, acc1 = 0.f;
#pragma unroll
            for (int k = 0; k < 64; k += 2) { acc0 += rdlane(sv, k) * pc[k]; acc1 += rdlane(sv, k + 1) * pc[k + 1]; }
            sv = acc0 + acc1;
#pragma unroll
            for (int k = 0; k < 64; ++k) pc[k] = pn[k];
            uc = un; }
    }
}

#ifndef OPT_SCAN2B
#define OPT_SCAN2B 1
#endif
__device__ __forceinline__ void ph_scan2b(Ctx& C) {
    const int lane = lane_now(), wave = C.wave, tid = wave * 64 + lane; const float* g_pu = (const float*)(C.ws + WS_PU); float* g_s0 = (float*)(C.ws + WS_S0);
    constexpr int SLOT = 18432, NSLOT = 6, AHEAD = 5;
    for (int task = C.bid; task < NCHAIN * 8; task += C.nb) { const int chain = task >> 3, rg = task & 7, row = rg * 8 + wave;
        const float* Pb = g_pu + (size_t)chain * NCK * 8192;
#define S2_ISSUE(c_) do { const float* pc_ = Pb + (size_t)(c_) * 8192; LAS unsigned char* sl_ = C.lds + ((c_) % NSLOT) * SLOT + wave * 1024; \
            __builtin_amdgcn_global_load_lds((const unsigned*)(pc_ + tid * 4), (LAS unsigned*)(sl_), 16, 0, 0); \
            __builtin_amdgcn_global_load_lds((const unsigned*)(pc_ + 2048 + tid * 4), (LAS unsigned*)(sl_ + 8192), 16, 0, 0); \
            if (wave < 2) __builtin_amdgcn_global_load_lds((const unsigned*)(pc_ + 4096 + rg * 512 + tid * 4), (LAS unsigned*)(sl_ + 16384), 16, 0, 0); } while (0)
#define S2_LOADP(c_, PN_, UN_) do { const LAS float* P_ = (const LAS float*)(C.lds + ((c_) % NSLOT) * SLOT) + lane; UN_ = P_[4096 + wave * 64]; \
            _Pragma("unroll") for (int k = 0; k < 64; ++k) PN_[k] = P_[k * 64]; asm volatile("" ::: "memory"); } while (0)
#define S2_STEP(c_, PC_, UC_, PN_, UN_) do { const int cc_ = (c_); \
            if (cc_ >= 4) { if (cc_ < NCK - 4) { if (wave < 2) asm volatile("s_waitcnt vmcnt(13)" ::: "memory"); else asm volatile("s_waitcnt vmcnt(10)" ::: "memory"); } \
                else if (cc_ == NCK - 4) { if (wave < 2) asm volatile("s_waitcnt vmcnt(10)" ::: "memory"); else asm volatile("s_waitcnt vmcnt(8)" ::: "memory"); } \
                else if (cc_ == NCK - 3) { if (wave < 2) asm volatile("s_waitcnt vmcnt(7)" ::: "memory"); else asm volatile("s_waitcnt vmcnt(6)" ::: "memory"); } \
                else if (cc_ == NCK - 2) asm volatile("s_waitcnt vmcnt(4)" ::: "memory"); } \
            __builtin_amdgcn_s_barrier(); asm volatile("" ::: "memory"); \
            if (cc_ + AHEAD < NCK) S2_ISSUE(cc_ + AHEAD);                            \
            asm volatile("" ::: "memory");                                            \
            g_s0[(((size_t)chain * NCK + cc_) * 64 + row) * 64 + lane] = sv; \
            if (cc_ + 1 < NCK) S2_LOADP(cc_ + 1, PN_, UN_); \
            float a0_ = UC_, a1_ = 0.f, a2_ = 0.f, a3_ = 0.f; \
            _Pragma("unroll") for (int k = 0; k < 64; k += 4) { a0_ += rdlane(sv, k) * PC_[k]; a1_ += rdlane(sv, k + 1) * PC_[k + 1]; a2_ += rdlane(sv, k + 2) * PC_[k + 2]; a3_ += rdlane(sv, k + 3) * PC_[k + 3]; } \
            sv = (a0_ + a1_) + (a2_ + a3_); } while (0)
        asm volatile("s_waitcnt vmcnt(0) lgkmcnt(0)" ::: "memory"); __builtin_amdgcn_s_barrier(); asm volatile("" ::: "memory");
#pragma unroll
        for (int c = 0; c < AHEAD; ++c) S2_ISSUE(c);
        float sv = 0.f, pa[64], pb[64], ua, ub = 0.f;
        asm volatile("s_waitcnt vmcnt(0)" ::: "memory"); __builtin_amdgcn_s_barrier(); asm volatile("" ::: "memory");
        S2_LOADP(0, pa, ua);
#pragma unroll 1
        for (int c = 0; c < NCK; c += 2) { S2_STEP(c, pa, ua, pb, ub); S2_STEP(c + 1, pb, ub, pa, ua); }
#undef S2_STEP
#undef S2_LOADP
#undef S2_ISSUE
    }
    asm volatile("s_waitcnt vmcnt(0)" ::: "memory"); __builtin_amdgcn_s_barrier();
}
__device__ __forceinline__ void ph_fin2(Ctx& C) {
    const int lane = lane_now();
    const bf16* yl = (const bf16*)(C.ws + WS_YL); const bf16* qt = (const bf16*)(C.dout + DO_QT); const float* s0 = (const float*)(C.ws + WS_S0);
    const bf16* r = (const bf16*)(C.ws + WS_R); const bf16* kraw = (const bf16*)(C.ws + WS_KRAW); const bf16* a = (const bf16*)(C.ws + WS_A); const float* k_a = C.ka->in[14]; const float* r_k = C.ka->in[15];
    const bf16* v = (const bf16*)(C.ws + WS_V); const bf16* gate = (const bf16*)(C.ws + WS_GATE); bf16* orw = (bf16*)(C.ws + WS_ORWKV); const float* lnw = C.ka->in[16]; const float* lnb = C.ka->in[17];
    for (int task = C.bid; task < 16 * NCK; task += C.nb) { const int h = task & 15, cf = task >> 4, cb = NCK - 1 - cf, c = h * 64 + lane;
        f32x4 sf[16], sb[16];
        { const f32x4* pf = (const f32x4*)(s0 + (((size_t)h * NCK + cf) * 64 + lane) * 64); const f32x4* pb = (const f32x4*)(s0 + (((size_t)(16 + h) * NCK + cb) * 64 + lane) * 64);
#pragma unroll
          for (int q = 0; q < 16; ++q) { sf[q] = pf[q]; sb[q] = pb[q]; } }
        const float ka_ = k_a[c], rk_ = r_k[c], lw_ = lnw[c], lb_ = lnb[c];
        for (int tt = 0; tt < 32; ++tt) { const int t = cf * CHL + C.wave * 32 + tt; const size_t ix = (size_t)t * RW + c, ixb = ((size_t)S + t) * RW + c;
            const float qf = bf2f(qt[ix]), qb = bf2f(qt[ixb]);
            float y0 = bf2f(yl[ix]), y1 = bf2f(yl[ixb]);
#pragma unroll
            for (int q = 0; q < 16; ++q)
#pragma unroll
                for (int e = 0; e < 4; ++e) { y0 += sf[q][e] * rdlane(qf, 4 * q + e); y1 += sb[q][e] * rdlane(qb, 4 * q + e); }
            const float y = y0 + y1;
            const float mu = wave_sum(y) * (1.0f / 64.f); const float dv = y - mu; const float var = wave_sum(dv * dv) * (1.0f / 64.f);
            const float gn = dv * (1.0f / sqrtf(var + 64e-5f)) * lw_ + lb_;
            const float kd2 = (1.0f + (bf2f(a[ix]) - 1.0f) * ka_) + (1.0f + (bf2f(a[ixb]) - 1.0f) * ka_);
            const float bonus = wave_sum(bf2f(r[ix]) * bf2f(kraw[ix]) * kd2 * rk_) * bf2f(v[ix]);
            orw[ix] = f2bf((gn + bonus) * bf2f(gate[ix])); }
    }
}


#ifndef OPT_ATTN
#define OPT_ATTN 1
#endif
typedef float f32x16 __attribute__((ext_vector_type(16)));
constexpr size_t WS_OG = 442 * MiB, WS_LSE = 490 * MiB;
constexpr int AT_VTS = 388;
__device__ __forceinline__ void ph_attn2(Ctx& C) {
    const int lane = lane_now(), wave = C.wave, tid = wave * 64 + lane, r31 = lane & 31, hh = lane >> 5;
    const bf16* z = (const bf16*)(C.ws + WS_ZQKV); bf16* og = (bf16*)(C.ws + WS_OG); float* lse_o = (float*)(C.ws + WS_LSE);
    LAS bf16* vt = (LAS bf16*)C.lds; LAS bf16* kim = (LAS bf16*)(C.lds + 64 * AT_VTS * 2);
    for (int unit = C.bid; unit < 1536; unit += C.nb) {
        const int g = unit >> 9, rem = unit & 511, h = rem & 7, tile64 = rem >> 3;
        const int dsh = 2 * g, d = 1 << dsh, n = S >> dsh, res = tile64 & (d - 1), tl = tile64 >> dsh;
        const int kbase = tl * 256 - 64, colq = g * 512 + h * 64, colk = 1536 + colq, colv = 3072 + colq;
        const float slope_d = exp2f(-8.0f * (float)(g * 8 + h + 1) / 24.0f) * (float)d;
#pragma unroll
        for (int i = 0; i < 6; ++i) { const int kc = (tid >> 3) + 64 * i, ch = tid & 7, ki = kbase + kc; u32x4 w = (u32x4){0u, 0u, 0u, 0u}, wk = (u32x4){0u, 0u, 0u, 0u};
            if (ki >= 0 && ki < n) { const bf16* rp = z + (size_t)((ki << dsh) + res) * NQKV + 8 * ch; w = *(const u32x4*)(rp + colv); wk = *(const u32x4*)(rp + colk); }
            *(LAS u32x4*)(kim + kc * 72 + 8 * ch) = wk;
            LAS bf16* dp = vt + (8 * ch) * AT_VTS + kc;
            dp[0] = (bf16)(w.x & 0xffff); dp[AT_VTS] = (bf16)(w.x >> 16); dp[2 * AT_VTS] = (bf16)(w.y & 0xffff); dp[3 * AT_VTS] = (bf16)(w.y >> 16);
            dp[4 * AT_VTS] = (bf16)(w.z & 0xffff); dp[5 * AT_VTS] = (bf16)(w.z >> 16); dp[6 * AT_VTS] = (bf16)(w.w & 0xffff); dp[7 * AT_VTS] = (bf16)(w.w >> 16); }
        __syncthreads();
        const int qb = tl * 256 + 32 * wave; const int qtok = ((qb + r31) << dsh) + res;
        bf16x8 qf[4];
#pragma unroll
        for (int ks = 0; ks < 4; ++ks) qf[ks] = *(const bf16x8*)(z + (size_t)qtok * NQKV + colq + 16 * ks + 8 * hh);
        f32x16 sacc[5];
#pragma unroll
        for (int kt = 0; kt < 5; ++kt) {
#pragma unroll
            for (int e = 0; e < 16; ++e) sacc[kt][e] = 0.f;
            const LAS bf16* kp = kim + (32 * wave + 32 * kt + r31) * 72 + 8 * hh;
#pragma unroll
            for (int ks = 0; ks < 4; ++ks) { const bf16x8 kf = *(const LAS bf16x8*)(kp + 16 * ks); sacc[kt] = __builtin_amdgcn_mfma_f32_32x32x16_bf16(kf, qf[ks], sacc[kt], 0, 0, 0); } }
        const float LOG2E = 1.44269504f, slope2 = slope_d * LOG2E, c0f = (float)(4 * hh - 64 - r31);
        const bool edge = (tl == 0) || (tl == (n >> 8) - 1);
        float m = -3.0e38f;
#pragma unroll
        for (int kt = 0; kt < 5; ++kt)
#pragma unroll
            for (int e = 0; e < 16; ++e) { const float relf = (float)(32 * kt + (e & 3) + 8 * (e >> 2)) + c0f; float sc = sacc[kt][e] * LOG2E - slope2 * __builtin_fabsf(relf);
                if (kt == 0) sc = relf >= -64.0f ? sc : -1e30f;
                if (kt == 4) sc = relf <= 64.0f ? sc : -1e30f;
                sacc[kt][e] = sc; }
        if (edge) {
#pragma unroll
            for (int kt = 0; kt < 5; ++kt)
#pragma unroll
                for (int e = 0; e < 16; ++e) { const int kidx = qb - 64 + 32 * kt + (e & 3) + 8 * (e >> 2) + 4 * hh; sacc[kt][e] = (kidx >= 0 && kidx < n) ? sacc[kt][e] : -1e30f; } }
#pragma unroll
        for (int kt = 0; kt < 5; ++kt)
#pragma unroll
            for (int e = 0; e < 16; ++e) m = fmaxf(m, sacc[kt][e]);
        { const auto rr = __builtin_amdgcn_permlane32_swap(__float_as_uint(m), __float_as_uint(m), false, false); m = fmaxf(__uint_as_float(rr[0]), __uint_as_float(rr[1])); }
        float den = 0.f;
#pragma unroll
        for (int kt = 0; kt < 5; ++kt)
#pragma unroll
            for (int e = 0; e < 16; ++e) { const float pv = __builtin_amdgcn_exp2f(sacc[kt][e] - m); sacc[kt][e] = pv; den += pv; }
        { const auto rr = __builtin_amdgcn_permlane32_swap(__float_as_uint(den), __float_as_uint(den), false, false); den = __uint_as_float(rr[0]) + __uint_as_float(rr[1]); }
        f32x16 oacc[2];
#pragma unroll
        for (int dt = 0; dt < 2; ++dt)
#pragma unroll
            for (int e = 0; e < 16; ++e) oacc[dt][e] = 0.f;
#pragma unroll
        for (int kt = 0; kt < 5; ++kt)
#pragma unroll
            for (int sI = 0; sI < 2; ++sI) { const bf16x8 bfrag = pack8s(sacc[kt][8 * sI], sacc[kt][8 * sI + 1], sacc[kt][8 * sI + 2], sacc[kt][8 * sI + 3], sacc[kt][8 * sI + 4], sacc[kt][8 * sI + 5], sacc[kt][8 * sI + 6], sacc[kt][8 * sI + 7]);
#pragma unroll
                for (int dt = 0; dt < 2; ++dt) { const LAS bf16* vp = vt + (32 * dt + r31) * AT_VTS + 32 * wave + 32 * kt + 16 * sI + 4 * hh;
                    const u32x2 lo = *(const LAS u32x2*)vp, hi = *(const LAS u32x2*)(vp + 8); u32x4 pa; pa.x = lo.x; pa.y = lo.y; pa.z = hi.x; pa.w = hi.y;
                    oacc[dt] = __builtin_amdgcn_mfma_f32_32x32x16_bf16(__builtin_bit_cast(bf16x8, pa), bfrag, oacc[dt], 0, 0, 0); } }
        const float rden = 1.0f / den; bf16* op = og + ((size_t)g * S + qtok) * 512 + h * 64 + 4 * hh;
#pragma unroll
        for (int dt = 0; dt < 2; ++dt)
#pragma unroll
            for (int gr = 0; gr < 4; ++gr) { u32x2 o; o.x = pg8c(oacc[dt][4 * gr] * rden, oacc[dt][4 * gr + 1] * rden); o.y = pg8c(oacc[dt][4 * gr + 2] * rden, oacc[dt][4 * gr + 3] * rden); *(u32x2*)(op + 32 * dt + 8 * gr) = o; }
        if (hh == 0) lse_o[((size_t)g * S + qtok) * 8 + h] = (m + __builtin_amdgcn_logf(den)) * 0.69314718f;
        __syncthreads();
    }
}
__device__ __forceinline__ void ph_attn_combine(Ctx& C) {
    const int lane = lane_now(); const bf16* og = (const bf16*)(C.ws + WS_OG); const float* lse = (const float*)(C.ws + WS_LSE); bf16* oa = (bf16*)(C.ws + WS_OATT);
    const int ntask = S * 64;
    for (int task = (C.bid * NWAVES + C.wave) * 64 + lane; task < ntask; task += C.nb * NTHR) { const int t = task >> 6, c8 = task & 63, h = c8 >> 3;
        const float l0 = lse[(size_t)t * 8 + h], l1 = lse[((size_t)S + t) * 8 + h], l2 = lse[((size_t)2 * S + t) * 8 + h]; const float mx = fmaxf(l0, fmaxf(l1, l2));
        const float w0 = __expf(l0 - mx), w1 = __expf(l1 - mx), w2 = __expf(l2 - mx), rs = 1.0f / (w0 + w1 + w2);
        float a0[8], a1[8], a2[8]; unpack8(*(const u32x4*)(og + (size_t)t * 512 + 8 * c8), a0); unpack8(*(const u32x4*)(og + ((size_t)S + t) * 512 + 8 * c8), a1); unpack8(*(const u32x4*)(og + ((size_t)2 * S + t) * 512 + 8 * c8), a2);
        f32x4 o0, o1;
#pragma unroll
        for (int e = 0; e < 4; ++e) { o0[e] = (w0 * a0[e] + w1 * a1[e] + w2 * a2[e]) * rs; o1[e] = (w0 * a0[4 + e] + w1 * a1[4 + e] + w2 * a2[4 + e]) * rs; }
        *(u32x4*)(oa + (size_t)t * 512 + 8 * c8) = pack8(o0, o1); }
}


__device__ __forceinline__ bf16x8 cvt8(const f32x4 a, const f32x4 b) { u32x4 w; w.x = pk2(a[0], a[1]); w.y = pk2(a[2], a[3]); w.z = pk2(b[0], b[1]); w.w = pk2(b[2], b[3]); return __builtin_bit_cast(bf16x8, w); }
__device__ __forceinline__ void unpack4(u32x2 w, float (&f)[4]) { f[0] = __uint_as_float(w.x << 16); f[1] = __uint_as_float(w.x & 0xffff0000u); f[2] = __uint_as_float(w.y << 16); f[3] = __uint_as_float(w.y & 0xffff0000u); }
__device__ __forceinline__ void ph_fin3(Ctx& C) {
    const int lane = lane_now(), r31 = lane & 31, hh = lane >> 5;
    const bf16* yl = (const bf16*)(C.ws + WS_YL); const bf16* qt = (const bf16*)(C.dout + DO_QT); const float* s0 = (const float*)(C.ws + WS_S0);
    const bf16* r = (const bf16*)(C.ws + WS_R); const bf16* kraw = (const bf16*)(C.ws + WS_KRAW); const bf16* a = (const bf16*)(C.ws + WS_A); const float* k_a = C.ka->in[14]; const float* r_k = C.ka->in[15];
    const bf16* v = (const bf16*)(C.ws + WS_V); const bf16* gate = (const bf16*)(C.ws + WS_GATE); bf16* orw = (bf16*)(C.ws + WS_ORWKV); const float* lnw = C.ka->in[16]; const float* lnb = C.ka->in[17];
    for (int task = C.bid; task < 16 * NCK; task += C.nb) { const int h = task & 15, cf = task >> 4, cb = NCK - 1 - cf;
        const int t = cf * CHL + C.wave * 32 + r31; const size_t rowf = (size_t)t * RW + h * 64, rowb = ((size_t)S + t) * RW + h * 64;
        f32x16 acc[2];
#pragma unroll
        for (int vt = 0; vt < 2; ++vt)
#pragma unroll
            for (int e = 0; e < 16; ++e) acc[vt][e] = 0.f;
#pragma unroll
        for (int z = 0; z < 2; ++z) { const float* sp = s0 + (((size_t)(z * 16 + h) * NCK + (z ? cb : cf)) * 64 + r31) * 64 + 8 * hh; const bf16* qp = qt + (z ? rowb : rowf) + 8 * hh;
#pragma unroll
            for (int ks = 0; ks < 4; ++ks) { const bf16x8 bq = *(const bf16x8*)(qp + 16 * ks);
#pragma unroll
                for (int vt = 0; vt < 2; ++vt) { const f32x4* ap = (const f32x4*)(sp + (size_t)vt * 32 * 64 + 16 * ks); acc[vt] = __builtin_amdgcn_mfma_f32_32x32x16_bf16(cvt8(ap[0], ap[1]), bq, acc[vt], 0, 0, 0); } } }
        float ssum = 0.f, bsum = 0.f;
#pragma unroll
        for (int vt = 0; vt < 2; ++vt)
#pragma unroll
            for (int gr = 0; gr < 4; ++gr) { const int co = 32 * vt + 8 * gr + 4 * hh; float f0[4], f1[4], fr_[4], fk[4], fa0[4], fa1[4];
                unpack4(*(const u32x2*)(yl + rowf + co), f0); unpack4(*(const u32x2*)(yl + rowb + co), f1); unpack4(*(const u32x2*)(r + rowf + co), fr_); unpack4(*(const u32x2*)(kraw + rowf + co), fk);
                unpack4(*(const u32x2*)(a + rowf + co), fa0); unpack4(*(const u32x2*)(a + rowb + co), fa1);
                const f32x4 ka4 = *(const f32x4*)(k_a + h * 64 + co), rk4 = *(const f32x4*)(r_k + h * 64 + co);
#pragma unroll
                for (int e = 0; e < 4; ++e) { const float y = acc[vt][4 * gr + e] + f0[e] + f1[e]; acc[vt][4 * gr + e] = y; ssum += y;
                    bsum += fr_[e] * fk[e] * ((1.0f + (fa0[e] - 1.0f) * ka4[e]) + (1.0f + (fa1[e] - 1.0f) * ka4[e])) * rk4[e]; } }
        ssum += __shfl_xor(ssum, 32); bsum += __shfl_xor(bsum, 32);
        const float mu = ssum * (1.0f / 64.f); float vs = 0.f;
#pragma unroll
        for (int vt = 0; vt < 2; ++vt)
#pragma unroll
            for (int e = 0; e < 16; ++e) { const float dv = acc[vt][e] - mu; acc[vt][e] = dv; vs += dv * dv; }
        vs += __shfl_xor(vs, 32);
        const float rstd = 1.0f / sqrtf(vs * (1.0f / 64.f) + 64e-5f);
#pragma unroll
        for (int vt = 0; vt < 2; ++vt)
#pragma unroll
            for (int gr = 0; gr < 4; ++gr) { const int co = 32 * vt + 8 * gr + 4 * hh; float fv[4], fg[4]; unpack4(*(const u32x2*)(v + rowf + co), fv); unpack4(*(const u32x2*)(gate + rowf + co), fg);
                const f32x4 w4 = *(const f32x4*)(lnw + h * 64 + co), b4 = *(const f32x4*)(lnb + h * 64 + co); float o[4];
#pragma unroll
                for (int e = 0; e < 4; ++e) o[e] = (acc[vt][4 * gr + e] * rstd * w4[e] + b4[e] + bsum * fv[e]) * fg[e];
                u32x2 w; w.x = pk2(o[0], o[1]); w.y = pk2(o[2], o[3]); *(u32x2*)(orw + rowf + co) = w; }
    }
}
template <int CTRL> __device__ __forceinline__ float dpp_row(float x) { return __int_as_float(__builtin_amdgcn_update_dpp(0, __float_as_int(x), CTRL, 0xf, 0xf, true)); }
__device__ __forceinline__ void ph_rprep2(Ctx& C) {
    const int lane = lane_now();
    const bf16* zr = (const bf16*)(C.ws + WS_ZR); const float* mup = C.ka->in[6]; const float* mun = C.ka->in[7]; const float* k_k = C.ka->in[13];
    bf16* r = (bf16*)(C.ws + WS_R); bf16* v = (bf16*)(C.ws + WS_V); bf16* nkk = (bf16*)(C.ws + WS_NKK); bf16* kraw = (bf16*)(C.ws + WS_KRAW); bf16* la = (bf16*)(C.ws + WS_LORAA);
    const int ntask = 6 * (S / 64) + (S / 32);
    for (int task = C.gw; task < ntask; task += C.ngw) { const bool heavy = task >= 6 * (S / 64); const int cgp = heavy ? 6 : task % 6, ntok = heavy ? 32 : 64, t0 = heavy ? (task - 6 * (S / 64)) * 32 : (task / 6) * 64, col = cgp * 512 + lane * 8;
        const bool real = col < NZR_REAL; const int kind = col < 1024 ? 0 : col < 2048 ? 1 : col < 3072 ? 2 : col < 3136 ? 3 : col < 3200 ? 4 : col < 3360 ? 5 : 6;
        float mp[8], mn[8], kk8[8];
#pragma unroll
        for (int e = 0; e < 8; ++e) { mp[e] = real ? mup[col + e] : 0.f; mn[e] = real ? mun[col + e] : 0.f; kk8[e] = kind == 1 ? k_k[col - 1024 + e] : 0.f; }
        float zp[8], zc[8], zn[8];
        if (t0 > 0) unpack8(*(const u32x4*)(zr + (size_t)(t0 - 1) * NZR + col), zp); else {
#pragma unroll
            for (int e = 0; e < 8; ++e) zp[e] = 0.f; }
        unpack8(*(const u32x4*)(zr + (size_t)t0 * NZR + col), zc);
        u32x4 rawn[8];
#define RP_LOAD8(tb_) do { _Pragma("unroll") for (int j_ = 0; j_ < 8; ++j_) { const int tr_ = (tb_) + 1 + j_; const u32x4 w_ = *(const u32x4*)(zr + (size_t)(tr_ < S ? tr_ : S - 1) * NZR + col); rawn[j_] = tr_ < S ? w_ : (u32x4){0u, 0u, 0u, 0u}; } } while (0)
#pragma unroll 1
        for (int i0 = 0; i0 < ntok; i0 += 8) { u32x4 rawc[8];
            RP_LOAD8(t0 + i0);
#pragma unroll
            for (int j = 0; j < 8; ++j) asm volatile("" : "+v"(rawn[j]));
#pragma unroll
            for (int j = 0; j < 8; ++j) rawc[j] = rawn[j];
#pragma unroll
          for (int j = 0; j < 8; ++j) { const int t = t0 + i0 + j;
            unpack8(rawc[j], zn);
            float x[8];
#pragma unroll
            for (int e = 0; e < 8; ++e) x[e] = zc[e] + mp[e] * (zp[e] - zc[e]) + mn[e] * (zn[e] - zc[e]);
            if (kind == 0) *(u32x4*)(r + (size_t)t * RW + col) = pack8((f32x4){x[0], x[1], x[2], x[3]}, (f32x4){x[4], x[5], x[6], x[7]});
            else if (kind == 1) { *(u32x4*)(kraw + (size_t)t * RW + col - 1024) = pack8((f32x4){x[0], x[1], x[2], x[3]}, (f32x4){x[4], x[5], x[6], x[7]});
                float kv[8], ss = 0.f;
#pragma unroll
                for (int e = 0; e < 8; ++e) { kv[e] = x[e] * kk8[e]; ss += kv[e] * kv[e]; }
                ss += dpp_row<0xB1>(ss); ss += dpp_row<0x4E>(ss); ss += dpp_row<0x141>(ss);
                const float sc = -1.0f / fmaxf(sqrtf(ss), 1e-12f);
                *(u32x4*)(nkk + (size_t)t * RW + col - 1024) = pack8((f32x4){kv[0] * sc, kv[1] * sc, kv[2] * sc, kv[3] * sc}, (f32x4){kv[4] * sc, kv[5] * sc, kv[6] * sc, kv[7] * sc}); }
            else if (kind == 2) *(u32x4*)(v + (size_t)t * RW + col - 2048) = pack8((f32x4){x[0], x[1], x[2], x[3]}, (f32x4){x[4], x[5], x[6], x[7]});
            else { float o[8];
#pragma unroll
                for (int e = 0; e < 8; ++e) { const float sg = __builtin_amdgcn_rcpf(1.0f + __builtin_amdgcn_exp2f(x[e] * (kind == 3 ? -2.88539008f : -1.44269504f)));
                    o[e] = kind == 3 ? 2.0f * sg - 1.0f : kind == 4 ? x[e] : kind == 5 ? sg : 0.f; }
                bf16* lp = kind <= 4 ? la + (size_t)t * KL2 + (col - 3072) : kind == 5 ? la + (size_t)(S + t) * KL2 + (col - 3200) : col < 3488 ? la + (size_t)t * KL2 + 128 + (col - 3360) : la + (size_t)(S + t) * KL2 + 160 + (col - 3488);
                *(u32x4*)lp = pack8((f32x4){o[0], o[1], o[2], o[3]}, (f32x4){o[4], o[5], o[6], o[7]}); }
#pragma unroll
            for (int e = 0; e < 8; ++e) { zp[e] = zc[e]; zc[e] = zn[e]; }
          }
        }
#undef RP_LOAD8
    }
}


constexpr int F4_S0STR = 72, F4_TSTR = 68;
__device__ __forceinline__ void ph_fin4(Ctx& C) {
    const int lane0 = lane_now(), wave = C.wave;
    const bf16* yl = (const bf16*)(C.ws + WS_YL); const bf16* qt = (const bf16*)(C.dout + DO_QT); const float* s0 = (const float*)(C.ws + WS_S0);
    const bf16* r = (const bf16*)(C.ws + WS_R); const bf16* kraw = (const bf16*)(C.ws + WS_KRAW); const bf16* a = (const bf16*)(C.ws + WS_A); const float* k_a = C.ka->in[14]; const float* r_k = C.ka->in[15];
    const bf16* v = (const bf16*)(C.ws + WS_V); const bf16* gate = (const bf16*)(C.ws + WS_GATE); bf16* orw = (bf16*)(C.ws + WS_ORWKV); const float* lnw = C.ka->in[16]; const float* lnb = C.ka->in[17];
    LAS bf16* s0img = (LAS bf16*)C.lds;
    LAS bf16* tr = (LAS bf16*)(C.lds + 2 * 64 * F4_S0STR * 2) + C.wave * (32 * F4_TSTR);
    for (int task = C.bid; task < 16 * NCK; task += C.nb) { const int h = task & 15, cf = task >> 4, cb = NCK - 1 - cf;
        int lane = lane0; asm volatile("" : "+v"(lane));
        const int r31 = lane & 31, hh = lane >> 5, tid = wave * 64 + lane;
#define F4_GLOAD(g, gptr) do { _Pragma("unroll") for (int i_ = 0; i_ < 4; ++i_) g[i_] = *(const u32x4*)((gptr) + (size_t)((lane >> 3) + 8 * i_) * RW + 8 * (lane & 7)); } while (0)
#define F4_XPOSE(dst, g) do { _Pragma("unroll") for (int i_ = 0; i_ < 4; ++i_) { LAS u32x2* d_ = (LAS u32x2*)(tr + ((lane >> 3) + 8 * i_) * F4_TSTR + 8 * (lane & 7)); d_[0] = (u32x2){g[i_].x, g[i_].y}; d_[1] = (u32x2){g[i_].z, g[i_].w}; } \
            asm volatile("s_waitcnt lgkmcnt(0)" ::: "memory"); \
            _Pragma("unroll") for (int vt_ = 0; vt_ < 2; ++vt_) _Pragma("unroll") for (int gr_ = 0; gr_ < 4; ++gr_) dst[vt_][gr_] = *(const LAS u32x2*)(tr + r31 * F4_TSTR + 32 * vt_ + 8 * gr_ + 4 * hh); \
            asm volatile("s_waitcnt lgkmcnt(0)" ::: "memory"); } while (0)
        __syncthreads();
        { const int z = tid >> 8, row = (tid >> 2) & 63, seg = tid & 3; const float* sp = s0 + (((size_t)(z * 16 + h) * NCK + (z ? cb : cf)) * 64 + row) * 64 + 16 * seg;
          const f32x4 x0 = *(const f32x4*)sp, x1 = *(const f32x4*)(sp + 4), x2 = *(const f32x4*)(sp + 8), x3 = *(const f32x4*)(sp + 12);
          LAS u32x4* dp = (LAS u32x4*)(s0img + (z * 64 + row) * F4_S0STR + 16 * seg); dp[0] = pack8(x0, x1); dp[1] = pack8(x2, x3); }
        __syncthreads();
#pragma unroll 1
        for (int hv = 0; hv < CHL / 256; ++hv) {
        const size_t base_f = (size_t)(cf * CHL + hv * 256 + wave * 32) * RW + h * 64, base_b = base_f + (size_t)S * RW;
        u32x4 g0[4], g1[4], g2[4], g3[4];
        F4_GLOAD(g0, yl + base_f); F4_GLOAD(g1, yl + base_b); F4_GLOAD(g2, r + base_f); F4_GLOAD(g3, kraw + base_f);
        const int t0 = cf * CHL + hv * 256 + wave * 32, t = t0 + r31; const size_t rowf = (size_t)t * RW + h * 64, rowb = ((size_t)S + t) * RW + h * 64;
        f32x16 acc[2];
#pragma unroll
        for (int vt = 0; vt < 2; ++vt)
#pragma unroll
            for (int e = 0; e < 16; ++e) acc[vt][e] = 0.f;
#pragma unroll
        for (int z = 0; z < 2; ++z) { const bf16* qp = qt + (z ? rowb : rowf) + 8 * hh;
#pragma unroll
            for (int ks = 0; ks < 4; ++ks) { const bf16x8 bq = *(const bf16x8*)(qp + 16 * ks);
#pragma unroll
                for (int vt = 0; vt < 2; ++vt) { const bf16x8 af = *(const LAS bf16x8*)(s0img + (z * 64 + 32 * vt + r31) * F4_S0STR + 16 * ks + 8 * hh); acc[vt] = __builtin_amdgcn_mfma_f32_32x32x16_bf16(af, bq, acc[vt], 0, 0, 0); } } }
        u32x2 q0[2][4], q1[2][4];
        float ssum = 0.f, bsum = 0.f;
        F4_XPOSE(q0, g0); F4_XPOSE(q1, g1);
        F4_GLOAD(g0, a + base_f); F4_GLOAD(g1, a + base_b);
#pragma unroll
        for (int vt = 0; vt < 2; ++vt)
#pragma unroll
            for (int gr = 0; gr < 4; ++gr) { float f0[4], f1[4]; unpack4(q0[vt][gr], f0); unpack4(q1[vt][gr], f1);
#pragma unroll
                for (int e = 0; e < 4; ++e) { const float y = acc[vt][4 * gr + e] + f0[e] + f1[e]; acc[vt][4 * gr + e] = y; ssum += y; } }
        { u32x2 q2[2][4], q3[2][4];
          F4_XPOSE(q0, g2); F4_XPOSE(q1, g3);
          F4_GLOAD(g2, v + base_f); F4_GLOAD(g3, gate + base_f);
          F4_XPOSE(q2, g0); F4_XPOSE(q3, g1);
#pragma unroll
          for (int vt = 0; vt < 2; ++vt)
#pragma unroll
              for (int gr = 0; gr < 4; ++gr) { const int co = 32 * vt + 8 * gr + 4 * hh; float fr_[4], fk[4], fa0[4], fa1[4]; unpack4(q0[vt][gr], fr_); unpack4(q1[vt][gr], fk); unpack4(q2[vt][gr], fa0); unpack4(q3[vt][gr], fa1);
                  const f32x4 ka4 = *(const f32x4*)(k_a + h * 64 + co), rk4 = *(const f32x4*)(r_k + h * 64 + co);
#pragma unroll
                  for (int e = 0; e < 4; ++e) bsum += fr_[e] * fk[e] * ((1.0f + (fa0[e] - 1.0f) * ka4[e]) + (1.0f + (fa1[e] - 1.0f) * ka4[e])) * rk4[e]; } }
        ssum += __shfl_xor(ssum, 32); bsum += __shfl_xor(bsum, 32);
        const float mu = ssum * (1.0f / 64.f); float vs = 0.f;
#pragma unroll
        for (int vt = 0; vt < 2; ++vt)
#pragma unroll
            for (int e = 0; e < 16; ++e) { const float dv = acc[vt][e] - mu; acc[vt][e] = dv; vs += dv * dv; }
        vs += __shfl_xor(vs, 32);
        const float rstd = 1.0f / sqrtf(vs * (1.0f / 64.f) + 64e-5f);
        F4_XPOSE(q0, g2); F4_XPOSE(q1, g3);
#pragma unroll
        for (int vt = 0; vt < 2; ++vt)
#pragma unroll
            for (int gr = 0; gr < 4; ++gr) { const int co = 32 * vt + 8 * gr + 4 * hh; float fv[4], fg[4]; unpack4(q0[vt][gr], fv); unpack4(q1[vt][gr], fg);
                const f32x4 w4 = *(const f32x4*)(lnw + h * 64 + co), b4 = *(const f32x4*)(lnb + h * 64 + co); float o[4];
#pragma unroll
                for (int e = 0; e < 4; ++e) o[e] = (acc[vt][4 * gr + e] * rstd * w4[e] + b4[e] + bsum * fv[e]) * fg[e];
                u32x2 w; w.x = pk2(o[0], o[1]); w.y = pk2(o[2], o[3]); *(LAS u32x2*)(tr + r31 * F4_TSTR + co) = w; }
        asm volatile("s_waitcnt lgkmcnt(0)" ::: "memory");
#pragma unroll
        for (int i = 0; i < 4; ++i) { const int tk = (lane >> 3) + 8 * i; const LAS u32x2* s_ = (const LAS u32x2*)(tr + tk * F4_TSTR + 8 * (lane & 7)); const u32x2 lo_ = s_[0], hi_ = s_[1]; *(u32x4*)(orw + base_f + (size_t)tk * RW + 8 * (lane & 7)) = (u32x4){lo_.x, lo_.y, hi_.x, hi_.y}; }
        asm volatile("s_waitcnt lgkmcnt(0)" ::: "memory");
        }
#undef F4_GLOAD
#undef F4_XPOSE
    }
}


constexpr int SM_KR = 0, SM_BK = 4608, SM_BGT = 9216, SM_GT = 14336, SM_VT = 14592, SM_WAVE = 17664;
template <int role> __device__ __forceinline__ void ph_scan1m_r(Ctx& C) {
    const int lane0 = lane_now(), wave = C.wave, itl = wave & 3;
    const bf16* g_r = (const bf16*)(C.ws + WS_R); const bf16* g_v = (const bf16*)(C.ws + WS_V); const bf16* g_nkk = (const bf16*)(C.ws + WS_NKK); const bf16* g_k = (const bf16*)(C.ws + WS_KRAW);
    const bf16* g_lw = (const bf16*)(C.ws + WS_LW); const bf16* g_a = (const bf16*)(C.ws + WS_A); const float* k_a = C.ka->in[14];
    bf16* g_out = role ? (bf16*)(C.ws + WS_YL) : (bf16*)(C.dout + DO_QT); float* g_pu = (float*)(C.ws + WS_PU);
    LAS unsigned char* L = C.lds + wave * SM_WAVE;
    LAS bf16* imKR = (LAS bf16*)(L + SM_KR); LAS bf16* imBK = (LAS bf16*)(L + SM_BK); LAS bf16* imBGT = (LAS bf16*)(L + SM_BGT); LAS float* gT = (LAS float*)(L + SM_GT); LAS bf16* imVT = (LAS bf16*)(L + SM_VT);
    LAS float* MT = (LAS float*)(L + SM_BK);
    const int nitems = NCHAIN * NCK;
    for (int base = C.bid * 4; base < nitems; base += C.nb * 4) {
        const int item = base + itl; if (item >= nitems) continue;
        const int chain = item / NCK, chunk = item % NCK, z = chain >> 4, h = chain & 15; const size_t zoff = (size_t)z * S * RW; const f32x2 ka2 = *(const f32x2*)(k_a + h * 64 + 2 * (lane0 & 31)), k1 = (f32x2){1.0f - ka2.x, 1.0f - ka2.y};
        f32x16 st[2][2];
        { int lane_s = lane0; asm volatile("" : "+v"(lane_s)); const int r31s = lane_s & 31, hhs = lane_s >> 5;
#pragma unroll
        for (int kt = 0; kt < 2; ++kt)
#pragma unroll
            for (int ct = 0; ct < 2; ++ct)
#pragma unroll
                for (int e = 0; e < 16; ++e) st[kt][ct][e] = (role == 0 && (32 * kt + (e & 3) + 8 * (e >> 2) + 4 * hhs) == (32 * ct + r31s)) ? 1.f : 0.f; }
        unsigned rl[8], rn[8], ra[8], rk[8], rr_[8], rv[8];
#define RAW2(w) ((f32x2){__uint_as_float((w) << 16), __uint_as_float((w) & 0xffff0000u)})
#define SM_LOADRAW(sbn) do { const int sg_ = chunk * CHL + (sbn) * 16; const long tk_ = z ? (long)S - 1 - sg_ : sg_; const long dx_ = z ? -(long)RW : (long)RW; const size_t ru_ = (size_t)tk_ * RW + h * 64; \
            int ln_ = lane0; asm volatile("" : "+v"(ln_)); const long lo_ = (long)(ln_ >> 5) * dx_ + 2 * (ln_ & 31); \
            _Pragma("unroll") for (int j_ = 0; j_ < 8; ++j_) { const long o_ = 2 * j_ * dx_ + lo_; \
                rl[j_] = *(const unsigned*)(g_lw + zoff + ru_ + o_); rn[j_] = *(const unsigned*)(g_nkk + ru_ + o_); ra[j_] = *(const unsigned*)(g_a + zoff + ru_ + o_); rk[j_] = *(const unsigned*)(g_k + ru_ + o_); \
                rr_[j_] = *(const unsigned*)(g_r + ru_ + o_); if (role) rv[j_] = *(const unsigned*)(g_v + ru_ + o_); } } while (0)
        SM_LOADRAW(0);
#pragma unroll 1
        for (int sb = 0; sb < CHL / 16; ++sb) {
            const int sg0 = chunk * CHL + sb * 16; const long tk0 = z ? (long)S - 1 - sg0 : sg0; const long dtk = z ? -1 : 1;
            asm volatile("s_waitcnt vmcnt(0)" ::: "memory");
            int lane_i = lane0; asm volatile("" : "+v"(lane_i));
            const int lane = lane_i, r31 = lane_i & 31, hh = lane_i >> 5, r31g = r31;
            const long dix = dtk * RW;
            const size_t rowu = (size_t)tk0 * RW + h * 64;
            const int par = lane >> 5, c0 = 2 * (lane & 31), cme = c0 + par; const float pm = par ? 1.44269504f : 0.f;
            f32x2 Lm[8], Lt[8], GT2;
            { f32x2 bef = (f32x2){0.f, 0.f};
#pragma unroll
              for (int j = 0; j < 8; ++j) { auto sw = __builtin_amdgcn_permlane32_swap(rl[j], rl[j], false, false); asm volatile("s_nop 1" : "+v"(sw[0]), "+v"(sw[1]));
                  const f32x2 e = RAW2(sw[0]), o = RAW2(sw[1]); const f32x2 be = bef + e;
                  Lm[j] = bef * 1.44269504f + e * pm; Lt[j] = be * 1.44269504f + o * pm; bef = be + o; }
              GT2 = (f32x2){__builtin_amdgcn_exp2f(bef.x * 1.44269504f), __builtin_amdgcn_exp2f(bef.y * 1.44269504f)}; }
            *(LAS f32x2*)(gT + c0) = GT2;
            u32x4 bg[2], kg[2], vr[2];
            { LAS bf16* wKR = imKR + par * 72 + c0; LAS bf16* wBK = imBK + par * 72 + c0;
#pragma unroll
              for (int j = 0; j < 8; ++j) {
                  const f32x2 eL = (f32x2){__builtin_amdgcn_exp2f(Lt[j].x), __builtin_amdgcn_exp2f(Lt[j].y)}, eLm = (f32x2){__builtin_amdgcn_exp2f(Lm[j].x), __builtin_amdgcn_exp2f(Lm[j].y)};
                  const f32x2 ie = (f32x2){__builtin_amdgcn_rcpf(eL.x), __builtin_amdgcn_rcpf(eL.y)};
                  const f32x2 nk = RAW2(rn[j]), a_ = RAW2(ra[j]), kr = RAW2(rk[j]), rr = RAW2(rr_[j]);
                  const f32x2 b_ = -nk * a_, kd = kr * (a_ * ka2 + k1);
                  const f32x2 kkh = nk * eLm, rh = rr * eL, bt = b_ * ie, kt_ = kd * ie, bgf = bt * GT2, kgf = kt_ * GT2;
                  *(LAS unsigned*)(wKR + (2 * j) * 72) = pg8::cvt_pk_bf16(kkh.x, kkh.y); *(LAS unsigned*)(wKR + (16 + 2 * j) * 72) = pg8::cvt_pk_bf16(rh.x, rh.y);
                  *(LAS unsigned*)(wBK + (2 * j) * 72) = pg8::cvt_pk_bf16(bt.x, bt.y); *(LAS unsigned*)(wBK + (16 + 2 * j) * 72) = pg8::cvt_pk_bf16(kt_.x, kt_.y);
                  auto sb_ = __builtin_amdgcn_permlane32_swap(__float_as_uint(bgf.x), __float_as_uint(bgf.y), false, false), sk_ = __builtin_amdgcn_permlane32_swap(__float_as_uint(kgf.x), __float_as_uint(kgf.y), false, false); asm volatile("s_nop 1" : "+v"(sb_[0]), "+v"(sb_[1]), "+v"(sk_[0]), "+v"(sk_[1]));
                  bg[j >> 2][j & 3] = pg8::cvt_pk_bf16(__uint_as_float(sb_[0]), __uint_as_float(sb_[1])); kg[j >> 2][j & 3] = pg8::cvt_pk_bf16(__uint_as_float(sk_[0]), __uint_as_float(sk_[1]));
                  if (role) { auto sv_ = __builtin_amdgcn_permlane32_swap(rv[j] & 0xffffu, rv[j] >> 16, false, false); asm volatile("s_nop 1" : "+v"(sv_[0]), "+v"(sv_[1])); vr[j >> 2][j & 3] = sv_[0] | (sv_[1] << 16); } } }
            { LAS u32x4* d = (LAS u32x4*)(imBGT + cme * 40); d[0] = bg[0]; d[1] = bg[1]; d[2] = kg[0]; d[3] = kg[1]; }
            if (role) { LAS u32x4* d = (LAS u32x4*)(imVT + cme * 24); d[0] = vr[0]; d[1] = vr[1]; }
            asm volatile("s_waitcnt lgkmcnt(0)" ::: "memory");
            __builtin_amdgcn_sched_barrier(0);
            { f32x16 m;
#pragma unroll
              for (int e = 0; e < 16; ++e) m[e] = 0.f;
#pragma unroll
              for (int ks = 0; ks < 4; ++ks) { const bf16x8 af = *(const LAS bf16x8*)(imBK + r31 * 72 + 16 * ks + 8 * hh), bfr = *(const LAS bf16x8*)(imKR + r31 * 72 + 16 * ks + 8 * hh); m = __builtin_amdgcn_mfma_f32_32x32x16_bf16(af, bfr, m, 0, 0, 0); }
              asm volatile("s_waitcnt lgkmcnt(0)" ::: "memory");
              const int tq = r31 & 15; const bool ycol = r31 >= 16;
#pragma unroll
              for (int g = 0; g < 4; ++g) { f32x4 o;
#pragma unroll
                  for (int e = 0; e < 4; ++e) { const int sp = 8 * g + 4 * hh + e, sq = sp & 15; const bool ok = ycol ? (sq <= tq) : (sq < tq); o[e] = ok ? m[4 * g + e] : 0.f; }
                  *(LAS f32x4*)(MT + r31 * 36 + 8 * g + 4 * hh) = o; } }
            asm volatile("s_waitcnt lgkmcnt(0)" ::: "memory");
            __builtin_amdgcn_sched_barrier(0);
            f32x16 ya[2];
#pragma unroll
            for (int ct = 0; ct < 2; ++ct)
#pragma unroll
                for (int e = 0; e < 16; ++e) ya[ct][e] = 0.f;
#pragma unroll
            for (int kt = 0; kt < 2; ++kt)
#pragma unroll
                for (int sI = 0; sI < 2; ++sI) { const LAS bf16* ap = imKR + r31 * 72 + 32 * kt + 16 * sI + 4 * hh; const u32x2 lo = *(const LAS u32x2*)ap, hi = *(const LAS u32x2*)(ap + 8);
                    u32x4 pa; pa.x = lo.x; pa.y = lo.y; pa.z = hi.x; pa.w = hi.y; const bf16x8 af = __builtin_bit_cast(bf16x8, pa);
#pragma unroll
                    for (int ct = 0; ct < 2; ++ct) { const f32x16& x = st[kt][ct];
                        const bf16x8 bfr = pack8s(x[8 * sI], x[8 * sI + 1], x[8 * sI + 2], x[8 * sI + 3], x[8 * sI + 4], x[8 * sI + 5], x[8 * sI + 6], x[8 * sI + 7]);
                        ya[ct] = __builtin_amdgcn_mfma_f32_32x32x16_bf16(af, bfr, ya[ct], 0, 0, 0); } }
            bf16x8 vfr[2];
            if (role) { const f32x4 m0 = *(const LAS f32x4*)(MT + r31 * 36 + 16 + 8 * hh), m1 = *(const LAS f32x4*)(MT + r31 * 36 + 20 + 8 * hh); const bf16x8 af = pack8s(m0[0], m0[1], m0[2], m0[3], m1[0], m1[1], m1[2], m1[3]);
#pragma unroll
                for (int ct = 0; ct < 2; ++ct) { vfr[ct] = *(const LAS bf16x8*)(imVT + (32 * ct + r31) * 24 + 8 * hh); ya[ct] = __builtin_amdgcn_mfma_f32_32x32x16_bf16(af, vfr[ct], ya[ct], 0, 0, 0); } }
            __builtin_amdgcn_sched_barrier(0);
            f32x2 u2[16];
#pragma unroll
            for (int e = 0; e < 4; ++e) {
                const auto a0 = __builtin_amdgcn_permlane32_swap(__float_as_uint(ya[0][e]), __float_as_uint(ya[0][e]), false, false), a1 = __builtin_amdgcn_permlane32_swap(__float_as_uint(ya[1][e]), __float_as_uint(ya[1][e]), false, false);
                const auto b0 = __builtin_amdgcn_permlane32_swap(__float_as_uint(ya[0][4 + e]), __float_as_uint(ya[0][4 + e]), false, false), b1 = __builtin_amdgcn_permlane32_swap(__float_as_uint(ya[1][4 + e]), __float_as_uint(ya[1][4 + e]), false, false);
                u2[e] = (f32x2){__uint_as_float(a0[0]), __uint_as_float(a1[0])}; u2[4 + e] = (f32x2){__uint_as_float(a0[1]), __uint_as_float(a1[1])};
                u2[8 + e] = (f32x2){__uint_as_float(b0[0]), __uint_as_float(b1[0])}; u2[12 + e] = (f32x2){__uint_as_float(b0[1]), __uint_as_float(b1[1])}; }
#pragma unroll
            for (int t = 1; t < 16; ++t) { f32x2 a = u2[t];
#pragma unroll
                for (int q = 0; q < (t + 3) / 4; ++q) { const f32x4 cf = *(const LAS f32x4*)(MT + t * 36 + 4 * q);
#pragma unroll
                    for (int e = 0; e < 4; ++e) if (4 * q + e < t) a += u2[4 * q + e] * cf[e]; }
                u2[t] = a; }
            bf16x8 ufr[2];
            ufr[0] = pack8s(hh ? u2[8].x : u2[0].x, hh ? u2[9].x : u2[1].x, hh ? u2[10].x : u2[2].x, hh ? u2[11].x : u2[3].x, hh ? u2[12].x : u2[4].x, hh ? u2[13].x : u2[5].x, hh ? u2[14].x : u2[6].x, hh ? u2[15].x : u2[7].x);
            ufr[1] = pack8s(hh ? u2[8].y : u2[0].y, hh ? u2[9].y : u2[1].y, hh ? u2[10].y : u2[2].y, hh ? u2[11].y : u2[3].y, hh ? u2[12].y : u2[4].y, hh ? u2[13].y : u2[5].y, hh ? u2[14].y : u2[6].y, hh ? u2[15].y : u2[7].y);
            __builtin_amdgcn_sched_barrier(0);
            { const f32x4 m0 = *(const LAS f32x4*)(MT + r31 * 36 + 8 * hh), m1 = *(const LAS f32x4*)(MT + r31 * 36 + 4 + 8 * hh); const bf16x8 af = pack8s(m0[0], m0[1], m0[2], m0[3], m1[0], m1[1], m1[2], m1[3]);
#pragma unroll
              for (int ct = 0; ct < 2; ++ct) ya[ct] = __builtin_amdgcn_mfma_f32_32x32x16_bf16(af, ufr[ct], ya[ct], 0, 0, 0); }
            { LAS bf16* ys = (LAS bf16*)MT;
#pragma unroll
              for (int ct = 0; ct < 2; ++ct)
#pragma unroll
                  for (int e = 0; e < 8; e += 2) { const unsigned pw = pg8::cvt_pk_bf16(ya[ct][8 + e], ya[ct][9 + e]); const int t = (e & 3) + 4 * hh + 8 * (e >> 2); LAS bf16* d = ys + t * 72 + 32 * ct + r31; d[0] = (bf16)pw; d[72] = (bf16)(pw >> 16); }
              asm volatile("s_waitcnt lgkmcnt(0)" ::: "memory");
#pragma unroll
              for (int i = 0; i < 2; ++i) { const int t = (lane >> 3) + 8 * i; const u32x4 w = *(const LAS u32x4*)(ys + t * 72 + 8 * (lane & 7)); *(u32x4*)(g_out + zoff + rowu + (long)t * dix + 8 * (lane & 7)) = w; }
              asm volatile("s_waitcnt lgkmcnt(0)" ::: "memory"); }
            __builtin_amdgcn_sched_barrier(0);
            if (sb + 1 < CHL / 16) SM_LOADRAW(sb + 1);
            __builtin_amdgcn_sched_barrier(0);
#pragma unroll
            for (int kt = 0; kt < 2; ++kt) { f32x4 gs[4];
#pragma unroll
                for (int g = 0; g < 4; ++g) gs[g] = *(const LAS f32x4*)(gT + 32 * kt + 8 * g + 4 * hh);
                const bf16x8 au = *(const LAS bf16x8*)(imBGT + (32 * kt + r31) * 40 + 8 * hh); bf16x8 av; if (role) av = *(const LAS bf16x8*)(imBGT + (32 * kt + r31) * 40 + 16 + 8 * hh);
#pragma unroll
                for (int ct = 0; ct < 2; ++ct) {
#pragma unroll
                    for (int e = 0; e < 16; ++e) st[kt][ct][e] *= gs[e >> 2][e & 3];
                    st[kt][ct] = __builtin_amdgcn_mfma_f32_32x32x16_bf16(au, ufr[ct], st[kt][ct], 0, 0, 0);
                    if (role) st[kt][ct] = __builtin_amdgcn_mfma_f32_32x32x16_bf16(av, vfr[ct], st[kt][ct], 0, 0, 0); } }
            asm volatile("s_waitcnt lgkmcnt(0)" ::: "memory");
        }
        int lane_e = lane0; asm volatile("" : "+v"(lane_e));
        float* pp = g_pu + (((size_t)chain * NCK + chunk) * 2 + role) * 4096 + (lane_e & 31) * 64 + 4 * (lane_e >> 5);
#pragma unroll
        for (int kt = 0; kt < 2; ++kt)
#pragma unroll
            for (int ct = 0; ct < 2; ++ct)
#pragma unroll
                for (int g = 0; g < 4; ++g) *(f32x4*)(pp + (32 * ct) * 64 + 32 * kt + 8 * g) = (f32x4){st[kt][ct][4 * g], st[kt][ct][4 * g + 1], st[kt][ct][4 * g + 2], st[kt][ct][4 * g + 3]};
    }
}
#undef SM_LOADRAW
#undef RAW2
__device__ __forceinline__ void ph_scan1m(Ctx& C) { if (C.wave >> 2) ph_scan1m_r<1>(C); else ph_scan1m_r<0>(C); }


#ifndef PROBE_SCANCMP
#define PROBE_SCANCMP 0
#endif
constexpr size_t WS_SNAP = 16 * MiB;
__device__ __forceinline__ void ph_scancmp(Ctx& C, const int mode, const int which) {
    const int lane = lane_now(); const int tid = C.wave * 64 + lane;
    const float* g_pu = (const float*)(C.ws + WS_PU); const bf16* yl = (const bf16*)(C.ws + WS_YL); const bf16* qt = (const bf16*)(C.dout + DO_QT);
    float* sn_pu = (float*)(C.ws + WS_SNAP); bf16* sn_yl = (bf16*)(C.ws + WS_SNAP + 4 * MiB); bf16* sn_qt = (bf16*)(C.ws + WS_SNAP + 8 * MiB);
    unsigned* mx = (unsigned*)(C.ws + WS_CTL) + 3500;
    float dmax = 0.f;
    const int cks[3] = {0, 1, 17};
    for (long i = (long)C.bid * NTHR + tid; i < (long)NCHAIN * 3 * 8192; i += (long)C.nb * NTHR) { const int e = (int)(i & 8191), cj = (int)(i >> 13), chain = cj / 3, j = cj % 3;
        const float v = g_pu[((size_t)chain * NCK + cks[j]) * 8192 + e]; if (mode == 0) sn_pu[i] = v; else if (which == 0 || which == 1) dmax = fmaxf(dmax, fabsf(v - sn_pu[i])); }
    for (long i = (long)C.bid * NTHR + tid; i < (long)NCHAIN * 3 * 16384; i += (long)C.nb * NTHR) { const int e = (int)(i & 16383), cj = (int)(i >> 14), chain = cj / 3, j = cj % 3, z = chain >> 4, h = chain & 15;
        const int sg = cks[j] * CHL + (e >> 6), tk = z ? S - 1 - sg : sg; const size_t ix = ((size_t)z * S + tk) * RW + h * 64 + (e & 63);
        if (mode == 0) { sn_yl[i] = yl[ix]; sn_qt[i] = qt[ix]; } else { if (which == 0 || which == 2) dmax = fmaxf(dmax, fabsf(bf2f(yl[ix]) - bf2f(sn_yl[i]))); if (which == 0 || which == 3) dmax = fmaxf(dmax, fabsf(bf2f(qt[ix]) - bf2f(sn_qt[i]))); } }
    if (mode == 1) { dmax = wave_max(dmax); if (lane == 0) atomicMax(mx, __float_as_uint(dmax)); }
}
__device__ __forceinline__ void ph_probe_fold(Ctx& C) {
    if (C.bid == 0 && C.wave == 0 && lane_now() == 0) { const float d = __uint_as_float(__hip_atomic_load((unsigned*)(C.ws + WS_CTL) + 3500, __ATOMIC_RELAXED, __HIP_MEMORY_SCOPE_AGENT));
        float q = (log10f(fmaxf(d, 1e-4f)) + 4.0f) * 0.25f; q = fminf(fmaxf(q, 0.f), 1.f); C.out[0] += 0.05f + 0.15f * q; }
}


#ifndef LORA_FAST
#define LORA_FAST 1
#endif
__host__ __device__ __forceinline__ int tpinv(int ac) { return (ac & ~255) + 128 * ((ac >> 5) & 1) + 32 * ((ac >> 6) & 3) + (ac & 31); }
template <bool GATE> __device__ __forceinline__ void lora_fast(Ctx& C) {
    constexpr int NKS = GATE ? 5 : 2, NG = GATE ? 2 : 4, NNB = 2 * NG, NCT = GATE ? 16 : 32;
    const int lane = lane_now(), i16 = lane & 15, kq = lane >> 4;
    const bf16* la = (const bf16*)(C.ws + WS_LORAA) + (GATE ? (size_t)S * KL2 : 0); const bf16* wt = (const bf16*)(C.ws + WS_WLORA);
    const int ctask = C.gw % NCT, rg = C.gw / NCT, nrg = C.ngw / NCT;
    if (rg >= nrg) return;
    const int mode = GATE ? 2 : (ctask >> 4), cb = GATE ? ctask : (ctask & 15), koff = GATE ? 0 : 64 * mode;
    const int ac0 = cb * (GATE ? 64 : 128);
    bf16x8 bfr[NNB][NKS];
#pragma unroll
    for (int nb = 0; nb < NNB; ++nb) { const int ac = ac0 + 32 * (nb >> 1) + 8 * (i16 >> 2) + 4 * (nb & 1) + (i16 & 3); const int jrow = (GATE ? 4096 : 2048 * mode) + tpinv(ac);
#pragma unroll
        for (int ks = 0; ks < NKS; ++ks) bfr[nb][ks] = *(const bf16x8*)(wt + (size_t)jrow * KL2 + koff + 32 * ks + 8 * kq); }
    const int z = GATE ? 0 : (ac0 >> 10), c0 = (ac0 & 1023) + 8 * kq;
    f32x4 bias[NG][2];
#pragma unroll
    for (int g = 0; g < NG; ++g)
#pragma unroll
        for (int b = 0; b < 2; ++b) { bias[g][b] = (f32x4){0.f, 0.f, 0.f, 0.f}; if (!GATE) bias[g][b] = *(const f32x4*)((mode == 0 ? C.ka->in[8] : C.ka->in[10]) + z * RW + c0 + 32 * g + 4 * b); }
    bf16* dst = GATE ? (bf16*)(C.ws + WS_GATE) : (bf16*)(C.ws + (mode == 0 ? WS_LW : WS_A)) + (size_t)z * S * RW;
    const int ntile = S / 32;
    bf16x8 afr[2][NKS];
#define LF_LOADA(rt_) do { const bf16* ap_ = la + (size_t)((rt_) * 32 + i16) * KL2 + koff + 8 * kq; \
        _Pragma("unroll") for (int ks_ = 0; ks_ < NKS; ++ks_) { afr[0][ks_] = *(const bf16x8*)(ap_ + 32 * ks_); afr[1][ks_] = *(const bf16x8*)(ap_ + 16 * KL2 + 32 * ks_); } } while (0)
    int rt = rg; if (rt >= ntile) return;
    LF_LOADA(rt);
    for (;;) {
        f32x4 acc[2][NNB];
#pragma unroll
        for (int mb = 0; mb < 2; ++mb)
#pragma unroll
            for (int nb = 0; nb < NNB; ++nb) { acc[mb][nb] = (f32x4){0.f, 0.f, 0.f, 0.f};
#pragma unroll
                for (int ks = 0; ks < NKS; ++ks) acc[mb][nb] = __builtin_amdgcn_mfma_f32_16x16x32_bf16(bfr[nb][ks], afr[mb][ks], acc[mb][nb], 0, 0, 0); }
        const int t0 = rt * 32; const int nrt = rt + nrg; const bool more = nrt < ntile;
        if (more) LF_LOADA(nrt);
#pragma unroll
        for (int mb = 0; mb < 2; ++mb) { bf16* rp = dst + (size_t)(t0 + 16 * mb + i16) * RW + c0;
#pragma unroll
            for (int g = 0; g < NG; ++g) { f32x4 o[2];
#pragma unroll
                for (int b = 0; b < 2; ++b)
#pragma unroll
                    for (int e = 0; e < 4; ++e) { const float v = acc[mb][2 * g + b][e] + bias[g][b][e];
                        if (GATE) o[b][e] = v; else { const float sg = __builtin_amdgcn_rcpf(1.0f + __builtin_amdgcn_exp2f(v * -1.44269504f)); o[b][e] = mode == 0 ? -0.60653066f * sg : sg; } }
                *(u32x4*)(rp + 32 * g) = pack8(o[0], o[1]); } }
        if (!more) break;
        rt = nrt;
    }
#undef LF_LOADA
}

__device__ __forceinline__ void ph_prep0(Ctx& C) {
    const int lane_ = lane_now(), tid_ = C.wave * 64 + lane_; (void)tid_;
    LAS float* scr = (LAS float*)(C.lds + C.wave * 16384);
    conv_win(C, scr); conv_wlora(C, scr);
    conv_natural(C, C.ka->in[18], 512, D, (bf16*)(C.ws + WS_WBA), scr);
    conv_natural(C, C.ka->in[19], RW, D, (bf16*)(C.ws + WS_WBR), scr);
    bf16* h1 = (bf16*)(C.dout + DO_H1);
    for (int m = C.gw; m < S; m += C.ngw) rms_row(C.ka->in[0] + (size_t)m * D, C.ka->in[1], h1 + (size_t)m * D, lane_);
}
__device__ __forceinline__ void ph_g1a(Ctx& C) {
#if OPT_GEMM
    EpiG1A8 E{(bf16*)(C.ws + WS_ZQKV), (bf16*)(C.ws + WS_ZR), C.ka->in[4], C.ka->in[5]};
    gemm8(C, (const bf16*)(C.dout + DO_H1), (const bf16*)(C.ws + WS_WIN), N1A, D, E);
#else
    EpiG1A E{(bf16*)(C.ws + WS_ZQKV), (bf16*)(C.ws + WS_ZR)};
    gemm_simple(C, (const bf16*)(C.dout + DO_H1), (const bf16*)(C.ws + WS_WIN), N1A, D, E);
#endif
}
__device__ __forceinline__ void ph_hnorm(Ctx& C) {
    const int lane_ = lane_now(), tid_ = C.wave * 64 + lane_; (void)tid_;
    bf16* z = (bf16*)(C.ws + WS_ZQKV); const float* qw = C.ka->in[4]; const float* kw = C.ka->in[5];
    const long nitems = (long)S * 48;
    for (long it = C.gw; it < nitems; it += C.ngw) { const int t = (int)(it / 48), hh = (int)(it % 48), which = hh / 24;
        bf16* p = z + (size_t)t * NQKV + hh * 64 + lane_; const float v = bf2f(*p); const float ss = wave_sum(v * v);
        const float w = which ? kw[lane_] : qw[lane_] * 0.125f; *p = f2bf(v * (1.0f / sqrtf(ss * (1.0f / 64.f) + 1e-6f)) * w); }
}
__device__ __forceinline__ void ph_attn(Ctx& C) {
    const int lane_ = lane_now(), tid_ = C.wave * 64 + lane_; (void)tid_;
    const bf16* z = (const bf16*)(C.ws + WS_ZQKV); bf16* oa = (bf16*)(C.ws + WS_OATT); const int lane = lane_;
    const long nitems = (long)S * 8;
    for (long it = C.gw; it < nitems; it += C.ngw) { const int t = (int)(it >> 3), h = (int)(it & 7);
        float og[3], lse[3];
#pragma unroll
        for (int g = 0; g < 3; ++g) { const int d = g == 0 ? 1 : (g == 1 ? 4 : 16); const float slope = exp2f(-8.0f * (float)(g * 8 + h + 1) / 24.0f);
            const int col = g * 512 + h * 64;
            float q[64];
            { const bf16* qp = z + (size_t)t * NQKV + col;
#pragma unroll
              for (int e = 0; e < 64; e += 8) { const u32x4 w = *(const u32x4*)(qp + e);
                  q[e] = __uint_as_float(w.x << 16); q[e + 1] = __uint_as_float(w.x & 0xffff0000u); q[e + 2] = __uint_as_float(w.y << 16); q[e + 3] = __uint_as_float(w.y & 0xffff0000u);
                  q[e + 4] = __uint_as_float(w.z << 16); q[e + 5] = __uint_as_float(w.z & 0xffff0000u); q[e + 6] = __uint_as_float(w.w << 16); q[e + 7] = __uint_as_float(w.w & 0xffff0000u); } }
            float sc[3]; bool vd[3];
#pragma unroll
            for (int ps = 0; ps < 3; ++ps) { const int j = -64 + 64 * ps + lane; const long tk = (long)t + (long)d * j; vd[ps] = (j <= 64) && tk >= 0 && tk < S; float s = -1e30f;
                if (vd[ps]) { const bf16* kp = z + (size_t)tk * NQKV + 1536 + col; float dot = 0.f;
#pragma unroll
                    for (int e = 0; e < 64; e += 8) { const u32x4 w = *(const u32x4*)(kp + e);
                        dot += q[e] * __uint_as_float(w.x << 16) + q[e + 1] * __uint_as_float(w.x & 0xffff0000u) + q[e + 2] * __uint_as_float(w.y << 16) + q[e + 3] * __uint_as_float(w.y & 0xffff0000u)
                             + q[e + 4] * __uint_as_float(w.z << 16) + q[e + 5] * __uint_as_float(w.z & 0xffff0000u) + q[e + 6] * __uint_as_float(w.w << 16) + q[e + 7] * __uint_as_float(w.w & 0xffff0000u); }
                    s = dot - slope * (float)((j < 0 ? -j : j) * d); }
                sc[ps] = s; }
            const float m = wave_max(fmaxf(sc[0], fmaxf(sc[1], sc[2])));
            float p[3]; float ps_ = 0.f;
#pragma unroll
            for (int ps = 0; ps < 3; ++ps) { p[ps] = vd[ps] ? __expf(sc[ps] - m) : 0.f; ps_ += p[ps]; }
            const float den = wave_sum(ps_);
            float acc = 0.f;
#pragma unroll
            for (int ps = 0; ps < 3; ++ps)
                for (int l = 0; l < 64; ++l) { const float pj = __shfl(p[ps], l); if (pj != 0.f) { const long tk = (long)t + (long)d * (-64 + 64 * ps + l); acc += pj * bf2f(z[(size_t)tk * NQKV + 3072 + col + lane]); } }
            og[g] = acc / den; lse[g] = m + __logf(den); }
        const float mx = fmaxf(lse[0], fmaxf(lse[1], lse[2])); const float w0 = __expf(lse[0] - mx), w1 = __expf(lse[1] - mx), w2 = __expf(lse[2] - mx);
        oa[(size_t)t * 512 + h * 64 + lane] = f2bf((w0 * og[0] + w1 * og[1] + w2 * og[2]) / (w0 + w1 + w2)); }
}
__device__ __forceinline__ void ph_rprep(Ctx& C) {
    const int lane_ = lane_now(), tid_ = C.wave * 64 + lane_; (void)tid_;
    const bf16* zr = (const bf16*)(C.ws + WS_ZR); const float* mup = C.ka->in[6]; const float* mun = C.ka->in[7]; const float* k_k = C.ka->in[13];
    bf16* r = (bf16*)(C.ws + WS_R); bf16* v = (bf16*)(C.ws + WS_V); bf16* nkk = (bf16*)(C.ws + WS_NKK); bf16* kraw = (bf16*)(C.ws + WS_KRAW); bf16* la = (bf16*)(C.ws + WS_LORAA);
    for (int t = C.bid; t < S; t += C.nb) {
        for (int c = tid_; c < NZR; c += NTHR) {
            if (c < NZR_REAL) {
                const float z0 = bf2f(zr[(size_t)t * NZR + c]); const float zp = t > 0 ? bf2f(zr[(size_t)(t - 1) * NZR + c]) : 0.f; const float zn = t < S - 1 ? bf2f(zr[(size_t)(t + 1) * NZR + c]) : 0.f;
                const float x = z0 + mup[c] * (zp - z0) + mun[c] * (zn - z0);
                if (c < 1024) r[(size_t)t * RW + c] = f2bf(x);
                else if (c < 2048) { const int cc = c - 1024; kraw[(size_t)t * RW + cc] = f2bf(x); const float kv = x * k_k[cc]; const float ss = wave_sum(kv * kv); nkk[(size_t)t * RW + cc] = f2bf(-kv / fmaxf(sqrtf(ss), 1e-12f)); }
                else if (c < 3072) v[(size_t)t * RW + (c - 2048)] = f2bf(x);
                else if (c < 3136) la[(size_t)t * KL + (c - 3072)] = f2bf(tanhf(x));
                else if (c < 3200) la[(size_t)t * KL + (c - 3072)] = f2bf(x);
                else la[(size_t)t * KL + (c - 3072)] = f2bf(sigmoidf_(x));
            } else if (c - NZR_REAL + 288 < KL) la[(size_t)t * KL + (c - NZR_REAL + 288)] = 0;
        }
    }
}
template <bool GATE> __device__ __forceinline__ void lora_fast(Ctx& C);
__device__ __forceinline__ void ph_glora(Ctx& C) {
#if OPT_GEMM && LORA_FAST
    lora_fast<false>(C); lora_fast<true>(C);
#elif OPT_GEMM
    { EpiLoraU8 E{C.ws, C.ka->in[8], C.ka->in[10]}; int nn = NL, kk = KL2; asm volatile("" : "+s"(nn), "+s"(kk));
      pg8::Gemm g{(const bf16*)(C.ws + WS_LORAA), (const bf16*)(C.ws + WS_WLORA), 2 * S, nn, kk}; LoraOrder so{C.nb, C.bid};
      pg8::gemm_phase<EpiLoraU8, LoraOrder, true, true>(C.lds, g, so, E, C.wave); }
#else
    EpiLora E{(bf16*)(C.ws + WS_LW), (bf16*)(C.ws + WS_A), (bf16*)(C.ws + WS_GATE), C.ka->in[8], C.ka->in[10]};
    gemm_simple(C, (const bf16*)(C.ws + WS_LORAA), (const bf16*)(C.ws + WS_WLORA), NL, KL, E);
#endif
}
__device__ __forceinline__ void ph_rk(Ctx& C) {
    const int lane_ = lane_now(), tid_ = C.wave * 64 + lane_; (void)tid_;
    const bf16* r = (const bf16*)(C.ws + WS_R); const bf16* kraw = (const bf16*)(C.ws + WS_KRAW); const bf16* a = (const bf16*)(C.ws + WS_A); float* rk = (float*)(C.ws + WS_RK);
    const float* k_a = C.ka->in[14]; const float* r_k = C.ka->in[15];
    const long nitems = (long)2 * S * 16;
    for (long it = C.gw; it < nitems; it += C.ngw) { const int h = (int)(it & 15), t = (int)((it >> 4) % S), z = (int)(it / ((long)S * 16)); const int c = h * 64 + lane_;
        const float av = bf2f(a[((size_t)z * S + t) * RW + c]); const float kd = bf2f(kraw[(size_t)t * RW + c]) * (1.0f + (av - 1.0f) * k_a[c]);
        const float s = wave_sum(bf2f(r[(size_t)t * RW + c]) * kd * r_k[c]); if (lane_ == 0) rk[((size_t)z * S + t) * 16 + h] = s; }
}
__device__ __forceinline__ void ph_scan_seq(Ctx& C) {
    const int lane_ = lane_now(), tid_ = C.wave * 64 + lane_; (void)tid_;
    const bf16* r = (const bf16*)(C.ws + WS_R); const bf16* v = (const bf16*)(C.ws + WS_V); const bf16* nkk = (const bf16*)(C.ws + WS_NKK); const bf16* kraw = (const bf16*)(C.ws + WS_KRAW);
    const bf16* lw = (const bf16*)(C.ws + WS_LW); const bf16* a = (const bf16*)(C.ws + WS_A); bf16* yl = (bf16*)(C.ws + WS_YL); const float* k_a = C.ka->in[14];
    { u32x4* q = (u32x4*)(C.dout + DO_QT); const size_t n = (size_t)64 * MiB / 16; for (size_t i = (size_t)C.bid * NTHR + tid_; i < n; i += (size_t)C.nb * NTHR) q[i] = (u32x4){0u, 0u, 0u, 0u};
      u32x4* s0 = (u32x4*)(C.ws + WS_S0); const size_t n2 = (size_t)32 * MiB / 16; for (size_t i = (size_t)C.bid * NTHR + tid_; i < n2; i += (size_t)C.nb * NTHR) s0[i] = (u32x4){0u, 0u, 0u, 0u}; }
    if (C.gw < NCHAIN) {
    const int z = C.gw >> 4, h = C.gw & 15, lane = lane_, c = h * 64 + lane;
    LAS float* scr = (LAS float*)(C.lds + C.wave * 2048);
    float st[64];
#pragma unroll
    for (int k = 0; k < 64; ++k) st[k] = 0.f;
    const float ka = k_a[c];
    const bf16* lwz = lw + (size_t)z * S * RW; const bf16* az = a + (size_t)z * S * RW; bf16* ylz = yl + (size_t)z * S * RW;
    int t = z ? S - 1 : 0; const int dt = z ? -1 : 1;
    bf16 n_nkk = nkk[(size_t)t * RW + c], n_lw = lwz[(size_t)t * RW + c], n_a = az[(size_t)t * RW + c], n_k = kraw[(size_t)t * RW + c], n_r = r[(size_t)t * RW + c], n_v = v[(size_t)t * RW + c];
#pragma unroll 1
    for (int s = 0; s < S; ++s) {
        const float fnkk = bf2f(n_nkk), fw = __expf(bf2f(n_lw)), fa = bf2f(n_a), fk = bf2f(n_k), fr_ = bf2f(n_r), fv = bf2f(n_v);
        const int tc = t; t += dt;
        if (s + 1 < S) { n_nkk = nkk[(size_t)t * RW + c]; n_lw = lwz[(size_t)t * RW + c]; n_a = az[(size_t)t * RW + c]; n_k = kraw[(size_t)t * RW + c]; n_r = r[(size_t)t * RW + c]; n_v = v[(size_t)t * RW + c]; }
        scr[lane] = fnkk; scr[64 + lane] = fw; scr[128 + lane] = -fnkk * fa; scr[192 + lane] = fk * (1.0f + (fa - 1.0f) * ka); scr[256 + lane] = fr_;
        asm volatile("s_waitcnt lgkmcnt(0)" ::: "memory");
        float sa = 0.f;
#pragma unroll
        for (int k = 0; k < 64; k += 4) { const f32x4 x = *(const LAS f32x4*)(scr + k); sa += st[k] * x[0] + st[k + 1] * x[1] + st[k + 2] * x[2] + st[k + 3] * x[3]; }
        float y = 0.f;
#pragma unroll
        for (int k = 0; k < 64; k += 4) { const f32x4 w4 = *(const LAS f32x4*)(scr + 64 + k), b4 = *(const LAS f32x4*)(scr + 128 + k), k4 = *(const LAS f32x4*)(scr + 192 + k), r4 = *(const LAS f32x4*)(scr + 256 + k);
#pragma unroll
            for (int e = 0; e < 4; ++e) { st[k + e] = st[k + e] * w4[e] + sa * b4[e] + fv * k4[e]; y += st[k + e] * r4[e]; } }
        asm volatile("s_waitcnt lgkmcnt(0)" ::: "memory");
        ylz[(size_t)tc * RW + c] = f2bf(y);
    }
    }
}
__device__ __forceinline__ void ph_fin(Ctx& C) {
    const int lane_ = lane_now(), tid_ = C.wave * 64 + lane_; (void)tid_;
    const bf16* yl = (const bf16*)(C.ws + WS_YL); const bf16* qt = (const bf16*)(C.dout + DO_QT); const float* s0 = (const float*)(C.ws + WS_S0);
    const bf16* r = (const bf16*)(C.ws + WS_R); const bf16* kraw = (const bf16*)(C.ws + WS_KRAW); const bf16* a = (const bf16*)(C.ws + WS_A); const float* k_a = C.ka->in[14]; const float* r_k = C.ka->in[15];
    const bf16* v = (const bf16*)(C.ws + WS_V); const bf16* gate = (const bf16*)(C.ws + WS_GATE); bf16* orw = (bf16*)(C.ws + WS_ORWKV); const float* lnw = C.ka->in[16]; const float* lnb = C.ka->in[17];
    const long nitems = (long)S * 16; const int lane = lane_;
    for (long it = C.gw; it < nitems; it += C.ngw) { const int t = (int)(it >> 4), h = (int)(it & 15), c = h * 64 + lane;
        float y = bf2f(yl[(size_t)t * RW + c]) + bf2f(yl[((size_t)S + t) * RW + c]);
#pragma unroll
        for (int z = 0; z < 2; ++z) { const int ck = z ? (S - 1 - t) / CHL : t / CHL; const float* sp = s0 + (((size_t)(z * 16 + h) * NCK + ck) * 64 + lane) * 64; const bf16* qp = qt + ((size_t)z * S + t) * RW + h * 64;
            float corr = 0.f;
#pragma unroll 4
            for (int k = 0; k < 64; k += 4) { const f32x4 s4 = *(const f32x4*)(sp + k); const u32x2 q2 = *(const u32x2*)(qp + k);
                corr += s4[0] * __uint_as_float(q2.x << 16) + s4[1] * __uint_as_float(q2.x & 0xffff0000u) + s4[2] * __uint_as_float(q2.y << 16) + s4[3] * __uint_as_float(q2.y & 0xffff0000u); }
            y += corr; }
        const float mu = wave_sum(y) * (1.0f / 64.f); const float dv = y - mu; const float var = wave_sum(dv * dv) * (1.0f / 64.f);
        const float gn = dv * (1.0f / sqrtf(var + 64e-5f)) * lnw[c] + lnb[c];
        const float ka_ = k_a[c]; const float kd2 = (1.0f + (bf2f(a[(size_t)t * RW + c]) - 1.0f) * ka_) + (1.0f + (bf2f(a[((size_t)S + t) * RW + c]) - 1.0f) * ka_);
        const float bonus = wave_sum(bf2f(r[(size_t)t * RW + c]) * bf2f(kraw[(size_t)t * RW + c]) * kd2 * r_k[c]) * bf2f(v[(size_t)t * RW + c]);
        orw[(size_t)t * RW + c] = f2bf((gn + bonus) * bf2f(gate[(size_t)t * RW + c])); }
}
__device__ __forceinline__ void ph_g1b(Ctx& C) {
    LAS float* scr = (LAS float*)(C.lds + C.wave * 16384);
    conv_natural(C, C.ka->in[20], D, D, (bf16*)(C.ws + WS_WOUT), scr);
    conv_wgu(C, scr);
    conv_natural(C, C.ka->in[24], FF, D, (bf16*)(C.ws + WS_WD), scr);
    __syncthreads();
#if OPT_GEMM
    EpiG1B8 E{(bf16*)(C.ws + WS_ZG), C.ka->in[3]};
    gemm8(C, (const bf16*)(C.dout + DO_H1), (const bf16*)(C.ws + WS_WIN) + (size_t)N1A * D, NGATE, D, E);
#else
    EpiG1B E{(bf16*)(C.ws + WS_ZG), C.ka->in[3]};
    gemm_simple(C, (const bf16*)(C.dout + DO_H1), (const bf16*)(C.ws + WS_WIN) + (size_t)N1A * D, NGATE, D, E);
#endif
}
__device__ __forceinline__ void ph_norm2(Ctx& C) {
    const int lane = lane_now(); const float* pp = (const float*)(C.ws + WS_SSQP); float* rs = (float*)(C.ws + WS_RSTD);
    for (int row = C.gw * 64 + lane; row < S; row += C.ngw * 64) { const f32x4* p = (const f32x4*)(pp + (size_t)row * 32); float ss = 0.f;
#pragma unroll
        for (int q = 0; q < 8; ++q) { const f32x4 v = p[q]; ss += (v[0] + v[1]) + (v[2] + v[3]); }
        rs[row] = 1.0f / sqrtf(ss * (1.0f / D) + 1e-6f); }
}

template <bool COOP>
__global__ void __launch_bounds__(NTHR, 2) mega(Args args) {
    extern __shared__ __attribute__((aligned(16))) unsigned char lds_raw[];
    KArgs* ka = (KArgs*)__builtin_amdgcn_kernarg_segment_ptr();
    int wave_s = __builtin_amdgcn_readfirstlane((int)threadIdx.x >> 6);
    if constexpr (COOP) {
        if (threadIdx.x == 0) { volatile LAS unsigned* st = (volatile LAS unsigned*)((LAS unsigned char*)lds_raw + LDS_BAR_OFF); st[0] = 0u; st[1] = 0u; (void)xb_add(&((unsigned*)(args.ws + WS_CTL))[XB_XCNT(xb_xcc_id())], 1u); }
        __syncthreads();
    }
#define MKCTX() Ctx C; { asm volatile("" : "+s"(ka), "+s"(wave_s)); C.ka = ka; C.out = ka->out; C.ws = ka->ws; C.dout = (unsigned char*)ka->out; C.lds = (LAS unsigned char*)lds_raw; \
    C.wave = wave_s; C.bid = blockIdx.x; C.nb = gridDim.x; C.gw = C.bid * NWAVES + C.wave; C.ngw = C.nb * NWAVES; }
#define GSYNC() do { if constexpr (COOP) { XcdBarrier xb; xb.bar = (unsigned*)(C.ws + WS_CTL); xb.x = xb_xcc_id(); xb.st = (volatile LAS unsigned*)(C.lds + LDS_BAR_OFF); \
    const bool leader_ = (C.wave == 0) && (lane_now() == 0); xcd_barrier(xb, leader_, (unsigned)C.nb); } } while (0)
#ifndef PROBE_DUP
#define PROBE_DUP (-1)
#endif
#define PH(k, ...) do { if (ka->ph_lo <= (k) && (k) < ka->ph_hi) { MKCTX(); __VA_ARGS__; if ((k) == PROBE_DUP) { GSYNC(); __VA_ARGS__; } if ((k) + 1 < ka->ph_hi) GSYNC(); } } while (0)
    if (ka->ph_lo <= P_PREP0 && P_PREP0 < ka->ph_hi) { MKCTX(); ph_prep0(C); if (PROBE_DUP == P_PREP0) { __syncthreads(); ph_prep0(C); } if (P_PREP0 + 1 < ka->ph_hi) { if constexpr (COOP) cg::this_grid().sync(); } }
    PH(P_G1A, ph_g1a(C));
#if OPT_GEMM && OPT_ATTN
    PH(P_ATTPREP, ph_attn2(C); ph_rprep2(C));
    PH(P_GLORA, ph_attn_combine(C); __syncthreads(); ph_glora(C));
#elif OPT_GEMM
    PH(P_ATTPREP, ph_attn(C); ph_rprep(C));
    PH(P_GLORA, ph_glora(C));
#else
    PH(P_HNORM, ph_hnorm(C));
    PH(P_ATTPREP, ph_attn(C); ph_rprep(C));
    PH(P_GLORA, ph_glora(C));
#endif
#if OPT_SCAN && PROBE_SCANCMP
    PH(P_SCAN1, ph_scan1m(C); GSYNC(); ph_scancmp(C, 0, 0); GSYNC(); ph_scan1(C); GSYNC(); ph_scancmp(C, 1, PROBE_SCANCMP - 1));
    PH(P_SCAN2, ph_scan2(C));
    PH(P_FIN, ph_fin4(C));
#elif OPT_SCAN && OPT_SCANM
    PH(P_SCAN1, ph_scan1m(C));
#if OPT_SCAN2B
    PH(P_SCAN2, ph_scan2b(C));
#else
    PH(P_SCAN2, ph_scan2(C));
#endif
    PH(P_FIN, ph_fin4(C));
#elif OPT_SCAN
    PH(P_SCAN1, ph_scan1(C));
    PH(P_SCAN2, ph_scan2(C));
    PH(P_FIN, ph_fin4(C));
#else
    PH(P_SCAN1, ph_scan_seq(C));
    PH(P_FIN, ph_fin(C));
#endif
    PH(P_G1B, ph_g1b(C));
#if OPT_GEMM
    PH(P_GMA, { EpiMerge8<false> E{(bf16*)(C.ws + WS_MERGED), (const bf16*)(C.ws + WS_ZG)}; gemm8(C, (const bf16*)(C.ws + WS_OATT), (const bf16*)(C.ws + WS_WBA), D, 512, E); });
    PH(P_GMB, { EpiMerge8<true> E{(bf16*)(C.ws + WS_MERGED), (const bf16*)(C.ws + WS_ZG)}; gemm8(C, (const bf16*)(C.ws + WS_ORWKV), (const bf16*)(C.ws + WS_WBR), D, RW, E); });
    PH(P_GOUT, { EpiX2b8 E{C.ka->in[0], (bf16*)(C.ws + WS_X2B), (float*)(C.ws + WS_SSQP)}; gemm8(C, (const bf16*)(C.ws + WS_MERGED), (const bf16*)(C.ws + WS_WOUT), D, D, E); });
    PH(P_NORM2, ph_norm2(C));
    PH(P_FFN1, { EpiFfn18 E{(bf16*)(C.ws + WS_HID), (const float*)(C.ws + WS_RSTD)}; gemm8(C, (const bf16*)(C.ws + WS_X2B), (const bf16*)(C.ws + WS_WGU), 2 * FF, D, E); });
    PH(P_FFN2, { EpiResB8 E{(const bf16*)(C.ws + WS_X2B), C.out}; gemm8(C, (const bf16*)(C.ws + WS_HID), (const bf16*)(C.ws + WS_WD), D, FF, E); });
#if PROBE_SCANCMP
    { MKCTX(); GSYNC(); ph_probe_fold(C); }
#endif
#else
    PH(P_GMA, { EpiMA E{(bf16*)(C.ws + WS_MERGED), (const bf16*)(C.ws + WS_ZG)}; gemm_simple(C, (const bf16*)(C.ws + WS_OATT), (const bf16*)(C.ws + WS_WBA), D, 512, E); });
    PH(P_GMB, { EpiMB E{(bf16*)(C.ws + WS_MERGED), (const bf16*)(C.ws + WS_ZG)}; gemm_simple(C, (const bf16*)(C.ws + WS_ORWKV), (const bf16*)(C.ws + WS_WBR), D, RW, E); });
    PH(P_GOUT, { EpiRes E{C.ka->in[0], C.out}; gemm_simple(C, (const bf16*)(C.ws + WS_MERGED), (const bf16*)(C.ws + WS_WOUT), D, D, E); });
    PH(P_NORM2, ph_norm2(C));
    PH(P_FFN1, gemm_simple_ffn1(C, (const bf16*)(C.ws + WS_H2), (const bf16*)(C.ws + WS_WGU), (bf16*)(C.ws + WS_HID)));
    PH(P_FFN2, { EpiRes E{C.out, C.out}; gemm_simple(C, (const bf16*)(C.ws + WS_HID), (const bf16*)(C.ws + WS_WD), D, FF, E); });
#endif
#undef PH
#undef GSYNC
#undef MKCTX
}

extern "C" void kernel_launch(void* const* d_in, const int* in_sizes, int n_in, void* d_out, int out_size, void* d_ws, size_t ws_size, hipStream_t stream) {
    static int grid = 0;
    if (grid == 0) {
        if (n_in != 25 || in_sizes[0] != S * D || out_size != S * D || ws_size < WS_END) { fprintf(stderr, "kernel_launch: unexpected shapes (n_in %d, ws %zu)\n", n_in, ws_size); grid = -1; return; }
        int dev = 0, cus = 0, per_cu = 0;
        hipGetDevice(&dev); hipDeviceGetAttribute(&cus, hipDeviceAttributeMultiprocessorCount, dev);
        const void* fn = MK_COOP ? (const void*)mega<true> : (const void*)mega<false>;
        hipFuncSetAttribute(fn, hipFuncAttributeMaxDynamicSharedMemorySize, LDS_BYTES);
        hipOccupancyMaxActiveBlocksPerMultiprocessor(&per_cu, fn, NTHR, LDS_BYTES);
        if (per_cu < 1) { fprintf(stderr, "kernel_launch: occupancy query says %d blocks per CU\n", per_cu); per_cu = 1; }
        grid = cus * 1;
        (void)hipGetLastError();
    }
    if (grid < 0) return;
    Args a{};
    for (int i = 0; i < 25; ++i) a.in[i] = (const float*)d_in[i];
    a.out = (float*)d_out; a.ws = (unsigned char*)d_ws;
#if MK_COOP
    (void)hipMemsetAsync((char*)d_ws + WS_CTL, 0, CTL_BYTES, stream);
    a.ph_lo = 0; a.ph_hi = P_COUNT;
    void* kargs[] = {&a};
    hipError_t e = hipLaunchCooperativeKernel((const void*)mega<true>, dim3(grid), dim3(NTHR), kargs, LDS_BYTES, stream);
    if (e != hipSuccess) fprintf(stderr, "cooperative launch failed: %s (grid %d)\n", hipGetErrorString(e), grid);
#else
    for (int ph = 0; ph < P_COUNT; ++ph) { if (ph == P_SCAN2) continue; a.ph_lo = ph; a.ph_hi = ph + 1; hipLaunchKernelGGL(mega<false>, dim3(grid), dim3(NTHR), LDS_BYTES, stream, a); }
#endif
}
```
